# Optimizing an MI355X kernel written in HIP

```python
import math
import jax, jax.numpy as jnp
from jax import lax
import numpy as np

D_MODEL = 1024
BATCH = 32
SEQ = 2048
DEPTH = 1

CHUNK = 64
Q_BLOCK = 128
A_HEADS = 8
A_HEAD_DIM = 64
A_Q = A_HEADS * A_HEAD_DIM
A_LATENT = 128
IDX_HEADS = 8
IDX_DIM = 64
TOPK_MAX = 256
REL_BUCKETS = 32
REL_MAX_DIST = 128
B_HEADS = 4
B_KEY_DIM = 128
B_VAL_DIM = 128
B_K = B_HEADS * B_KEY_DIM
B_V = B_HEADS * B_VAL_DIM
PEER_HEADS = 8
PEER_KEYS = 128
PEER_EXPERTS = PEER_KEYS * PEER_KEYS
PEER_QDIM = 256
PEER_TOPK = 16
PEER_TOKEN_BLOCK = 512
ALPHA = (2 * DEPTH) ** 0.25
BETA = (8 * DEPTH) ** -0.25
LN_EPS = 1e-5
RMS_EPS = 1e-6

IN_SPLITS = (A_Q, A_LATENT, IDX_HEADS * IDX_DIM, IDX_DIM, IDX_HEADS, B_K, B_K, B_V, B_V, D_MODEL, D_MODEL)
IN_COLS = A_Q + A_LATENT + IDX_HEADS * IDX_DIM + IDX_DIM + IDX_HEADS + 2 * B_K + 2 * B_V + 2 * D_MODEL

kernel_name = "hybrid_dsa_hgrn2_peer_deepnorm"


def layer_norm(x, g, b):
    xf = x.astype(jnp.float32)
    mu = jnp.mean(xf, -1, keepdims=True)
    var = jnp.mean(jnp.square(xf - mu), -1, keepdims=True)
    return ((xf - mu) * lax.rsqrt(var + LN_EPS) * g + b).astype(x.dtype)


def rms_norm(x, g):
    xf = x.astype(jnp.float32)
    return (xf * lax.rsqrt(jnp.mean(xf * xf, -1, keepdims=True) + RMS_EPS) * g).astype(x.dtype)


def t5_bucket(rel):
    half = REL_BUCKETS // 2
    max_exact = half // 2
    base = jnp.where(rel > 0, half, 0)
    n = jnp.abs(rel)
    nf = jnp.maximum(n, 1).astype(jnp.float32)
    large = max_exact + (jnp.log(nf / max_exact) / math.log(REL_MAX_DIST / max_exact) * (half - max_exact)).astype(jnp.int32)
    large = jnp.minimum(large, half - 1)
    return base + jnp.where(n < max_exact, n, large)


def dsa_mixer(q, c_kv, q_idx, k_idx, w_idx, w_uk, w_uv, rel_bias):
    B, S = q.shape[0], q.shape[1]
    n_sel = min(TOPK_MAX, S // 4)
    nblk = S // Q_BLOCK
    q_lat = jnp.einsum('bshd,chd->bshc', q, w_uk)
    key_chunk = jnp.arange(S) // CHUNK
    scale = A_HEAD_DIM ** -0.5

    def to_blocks(t):
        return jnp.moveaxis(t.reshape((B, nblk, Q_BLOCK) + t.shape[2:]), 1, 0)

    def block(args):
        ql, qi, wi, qpos = args
        q_chunk = qpos // CHUNK
        logits = jnp.einsum('bthd,bsd->bths', qi, k_idx)
        score = jnp.einsum('bths,bth->bts', jax.nn.relu(logits), wi).astype(jnp.float32)
        visible = key_chunk[None, :] <= q_chunk[:, None]
        score = jnp.where(visible[None], score, -jnp.inf)
        _, idx = lax.top_k(score, n_sel)
        valid = (idx // CHUNK) <= q_chunk[None, :, None]
        c_sel = jax.vmap(lambda c, i: c[i])(c_kv, idx.reshape(B, -1)).reshape(B, Q_BLOCK, n_sel, A_LATENT)
        bias = rel_bias[t5_bucket(idx - qpos[None, :, None])]
        s = jnp.einsum('bthc,btkc->bthk', ql, c_sel).astype(jnp.float32) * scale + jnp.moveaxis(bias, -1, 2)
        s = jnp.where(valid[:, :, None, :], s, -jnp.inf)
        p = jax.nn.softmax(s, axis=-1).astype(c_sel.dtype)
        return jnp.einsum('bthk,btkc->bthc', p, c_sel)

    pos = jnp.arange(S).reshape(nblk, Q_BLOCK)
    o_lat = lax.map(block, (to_blocks(q_lat), to_blocks(q_idx), to_blocks(w_idx), pos))
    o_lat = jnp.moveaxis(o_lat, 0, 1).reshape(B, S, A_HEADS, A_LATENT)
    o = jnp.einsum('bshc,chd->bshd', o_lat, w_uv)
    return o.reshape(B, S, A_Q)


def hgrn2_mixer(q, f_logit, i, g, lb, norm_g):
    B, S, H, dk = q.shape
    dv = i.shape[-1]
    n = S // CHUNK
    f32 = jnp.float32
    lbh = lb.reshape(H, dk).astype(f32)
    z = f_logit.astype(f32)
    log_f = jnp.log(lbh + (1.0 - lbh) * jax.nn.sigmoid(z))
    k = (1.0 - lbh) * jax.nn.sigmoid(-z)

    def chunks(t):
        return t.astype(f32).reshape(B, n, CHUNK, H, t.shape[-1]).transpose(0, 3, 1, 2, 4)

    qc, kc, vc = chunks(q), chunks(k), chunks(i)
    bc = jnp.cumsum(chunks(log_f), axis=3)
    b_ref = bc[..., CHUNK // 2 - 1:CHUNK // 2, :]
    q_in = qc * jnp.exp(bc - b_ref)
    k_in = kc * jnp.exp(b_ref - bc)
    causal = jnp.tril(jnp.ones((CHUNK, CHUNK), dtype=bool))
    attn = jnp.where(causal, jnp.einsum('bhntd,bhnsd->bhnts', q_in, k_in), 0.0)
    o_intra = jnp.einsum('bhnts,bhnsv->bhntv', attn, vc)
    b_last = bc[..., -1:, :]
    dS = jnp.einsum('bhnsd,bhnsv->bhndv', kc * jnp.exp(b_last - bc), vc)
    decay = jnp.exp(b_last[..., 0, :])

    def step(state, xs):
        dS_n, dec_n = xs
        return dec_n[..., None] * state + dS_n, state

    _, S_before = lax.scan(step, jnp.zeros((B, H, dk, dv), f32), (jnp.moveaxis(dS, 2, 0), jnp.moveaxis(decay, 2, 0)))
    S_before = jnp.moveaxis(S_before, 0, 2)
    o_inter = jnp.einsum('bhntd,bhndv->bhntv', qc * jnp.exp(bc), S_before)
    o = (o_intra + o_inter).transpose(0, 2, 3, 1, 4).reshape(B, S, H, dv)
    gf = g.astype(f32)
    o = rms_norm(o, norm_g) * gf * jax.nn.sigmoid(gf)
    return o.reshape(B, S, H * dv).astype(q.dtype)


def mixer_sublayer(x, w_in, kv_norm_g, w_uk, w_uv, rel_bias, lb, b_norm_g, w_br_a, w_br_b, w_o):
    B, S, _ = x.shape
    proj = x @ w_in
    offs = np.cumsum(np.array(IN_SPLITS))[:-1].tolist()
    qa, ckv, qi, ki, wi, qb, fb, ib, gb, gate_a, gate_b = jnp.split(proj, offs, axis=-1)
    ya = dsa_mixer(qa.reshape(B, S, A_HEADS, A_HEAD_DIM), rms_norm(ckv, kv_norm_g),
                   qi.reshape(B, S, IDX_HEADS, IDX_DIM), ki, wi * (IDX_HEADS * IDX_DIM) ** -0.5,
                   w_uk, w_uv, rel_bias) @ w_br_a
    yb = hgrn2_mixer(qb.reshape(B, S, B_HEADS, B_KEY_DIM), fb.reshape(B, S, B_HEADS, B_KEY_DIM),
                     ib.reshape(B, S, B_HEADS, B_VAL_DIM), gb.reshape(B, S, B_HEADS, B_VAL_DIM),
                     lb, b_norm_g) @ w_br_b
    merged = jax.nn.sigmoid(gate_a) * ya + jax.nn.sigmoid(gate_b) * yb
    return merged @ w_o


def peer_sublayer(x, w_pq, sub_keys1, sub_keys2, u_table, v_table):
    B, S, D = x.shape
    T = B * S
    blk = math.gcd(T, PEER_TOKEN_BLOCK)

    def block(xb):
        q = (xb @ w_pq).reshape(blk, PEER_HEADS, 2, PEER_QDIM // 2)
        s1 = jnp.einsum('thd,nd->thn', q[:, :, 0], sub_keys1).astype(jnp.float32)
        s2 = jnp.einsum('thd,nd->thn', q[:, :, 1], sub_keys2).astype(jnp.float32)
        v1, i1 = lax.top_k(s1, PEER_TOPK)
        v2, i2 = lax.top_k(s2, PEER_TOPK)
        cand = (v1[..., :, None] + v2[..., None, :]).reshape(blk, PEER_HEADS, PEER_TOPK * PEER_TOPK)
        cand_id = (i1[..., :, None] * PEER_KEYS + i2[..., None, :]).reshape(blk, PEER_HEADS, PEER_TOPK * PEER_TOPK)
        top_s, pos = lax.top_k(cand, PEER_TOPK)
        ids = jnp.take_along_axis(cand_id, pos, axis=-1).reshape(blk, PEER_HEADS * PEER_TOPK)
        gate = jax.nn.softmax(top_s, axis=-1).reshape(blk, PEER_HEADS * PEER_TOPK).astype(xb.dtype)
        u = jnp.take(u_table, ids, axis=0)
        h = jax.nn.gelu(jnp.einsum('tkd,td->tk', u, xb), approximate=False)
        v = jnp.take(v_table, ids, axis=0)
        return jnp.einsum('tk,tkd->td', gate * h, v)

    out = lax.map(block, x.reshape(T // blk, blk, D))
    return out.reshape(B, S, D)


def setup_inputs(seed: int = 0) -> dict:
    key = jax.random.key(seed)
    ks = jax.random.split(key, 21)
    L = DEPTH

    def nrm(k, shape, scale):
        return jax.random.normal(k, shape, jnp.float32) * scale

    return {
        "x": nrm(ks[0], (BATCH, SEQ, D_MODEL), 1.0),
        "w_in": nrm(ks[1], (L, D_MODEL, IN_COLS), D_MODEL ** -0.5),
        "kv_norm_g": 1.0 + nrm(ks[2], (L, A_LATENT), 0.02),
        "w_uk": nrm(ks[3], (L, A_LATENT, A_HEADS, A_HEAD_DIM), A_LATENT ** -0.5),
        "w_uv": nrm(ks[4], (L, A_LATENT, A_HEADS, A_HEAD_DIM), A_LATENT ** -0.5),
        "rel_bias": nrm(ks[5], (REL_BUCKETS, A_HEADS), 0.5),
        "lb_params": 1.0 + nrm(ks[6], (DEPTH + 1, B_K), 0.1),
        "b_norm_g": 1.0 + nrm(ks[7], (L, B_VAL_DIM), 0.02),
        "w_br_a": nrm(ks[8], (L, A_Q, D_MODEL), A_Q ** -0.5 * BETA),
        "w_br_b": nrm(ks[9], (L, B_V, D_MODEL), B_V ** -0.5 * BETA),
        "w_o": nrm(ks[10], (L, D_MODEL, D_MODEL), D_MODEL ** -0.5 * BETA),
        "ln1_g": 1.0 + nrm(ks[11], (L, D_MODEL), 0.02),
        "ln1_b": nrm(ks[12], (L, D_MODEL), 0.01),
        "w_pq": nrm(ks[13], (L, D_MODEL, PEER_HEADS * PEER_QDIM), D_MODEL ** -0.5),
        "sub_keys1": nrm(ks[14], (L, PEER_KEYS, PEER_QDIM // 2), (PEER_QDIM // 2) ** -0.5),
        "sub_keys2": nrm(ks[15], (L, PEER_KEYS, PEER_QDIM // 2), (PEER_QDIM // 2) ** -0.5),
        "u_table": nrm(ks[16], (L, PEER_EXPERTS, D_MODEL), D_MODEL ** -0.5),
        "v_table": nrm(ks[17], (L, PEER_EXPERTS, D_MODEL), BETA * PEER_HEADS ** -0.5),
        "ln2_g": 1.0 + nrm(ks[18], (L, D_MODEL), 0.02),
        "ln2_b": nrm(ks[19], (L, D_MODEL), 0.01),
    }


def reference(x, w_in, kv_norm_g, w_uk, w_uv, rel_bias, lb_params, b_norm_g, w_br_a, w_br_b, w_o,
              ln1_g, ln1_b, w_pq, sub_keys1, sub_keys2, u_table, v_table, ln2_g, ln2_b):
    lower_bounds = jnp.cumsum(jax.nn.softmax(lb_params.astype(jnp.float32), axis=0), axis=0)
    for l in range(DEPTH):
        mix = mixer_sublayer(x, w_in[l], kv_norm_g[l], w_uk[l], w_uv[l], rel_bias, lower_bounds[l],
                             b_norm_g[l], w_br_a[l], w_br_b[l], w_o[l])
        x = layer_norm(ALPHA * x + mix, ln1_g[l], ln1_b[l])
        ffn = peer_sublayer(x, w_pq[l], sub_keys1[l], sub_keys2[l], u_table[l], v_table[l])
        x = layer_norm(ALPHA * x + ffn, ln2_g[l], ln2_b[l])
    return x
```

```cpp
#include <hip/hip_runtime.h>
#include <cstdio>
#include <cstdint>

#ifndef MK_N_LAUNCHES
#define MK_N_LAUNCHES 10
#endif

namespace pg8 {
#define PG8_LAS __attribute__((address_space(3)))
typedef unsigned short bf16_t;
typedef short bf16x8 __attribute__((ext_vector_type(8)));
typedef float f32x4 __attribute__((ext_vector_type(4)));
typedef unsigned u32x4 __attribute__((ext_vector_type(4)));
constexpr int BM = 256, BK = 64, HALF = 128, HTB = HALF * BK * 2, STAGE_BYTES = 8 * HTB, NXCD = 8, WGM = 8;

__host__ __device__ __forceinline__ int lds_byte(int r, int c) { const int st = (r >> 4) * 2 + (c >> 5), rr = r & 15, cc = c & 31, ob = rr * 64 + cc * 2; return st * 1024 + (ob ^ (((ob >> 9) & 1) << 5)); }
__host__ __device__ __forceinline__ void stage_rc(int b, int& R, int& C) { const int st = b / 1024, sb = b % 1024, swz = sb ^ (((sb >> 9) & 1) << 5); R = (st >> 1) * 16 + swz / 64; C = (st & 1) * 32 + (swz % 64) / 2; }
__host__ __device__ __forceinline__ int perm32(int rho) { const int n = rho >> 4, i = rho & 15; return 8 * (i >> 2) + 4 * n + (i & 3); }

struct Unit { int pm, pn; };
struct Gemm { const bf16_t* A; const bf16_t* Bt; int M, N, K; };

struct StaticOrder {
    int nM, nN, nwg, G, c;
    __host__ __device__ void init(int M, int N, int G_, int c_) { nM = M / BM; nN = N / BM; nwg = nM * nN; G = G_; c = c_; }
    __host__ __device__ bool next(int i, Unit& u) const {
        const long L = (long)i * G + c; if (L >= nwg) return false;
        int wgid = (int)L; { const int q = nwg / NXCD, r = nwg % NXCD, xcd = wgid % NXCD, off = wgid / NXCD; wgid = (xcd < r ? xcd * (q + 1) : r * (q + 1) + (xcd - r) * q) + off; }
        const int nig = WGM * nN, gid = wgid / nig, fm = gid * WGM, gsz = (nM - fm) < WGM ? (nM - fm) : WGM;
        u.pm = fm + ((wgid % nig) % gsz); u.pn = (wgid % nig) / gsz; return true;
    }
    __device__ __forceinline__ void a_ready(const Unit&) const {}
    __device__ __forceinline__ void done(const Unit&) const {}
};

__device__ __forceinline__ unsigned cvt_pk_bf16(float lo, float hi) { unsigned r; asm volatile("v_cvt_pk_bf16_f32 %0, %1, %2" : "=v"(r) : "v"(lo), "v"(hi)); return r; }

template <class Epi, class Sched>
__device__ __forceinline__ void gemm_phase(PG8_LAS unsigned char* lds, const Gemm g, const Sched& S, const Epi& E, const int tid) {
    const int wid = __builtin_amdgcn_readfirstlane(tid >> 6), lane = tid & 63, wr = wid >> 2, wc = wid & 3, fr = lane & 15, fq = lane >> 4;
    const int K = g.K, nt = K / BK;
    unsigned voffA[2], voffB[2];
#pragma unroll
    for (int i = 0; i < 2; ++i) { int R, C; stage_rc(tid * 16 + i * 8192, R, C); const int Rb = Epi::PERM ? ((R & ~31) + perm32(R & 31)) : R;
        voffA[i] = (unsigned)(R * K + C) * 2u; voffB[i] = (unsigned)(Rb * K + C) * 2u; }
    const size_t kstep = (size_t)(BK * 2);
    const size_t hstep = (size_t)HALF * K * 2;
    const size_t tstep = 2 * hstep;
    const unsigned ldsw = (unsigned)wid * 1024u;
    const int aoff = lds_byte(wr * 64 + fr, fq * 8), boff = lds_byte(wc * 32 + fr, fq * 8);
#define PG8_SA(b, h) (((b) * 2 + (h)) * HTB)
#define PG8_SB(b, h) ((4 + (b) * 2 + (h)) * HTB)
#define PG8_STAGE(bufoff, gbase, voff) do { _Pragma("unroll") for (int _i = 0; _i < 2; ++_i) \
        __builtin_amdgcn_global_load_lds((const unsigned*)((const char*)(gbase) + (voff)[_i]), (PG8_LAS unsigned*)(lds + (bufoff) + ldsw + _i * 8192), 16, 0, 0); } while (0)
#define PG8_LDA(dst, b, h) do { _Pragma("unroll") for (int m = 0; m < 4; ++m) _Pragma("unroll") for (int k = 0; k < 2; ++k) dst[m][k] = *(const PG8_LAS bf16x8*)(lds + PG8_SA(b, h) + aoff + m * 2048 + k * 1024); } while (0)
#define PG8_LDB(dst, b, h) do { _Pragma("unroll") for (int n = 0; n < 2; ++n) _Pragma("unroll") for (int k = 0; k < 2; ++k) dst[n][k] = *(const PG8_LAS bf16x8*)(lds + PG8_SB(b, h) + boff + n * 2048 + k * 1024); } while (0)
#define PG8_MMA(ai, bj, At, Bt) do { __builtin_amdgcn_s_setprio(1); _Pragma("unroll") for (int m = 0; m < 4; ++m) _Pragma("unroll") for (int n = 0; n < 2; ++n) _Pragma("unroll") for (int k = 0; k < 2; ++k) \
        acc[ai][bj][m][n] = __builtin_amdgcn_mfma_f32_16x16x32_bf16(Bt[n][k], At[m][k], acc[ai][bj][m][n], 0, 0, 0); __builtin_amdgcn_s_setprio(0); } while (0)
#define PG8_WAIT_V(n) asm volatile("s_waitcnt vmcnt(" #n ")" ::: "memory")
#define PG8_WAIT_L(n) asm volatile("s_waitcnt lgkmcnt(" #n ")" ::: "memory")
#define PG8_BAR __builtin_amdgcn_s_barrier()
#define PG8_SCHED __builtin_amdgcn_sched_barrier(0)
    Unit cur, nxt; int ui = 0;
    if (!S.next(0, cur)) return;
    f32x4 acc[2][2][4][2];
#pragma unroll
    for (int a = 0; a < 2; ++a)
#pragma unroll
        for (int b = 0; b < 2; ++b)
#pragma unroll
            for (int m = 0; m < 4; ++m)
#pragma unroll
                for (int n = 0; n < 2; ++n) acc[a][b][m][n] = (f32x4){0.f, 0.f, 0.f, 0.f};
    bf16x8 At[4][2], B0[2][2], B1[2][2];
    const char* cA = (const char*)g.A + (size_t)cur.pm * tstep; const char* cB = (const char*)g.Bt + (size_t)cur.pn * tstep;
    S.a_ready(cur);
    PG8_STAGE(PG8_SB(0, 0), cB, voffB); PG8_STAGE(PG8_SA(0, 0), cA, voffA); PG8_STAGE(PG8_SB(0, 1), cB + hstep, voffB); PG8_STAGE(PG8_SA(0, 1), cA + hstep, voffA);
    if (wr == 1) PG8_BAR;
    PG8_WAIT_V(4); PG8_BAR;
    PG8_STAGE(PG8_SB(1, 0), cB + kstep, voffB); PG8_STAGE(PG8_SA(1, 0), cA + kstep, voffA); PG8_STAGE(PG8_SB(1, 1), cB + hstep + kstep, voffB);
    PG8_WAIT_V(6); PG8_BAR;
    for (;;) {
        const bool has_next = S.next(ui + 1, nxt);
        const char* nA = has_next ? (const char*)g.A + (size_t)nxt.pm * tstep : cA; const char* nB = has_next ? (const char*)g.Bt + (size_t)nxt.pn * tstep : cB;
        for (int t = 0; t < nt; t += 2) {
            const bool last = (t == nt - 2);
            const char* a1 = cA + (size_t)(t + 1) * kstep;
            const char* a2 = last ? nA : cA + (size_t)(t + 2) * kstep; const char* b2 = last ? nB : cB + (size_t)(t + 2) * kstep;
            const char* a3 = a2 + kstep; const char* b3 = b2 + kstep;
            if (last && has_next) S.a_ready(nxt);
            PG8_LDB(B0, 0, 0); PG8_SCHED; PG8_LDA(At, 0, 0); PG8_STAGE(PG8_SA(1, 1), a1 + hstep, voffA);
            PG8_WAIT_L(8); PG8_BAR; PG8_WAIT_L(0); PG8_MMA(0, 0, At, B0); PG8_BAR; PG8_SCHED;
            PG8_LDB(B1, 0, 1); PG8_STAGE(PG8_SB(0, 0), b2, voffB);
            PG8_BAR; PG8_WAIT_L(0); PG8_MMA(0, 1, At, B1); PG8_BAR;
            PG8_LDA(At, 0, 1); PG8_STAGE(PG8_SA(0, 0), a2, voffA);
            PG8_BAR; PG8_WAIT_L(0); PG8_MMA(1, 0, At, B0); PG8_BAR; PG8_SCHED;
            PG8_STAGE(PG8_SB(0, 1), b2 + hstep, voffB);
            PG8_WAIT_V(6); PG8_BAR; PG8_MMA(1, 1, At, B1); PG8_BAR;
            PG8_LDB(B0, 1, 0); PG8_SCHED; PG8_LDA(At, 1, 0); PG8_STAGE(PG8_SA(0, 1), a2 + hstep, voffA);
            PG8_WAIT_L(8); PG8_BAR; PG8_WAIT_L(0); PG8_MMA(0, 0, At, B0); PG8_BAR; PG8_SCHED;
            PG8_LDB(B1, 1, 1); PG8_STAGE(PG8_SB(1, 0), b3, voffB);
            PG8_BAR; PG8_WAIT_L(0); PG8_MMA(0, 1, At, B1); PG8_BAR;
            PG8_LDA(At, 1, 1); PG8_STAGE(PG8_SA(1, 0), a3, voffA);
            PG8_BAR; PG8_WAIT_L(0); PG8_MMA(1, 0, At, B0); PG8_BAR; PG8_SCHED;
            PG8_STAGE(PG8_SB(1, 1), b3 + hstep, voffB);
            PG8_WAIT_V(6); PG8_BAR; PG8_MMA(1, 1, At, B1); PG8_BAR;
        }
        E(acc, cur, wr, wc, fr, fq); S.done(cur);
        if (!has_next) break;
#pragma unroll
        for (int a = 0; a < 2; ++a)
#pragma unroll
            for (int b = 0; b < 2; ++b)
#pragma unroll
                for (int m = 0; m < 4; ++m)
#pragma unroll
                    for (int n = 0; n < 2; ++n) acc[a][b][m][n] = (f32x4){0.f, 0.f, 0.f, 0.f};
        cur = nxt; cA = nA; cB = nB; ++ui;
    }
    PG8_WAIT_V(0);
    if (wr == 0) PG8_BAR;
    PG8_BAR;
#undef PG8_SA
#undef PG8_SB
#undef PG8_STAGE
#undef PG8_LDA
#undef PG8_LDB
#undef PG8_MMA
#undef PG8_WAIT_V
#undef PG8_WAIT_L
#undef PG8_BAR
#undef PG8_SCHED
}
}

constexpr int NWAVES = 8, NTHREADS = 512;
constexpr int NB = 32, SEQ = 2048, DM = 1024, T = NB * SEQ;
constexpr int IN_COLS = 5320, NPROJ = 5888;
constexpr int N_PHASES = 10;
constexpr float ALPHA = 1.189207115002721f;
constexpr float LN_EPS = 1e-5f, RMS_EPS = 1e-6f;

constexpr size_t MiB = 1u << 20;
constexpr size_t WS_CTL = 0, CTL_ZERO_BYTES = 1 * MiB;
constexpr size_t WS_WIN = 1 * MiB, WS_WA = 13 * MiB, WS_WB = 15 * MiB, WS_WO = 16 * MiB, WS_WPQ = 18 * MiB;
constexpr size_t WS_UT = 24 * MiB, WS_VT = 56 * MiB;
constexpr size_t WS_XB = 88 * MiB;
constexpr size_t WS_QL = 216 * MiB;
constexpr size_t WS_MISC = 344 * MiB;
constexpr size_t WS_CKV = 376 * MiB;
constexpr size_t WS_QI = 392 * MiB, WS_QB = 456 * MiB, WS_FB = 520 * MiB, WS_IB = 584 * MiB, WS_GB = 648 * MiB;
constexpr size_t WS_GA = 712 * MiB, WS_GBT = 840 * MiB;
constexpr size_t WS_BM = 968 * MiB;
constexpr size_t WS_END = 984 * MiB;
constexpr size_t WS_MERGED = WS_XB, WS_X1B = WS_QL, WS_PQ = WS_QI, WS_IDS = WS_GB, WS_GATES = WS_GB + 32 * MiB;
constexpr int CW_BAR = 4096;

constexpr int RING_BYTES = 131072;
constexpr int LDSCTL_OFF = RING_BYTES, MISC_OFF = LDSCTL_OFF + 320;
constexpr int LDS_BYTES = 147456;

#define GAS __attribute__((address_space(1)))
#define LAS __attribute__((address_space(3)))
typedef unsigned short bf16;
typedef unsigned v4u __attribute__((ext_vector_type(4)));
typedef unsigned v2u __attribute__((ext_vector_type(2)));
typedef float f32x4 __attribute__((ext_vector_type(4)));
typedef float f32x2 __attribute__((ext_vector_type(2)));
typedef GAS unsigned gu32;
#define RLX_AGENT __ATOMIC_RELAXED, __HIP_MEMORY_SCOPE_AGENT
#define LDS_WAIT() asm volatile("s_waitcnt lgkmcnt(0)" ::: "memory")
#define VM_WAIT() asm volatile("s_waitcnt vmcnt(0)" ::: "memory")
__device__ __forceinline__ unsigned pk2(float lo, float hi) { return pg8::cvt_pk_bf16(lo, hi); }
__device__ __forceinline__ float bflo(unsigned u) { return __uint_as_float(u << 16); }
__device__ __forceinline__ float bfhi(unsigned u) { return __uint_as_float(u & 0xffff0000u); }
__device__ __forceinline__ float bf2f(bf16 b) { return __uint_as_float(((unsigned)b) << 16); }
__device__ __forceinline__ float sigmoidf_(float x) { return 1.0f / (1.0f + __expf(-x)); }

#define XB_TMO      128
#define XB_XCNT(j)  (256  + 64 * (j))
#define XB_XSUB(j)  (1280 + 64 * (j))
#define XB_XGEN(j)  (2304 + 64 * (j))
#define XB_TOP      3328
#define XB_TOPGEN   3392
#define XCD_BAR_WORDS 3456
#define XB_SPIN_CAP (1u << 22)
__device__ __forceinline__ unsigned xb_ld(unsigned* p)              { return __hip_atomic_load(p, __ATOMIC_RELAXED, __HIP_MEMORY_SCOPE_AGENT); }
__device__ __forceinline__ unsigned xb_add(unsigned* p, unsigned v) { return __hip_atomic_fetch_add(p, v, __ATOMIC_RELAXED, __HIP_MEMORY_SCOPE_AGENT); }
__device__ __forceinline__ unsigned xb_xcc_id() { return (unsigned)__builtin_amdgcn_s_getreg((3 << 11) | 20) & 0xFu; }
#define XB_SPIN(cond, bar) do { unsigned _sp = 0; while (cond) { __builtin_amdgcn_s_sleep(1); \
    if ((++_sp & 255u) == 0u) { if (xb_ld(&(bar)[XB_TMO])) break; if (_sp > XB_SPIN_CAP) { atomicAdd(&(bar)[XB_TMO], 1u); break; } } } } while (0)
struct XcdBarrier { unsigned* bar; unsigned x; volatile LAS unsigned* st; };
__device__ __forceinline__ XcdBarrier xcd_barrier_post(unsigned* bar, volatile LAS unsigned* st) {
    XcdBarrier b; b.bar = bar; b.x = xb_xcc_id(); b.st = st;
    if (threadIdx.x == 0) (void)xb_add(&bar[XB_XCNT(b.x)], 1u);
    return b;
}
__device__ __forceinline__ void xcd_barrier_complete(unsigned* bar, unsigned x, unsigned& nloc, unsigned& nx) {
    const unsigned G = gridDim.x * gridDim.y * gridDim.z;
    unsigned sum, cnt, mine, sp = 0u;
    for (;;) {
        sum = 0u; cnt = 0u; mine = 0u;
#pragma unroll
        for (unsigned j = 0; j < 16; ++j) { const unsigned c = xb_ld(&bar[XB_XCNT(j)]); sum += c; cnt += (c > 0u) ? 1u : 0u; mine = (j == x) ? c : mine; }
        if (sum == G) break;
        __builtin_amdgcn_s_sleep(1);
        if ((++sp & 255u) == 0u) { if (xb_ld(&bar[XB_TMO])) break; if (sp > XB_SPIN_CAP) { atomicAdd(&bar[XB_TMO], 1u); break; } }
    }
    nloc = mine > 0u ? mine : 1u; nx = cnt > 0u ? cnt : 1u;
}
__device__ __forceinline__ void xcd_barrier(const XcdBarrier& b) {
    asm volatile("s_waitcnt vmcnt(0)" ::: "memory");
    __syncthreads();
    if (threadIdx.x == 0) {
        unsigned* bar = b.bar;
        __builtin_amdgcn_s_waitcnt(0);
        unsigned nloc = b.st[0], nx = b.st[1];
        if (nloc == 0u) { xcd_barrier_complete(bar, b.x, nloc, nx); b.st[0] = nloc; b.st[1] = nx; }
        const unsigned old = xb_add(&bar[XB_XSUB(b.x)], 1u);
        const unsigned gen = old / nloc;
        if (old + 1u == (gen + 1u) * nloc) {
            __builtin_amdgcn_fence(__ATOMIC_RELEASE, "agent");
            asm volatile("s_waitcnt vmcnt(0)" ::: "memory");
            const unsigned og = xb_add(&bar[XB_TOP], 1u);
            const unsigned tg = og / nx;
            if (og + 1u == (tg + 1u) * nx) xb_add(&bar[XB_TOPGEN], 1u);
            else XB_SPIN(xb_ld(&bar[XB_TOPGEN]) == tg, bar);
            __builtin_amdgcn_fence(__ATOMIC_ACQUIRE, "agent");
            xb_add(&bar[XB_XGEN(b.x)], 1u);
            asm volatile("s_waitcnt vmcnt(0)" ::: "memory");
        } else {
            XB_SPIN(xb_ld(&bar[XB_XGEN(b.x)]) == gen, bar);
            __builtin_amdgcn_fence(__ATOMIC_ACQUIRE, "agent");
            asm volatile("s_waitcnt vmcnt(0)" ::: "memory");
        }
    }
    __syncthreads();
}

struct Args { const float* in[20]; float* out; unsigned char* ws; int ph_lo, ph_hi, li, pad; };
enum { I_X = 0, I_WIN, I_KVG, I_WUK, I_WUV, I_RELB, I_LBP, I_BNG, I_WBRA, I_WBRB, I_WO, I_LN1G, I_LN1B, I_WPQ, I_SK1, I_SK2, I_UT, I_VT, I_LN2G, I_LN2B };

typedef const __attribute__((address_space(4))) Args* KArgs;
struct Frame {
    LAS unsigned char* lds;
    int tid, lane, wave, G;
    KArgs a;
    unsigned char* ws;
};

__device__ __forceinline__ float wave_sum(float v) {
#pragma unroll
    for (int o = 1; o < 64; o <<= 1) v += __shfl_xor(v, o);
    return v;
}
__device__ __forceinline__ float wave_max(float v) {
#pragma unroll
    for (int o = 1; o < 64; o <<= 1) v = fmaxf(v, __shfl_xor(v, o));
    return v;
}

__device__ __forceinline__ void cvt_bf16_stream(const float* src, bf16* dst, size_t n8, size_t gtid, size_t gthreads) {
    for (size_t i = gtid; i < n8; i += gthreads) {
        const f32x4 a = ((const f32x4*)src)[2 * i], b = ((const f32x4*)src)[2 * i + 1];
        v4u o; o.x = pk2(a.x, a.y); o.y = pk2(a.z, a.w); o.z = pk2(b.x, b.y); o.w = pk2(b.z, b.w);
        ((v4u*)dst)[i] = o;
    }
}
__device__ __forceinline__ void transpose_item(const float* W, int ldw, int K, int c0, int nvalid, bf16* WT, int r0, int k0, LAS float* scr, int lane) {
#pragma unroll 8
    for (int i = 0; i < 32; ++i) { const int kk = 2 * i + (lane >> 5), n = lane & 31; scr[kk * 33 + n] = (n < nvalid) ? W[(size_t)(k0 + kk) * ldw + c0 + n] : 0.f; }
    LDS_WAIT(); asm volatile("" ::: "memory");
    const int c = lane & 7;
#pragma unroll
    for (int j = 0; j < 4; ++j) { const int n = (lane >> 3) + 8 * j; const LAS float* s = scr + (8 * c) * 33 + n;
        v4u o; o.x = pk2(s[0 * 33], s[1 * 33]); o.y = pk2(s[2 * 33], s[3 * 33]); o.z = pk2(s[4 * 33], s[5 * 33]); o.w = pk2(s[6 * 33], s[7 * 33]);
        *(v4u*)(WT + (size_t)(r0 + n) * K + k0 + 8 * c) = o; }
    LDS_WAIT(); asm volatile("" ::: "memory");
}
__device__ __forceinline__ void win_block(int cb, int& c0, int& r0, int& nv) {
    nv = 32;
    if (cb < 4)        { c0 = 512 + 32 * cb;          r0 = 1024 + 32 * cb; }
    else if (cb < 6)   { c0 = 1152 + 32 * (cb - 4);   r0 = 1152 + 32 * (cb - 4); }
    else if (cb == 6)  { c0 = 1216;                   r0 = 1216; nv = 8; }
    else if (cb == 7)  { c0 = 0;                      r0 = 1248; nv = 0; }
    else if (cb < 24)  { c0 = 640 + 32 * (cb - 8);    r0 = 1280 + 32 * (cb - 8); }
    else if (cb < 40)  { c0 = 1224 + 32 * (cb - 24);  r0 = 1792 + 32 * (cb - 24); }
    else if (cb < 56)  { c0 = 1736 + 32 * (cb - 40);  r0 = 2304 + 32 * (cb - 40); }
    else if (cb < 72)  { c0 = 2248 + 32 * (cb - 56);  r0 = 2816 + 32 * (cb - 56); }
    else if (cb < 88)  { c0 = 2760 + 32 * (cb - 72);  r0 = 3328 + 32 * (cb - 72); }
    else if (cb < 120) { c0 = 3272 + 32 * (cb - 88);  r0 = 3840 + 32 * (cb - 88); }
    else               { c0 = 4296 + 32 * (cb - 120); r0 = 4864 + 32 * (cb - 120); }
}
__device__ __forceinline__ void p0_prologue(Frame& F) {
    KArgs const Ap = F.a;
    const size_t gtid = (size_t)blockIdx.x * NTHREADS + F.tid, gthreads = (size_t)F.G * NTHREADS;
    cvt_bf16_stream(Ap->in[I_X], (bf16*)(F.ws + WS_XB), (size_t)T * DM / 8, gtid, gthreads);
    cvt_bf16_stream(Ap->in[I_UT], (bf16*)(F.ws + WS_UT), (size_t)16384 * DM / 8, gtid, gthreads);
    cvt_bf16_stream(Ap->in[I_VT], (bf16*)(F.ws + WS_VT), (size_t)16384 * DM / 8, gtid, gthreads);
    LAS float* scr = (LAS float*)(F.lds + F.wave * 16384);
    const int gw = blockIdx.x * NWAVES + F.wave, NGW = F.G * NWAVES;
    constexpr int I_IN = 152 * 16, I_B = 32 * 8, I_O = 32 * 16, I_PQ = 64 * 16;
    for (int it = gw; it < I_IN + I_B + I_O + I_PQ; it += NGW) {
        int r = it;
        if (r < I_IN) { const int cb = r >> 4, kb = r & 15; int c0, r0, nv; win_block(cb, c0, r0, nv);
            transpose_item(Ap->in[I_WIN], IN_COLS, 1024, c0, nv, (bf16*)(F.ws + WS_WIN), r0, 64 * kb, scr, F.lane); continue; }
        r -= I_IN;
        if (r < I_B) { const int cb = r >> 3, kb = r & 7; transpose_item(Ap->in[I_WBRB], 1024, 512, 32 * cb, 32, (bf16*)(F.ws + WS_WB), 32 * cb, 64 * kb, scr, F.lane); continue; }
        r -= I_B;
        if (r < I_O) { const int cb = r >> 4, kb = r & 15; transpose_item(Ap->in[I_WO], 1024, 1024, 32 * cb, 32, (bf16*)(F.ws + WS_WO), 32 * cb, 64 * kb, scr, F.lane); continue; }
        r -= I_O;
        { const int cb = r >> 4, kb = r & 15; transpose_item(Ap->in[I_WPQ], 2048, 1024, 32 * cb, 32, (bf16*)(F.ws + WS_WPQ), 32 * cb, 64 * kb, scr, F.lane); }
    }
    __syncthreads();
    LAS float* Xa = (LAS float*)(F.lds);
    LAS float* Xb = (LAS float*)(F.lds + 128 * 65 * 4);
    const float* w_in = Ap->in[I_WIN]; const float* w_uk = Ap->in[I_WUK]; const float* w_uv = Ap->in[I_WUV]; const float* w_bra = Ap->in[I_WBRA];
    for (int it = blockIdx.x; it < 256; it += F.G) {
        if (it < 128) {
            const int h = it >> 4, k0 = (it & 15) * 64;
            for (int e = F.tid; e < 128 * 64; e += NTHREADS) { const int c = e >> 6, d = e & 63; Xa[c * 65 + d] = w_uk[c * 512 + h * 64 + d]; }
            for (int e = F.tid; e < 64 * 64; e += NTHREADS) { const int kk = e >> 6, d = e & 63; Xb[kk * 65 + d] = w_in[(size_t)(k0 + kk) * IN_COLS + h * 64 + d]; }
            __syncthreads();
            const int kk = F.tid & 63;
            for (int j = 0; j < 16; ++j) { const int c = (F.tid >> 6) + 8 * j; float s = 0.f;
#pragma unroll 16
                for (int d = 0; d < 64; ++d) s += Xb[kk * 65 + d] * Xa[c * 65 + d];
                ((bf16*)(F.ws + WS_WIN))[(size_t)(h * 128 + c) * 1024 + k0 + kk] = (bf16)(pk2(s * 0.125f, 0.f) & 0xffffu); }
            __syncthreads();
        } else {
            const int i2 = it - 128, h = i2 >> 4, n0 = (i2 & 15) * 64;
            for (int e = F.tid; e < 128 * 64; e += NTHREADS) { const int c = e >> 6, d = e & 63; Xa[c * 65 + d] = w_uv[c * 512 + h * 64 + d]; }
            for (int e = F.tid; e < 64 * 64; e += NTHREADS) { const int d = e >> 6, n = e & 63; Xb[d * 65 + n] = w_bra[(size_t)(h * 64 + d) * 1024 + n0 + n]; }
            __syncthreads();
            const int c = F.tid & 127;
            for (int j = 0; j < 16; ++j) { const int n = (F.tid >> 7) + 4 * j; float s = 0.f;
#pragma unroll 16
                for (int d = 0; d < 64; ++d) s += Xa[c * 65 + d] * Xb[d * 65 + n];
                ((bf16*)(F.ws + WS_WA))[(size_t)(n0 + n) * 1024 + h * 128 + c] = (bf16)(pk2(s, 0.f) & 0xffffu); }
            __syncthreads();
        }
    }
}

struct EpiProj {
    static constexpr bool PERM = true;
    unsigned char* ws;
    __device__ __forceinline__ void operator()(const f32x4 (&acc)[2][2][4][2], const pg8::Unit& u, int wr, int wc, int fr, int fq) const {
        const int pn = u.pn; size_t boff; int ldc, colt; bool sg = false;
        if (pn < 4)       { boff = WS_QL;   ldc = 1024; colt = pn * 256; }
        else if (pn == 4) { boff = WS_MISC; ldc = 256;  colt = 0; }
        else if (pn < 7)  { boff = WS_QI;   ldc = 512;  colt = (pn - 5) * 256; }
        else if (pn < 9)  { boff = WS_QB;   ldc = 512;  colt = (pn - 7) * 256; }
        else if (pn < 11) { boff = WS_FB;   ldc = 512;  colt = (pn - 9) * 256; }
        else if (pn < 13) { boff = WS_IB;   ldc = 512;  colt = (pn - 11) * 256; }
        else if (pn < 15) { boff = WS_GB;   ldc = 512;  colt = (pn - 13) * 256; }
        else if (pn < 19) { boff = WS_GA;   ldc = 1024; colt = (pn - 15) * 256; sg = true; }
        else              { boff = WS_GBT;  ldc = 1024; colt = (pn - 19) * 256; sg = true; }
        bf16* base = (bf16*)(ws + boff);
        const int row0 = u.pm * 256 + wr * 64 + fr, col0 = colt + wc * 32 + 8 * fq;
#pragma unroll
        for (int ai = 0; ai < 2; ++ai)
#pragma unroll
            for (int m = 0; m < 4; ++m) { bf16* rowp = base + (size_t)(row0 + ai * 128 + m * 16) * ldc + col0;
#pragma unroll
                for (int bj = 0; bj < 2; ++bj) { f32x4 v0 = acc[ai][bj][m][0], v1 = acc[ai][bj][m][1];
                    if (sg) {
#pragma unroll
                        for (int j = 0; j < 4; ++j) { v0[j] = sigmoidf_(v0[j]); v1[j] = sigmoidf_(v1[j]); } }
                    v4u w; w.x = pk2(v0[0], v0[1]); w.y = pk2(v0[2], v0[3]); w.z = pk2(v1[0], v1[1]); w.w = pk2(v1[2], v1[3]);
                    *(v4u*)(rowp + bj * 128) = w; } }
    }
};
template <int MODE> struct EpiBranch {
    static constexpr bool PERM = true;
    const bf16* gate; bf16* O;
    __device__ __forceinline__ void operator()(const f32x4 (&acc)[2][2][4][2], const pg8::Unit& u, int wr, int wc, int fr, int fq) const {
        const int row0 = u.pm * 256 + wr * 64 + fr, col0 = u.pn * 256 + wc * 32 + 8 * fq;
#pragma unroll
        for (int ai = 0; ai < 2; ++ai)
#pragma unroll
            for (int m = 0; m < 4; ++m) { const size_t off = (size_t)(row0 + ai * 128 + m * 16) * 1024 + col0;
#pragma unroll
                for (int bj = 0; bj < 2; ++bj) { const f32x4 v0 = acc[ai][bj][m][0], v1 = acc[ai][bj][m][1];
                    const v4u g = *(const v4u*)(gate + off + bj * 128);
                    float r0 = v0[0] * bflo(g.x), r1 = v0[1] * bfhi(g.x), r2 = v0[2] * bflo(g.y), r3 = v0[3] * bfhi(g.y), r4 = v1[0] * bflo(g.z), r5 = v1[1] * bfhi(g.z), r6 = v1[2] * bflo(g.w), r7 = v1[3] * bfhi(g.w);
                    if (MODE == 1) { const v4u p = *(const v4u*)(O + off + bj * 128);
                        r0 += bflo(p.x); r1 += bfhi(p.x); r2 += bflo(p.y); r3 += bfhi(p.y); r4 += bflo(p.z); r5 += bfhi(p.z); r6 += bflo(p.w); r7 += bfhi(p.w); }
                    v4u w; w.x = pk2(r0, r1); w.y = pk2(r2, r3); w.z = pk2(r4, r5); w.w = pk2(r6, r7);
                    *(v4u*)(O + off + bj * 128) = w; } }
    }
};
struct EpiResF32 {
    static constexpr bool PERM = false;
    const float* X; float* Y;
    __device__ __forceinline__ void operator()(const f32x4 (&acc)[2][2][4][2], const pg8::Unit& u, int wr, int wc, int fr, int fq) const {
        const int row0 = u.pm * 256 + wr * 64 + fr, col0 = u.pn * 256 + wc * 32 + 4 * fq;
#pragma unroll
        for (int ai = 0; ai < 2; ++ai)
#pragma unroll
            for (int m = 0; m < 4; ++m) { const size_t off = (size_t)(row0 + ai * 128 + m * 16) * 1024 + col0;
#pragma unroll
                for (int bj = 0; bj < 2; ++bj)
#pragma unroll
                    for (int n = 0; n < 2; ++n) { const f32x4 xv = *(const f32x4*)(X + off + bj * 128 + n * 16);
                        *(f32x4*)(Y + off + bj * 128 + n * 16) = xv * ALPHA + acc[ai][bj][m][n]; } }
    }
};
struct EpiPlainBf16 {
    static constexpr bool PERM = true;
    bf16* O; int ldc;
    __device__ __forceinline__ void operator()(const f32x4 (&acc)[2][2][4][2], const pg8::Unit& u, int wr, int wc, int fr, int fq) const {
        const int row0 = u.pm * 256 + wr * 64 + fr, col0 = u.pn * 256 + wc * 32 + 8 * fq;
#pragma unroll
        for (int ai = 0; ai < 2; ++ai)
#pragma unroll
            for (int m = 0; m < 4; ++m) { bf16* rowp = O + (size_t)(row0 + ai * 128 + m * 16) * ldc + col0;
#pragma unroll
                for (int bj = 0; bj < 2; ++bj) { const f32x4 v0 = acc[ai][bj][m][0], v1 = acc[ai][bj][m][1];
                    v4u w; w.x = pk2(v0[0], v0[1]); w.y = pk2(v0[2], v0[3]); w.z = pk2(v1[0], v1[1]); w.w = pk2(v1[2], v1[3]);
                    *(v4u*)(rowp + bj * 128) = w; } }
    }
};

__device__ __forceinline__ void p2_ckv_norm(Frame& F) {
    const bf16* misc = (const bf16*)(F.ws + WS_MISC); bf16* ckv = (bf16*)(F.ws + WS_CKV); const float* g = F.a->in[I_KVG];
    const int gw = blockIdx.x * NWAVES + F.wave, NGW = F.G * NWAVES, sub = F.lane >> 4, l16 = F.lane & 15;
    float gv[8];
#pragma unroll
    for (int j = 0; j < 8; ++j) gv[j] = g[l16 * 8 + j];
    for (int r4 = gw; r4 < T / 4; r4 += NGW) {
        const int t = r4 * 4 + sub;
        const v4u p = *(const v4u*)(misc + (size_t)t * 256 + l16 * 8);
        float v[8] = {bflo(p.x), bfhi(p.x), bflo(p.y), bfhi(p.y), bflo(p.z), bfhi(p.z), bflo(p.w), bfhi(p.w)};
        float ss = 0.f;
#pragma unroll
        for (int j = 0; j < 8; ++j) ss += v[j] * v[j];
        ss += __shfl_xor(ss, 1); ss += __shfl_xor(ss, 2); ss += __shfl_xor(ss, 4); ss += __shfl_xor(ss, 8);
        const float r = rsqrtf(ss * (1.0f / 128.0f) + RMS_EPS);
        v4u o; o.x = pk2(v[0] * r * gv[0], v[1] * r * gv[1]); o.y = pk2(v[2] * r * gv[2], v[3] * r * gv[3]); o.z = pk2(v[4] * r * gv[4], v[5] * r * gv[5]); o.w = pk2(v[6] * r * gv[6], v[7] * r * gv[7]);
        *(v4u*)(ckv + (size_t)t * 128 + l16 * 8) = o;
    }
}

__device__ __forceinline__ void p2_hgrn_simple(Frame& F) {
    const bf16* QB = (const bf16*)(F.ws + WS_QB); const bf16* FBp = (const bf16*)(F.ws + WS_FB); bf16* IB = (bf16*)(F.ws + WS_IB);
    const float* lbp = F.a->in[I_LBP];
    const int v = F.tid >> 2, dq = F.tid & 3;
    for (int item = blockIdx.x; item < NB * 4; item += F.G) {
        const int b = item >> 2, h = item & 3;
        float lb[32], S[32];
#pragma unroll
        for (int i = 0; i < 32; ++i) { const int d = h * 128 + dq * 32 + i; lb[i] = 1.0f / (1.0f + __expf(lbp[512 + d] - lbp[d])); S[i] = 0.f; }
        for (int t = 0; t < SEQ; ++t) {
            const size_t row = (size_t)b * SEQ + t;
            const v4u* qp = (const v4u*)(QB + row * 512 + h * 128 + dq * 32);
            const v4u* fp = (const v4u*)(FBp + row * 512 + h * 128 + dq * 32);
            const float vv = bf2f(IB[row * 512 + h * 128 + v]);
            float part = 0.f;
#pragma unroll
            for (int c = 0; c < 4; ++c) { const v4u q4 = qp[c], f4 = fp[c];
#pragma unroll
                for (int e = 0; e < 4; ++e) {
                    const unsigned qa = e == 0 ? q4.x : e == 1 ? q4.y : e == 2 ? q4.z : q4.w, fa = e == 0 ? f4.x : e == 1 ? f4.y : e == 2 ? f4.z : f4.w;
#pragma unroll
                    for (int hh = 0; hh < 2; ++hh) { const int i = c * 8 + e * 2 + hh;
                        const float q = hh ? bfhi(qa) : bflo(qa), z = hh ? bfhi(fa) : bflo(fa);
                        const float sg = sigmoidf_(z), f = lb[i] + (1.0f - lb[i]) * sg, k = (1.0f - lb[i]) * (1.0f - sg);
                        S[i] = f * S[i] + k * vv; part += q * S[i]; } } }
            part += __shfl_xor(part, 1); part += __shfl_xor(part, 2);
            if (dq == 0) IB[row * 512 + h * 128 + v] = (bf16)(pk2(part, 0.f) & 0xffffu);
        }
    }
}

__device__ __forceinline__ unsigned mono_key(float f) { const unsigned u = __float_as_uint(f); return (u & 0x80000000u) ? ~u : (u | 0x80000000u); }
__device__ __forceinline__ void p2_indexer_simple(Frame& F) {
    typedef short bf16x8 __attribute__((ext_vector_type(8)));
    const bf16* misc = (const bf16*)(F.ws + WS_MISC); const bf16* QI = (const bf16*)(F.ws + WS_QI);
    unsigned long long* BMp = (unsigned long long*)(F.ws + WS_BM);
    LAS float* sc = (LAS float*)(F.lds + F.wave * 16384);
    const int gw = blockIdx.x * NWAVES + F.wave, NGW = F.G * NWAVES, lane = F.lane;
    const int l15 = lane & 15, q4 = lane >> 4;
    for (int tp = gw; tp < T / 2; tp += NGW) {
        const int t0 = tp * 2, b = t0 >> 11, pos = t0 & 2047, chunk = pos >> 6, nk = chunk + 1;
        if (nk <= 4) { if (lane < 32) { BMp[(size_t)t0 * 32 + lane] = (lane < nk) ? ~0ull : 0ull; BMp[(size_t)(t0 + 1) * 32 + lane] = (lane < nk) ? ~0ull : 0ull; } continue; }
        const bf16* ap = QI + (size_t)(t0 + (l15 >> 3)) * 512 + (l15 & 7) * 64 + 8 * q4;
        const bf16x8 a0 = *(const bf16x8*)ap, a1 = *(const bf16x8*)(ap + 32);
        float w[4];
        { const v2u p = *(const v2u*)(misc + (size_t)(t0 + (q4 >> 1)) * 256 + 192 + (q4 & 1) * 4); const float s_ = 0.04419417382415922f;
          w[0] = bflo(p.x) * s_; w[1] = bfhi(p.x) * s_; w[2] = bflo(p.y) * s_; w[3] = bfhi(p.y) * s_; }
        const bf16* kbase = misc + ((size_t)b * SEQ + l15) * 256 + 128 + 8 * q4;
#pragma unroll 2
        for (int kt = 0; kt < nk * 4; ++kt) {
            const bf16* kp = kbase + (size_t)kt * 16 * 256;
            const bf16x8 b0 = *(const bf16x8*)kp, b1 = *(const bf16x8*)(kp + 32);
            f32x4 acc = {0.f, 0.f, 0.f, 0.f};
            acc = __builtin_amdgcn_mfma_f32_16x16x32_bf16(a0, b0, acc, 0, 0, 0);
            acc = __builtin_amdgcn_mfma_f32_16x16x32_bf16(a1, b1, acc, 0, 0, 0);
            float part = w[0] * fmaxf(acc[0], 0.f) + w[1] * fmaxf(acc[1], 0.f) + w[2] * fmaxf(acc[2], 0.f) + w[3] * fmaxf(acc[3], 0.f);
            part += __shfl_xor(part, 16);
            if ((q4 & 1) == 0) sc[(q4 >> 1) * 2048 + kt * 16 + l15] = part;
        }
        for (int i = nk; i < 32; ++i) { sc[i * 64 + lane] = -INFINITY; sc[2048 + i * 64 + lane] = -INFINITY; }
        LDS_WAIT(); asm volatile("" ::: "memory");
#pragma unroll 1
        for (int tt = 0; tt < 2; ++tt) {
            unsigned long long* bmrow = BMp + (size_t)(t0 + tt) * 32;
            unsigned key[32];
#pragma unroll
            for (int i = 0; i < 32; ++i) key[i] = mono_key(sc[tt * 2048 + i * 64 + lane]);
            unsigned prefix = 0u;
#pragma unroll 1
            for (int bit = 31; bit >= 0; --bit) {
                const unsigned cand = prefix | (1u << bit); int cnt = 0;
#pragma unroll
                for (int i = 0; i < 32; ++i) { cnt += __builtin_popcountll(__ballot(key[i] >= cand)); if ((i & 3) == 3) __builtin_amdgcn_sched_barrier(0); }
                if (cnt >= 256) prefix = cand;
            }
            int ngt = 0;
#pragma unroll
            for (int i = 0; i < 32; ++i) { ngt += __builtin_popcountll(__ballot(key[i] > prefix)); if ((i & 3) == 3) __builtin_amdgcn_sched_barrier(0); }
            const int need = 256 - ngt; int running = 0;
            const unsigned long long lt_mask = (1ull << lane) - 1ull;
#pragma unroll
            for (int i = 0; i < 32; ++i) {
                const unsigned long long eq = __ballot(key[i] == prefix), gt = __ballot(key[i] > prefix);
                const int rank = running + __builtin_popcountll(eq & lt_mask);
                const unsigned long long se = __ballot(key[i] == prefix && rank < need);
                running += __builtin_popcountll(eq);
                const unsigned long long word = gt | se;
                if (lane == 0) bmrow[i] = word;
                __builtin_amdgcn_sched_barrier(0);
            }
        }
        LDS_WAIT(); asm volatile("" ::: "memory");
    }
}

__device__ __forceinline__ void p3_hg_finalize(Frame& F) {
    bf16* HG = (bf16*)(F.ws + WS_IB); const bf16* GBp = (const bf16*)(F.ws + WS_GB); const float* ng = F.a->in[I_BNG];
    const int gw = blockIdx.x * NWAVES + F.wave, NGW = F.G * NWAVES, sub = F.lane >> 4, l16 = F.lane & 15;
    float gv[8];
#pragma unroll
    for (int j = 0; j < 8; ++j) gv[j] = ng[l16 * 8 + j];
    for (int r4 = gw; r4 < T; r4 += NGW) {
        const size_t off = (size_t)r4 * 512 + sub * 128 + l16 * 8;
        const v4u p = *(const v4u*)(HG + off), q = *(const v4u*)(GBp + off);
        float v[8] = {bflo(p.x), bfhi(p.x), bflo(p.y), bfhi(p.y), bflo(p.z), bfhi(p.z), bflo(p.w), bfhi(p.w)};
        float gg[8] = {bflo(q.x), bfhi(q.x), bflo(q.y), bfhi(q.y), bflo(q.z), bfhi(q.z), bflo(q.w), bfhi(q.w)};
        float ss = 0.f;
#pragma unroll
        for (int j = 0; j < 8; ++j) ss += v[j] * v[j];
        ss += __shfl_xor(ss, 1); ss += __shfl_xor(ss, 2); ss += __shfl_xor(ss, 4); ss += __shfl_xor(ss, 8);
        const float r = rsqrtf(ss * (1.0f / 128.0f) + RMS_EPS);
        float o[8];
#pragma unroll
        for (int j = 0; j < 8; ++j) o[j] = v[j] * r * gv[j] * gg[j] * sigmoidf_(gg[j]);
        v4u w; w.x = pk2(o[0], o[1]); w.y = pk2(o[2], o[3]); w.z = pk2(o[4], o[5]); w.w = pk2(o[6], o[7]);
        *(v4u*)(HG + off) = w;
    }
}

__device__ __forceinline__ int t5_bucket(int rel) {
    const int n = rel < 0 ? -rel : rel; const int base = rel > 0 ? 16 : 0;
    int v;
    if (n < 8) v = n; else v = n >= 91 ? 15 : n >= 64 ? 14 : n >= 46 ? 13 : n >= 32 ? 12 : n >= 23 ? 11 : n >= 16 ? 10 : n >= 12 ? 9 : 8;
    return base + v;
}
__device__ __forceinline__ void p3_attn_simple(Frame& F) {
    const bf16* CKV = (const bf16*)(F.ws + WS_CKV); bf16* QL = (bf16*)(F.ws + WS_QL);
    const unsigned long long* BMp = (const unsigned long long*)(F.ws + WS_BM);
    LAS float* relb = (LAS float*)(F.lds + 8 * 12800);
    LAS float* qlf = (LAS float*)(F.lds + F.wave * 12800);
    LAS float* pl = (LAS float*)(F.lds + F.wave * 12800 + 4096);
    LAS unsigned short* idx = (LAS unsigned short*)(F.lds + F.wave * 12800 + 4096 + 8192);
    if (F.tid < 256) relb[F.tid] = F.a->in[I_RELB][F.tid];
    __syncthreads();
    const int gw = blockIdx.x * NWAVES + F.wave, NGW = F.G * NWAVES, lane = F.lane;
    const unsigned long long lt_mask = (1ull << lane) - 1ull;
    for (int t = gw; t < T; t += NGW) {
        const int b = t >> 11, pos = t & 2047, nk = (pos >> 6) + 1;
        {
#pragma unroll
            for (int j = 0; j < 2; ++j) { const v4u p = *(const v4u*)(QL + (size_t)t * 1024 + j * 512 + lane * 8);
                f32x4 a = {bflo(p.x), bfhi(p.x), bflo(p.y), bfhi(p.y)}, c = {bflo(p.z), bfhi(p.z), bflo(p.w), bfhi(p.w)};
                *(LAS f32x4*)(qlf + j * 512 + lane * 8) = a; *(LAS f32x4*)(qlf + j * 512 + lane * 8 + 4) = c; }
        }
        int n = 0;
        for (int i = 0; i < nk; ++i) {
            const unsigned long long word = BMp[(size_t)t * 32 + i];
            if ((word >> lane) & 1ull) idx[n + __builtin_popcountll(word & lt_mask)] = (unsigned short)(i * 64 + lane);
            n += __builtin_popcountll(word);
        }
        LDS_WAIT(); asm volatile("" ::: "memory");
#pragma unroll 1
        for (int j = 0; j < 4; ++j) {
            const int k = lane + 64 * j; const bool ok = k < n; const int s = ok ? (int)idx[k] : 0;
            const v4u* row = (const v4u*)(CKV + ((size_t)b * SEQ + s) * 128);
            float d[8];
#pragma unroll
            for (int h = 0; h < 8; ++h) d[h] = 0.f;
#pragma unroll 1
            for (int q4 = 0; q4 < 4; ++q4) {
                asm volatile("" ::: "memory");
                float ck[32];
#pragma unroll
                for (int c = 0; c < 4; ++c) { const v4u p = row[q4 * 4 + c]; ck[c * 8 + 0] = bflo(p.x); ck[c * 8 + 1] = bfhi(p.x); ck[c * 8 + 2] = bflo(p.y); ck[c * 8 + 3] = bfhi(p.y); ck[c * 8 + 4] = bflo(p.z); ck[c * 8 + 5] = bfhi(p.z); ck[c * 8 + 6] = bflo(p.w); ck[c * 8 + 7] = bfhi(p.w); }
#pragma unroll
                for (int h = 0; h < 8; ++h) {
#pragma unroll
                    for (int c = 0; c < 8; ++c) { const f32x4 q = *(const LAS f32x4*)(qlf + h * 128 + q4 * 32 + c * 4); d[h] += q.x * ck[c * 4] + q.y * ck[c * 4 + 1] + q.z * ck[c * 4 + 2] + q.w * ck[c * 4 + 3]; }
                    __builtin_amdgcn_sched_barrier(0);
                }
            }
            const int bk = t5_bucket(s - pos);
            f32x4 s0, s1;
            s0.x = ok ? d[0] + relb[bk * 8 + 0] : -INFINITY; s0.y = ok ? d[1] + relb[bk * 8 + 1] : -INFINITY; s0.z = ok ? d[2] + relb[bk * 8 + 2] : -INFINITY; s0.w = ok ? d[3] + relb[bk * 8 + 3] : -INFINITY;
            s1.x = ok ? d[4] + relb[bk * 8 + 4] : -INFINITY; s1.y = ok ? d[5] + relb[bk * 8 + 5] : -INFINITY; s1.z = ok ? d[6] + relb[bk * 8 + 6] : -INFINITY; s1.w = ok ? d[7] + relb[bk * 8 + 7] : -INFINITY;
            *(LAS f32x4*)(pl + k * 8) = s0; *(LAS f32x4*)(pl + k * 8 + 4) = s1;
        }
        LDS_WAIT(); asm volatile("" ::: "memory");
        {
            f32x4 a0[4], a1[4];
#pragma unroll
            for (int j = 0; j < 4; ++j) { a0[j] = *(const LAS f32x4*)(pl + (lane + 64 * j) * 8); a1[j] = *(const LAS f32x4*)(pl + (lane + 64 * j) * 8 + 4); }
#pragma unroll
            for (int h = 0; h < 8; ++h) {
                float v[4];
#pragma unroll
                for (int j = 0; j < 4; ++j) v[j] = h < 4 ? a0[j][h & 3] : a1[j][h & 3];
                float m = wave_max(fmaxf(fmaxf(v[0], v[1]), fmaxf(v[2], v[3])));
                float sum = 0.f;
#pragma unroll
                for (int j = 0; j < 4; ++j) { v[j] = __expf(v[j] - m); sum += v[j]; }
                const float inv = 1.0f / wave_sum(sum);
#pragma unroll
                for (int j = 0; j < 4; ++j) { if (h < 4) a0[j][h & 3] = v[j] * inv; else a1[j][h & 3] = v[j] * inv; }
            }
#pragma unroll
            for (int j = 0; j < 4; ++j) { *(LAS f32x4*)(pl + (lane + 64 * j) * 8) = a0[j]; *(LAS f32x4*)(pl + (lane + 64 * j) * 8 + 4) = a1[j]; }
        }
        LDS_WAIT(); asm volatile("" ::: "memory");
        float acc[8][2];
#pragma unroll
        for (int h = 0; h < 8; ++h) { acc[h][0] = 0.f; acc[h][1] = 0.f; }
        for (int k = 0; k < n; ++k) {
            const int s = (int)idx[k];
            const unsigned vv = *(const unsigned*)(CKV + ((size_t)b * SEQ + s) * 128 + 2 * lane);
            const float v0 = bflo(vv), v1 = bfhi(vv);
            const f32x4 p0 = *(const LAS f32x4*)(pl + k * 8), p1 = *(const LAS f32x4*)(pl + k * 8 + 4);
            acc[0][0] += p0.x * v0; acc[0][1] += p0.x * v1; acc[1][0] += p0.y * v0; acc[1][1] += p0.y * v1;
            acc[2][0] += p0.z * v0; acc[2][1] += p0.z * v1; acc[3][0] += p0.w * v0; acc[3][1] += p0.w * v1;
            acc[4][0] += p1.x * v0; acc[4][1] += p1.x * v1; acc[5][0] += p1.y * v0; acc[5][1] += p1.y * v1;
            acc[6][0] += p1.z * v0; acc[6][1] += p1.z * v1; acc[7][0] += p1.w * v0; acc[7][1] += p1.w * v1;
        }
#pragma unroll
        for (int h = 0; h < 8; ++h) *(unsigned*)(QL + (size_t)t * 1024 + h * 128 + 2 * lane) = pk2(acc[h][0], acc[h][1]);
        LDS_WAIT(); asm volatile("" ::: "memory");
    }
}

__device__ __forceinline__ void p6_ln1(Frame& F) {
    float* Y = F.a->out; bf16* X1B = (bf16*)(F.ws + WS_X1B); const float* g = F.a->in[I_LN1G]; const float* bb = F.a->in[I_LN1B];
    const int gw = blockIdx.x * NWAVES + F.wave, NGW = F.G * NWAVES, lane = F.lane;
    f32x4 gv[4], bv[4];
#pragma unroll
    for (int j = 0; j < 4; ++j) { gv[j] = ((const f32x4*)g)[lane + 64 * j]; bv[j] = ((const f32x4*)bb)[lane + 64 * j]; }
    for (int m = gw; m < T; m += NGW) {
        f32x4* yr = (f32x4*)(Y + (size_t)m * DM) + lane;
        f32x4 v[4]; float s = 0.f;
#pragma unroll
        for (int j = 0; j < 4; ++j) { v[j] = yr[64 * j]; s += (v[j].x + v[j].y) + (v[j].z + v[j].w); }
        const float mean = wave_sum(s) * (1.f / DM); float s2 = 0.f;
#pragma unroll
        for (int j = 0; j < 4; ++j) { v[j] = v[j] - mean; s2 += (v[j].x * v[j].x + v[j].y * v[j].y) + (v[j].z * v[j].z + v[j].w * v[j].w); }
        const float rstd = rsqrtf(wave_sum(s2) * (1.f / DM) + LN_EPS);
        v2u* o8 = (v2u*)(X1B + (size_t)m * DM) + lane;
#pragma unroll
        for (int j = 0; j < 4; ++j) { const f32x4 o = v[j] * rstd * gv[j] + bv[j]; yr[64 * j] = o; v2u w; w.x = pk2(o.x, o.y); w.y = pk2(o.z, o.w); o8[64 * j] = w; }
    }
}

#define TOP16_INSERT(tv, ti, val, id) do { \
    _Pragma("unroll") for (int _j = 15; _j >= 1; --_j) { const bool _up = (val) > tv[_j - 1]; const bool _here = (val) > tv[_j]; \
        tv[_j] = _up ? tv[_j - 1] : (_here ? (val) : tv[_j]); ti[_j] = _up ? ti[_j - 1] : (_here ? (id) : ti[_j]); } \
    { const bool _h0 = (val) > tv[0]; tv[0] = _h0 ? (val) : tv[0]; ti[0] = _h0 ? (id) : ti[0]; } } while (0)
__device__ __forceinline__ void p8_peer_route_simple(Frame& F) {
    const bf16* PQ = (const bf16*)(F.ws + WS_PQ); int* IDS = (int*)(F.ws + WS_IDS); float* GATES = (float*)(F.ws + WS_GATES);
    LAS float* K1 = (LAS float*)(F.lds); LAS float* K2 = (LAS float*)(F.lds + 65536);
    for (int e = F.tid; e < 16384; e += NTHREADS) { K1[e] = F.a->in[I_SK1][e]; K2[e] = F.a->in[I_SK2][e]; }
    __syncthreads();
    const size_t gtid = (size_t)blockIdx.x * NTHREADS + F.tid, gthreads = (size_t)F.G * NTHREADS;
    for (size_t item = gtid; item < (size_t)T * 8; item += gthreads) {
        const size_t t = item >> 3; const int h = (int)(item & 7);
        float v1[16], v2[16]; int i1[16], i2[16];
#pragma unroll
        for (int half = 0; half < 2; ++half) {
            const v4u* qp = (const v4u*)(PQ + t * 2048 + h * 256 + half * 128);
            v4u q[16];
#pragma unroll
            for (int c = 0; c < 16; ++c) q[c] = qp[c];
            float tv[16]; int ti[16];
#pragma unroll
            for (int j = 0; j < 16; ++j) { tv[j] = -INFINITY; ti[j] = 0; }
            const LAS float* KK = half ? K2 : K1;
#pragma unroll 1
            for (int n = 0; n < 128; ++n) {
                float d = 0.f;
#pragma unroll
                for (int c = 0; c < 16; ++c) { const f32x4 ka = *(const LAS f32x4*)(KK + n * 128 + c * 8), kb = *(const LAS f32x4*)(KK + n * 128 + c * 8 + 4);
                    d += ka.x * bflo(q[c].x) + ka.y * bfhi(q[c].x) + ka.z * bflo(q[c].y) + ka.w * bfhi(q[c].y) + kb.x * bflo(q[c].z) + kb.y * bfhi(q[c].z) + kb.z * bflo(q[c].w) + kb.w * bfhi(q[c].w);
                    if ((c & 3) == 3) __builtin_amdgcn_sched_barrier(0); }
                TOP16_INSERT(tv, ti, d, n);
            }
#pragma unroll
            for (int j = 0; j < 16; ++j) { if (half) { v2[j] = tv[j]; i2[j] = ti[j]; } else { v1[j] = tv[j]; i1[j] = ti[j]; } }
        }
        float tv[16]; int ti[16];
#pragma unroll
        for (int j = 0; j < 16; ++j) { tv[j] = -INFINITY; ti[j] = 0; }
#pragma unroll
        for (int a = 0; a < 16; ++a)
#pragma unroll
            for (int c = 0; c < 16; ++c)
                if ((a + 1) * (c + 1) <= 16) { const float val = v1[a] + v2[c]; const int id = i1[a] * 128 + i2[c]; TOP16_INSERT(tv, ti, val, id); }
        float ev[16], sum = 0.f;
#pragma unroll
        for (int j = 0; j < 16; ++j) { ev[j] = __expf(tv[j] - tv[0]); sum += ev[j]; }
        const float inv = 1.0f / sum;
#pragma unroll
        for (int j4 = 0; j4 < 4; ++j4) {
            *(int4*)(IDS + t * 128 + h * 16 + j4 * 4) = make_int4(ti[j4 * 4], ti[j4 * 4 + 1], ti[j4 * 4 + 2], ti[j4 * 4 + 3]);
            *(f32x4*)(GATES + t * 128 + h * 16 + j4 * 4) = (f32x4){ev[j4 * 4] * inv, ev[j4 * 4 + 1] * inv, ev[j4 * 4 + 2] * inv, ev[j4 * 4 + 3] * inv};
        }
    }
}

__device__ __forceinline__ void p9_peer_gather_simple(Frame& F) {
    float* X1 = F.a->out; const bf16* UT = (const bf16*)(F.ws + WS_UT); const bf16* VT = (const bf16*)(F.ws + WS_VT);
    const int* IDS = (const int*)(F.ws + WS_IDS); const float* GATES = (const float*)(F.ws + WS_GATES);
    const float* g = F.a->in[I_LN2G]; const float* bb = F.a->in[I_LN2B];
    const int gw = blockIdx.x * NWAVES + F.wave, NGW = F.G * NWAVES, lane = F.lane;
    f32x4 gv[4], bv[4];
#pragma unroll
    for (int j = 0; j < 4; ++j) { gv[j] = ((const f32x4*)g)[lane + 64 * j]; bv[j] = ((const f32x4*)bb)[lane + 64 * j]; }
    for (int t = gw; t < T; t += NGW) {
        f32x4* xr = (f32x4*)(X1 + (size_t)t * DM) + lane;
        f32x4 x[4], acc[4];
#pragma unroll
        for (int j = 0; j < 4; ++j) { x[j] = xr[64 * j]; acc[j] = (f32x4){0.f, 0.f, 0.f, 0.f}; }
        const int myid = IDS[(size_t)t * 128 + lane], myid2 = IDS[(size_t)t * 128 + 64 + lane];
        const float myg = GATES[(size_t)t * 128 + lane], myg2 = GATES[(size_t)t * 128 + 64 + lane];
        for (int k0 = 0; k0 < 128; k0 += 4) {
            float gt[4]; v2u uu[4][4], vv[4][4];
#pragma unroll
            for (int e = 0; e < 4; ++e) { const int k = k0 + e;
                const int id = __shfl(k0 < 64 ? myid : myid2, k & 63); gt[e] = __shfl(k0 < 64 ? myg : myg2, k & 63);
                const v2u* up = (const v2u*)(UT + (size_t)id * DM) + lane; const v2u* vp = (const v2u*)(VT + (size_t)id * DM) + lane;
#pragma unroll
                for (int j = 0; j < 4; ++j) { uu[e][j] = up[64 * j]; vv[e][j] = vp[64 * j]; } }
#pragma unroll
            for (int e = 0; e < 4; ++e) {
                float d = 0.f;
#pragma unroll
                for (int j = 0; j < 4; ++j) d += x[j].x * bflo(uu[e][j].x) + x[j].y * bfhi(uu[e][j].x) + x[j].z * bflo(uu[e][j].y) + x[j].w * bfhi(uu[e][j].y);
                d = wave_sum(d);
                const float hv = 0.5f * d * (1.0f + erff(d * 0.7071067811865476f));
                const float w = gt[e] * hv;
#pragma unroll
                for (int j = 0; j < 4; ++j) { acc[j].x += w * bflo(vv[e][j].x); acc[j].y += w * bfhi(vv[e][j].x); acc[j].z += w * bflo(vv[e][j].y); acc[j].w += w * bfhi(vv[e][j].y); }
            }
        }
        float s = 0.f;
#pragma unroll
        for (int j = 0; j < 4; ++j) { acc[j] = x[j] * ALPHA + acc[j]; s += (acc[j].x + acc[j].y) + (acc[j].z + acc[j].w); }
        const float mean = wave_sum(s) * (1.f / DM); float s2 = 0.f;
#pragma unroll
        for (int j = 0; j < 4; ++j) { acc[j] = acc[j] - mean; s2 += (acc[j].x * acc[j].x + acc[j].y * acc[j].y) + (acc[j].z * acc[j].z + acc[j].w * acc[j].w); }
        const float rstd = rsqrtf(wave_sum(s2) * (1.f / DM) + LN_EPS);
#pragma unroll
        for (int j = 0; j < 4; ++j) xr[64 * j] = acc[j] * rstd * gv[j] + bv[j];
    }
}

__global__ void __launch_bounds__(NTHREADS, 2) hybrid_fwd(Args args) {
    extern __shared__ __attribute__((aligned(16))) unsigned char lds[];
    Frame F;
    F.lds = (LAS unsigned char*)lds;
    F.tid = threadIdx.x; F.lane = F.tid & 63; F.wave = __builtin_amdgcn_readfirstlane(F.tid >> 6);
    F.G = gridDim.x; F.a = (KArgs)__builtin_amdgcn_kernarg_segment_ptr(); F.ws = args.ws;
#define FRESH() do { int _t = threadIdx.x; asm volatile("" : "+v"(_t)); F.tid = _t; F.lane = _t & 63; F.wave = __builtin_amdgcn_readfirstlane(_t >> 6); \
        KArgs _k = (KArgs)__builtin_amdgcn_kernarg_segment_ptr(); asm volatile("" : "+s"(_k)); F.a = _k; F.ws = _k->ws; } while (0)
    volatile LAS unsigned* MISC = (volatile LAS unsigned*)(F.lds + MISC_OFF);
    for (int u = F.tid; u < (LDS_BYTES - LDSCTL_OFF) / 4; u += NTHREADS) ((LAS unsigned*)(F.lds + LDSCTL_OFF))[u] = 0u;
    __syncthreads();
    const int lo = args.ph_lo, hi = args.ph_hi;
    const bool need_bar = (hi - lo) > 1;
    XcdBarrier bar; bar.bar = (unsigned*)(args.ws + WS_CTL) + CW_BAR + args.li * XCD_BAR_WORDS; bar.x = 0; bar.st = nullptr;
    if (need_bar) bar = xcd_barrier_post(bar.bar, MISC + 8);
#if defined(PHASE_MASK)
#define IN(k) (((PHASE_MASK >> (k)) & 1) && lo <= (k) && (k) < hi)
#elif defined(ONLY_PHASE)
#define IN(k) ((k) == ONLY_PHASE && lo <= (k) && (k) < hi)
#else
#define IN(k) (lo <= (k) && (k) < hi)
#endif
#define SEAM(k) do { if (IN(k) && IN((k) + 1)) xcd_barrier(bar); } while (0)
    LAS unsigned char* ring = F.lds;

    if (IN(0)) { FRESH(); p0_prologue(F); }
    SEAM(0);
    if (IN(1)) {
        FRESH();
        pg8::Gemm g{(const bf16*)(F.ws + WS_XB), (const bf16*)(F.ws + WS_WIN), T, NPROJ, 1024}; pg8::StaticOrder S; S.init(T, NPROJ, F.G, (int)blockIdx.x);
        EpiProj E{F.ws};
        pg8::gemm_phase<EpiProj, pg8::StaticOrder>(ring, g, S, E, F.tid);
    }
    SEAM(1);
    if (IN(2)) {
        FRESH();
#if !defined(P2SEL) || (P2SEL & 1)
        p2_ckv_norm(F);
#endif
#if !defined(P2SEL) || (P2SEL & 2)
        p2_hgrn_simple(F);
#endif
        __syncthreads();
        FRESH();
#if !defined(P2SEL) || (P2SEL & 4)
        p2_indexer_simple(F);
#endif
    }
    SEAM(2);
    if (IN(3)) { FRESH(); p3_hg_finalize(F); __syncthreads(); p3_attn_simple(F); }
    SEAM(3);
    if (IN(4)) {
        FRESH();
        { pg8::Gemm g{(const bf16*)(F.ws + WS_QL), (const bf16*)(F.ws + WS_WA), T, 1024, 1024}; pg8::StaticOrder S; S.init(T, 1024, F.G, (int)blockIdx.x);
          EpiBranch<0> E{(const bf16*)(F.ws + WS_GA), (bf16*)(F.ws + WS_MERGED)};
          pg8::gemm_phase<EpiBranch<0>, pg8::StaticOrder>(ring, g, S, E, F.tid); }
        FRESH();
        { pg8::Gemm g{(const bf16*)(F.ws + WS_IB), (const bf16*)(F.ws + WS_WB), T, 1024, 512}; pg8::StaticOrder S; S.init(T, 1024, F.G, (int)blockIdx.x);
          EpiBranch<1> E{(const bf16*)(F.ws + WS_GBT), (bf16*)(F.ws + WS_MERGED)};
          pg8::gemm_phase<EpiBranch<1>, pg8::StaticOrder>(ring, g, S, E, F.tid); }
    }
    SEAM(4);
    if (IN(5)) {
        FRESH();
        pg8::Gemm g{(const bf16*)(F.ws + WS_MERGED), (const bf16*)(F.ws + WS_WO), T, 1024, 1024}; pg8::StaticOrder S; S.init(T, 1024, F.G, (int)blockIdx.x);
        EpiResF32 E{F.a->in[I_X], F.a->out};
        pg8::gemm_phase<EpiResF32, pg8::StaticOrder>(ring, g, S, E, F.tid);
    }
    SEAM(5);
    if (IN(6)) { FRESH(); p6_ln1(F); }
    SEAM(6);
    if (IN(7)) {
        FRESH();
        pg8::Gemm g{(const bf16*)(F.ws + WS_X1B), (const bf16*)(F.ws + WS_WPQ), T, 2048, 1024}; pg8::StaticOrder S; S.init(T, 2048, F.G, (int)blockIdx.x);
        EpiPlainBf16 E{(bf16*)(F.ws + WS_PQ), 2048};
        pg8::gemm_phase<EpiPlainBf16, pg8::StaticOrder>(ring, g, S, E, F.tid);
    }
    SEAM(7);
    if (IN(8)) { FRESH(); p8_peer_route_simple(F); }
    SEAM(8);
    if (IN(9)) { FRESH(); p9_peer_gather_simple(F); }
#undef IN
#undef SEAM
}

extern "C" void kernel_launch(void* const* d_in, const int* in_sizes, int n_in, void* d_out, int out_size, void* d_ws, size_t ws_size, hipStream_t stream) {
    static int grid = 0;
    if (grid == 0) {
        if (n_in != 20 || out_size != T * DM || ws_size < WS_END) { fprintf(stderr, "kernel_launch: unexpected problem (n_in %d out %d ws %zu)\n", n_in, out_size, ws_size); grid = -1; return; }
        int dev = 0, cus = 0;
        if (hipGetDevice(&dev) != hipSuccess || hipDeviceGetAttribute(&cus, hipDeviceAttributeMultiprocessorCount, dev) != hipSuccess) { grid = -1; return; }
        if (hipFuncSetAttribute((const void*)hybrid_fwd, hipFuncAttributeMaxDynamicSharedMemorySize, LDS_BYTES) != hipSuccess) { fprintf(stderr, "kernel_launch: hipFuncSetAttribute failed\n"); grid = -1; return; }
        int per_cu = 0;
        if (hipOccupancyMaxActiveBlocksPerMultiprocessor(&per_cu, (const void*)hybrid_fwd, NTHREADS, LDS_BYTES) != hipSuccess || per_cu < 1) fprintf(stderr, "kernel_launch: occupancy query reports %d\n", per_cu);
        (void)hipGetLastError();
        grid = cus;
    }
    if (grid < 0) return;
    (void)hipMemsetAsync((char*)d_ws + WS_CTL, 0, CTL_ZERO_BYTES, stream);
    Args a{};
    for (int i = 0; i < 20; ++i) a.in[i] = (const float*)d_in[i];
    a.out = (float*)d_out; a.ws = (unsigned char*)d_ws;
    constexpr int NL = MK_N_LAUNCHES;
    for (int li = 0; li < NL; ++li) {
        a.ph_lo = (NL == 1) ? 0 : li; a.ph_hi = (NL == 1) ? N_PHASES : li + 1; a.li = li;
        hipLaunchKernelGGL(hybrid_fwd, dim3(grid), dim3(NTHREADS), LDS_BYTES, stream, a);
    }
}
```

```cpp
#include <hip/hip_runtime.h>
#include <cstdio>
#include <cstdint>

#ifndef MK_N_LAUNCHES
#define MK_N_LAUNCHES 1
#endif

namespace pg8 {
#define PG8_LAS __attribute__((address_space(3)))
typedef unsigned short bf16_t;
typedef short bf16x8 __attribute__((ext_vector_type(8)));
typedef float f32x4 __attribute__((ext_vector_type(4)));
typedef unsigned u32x4 __attribute__((ext_vector_type(4)));
constexpr int BM = 256, BK = 64, HALF = 128, HTB = HALF * BK * 2, STAGE_BYTES = 8 * HTB, NXCD = 8, WGM = 8;

__host__ __device__ __forceinline__ int lds_byte(int r, int c) { const int st = (r >> 4) * 2 + (c >> 5), rr = r & 15, cc = c & 31, ob = rr * 64 + cc * 2; return st * 1024 + (ob ^ (((ob >> 9) & 1) << 5)); }
__host__ __device__ __forceinline__ void stage_rc(int b, int& R, int& C) { const int st = b / 1024, sb = b % 1024, swz = sb ^ (((sb >> 9) & 1) << 5); R = (st >> 1) * 16 + swz / 64; C = (st & 1) * 32 + (swz % 64) / 2; }
__host__ __device__ __forceinline__ int perm32(int rho) { const int n = rho >> 4, i = rho & 15; return 8 * (i >> 2) + 4 * n + (i & 3); }

struct Unit { int pm, pn; };
struct Gemm { const bf16_t* A; const bf16_t* Bt; int M, N, K; };

struct StaticOrder {
    int nM, nN, nwg, G, c;
    __host__ __device__ void init(int M, int N, int G_, int c_) { nM = M / BM; nN = N / BM; nwg = nM * nN; G = G_; c = c_; }
    __host__ __device__ bool next(int i, Unit& u) const {
        const long L = (long)i * G + c; if (L >= nwg) return false;
        int wgid = (int)L; { const int q = nwg / NXCD, r = nwg % NXCD, xcd = wgid % NXCD, off = wgid / NXCD; wgid = (xcd < r ? xcd * (q + 1) : r * (q + 1) + (xcd - r) * q) + off; }
        const int nig = WGM * nN, gid = wgid / nig, fm = gid * WGM, gsz = (nM - fm) < WGM ? (nM - fm) : WGM;
        u.pm = fm + ((wgid % nig) % gsz); u.pn = (wgid % nig) / gsz; return true;
    }
    __device__ __forceinline__ void a_ready(const Unit&) const {}
    __device__ __forceinline__ void done(const Unit&) const {}
};

__device__ __forceinline__ unsigned cvt_pk_bf16(float lo, float hi) { unsigned r; asm volatile("v_cvt_pk_bf16_f32 %0, %1, %2" : "=v"(r) : "v"(lo), "v"(hi)); return r; }

template <class Epi, class Sched>
__device__ __forceinline__ void gemm_phase(PG8_LAS unsigned char* lds, const Gemm g, const Sched& S, const Epi& E, const int tid) {
    const int wid = __builtin_amdgcn_readfirstlane(tid >> 6), lane = tid & 63, wr = wid >> 2, wc = wid & 3, fr = lane & 15, fq = lane >> 4;
    const int K = g.K, nt = K / BK;
    unsigned voffA[2], voffB[2];
#pragma unroll
    for (int i = 0; i < 2; ++i) { int R, C; stage_rc(tid * 16 + i * 8192, R, C); const int Rb = Epi::PERM ? ((R & ~31) + perm32(R & 31)) : R;
        voffA[i] = (unsigned)(R * K + C) * 2u; voffB[i] = (unsigned)(Rb * K + C) * 2u; }
    const size_t kstep = (size_t)(BK * 2);
    const size_t hstep = (size_t)HALF * K * 2;
    const size_t tstep = 2 * hstep;
    const unsigned ldsw = (unsigned)wid * 1024u;
    const int aoff = lds_byte(wr * 64 + fr, fq * 8), boff = lds_byte(wc * 32 + fr, fq * 8);
#define PG8_SA(b, h) (((b) * 2 + (h)) * HTB)
#define PG8_SB(b, h) ((4 + (b) * 2 + (h)) * HTB)
#define PG8_STAGE(bufoff, gbase, voff) do { _Pragma("unroll") for (int _i = 0; _i < 2; ++_i) \
        __builtin_amdgcn_global_load_lds((const unsigned*)((const char*)(gbase) + (voff)[_i]), (PG8_LAS unsigned*)(lds + (bufoff) + ldsw + _i * 8192), 16, 0, 0); } while (0)
#define PG8_LDA(dst, b, h) do { _Pragma("unroll") for (int m = 0; m < 4; ++m) _Pragma("unroll") for (int k = 0; k < 2; ++k) dst[m][k] = *(const PG8_LAS bf16x8*)(lds + PG8_SA(b, h) + aoff + m * 2048 + k * 1024); } while (0)
#define PG8_LDB(dst, b, h) do { _Pragma("unroll") for (int n = 0; n < 2; ++n) _Pragma("unroll") for (int k = 0; k < 2; ++k) dst[n][k] = *(const PG8_LAS bf16x8*)(lds + PG8_SB(b, h) + boff + n * 2048 + k * 1024); } while (0)
#define PG8_MMA(ai, bj, At, Bt) do { __builtin_amdgcn_s_setprio(1); _Pragma("unroll") for (int m = 0; m < 4; ++m) _Pragma("unroll") for (int n = 0; n < 2; ++n) _Pragma("unroll") for (int k = 0; k < 2; ++k) \
        acc[ai][bj][m][n] = __builtin_amdgcn_mfma_f32_16x16x32_bf16(Bt[n][k], At[m][k], acc[ai][bj][m][n], 0, 0, 0); __builtin_amdgcn_s_setprio(0); } while (0)
#define PG8_WAIT_V(n) asm volatile("s_waitcnt vmcnt(" #n ")" ::: "memory")
#define PG8_WAIT_L(n) asm volatile("s_waitcnt lgkmcnt(" #n ")" ::: "memory")
#define PG8_BAR __builtin_amdgcn_s_barrier()
#define PG8_SCHED __builtin_amdgcn_sched_barrier(0)
    Unit cur, nxt; int ui = 0;
    if (!S.next(0, cur)) return;
    f32x4 acc[2][2][4][2];
#pragma unroll
    for (int a = 0; a < 2; ++a)
#pragma unroll
        for (int b = 0; b < 2; ++b)
#pragma unroll
            for (int m = 0; m < 4; ++m)
#pragma unroll
                for (int n = 0; n < 2; ++n) acc[a][b][m][n] = (f32x4){0.f, 0.f, 0.f, 0.f};
    bf16x8 At[4][2], B0[2][2], B1[2][2];
    const char* cA = (const char*)g.A + (size_t)cur.pm * tstep; const char* cB = (const char*)g.Bt + (size_t)cur.pn * tstep;
    S.a_ready(cur);
    PG8_STAGE(PG8_SB(0, 0), cB, voffB); PG8_STAGE(PG8_SA(0, 0), cA, voffA); PG8_STAGE(PG8_SB(0, 1), cB + hstep, voffB); PG8_STAGE(PG8_SA(0, 1), cA + hstep, voffA);
    if (wr == 1) PG8_BAR;
    PG8_WAIT_V(4); PG8_BAR;
    PG8_STAGE(PG8_SB(1, 0), cB + kstep, voffB); PG8_STAGE(PG8_SA(1, 0), cA + kstep, voffA); PG8_STAGE(PG8_SB(1, 1), cB + hstep + kstep, voffB);
    PG8_WAIT_V(6); PG8_BAR;
    for (;;) {
        const bool has_next = S.next(ui + 1, nxt);
        const char* nA = has_next ? (const char*)g.A + (size_t)nxt.pm * tstep : cA; const char* nB = has_next ? (const char*)g.Bt + (size_t)nxt.pn * tstep : cB;
        for (int t = 0; t < nt; t += 2) {
            const bool last = (t == nt - 2);
            const char* a1 = cA + (size_t)(t + 1) * kstep;
            const char* a2 = last ? nA : cA + (size_t)(t + 2) * kstep; const char* b2 = last ? nB : cB + (size_t)(t + 2) * kstep;
            const char* a3 = a2 + kstep; const char* b3 = b2 + kstep;
            if (last && has_next) S.a_ready(nxt);
            PG8_LDB(B0, 0, 0); PG8_SCHED; PG8_LDA(At, 0, 0); PG8_STAGE(PG8_SA(1, 1), a1 + hstep, voffA);
            PG8_WAIT_L(8); PG8_BAR; PG8_WAIT_L(0); PG8_MMA(0, 0, At, B0); PG8_BAR; PG8_SCHED;
            PG8_LDB(B1, 0, 1); PG8_STAGE(PG8_SB(0, 0), b2, voffB);
            PG8_BAR; PG8_WAIT_L(0); PG8_MMA(0, 1, At, B1); PG8_BAR;
            PG8_LDA(At, 0, 1); PG8_STAGE(PG8_SA(0, 0), a2, voffA);
            PG8_BAR; PG8_WAIT_L(0); PG8_MMA(1, 0, At, B0); PG8_BAR; PG8_SCHED;
            PG8_STAGE(PG8_SB(0, 1), b2 + hstep, voffB);
            PG8_WAIT_V(6); PG8_BAR; PG8_MMA(1, 1, At, B1); PG8_BAR;
            PG8_LDB(B0, 1, 0); PG8_SCHED; PG8_LDA(At, 1, 0); PG8_STAGE(PG8_SA(0, 1), a2 + hstep, voffA);
            PG8_WAIT_L(8); PG8_BAR; PG8_WAIT_L(0); PG8_MMA(0, 0, At, B0); PG8_BAR; PG8_SCHED;
            PG8_LDB(B1, 1, 1); PG8_STAGE(PG8_SB(1, 0), b3, voffB);
            PG8_BAR; PG8_WAIT_L(0); PG8_MMA(0, 1, At, B1); PG8_BAR;
            PG8_LDA(At, 1, 1); PG8_STAGE(PG8_SA(1, 0), a3, voffA);
            PG8_BAR; PG8_WAIT_L(0); PG8_MMA(1, 0, At, B0); PG8_BAR; PG8_SCHED;
            PG8_STAGE(PG8_SB(1, 1), b3 + hstep, voffB);
            PG8_WAIT_V(6); PG8_BAR; PG8_MMA(1, 1, At, B1); PG8_BAR;
        }
        E(acc, cur, wr, wc, fr, fq); S.done(cur);
        if (!has_next) break;
#pragma unroll
        for (int a = 0; a < 2; ++a)
#pragma unroll
            for (int b = 0; b < 2; ++b)
#pragma unroll
                for (int m = 0; m < 4; ++m)
#pragma unroll
                    for (int n = 0; n < 2; ++n) acc[a][b][m][n] = (f32x4){0.f, 0.f, 0.f, 0.f};
        cur = nxt; cA = nA; cB = nB; ++ui;
    }
    PG8_WAIT_V(0);
    if (wr == 0) PG8_BAR;
    PG8_BAR;
#undef PG8_SA
#undef PG8_SB
#undef PG8_STAGE
#undef PG8_LDA
#undef PG8_LDB
#undef PG8_MMA
#undef PG8_WAIT_V
#undef PG8_WAIT_L
#undef PG8_BAR
#undef PG8_SCHED
}
}

constexpr int NWAVES = 8, NTHREADS = 512;
constexpr int NB = 32, SEQ = 2048, DM = 1024, T = NB * SEQ;
constexpr int IN_COLS = 5320, NPROJ = 5888;
constexpr int N_PHASES = 10;
constexpr float ALPHA = 1.189207115002721f;
constexpr float LN_EPS = 1e-5f, RMS_EPS = 1e-6f;

constexpr size_t MiB = 1u << 20;
constexpr size_t WS_CTL = 0, CTL_ZERO_BYTES = 1 * MiB;
constexpr size_t WS_WIN = 1 * MiB, WS_WA = 13 * MiB, WS_WB = 15 * MiB, WS_WO = 16 * MiB, WS_WPQ = 18 * MiB;
constexpr size_t WS_UT = 24 * MiB, WS_VT = 56 * MiB;
constexpr size_t WS_XB = 88 * MiB;
constexpr size_t WS_QL = 216 * MiB;
constexpr size_t WS_MISC = 344 * MiB;
constexpr size_t WS_CKV = 376 * MiB;
constexpr size_t WS_QI = 392 * MiB, WS_QB = 456 * MiB, WS_FB = 520 * MiB, WS_IB = 584 * MiB, WS_GB = 648 * MiB;
constexpr size_t WS_GA = 712 * MiB, WS_GBT = 840 * MiB;
constexpr size_t WS_BM = 968 * MiB;
constexpr size_t WS_END = 984 * MiB;
constexpr size_t WS_MERGED = WS_XB, WS_X1B = WS_QL, WS_PQ = WS_QI, WS_IDS = WS_GB, WS_GATES = WS_GB + 32 * MiB;
constexpr int CW_BAR = 4096;

constexpr int RING_BYTES = 131072;
constexpr int LDSCTL_OFF = RING_BYTES, MISC_OFF = LDSCTL_OFF + 320;
constexpr int LDS_BYTES = 147456;

#define GAS __attribute__((address_space(1)))
#define LAS __attribute__((address_space(3)))
typedef unsigned short bf16;
typedef unsigned v4u __attribute__((ext_vector_type(4)));
typedef unsigned v2u __attribute__((ext_vector_type(2)));
typedef float f32x4 __attribute__((ext_vector_type(4)));
typedef float f32x2 __attribute__((ext_vector_type(2)));
typedef GAS unsigned gu32;
#define RLX_AGENT __ATOMIC_RELAXED, __HIP_MEMORY_SCOPE_AGENT
#define LDS_WAIT() asm volatile("s_waitcnt lgkmcnt(0)" ::: "memory")
#define VM_WAIT() asm volatile("s_waitcnt vmcnt(0)" ::: "memory")
__device__ __forceinline__ unsigned pk2(float lo, float hi) { return pg8::cvt_pk_bf16(lo, hi); }
__device__ __forceinline__ float bflo(unsigned u) { return __uint_as_float(u << 16); }
__device__ __forceinline__ float bfhi(unsigned u) { return __uint_as_float(u & 0xffff0000u); }
__device__ __forceinline__ float bf2f(bf16 b) { return __uint_as_float(((unsigned)b) << 16); }
__device__ __forceinline__ float sigmoidf_(float x) { return 1.0f / (1.0f + __expf(-x)); }

#define XB_TMO      128
#define XB_XCNT(j)  (256  + 64 * (j))
#define XB_XSUB(j)  (1280 + 64 * (j))
#define XB_XGEN(j)  (2304 + 64 * (j))
#define XB_TOP      3328
#define XB_TOPGEN   3392
#define XCD_BAR_WORDS 3456
#define XB_SPIN_CAP (1u << 22)
__device__ __forceinline__ unsigned xb_ld(unsigned* p)              { return __hip_atomic_load(p, __ATOMIC_RELAXED, __HIP_MEMORY_SCOPE_AGENT); }
__device__ __forceinline__ unsigned xb_add(unsigned* p, unsigned v) { return __hip_atomic_fetch_add(p, v, __ATOMIC_RELAXED, __HIP_MEMORY_SCOPE_AGENT); }
__device__ __forceinline__ unsigned xb_xcc_id() { return (unsigned)__builtin_amdgcn_s_getreg((3 << 11) | 20) & 0xFu; }
#define XB_SPIN(cond, bar) do { unsigned _sp = 0; while (cond) { __builtin_amdgcn_s_sleep(1); \
    if ((++_sp & 255u) == 0u) { if (xb_ld(&(bar)[XB_TMO])) break; if (_sp > XB_SPIN_CAP) { atomicAdd(&(bar)[XB_TMO], 1u); break; } } } } while (0)
struct XcdBarrier { unsigned* bar; unsigned x; volatile LAS unsigned* st; };
__device__ __forceinline__ XcdBarrier xcd_barrier_post(unsigned* bar, volatile LAS unsigned* st) {
    XcdBarrier b; b.bar = bar; b.x = xb_xcc_id(); b.st = st;
    if (threadIdx.x == 0) (void)xb_add(&bar[XB_XCNT(b.x)], 1u);
    return b;
}
__device__ __forceinline__ void xcd_barrier_complete(unsigned* bar, unsigned x, unsigned& nloc, unsigned& nx) {
    const unsigned G = gridDim.x * gridDim.y * gridDim.z;
    unsigned sum, cnt, mine, sp = 0u;
    for (;;) {
        sum = 0u; cnt = 0u; mine = 0u;
#pragma unroll
        for (unsigned j = 0; j < 16; ++j) { const unsigned c = xb_ld(&bar[XB_XCNT(j)]); sum += c; cnt += (c > 0u) ? 1u : 0u; mine = (j == x) ? c : mine; }
        if (sum == G) break;
        __builtin_amdgcn_s_sleep(1);
        if ((++sp & 255u) == 0u) { if (xb_ld(&bar[XB_TMO])) break; if (sp > XB_SPIN_CAP) { atomicAdd(&bar[XB_TMO], 1u); break; } }
    }
    nloc = mine > 0u ? mine : 1u; nx = cnt > 0u ? cnt : 1u;
}
__device__ __forceinline__ void xcd_barrier(const XcdBarrier& b) {
    asm volatile("s_waitcnt vmcnt(0)" ::: "memory");
    __syncthreads();
    if (threadIdx.x == 0) {
        unsigned* bar = b.bar;
        __builtin_amdgcn_s_waitcnt(0);
        unsigned nloc = b.st[0], nx = b.st[1];
        if (nloc == 0u) { xcd_barrier_complete(bar, b.x, nloc, nx); b.st[0] = nloc; b.st[1] = nx; }
        const unsigned old = xb_add(&bar[XB_XSUB(b.x)], 1u);
        const unsigned gen = old / nloc;
        if (old + 1u == (gen + 1u) * nloc) {
            __builtin_amdgcn_fence(__ATOMIC_RELEASE, "agent");
            asm volatile("s_waitcnt vmcnt(0)" ::: "memory");
            const unsigned og = xb_add(&bar[XB_TOP], 1u);
            const unsigned tg = og / nx;
            if (og + 1u == (tg + 1u) * nx) xb_add(&bar[XB_TOPGEN], 1u);
            else XB_SPIN(xb_ld(&bar[XB_TOPGEN]) == tg, bar);
            __builtin_amdgcn_fence(__ATOMIC_ACQUIRE, "agent");
            xb_add(&bar[XB_XGEN(b.x)], 1u);
            asm volatile("s_waitcnt vmcnt(0)" ::: "memory");
        } else {
            XB_SPIN(xb_ld(&bar[XB_XGEN(b.x)]) == gen, bar);
            __builtin_amdgcn_fence(__ATOMIC_ACQUIRE, "agent");
            asm volatile("s_waitcnt vmcnt(0)" ::: "memory");
        }
    }
    __syncthreads();
}

struct Args { const float* in[20]; float* out; unsigned char* ws; int ph_lo, ph_hi, li, pad; };
enum { I_X = 0, I_WIN, I_KVG, I_WUK, I_WUV, I_RELB, I_LBP, I_BNG, I_WBRA, I_WBRB, I_WO, I_LN1G, I_LN1B, I_WPQ, I_SK1, I_SK2, I_UT, I_VT, I_LN2G, I_LN2B };

typedef const __attribute__((address_space(4))) Args* KArgs;
struct Frame {
    LAS unsigned char* lds;
    int tid, lane, wave, G;
    KArgs a;
    unsigned char* ws;
};

__device__ __forceinline__ float wave_sum(float v) {
#pragma unroll
    for (int o = 1; o < 64; o <<= 1) v += __shfl_xor(v, o);
    return v;
}
__device__ __forceinline__ float wave_max(float v) {
#pragma unroll
    for (int o = 1; o < 64; o <<= 1) v = fmaxf(v, __shfl_xor(v, o));
    return v;
}

__device__ __forceinline__ void cvt_bf16_stream(const float* src, bf16* dst, size_t n8, size_t gtid, size_t gthreads) {
    for (size_t i = gtid; i < n8; i += gthreads) {
        const f32x4 a = ((const f32x4*)src)[2 * i], b = ((const f32x4*)src)[2 * i + 1];
        v4u o; o.x = pk2(a.x, a.y); o.y = pk2(a.z, a.w); o.z = pk2(b.x, b.y); o.w = pk2(b.z, b.w);
        ((v4u*)dst)[i] = o;
    }
}
__device__ __forceinline__ void transpose_item(const float* W, int ldw, int K, int c0, int nvalid, bf16* WT, int r0, int k0, LAS float* scr, int lane) {
#pragma unroll 8
    for (int i = 0; i < 32; ++i) { const int kk = 2 * i + (lane >> 5), n = lane & 31; scr[kk * 33 + n] = (n < nvalid) ? W[(size_t)(k0 + kk) * ldw + c0 + n] : 0.f; }
    LDS_WAIT(); asm volatile("" ::: "memory");
    const int c = lane & 7;
#pragma unroll
    for (int j = 0; j < 4; ++j) { const int n = (lane >> 3) + 8 * j; const LAS float* s = scr + (8 * c) * 33 + n;
        v4u o; o.x = pk2(s[0 * 33], s[1 * 33]); o.y = pk2(s[2 * 33], s[3 * 33]); o.z = pk2(s[4 * 33], s[5 * 33]); o.w = pk2(s[6 * 33], s[7 * 33]);
        *(v4u*)(WT + (size_t)(r0 + n) * K + k0 + 8 * c) = o; }
    LDS_WAIT(); asm volatile("" ::: "memory");
}
__device__ __forceinline__ void win_block(int cb, int& c0, int& r0, int& nv) {
    nv = 32;
    if (cb < 4)        { c0 = 512 + 32 * cb;          r0 = 1024 + 32 * cb; }
    else if (cb < 6)   { c0 = 1152 + 32 * (cb - 4);   r0 = 1152 + 32 * (cb - 4); }
    else if (cb == 6)  { c0 = 1216;                   r0 = 1216; nv = 8; }
    else if (cb == 7)  { c0 = 0;                      r0 = 1248; nv = 0; }
    else if (cb < 24)  { c0 = 640 + 32 * (cb - 8);    r0 = 1280 + 32 * (cb - 8); }
    else if (cb < 40)  { c0 = 1224 + 32 * (cb - 24);  r0 = 1792 + 32 * (cb - 24); }
    else if (cb < 56)  { c0 = 1736 + 32 * (cb - 40);  r0 = 2304 + 32 * (cb - 40); }
    else if (cb < 72)  { c0 = 2248 + 32 * (cb - 56);  r0 = 2816 + 32 * (cb - 56); }
    else if (cb < 88)  { c0 = 2760 + 32 * (cb - 72);  r0 = 3328 + 32 * (cb - 72); }
    else if (cb < 120) { c0 = 3272 + 32 * (cb - 88);  r0 = 3840 + 32 * (cb - 88); }
    else               { c0 = 4296 + 32 * (cb - 120); r0 = 4864 + 32 * (cb - 120); }
}
__device__ __forceinline__ void p0_prologue(Frame& F) {
    KArgs const Ap = F.a;
    const size_t gtid = (size_t)blockIdx.x * NTHREADS + F.tid, gthreads = (size_t)F.G * NTHREADS;
    cvt_bf16_stream(Ap->in[I_X], (bf16*)(F.ws + WS_XB), (size_t)T * DM / 8, gtid, gthreads);
    cvt_bf16_stream(Ap->in[I_UT], (bf16*)(F.ws + WS_UT), (size_t)16384 * DM / 8, gtid, gthreads);
    cvt_bf16_stream(Ap->in[I_VT], (bf16*)(F.ws + WS_VT), (size_t)16384 * DM / 8, gtid, gthreads);
    LAS float* scr = (LAS float*)(F.lds + F.wave * 16384);
    const int gw = blockIdx.x * NWAVES + F.wave, NGW = F.G * NWAVES;
    constexpr int I_IN = 152 * 16, I_B = 32 * 8, I_O = 32 * 16, I_PQ = 64 * 16;
    for (int it = gw; it < I_IN + I_B + I_O + I_PQ; it += NGW) {
        int r = it;
        if (r < I_IN) { const int cb = r >> 4, kb = r & 15; int c0, r0, nv; win_block(cb, c0, r0, nv);
            transpose_item(Ap->in[I_WIN], IN_COLS, 1024, c0, nv, (bf16*)(F.ws + WS_WIN), r0, 64 * kb, scr, F.lane); continue; }
        r -= I_IN;
        if (r < I_B) { const int cb = r >> 3, kb = r & 7; transpose_item(Ap->in[I_WBRB], 1024, 512, 32 * cb, 32, (bf16*)(F.ws + WS_WB), 32 * cb, 64 * kb, scr, F.lane); continue; }
        r -= I_B;
        if (r < I_O) { const int cb = r >> 4, kb = r & 15; transpose_item(Ap->in[I_WO], 1024, 1024, 32 * cb, 32, (bf16*)(F.ws + WS_WO), 32 * cb, 64 * kb, scr, F.lane); continue; }
        r -= I_O;
        { const int cb = r >> 4, kb = r & 15; transpose_item(Ap->in[I_WPQ], 2048, 1024, 32 * cb, 32, (bf16*)(F.ws + WS_WPQ), 32 * cb, 64 * kb, scr, F.lane); }
    }
    __syncthreads();
    LAS float* Xa = (LAS float*)(F.lds);
    LAS float* Xb = (LAS float*)(F.lds + 128 * 65 * 4);
    const float* w_in = Ap->in[I_WIN]; const float* w_uk = Ap->in[I_WUK]; const float* w_uv = Ap->in[I_WUV]; const float* w_bra = Ap->in[I_WBRA];
    for (int it = blockIdx.x; it < 256; it += F.G) {
        if (it < 128) {
            const int h = it >> 4, k0 = (it & 15) * 64;
            for (int e = F.tid; e < 128 * 64; e += NTHREADS) { const int c = e >> 6, d = e & 63; Xa[c * 65 + d] = w_uk[c * 512 + h * 64 + d]; }
            for (int e = F.tid; e < 64 * 64; e += NTHREADS) { const int kk = e >> 6, d = e & 63; Xb[kk * 65 + d] = w_in[(size_t)(k0 + kk) * IN_COLS + h * 64 + d]; }
            __syncthreads();
            const int kk = F.tid & 63;
            for (int j = 0; j < 16; ++j) { const int c = (F.tid >> 6) + 8 * j; float s = 0.f;
#pragma unroll 16
                for (int d = 0; d < 64; ++d) s += Xb[kk * 65 + d] * Xa[c * 65 + d];
                ((bf16*)(F.ws + WS_WIN))[(size_t)(h * 128 + c) * 1024 + k0 + kk] = (bf16)(pk2(s * 0.125f, 0.f) & 0xffffu); }
            __syncthreads();
        } else {
            const int i2 = it - 128, h = i2 >> 4, n0 = (i2 & 15) * 64;
            for (int e = F.tid; e < 128 * 64; e += NTHREADS) { const int c = e >> 6, d = e & 63; Xa[c * 65 + d] = w_uv[c * 512 + h * 64 + d]; }
            for (int e = F.tid; e < 64 * 64; e += NTHREADS) { const int d = e >> 6, n = e & 63; Xb[d * 65 + n] = w_bra[(size_t)(h * 64 + d) * 1024 + n0 + n]; }
            __syncthreads();
            const int c = F.tid & 127;
            for (int j = 0; j < 16; ++j) { const int n = (F.tid >> 7) + 4 * j; float s = 0.f;
#pragma unroll 16
                for (int d = 0; d < 64; ++d) s += Xa[c * 65 + d] * Xb[d * 65 + n];
                ((bf16*)(F.ws + WS_WA))[(size_t)(n0 + n) * 1024 + h * 128 + c] = (bf16)(pk2(s, 0.f) & 0xffffu); }
            __syncthreads();
        }
    }
}

struct EpiProj {
    static constexpr bool PERM = true;
    unsigned char* ws;
    __device__ __forceinline__ void operator()(const f32x4 (&acc)[2][2][4][2], const pg8::Unit& u, int wr, int wc, int fr, int fq) const {
        const int pn = u.pn; size_t boff; int ldc, colt; bool sg = false;
        if (pn < 4)       { boff = WS_QL;   ldc = 1024; colt = pn * 256; }
        else if (pn == 4) { boff = WS_MISC; ldc = 256;  colt = 0; }
        else if (pn < 7)  { boff = WS_QI;   ldc = 512;  colt = (pn - 5) * 256; }
        else if (pn < 9)  { boff = WS_QB;   ldc = 512;  colt = (pn - 7) * 256; }
        else if (pn < 11) { boff = WS_FB;   ldc = 512;  colt = (pn - 9) * 256; }
        else if (pn < 13) { boff = WS_IB;   ldc = 512;  colt = (pn - 11) * 256; }
        else if (pn < 15) { boff = WS_GB;   ldc = 512;  colt = (pn - 13) * 256; }
        else if (pn < 19) { boff = WS_GA;   ldc = 1024; colt = (pn - 15) * 256; sg = true; }
        else              { boff = WS_GBT;  ldc = 1024; colt = (pn - 19) * 256; sg = true; }
        bf16* base = (bf16*)(ws + boff);
        const int row0 = u.pm * 256 + wr * 64 + fr, col0 = colt + wc * 32 + 8 * fq;
#pragma unroll
        for (int ai = 0; ai < 2; ++ai)
#pragma unroll
            for (int m = 0; m < 4; ++m) { bf16* rowp = base + (size_t)(row0 + ai * 128 + m * 16) * ldc + col0;
#pragma unroll
                for (int bj = 0; bj < 2; ++bj) { f32x4 v0 = acc[ai][bj][m][0], v1 = acc[ai][bj][m][1];
                    if (sg) {
#pragma unroll
                        for (int j = 0; j < 4; ++j) { v0[j] = sigmoidf_(v0[j]); v1[j] = sigmoidf_(v1[j]); } }
                    v4u w; w.x = pk2(v0[0], v0[1]); w.y = pk2(v0[2], v0[3]); w.z = pk2(v1[0], v1[1]); w.w = pk2(v1[2], v1[3]);
                    *(v4u*)(rowp + bj * 128) = w; } }
    }
};
template <int MODE> struct EpiBranch {
    static constexpr bool PERM = true;
    const bf16* gate; bf16* O;
    __device__ __forceinline__ void operator()(const f32x4 (&acc)[2][2][4][2], const pg8::Unit& u, int wr, int wc, int fr, int fq) const {
        const int row0 = u.pm * 256 + wr * 64 + fr, col0 = u.pn * 256 + wc * 32 + 8 * fq;
#pragma unroll
        for (int ai = 0; ai < 2; ++ai)
#pragma unroll
            for (int m = 0; m < 4; ++m) { const size_t off = (size_t)(row0 + ai * 128 + m * 16) * 1024 + col0;
#pragma unroll
                for (int bj = 0; bj < 2; ++bj) { const f32x4 v0 = acc[ai][bj][m][0], v1 = acc[ai][bj][m][1];
                    const v4u g = *(const v4u*)(gate + off + bj * 128);
                    float r0 = v0[0] * bflo(g.x), r1 = v0[1] * bfhi(g.x), r2 = v0[2] * bflo(g.y), r3 = v0[3] * bfhi(g.y), r4 = v1[0] * bflo(g.z), r5 = v1[1] * bfhi(g.z), r6 = v1[2] * bflo(g.w), r7 = v1[3] * bfhi(g.w);
                    if (MODE == 1) { const v4u p = *(const v4u*)(O + off + bj * 128);
                        r0 += bflo(p.x); r1 += bfhi(p.x); r2 += bflo(p.y); r3 += bfhi(p.y); r4 += bflo(p.z); r5 += bfhi(p.z); r6 += bflo(p.w); r7 += bfhi(p.w); }
                    v4u w; w.x = pk2(r0, r1); w.y = pk2(r2, r3); w.z = pk2(r4, r5); w.w = pk2(r6, r7);
                    *(v4u*)(O + off + bj * 128) = w; } }
    }
};
struct EpiResF32 {
    static constexpr bool PERM = false;
    const float* X; float* Y;
    __device__ __forceinline__ void operator()(const f32x4 (&acc)[2][2][4][2], const pg8::Unit& u, int wr, int wc, int fr, int fq) const {
        const int row0 = u.pm * 256 + wr * 64 + fr, col0 = u.pn * 256 + wc * 32 + 4 * fq;
#pragma unroll
        for (int ai = 0; ai < 2; ++ai)
#pragma unroll
            for (int m = 0; m < 4; ++m) { const size_t off = (size_t)(row0 + ai * 128 + m * 16) * 1024 + col0;
#pragma unroll
                for (int bj = 0; bj < 2; ++bj)
#pragma unroll
                    for (int n = 0; n < 2; ++n) { const f32x4 xv = *(const f32x4*)(X + off + bj * 128 + n * 16);
                        *(f32x4*)(Y + off + bj * 128 + n * 16) = xv * ALPHA + acc[ai][bj][m][n]; } }
    }
};
struct EpiPlainBf16 {
    static constexpr bool PERM = true;
    bf16* O; int ldc;
    __device__ __forceinline__ void operator()(const f32x4 (&acc)[2][2][4][2], const pg8::Unit& u, int wr, int wc, int fr, int fq) const {
        const int row0 = u.pm * 256 + wr * 64 + fr, col0 = u.pn * 256 + wc * 32 + 8 * fq;
#pragma unroll
        for (int ai = 0; ai < 2; ++ai)
#pragma unroll
            for (int m = 0; m < 4; ++m) { bf16* rowp = O + (size_t)(row0 + ai * 128 + m * 16) * ldc + col0;
#pragma unroll
                for (int bj = 0; bj < 2; ++bj) { const f32x4 v0 = acc[ai][bj][m][0], v1 = acc[ai][bj][m][1];
                    v4u w; w.x = pk2(v0[0], v0[1]); w.y = pk2(v0[2], v0[3]); w.z = pk2(v1[0], v1[1]); w.w = pk2(v1[2], v1[3]);
                    *(v4u*)(rowp + bj * 128) = w; } }
    }
};

__device__ __forceinline__ void p2_ckv_norm(Frame& F) {
    const bf16* misc = (const bf16*)(F.ws + WS_MISC); bf16* ckv = (bf16*)(F.ws + WS_CKV); const float* g = F.a->in[I_KVG];
    const int gw = blockIdx.x * NWAVES + F.wave, NGW = F.G * NWAVES, sub = F.lane >> 4, l16 = F.lane & 15;
    float gv[8];
#pragma unroll
    for (int j = 0; j < 8; ++j) gv[j] = g[l16 * 8 + j];
    for (int r4 = gw; r4 < T / 4; r4 += NGW) {
        const int t = r4 * 4 + sub;
        const v4u p = *(const v4u*)(misc + (size_t)t * 256 + l16 * 8);
        float v[8] = {bflo(p.x), bfhi(p.x), bflo(p.y), bfhi(p.y), bflo(p.z), bfhi(p.z), bflo(p.w), bfhi(p.w)};
        float ss = 0.f;
#pragma unroll
        for (int j = 0; j < 8; ++j) ss += v[j] * v[j];
        ss += __shfl_xor(ss, 1); ss += __shfl_xor(ss, 2); ss += __shfl_xor(ss, 4); ss += __shfl_xor(ss, 8);
        const float r = rsqrtf(ss * (1.0f / 128.0f) + RMS_EPS);
        v4u o; o.x = pk2(v[0] * r * gv[0], v[1] * r * gv[1]); o.y = pk2(v[2] * r * gv[2], v[3] * r * gv[3]); o.z = pk2(v[4] * r * gv[4], v[5] * r * gv[5]); o.w = pk2(v[6] * r * gv[6], v[7] * r * gv[7]);
        *(v4u*)(ckv + (size_t)t * 128 + l16 * 8) = o;
    }
}

__device__ __forceinline__ void p2_hgrn_simple(Frame& F) {
    const bf16* QB = (const bf16*)(F.ws + WS_QB); const bf16* FBp = (const bf16*)(F.ws + WS_FB); bf16* IB = (bf16*)(F.ws + WS_IB);
    const float* lbp = F.a->in[I_LBP];
    const int v = F.tid >> 2, dq = F.tid & 3;
    for (int item = blockIdx.x; item < NB * 4; item += F.G) {
        const int b = item >> 2, h = item & 3;
        float lb[32], S[32];
#pragma unroll
        for (int i = 0; i < 32; ++i) { const int d = h * 128 + dq * 32 + i; lb[i] = 1.0f / (1.0f + __expf(lbp[512 + d] - lbp[d])); S[i] = 0.f; }
        for (int t = 0; t < SEQ; ++t) {
            const size_t row = (size_t)b * SEQ + t;
            const v4u* qp = (const v4u*)(QB + row * 512 + h * 128 + dq * 32);
            const v4u* fp = (const v4u*)(FBp + row * 512 + h * 128 + dq * 32);
            const float vv = bf2f(IB[row * 512 + h * 128 + v]);
            float part = 0.f;
#pragma unroll
            for (int c = 0; c < 4; ++c) { const v4u q4 = qp[c], f4 = fp[c];
#pragma unroll
                for (int e = 0; e < 4; ++e) {
                    const unsigned qa = e == 0 ? q4.x : e == 1 ? q4.y : e == 2 ? q4.z : q4.w, fa = e == 0 ? f4.x : e == 1 ? f4.y : e == 2 ? f4.z : f4.w;
#pragma unroll
                    for (int hh = 0; hh < 2; ++hh) { const int i = c * 8 + e * 2 + hh;
                        const float q = hh ? bfhi(qa) : bflo(qa), z = hh ? bfhi(fa) : bflo(fa);
                        const float sg = sigmoidf_(z), f = lb[i] + (1.0f - lb[i]) * sg, k = (1.0f - lb[i]) * (1.0f - sg);
                        S[i] = f * S[i] + k * vv; part += q * S[i]; } } }
            part += __shfl_xor(part, 1); part += __shfl_xor(part, 2);
            if (dq == 0) IB[row * 512 + h * 128 + v] = (bf16)(pk2(part, 0.f) & 0xffffu);
        }
    }
}

__device__ __forceinline__ unsigned mono_key(float f) { const unsigned u = __float_as_uint(f); return (u & 0x80000000u) ? ~u : (u | 0x80000000u); }
__device__ __forceinline__ void p2_indexer_simple(Frame& F) {
    typedef short bf16x8 __attribute__((ext_vector_type(8)));
    const bf16* misc = (const bf16*)(F.ws + WS_MISC); const bf16* QI = (const bf16*)(F.ws + WS_QI);
    unsigned long long* BMp = (unsigned long long*)(F.ws + WS_BM);
    LAS float* sc = (LAS float*)(F.lds + F.wave * 16384);
    const int gw = blockIdx.x * NWAVES + F.wave, NGW = F.G * NWAVES, lane = F.lane;
    const int l15 = lane & 15, q4 = lane >> 4;
    for (int tp = gw; tp < T / 2; tp += NGW) {
        const int t0 = tp * 2, b = t0 >> 11, pos = t0 & 2047, chunk = pos >> 6, nk = chunk + 1;
        if (nk <= 4) { if (lane < 32) { BMp[(size_t)t0 * 32 + lane] = (lane < nk) ? ~0ull : 0ull; BMp[(size_t)(t0 + 1) * 32 + lane] = (lane < nk) ? ~0ull : 0ull; } continue; }
        const bf16* ap = QI + (size_t)(t0 + (l15 >> 3)) * 512 + (l15 & 7) * 64 + 8 * q4;
        const bf16x8 a0 = *(const bf16x8*)ap, a1 = *(const bf16x8*)(ap + 32);
        float w[4];
        { const v2u p = *(const v2u*)(misc + (size_t)(t0 + (q4 >> 1)) * 256 + 192 + (q4 & 1) * 4); const float s_ = 0.04419417382415922f;
          w[0] = bflo(p.x) * s_; w[1] = bfhi(p.x) * s_; w[2] = bflo(p.y) * s_; w[3] = bfhi(p.y) * s_; }
        const bf16* kbase = misc + ((size_t)b * SEQ + l15) * 256 + 128 + 8 * q4;
#pragma unroll 2
        for (int kt = 0; kt < nk * 4; ++kt) {
            const bf16* kp = kbase + (size_t)kt * 16 * 256;
            const bf16x8 b0 = *(const bf16x8*)kp, b1 = *(const bf16x8*)(kp + 32);
            f32x4 acc = {0.f, 0.f, 0.f, 0.f};
            acc = __builtin_amdgcn_mfma_f32_16x16x32_bf16(a0, b0, acc, 0, 0, 0);
            acc = __builtin_amdgcn_mfma_f32_16x16x32_bf16(a1, b1, acc, 0, 0, 0);
            float part = w[0] * fmaxf(acc[0], 0.f) + w[1] * fmaxf(acc[1], 0.f) + w[2] * fmaxf(acc[2], 0.f) + w[3] * fmaxf(acc[3], 0.f);
            part += __shfl_xor(part, 16);
            if ((q4 & 1) == 0) sc[(q4 >> 1) * 2048 + kt * 16 + l15] = part;
        }
        for (int i = nk; i < 32; ++i) { sc[i * 64 + lane] = -INFINITY; sc[2048 + i * 64 + lane] = -INFINITY; }
        LDS_WAIT(); asm volatile("" ::: "memory");
#pragma unroll 1
        for (int tt = 0; tt < 2; ++tt) {
            unsigned long long* bmrow = BMp + (size_t)(t0 + tt) * 32;
            unsigned key[32];
#pragma unroll
            for (int i = 0; i < 32; ++i) key[i] = mono_key(sc[tt * 2048 + i * 64 + lane]);
            unsigned prefix = 0u;
#pragma unroll 1
            for (int bit = 31; bit >= 0; --bit) {
                const unsigned cand = prefix | (1u << bit); int cnt = 0;
#pragma unroll
                for (int i = 0; i < 32; ++i) { cnt += __builtin_popcountll(__ballot(key[i] >= cand)); if ((i & 3) == 3) __builtin_amdgcn_sched_barrier(0); }
                if (cnt >= 256) prefix = cand;
            }
            int ngt = 0;
#pragma unroll
            for (int i = 0; i < 32; ++i) { ngt += __builtin_popcountll(__ballot(key[i] > prefix)); if ((i & 3) == 3) __builtin_amdgcn_sched_barrier(0); }
            const int need = 256 - ngt; int running = 0;
            const unsigned long long lt_mask = (1ull << lane) - 1ull;
#pragma unroll
            for (int i = 0; i < 32; ++i) {
                const unsigned long long eq = __ballot(key[i] == prefix), gt = __ballot(key[i] > prefix);
                const int rank = running + __builtin_popcountll(eq & lt_mask);
                const unsigned long long se = __ballot(key[i] == prefix && rank < need);
                running += __builtin_popcountll(eq);
                const unsigned long long word = gt | se;
                if (lane == 0) bmrow[i] = word;
                __builtin_amdgcn_sched_barrier(0);
            }
        }
        LDS_WAIT(); asm volatile("" ::: "memory");
    }
}

__device__ __forceinline__ void p3_hg_finalize(Frame& F) {
    bf16* HG = (bf16*)(F.ws + WS_IB); const bf16* GBp = (const bf16*)(F.ws + WS_GB); const float* ng = F.a->in[I_BNG];
    const int gw = blockIdx.x * NWAVES + F.wave, NGW = F.G * NWAVES, sub = F.lane >> 4, l16 = F.lane & 15;
    float gv[8];
#pragma unroll
    for (int j = 0; j < 8; ++j) gv[j] = ng[l16 * 8 + j];
    for (int r4 = gw; r4 < T; r4 += NGW) {
        const size_t off = (size_t)r4 * 512 + sub * 128 + l16 * 8;
        const v4u p = *(const v4u*)(HG + off), q = *(const v4u*)(GBp + off);
        float v[8] = {bflo(p.x), bfhi(p.x), bflo(p.y), bfhi(p.y), bflo(p.z), bfhi(p.z), bflo(p.w), bfhi(p.w)};
        float gg[8] = {bflo(q.x), bfhi(q.x), bflo(q.y), bfhi(q.y), bflo(q.z), bfhi(q.z), bflo(q.w), bfhi(q.w)};
        float ss = 0.f;
#pragma unroll
        for (int j = 0; j < 8; ++j) ss += v[j] * v[j];
        ss += __shfl_xor(ss, 1); ss += __shfl_xor(ss, 2); ss += __shfl_xor(ss, 4); ss += __shfl_xor(ss, 8);
        const float r = rsqrtf(ss * (1.0f / 128.0f) + RMS_EPS);
        float o[8];
#pragma unroll
        for (int j = 0; j < 8; ++j) o[j] = v[j] * r * gv[j] * gg[j] * sigmoidf_(gg[j]);
        v4u w; w.x = pk2(o[0], o[1]); w.y = pk2(o[2], o[3]); w.z = pk2(o[4], o[5]); w.w = pk2(o[6], o[7]);
        *(v4u*)(HG + off) = w;
    }
}

__device__ __forceinline__ int t5_bucket(int rel) {
    const int n = rel < 0 ? -rel : rel; const int base = rel > 0 ? 16 : 0;
    int v;
    if (n < 8) v = n; else v = n >= 91 ? 15 : n >= 64 ? 14 : n >= 46 ? 13 : n >= 32 ? 12 : n >= 23 ? 11 : n >= 16 ? 10 : n >= 12 ? 9 : 8;
    return base + v;
}
__device__ __forceinline__ void p3_attn_simple(Frame& F) {
    const bf16* CKV = (const bf16*)(F.ws + WS_CKV); bf16* QL = (bf16*)(F.ws + WS_QL);
    const unsigned long long* BMp = (const unsigned long long*)(F.ws + WS_BM);
    LAS float* relb = (LAS float*)(F.lds + 8 * 12800);
    LAS float* qlf = (LAS float*)(F.lds + F.wave * 12800);
    LAS float* pl = (LAS float*)(F.lds + F.wave * 12800 + 4096);
    LAS unsigned short* idx = (LAS unsigned short*)(F.lds + F.wave * 12800 + 4096 + 8192);
    if (F.tid < 256) relb[F.tid] = F.a->in[I_RELB][F.tid];
    __syncthreads();
    const int gw = blockIdx.x * NWAVES + F.wave, NGW = F.G * NWAVES, lane = F.lane;
    const unsigned long long lt_mask = (1ull << lane) - 1ull;
    for (int t = gw; t < T; t += NGW) {
        const int b = t >> 11, pos = t & 2047, nk = (pos >> 6) + 1;
        {
#pragma unroll
            for (int j = 0; j < 2; ++j) { const v4u p = *(const v4u*)(QL + (size_t)t * 1024 + j * 512 + lane * 8);
                f32x4 a = {bflo(p.x), bfhi(p.x), bflo(p.y), bfhi(p.y)}, c = {bflo(p.z), bfhi(p.z), bflo(p.w), bfhi(p.w)};
                *(LAS f32x4*)(qlf + j * 512 + lane * 8) = a; *(LAS f32x4*)(qlf + j * 512 + lane * 8 + 4) = c; }
        }
        int n = 0;
        for (int i = 0; i < nk; ++i) {
            const unsigned long long word = BMp[(size_t)t * 32 + i];
            if ((word >> lane) & 1ull) idx[n + __builtin_popcountll(word & lt_mask)] = (unsigned short)(i * 64 + lane);
            n += __builtin_popcountll(word);
        }
        LDS_WAIT(); asm volatile("" ::: "memory");
#pragma unroll 1
        for (int j = 0; j < 4; ++j) {
            const int k = lane + 64 * j; const bool ok = k < n; const int s = ok ? (int)idx[k] : 0;
            const v4u* row = (const v4u*)(CKV + ((size_t)b * SEQ + s) * 128);
            float d[8];
#pragma unroll
            for (int h = 0; h < 8; ++h) d[h] = 0.f;
#pragma unroll 1
            for (int q4 = 0; q4 < 4; ++q4) {
                asm volatile("" ::: "memory");
                float ck[32];
#pragma unroll
                for (int c = 0; c < 4; ++c) { const v4u p = row[q4 * 4 + c]; ck[c * 8 + 0] = bflo(p.x); ck[c * 8 + 1] = bfhi(p.x); ck[c * 8 + 2] = bflo(p.y); ck[c * 8 + 3] = bfhi(p.y); ck[c * 8 + 4] = bflo(p.z); ck[c * 8 + 5] = bfhi(p.z); ck[c * 8 + 6] = bflo(p.w); ck[c * 8 + 7] = bfhi(p.w); }
#pragma unroll
                for (int h = 0; h < 8; ++h) {
#pragma unroll
                    for (int c = 0; c < 8; ++c) { const f32x4 q = *(const LAS f32x4*)(qlf + h * 128 + q4 * 32 + c * 4); d[h] += q.x * ck[c * 4] + q.y * ck[c * 4 + 1] + q.z * ck[c * 4 + 2] + q.w * ck[c * 4 + 3]; }
                    __builtin_amdgcn_sched_barrier(0);
                }
            }
            const int bk = t5_bucket(s - pos);
            f32x4 s0, s1;
            s0.x = ok ? d[0] + relb[bk * 8 + 0] : -INFINITY; s0.y = ok ? d[1] + relb[bk * 8 + 1] : -INFINITY; s0.z = ok ? d[2] + relb[bk * 8 + 2] : -INFINITY; s0.w = ok ? d[3] + relb[bk * 8 + 3] : -INFINITY;
            s1.x = ok ? d[4] + relb[bk * 8 + 4] : -INFINITY; s1.y = ok ? d[5] + relb[bk * 8 + 5] : -INFINITY; s1.z = ok ? d[6] + relb[bk * 8 + 6] : -INFINITY; s1.w = ok ? d[7] + relb[bk * 8 + 7] : -INFINITY;
            *(LAS f32x4*)(pl + k * 8) = s0; *(LAS f32x4*)(pl + k * 8 + 4) = s1;
        }
        LDS_WAIT(); asm volatile("" ::: "memory");
        {
            f32x4 a0[4], a1[4];
#pragma unroll
            for (int j = 0; j < 4; ++j) { a0[j] = *(const LAS f32x4*)(pl + (lane + 64 * j) * 8); a1[j] = *(const LAS f32x4*)(pl + (lane + 64 * j) * 8 + 4); }
#pragma unroll
            for (int h = 0; h < 8; ++h) {
                float v[4];
#pragma unroll
                for (int j = 0; j < 4; ++j) v[j] = h < 4 ? a0[j][h & 3] : a1[j][h & 3];
                float m = wave_max(fmaxf(fmaxf(v[0], v[1]), fmaxf(v[2], v[3])));
                float sum = 0.f;
#pragma unroll
                for (int j = 0; j < 4; ++j) { v[j] = __expf(v[j] - m); sum += v[j]; }
                const float inv = 1.0f / wave_sum(sum);
#pragma unroll
                for (int j = 0; j < 4; ++j) { if (h < 4) a0[j][h & 3] = v[j] * inv; else a1[j][h & 3] = v[j] * inv; }
            }
#pragma unroll
            for (int j = 0; j < 4; ++j) { *(LAS f32x4*)(pl + (lane + 64 * j) * 8) = a0[j]; *(LAS f32x4*)(pl + (lane + 64 * j) * 8 + 4) = a1[j]; }
        }
        LDS_WAIT(); asm volatile("" ::: "memory");
        float acc[8][2];
#pragma unroll
        for (int h = 0; h < 8; ++h) { acc[h][0] = 0.f; acc[h][1] = 0.f; }
        for (int k = 0; k < n; ++k) {
            const int s = (int)idx[k];
            const unsigned vv = *(const unsigned*)(CKV + ((size_t)b * SEQ + s) * 128 + 2 * lane);
            const float v0 = bflo(vv), v1 = bfhi(vv);
            const f32x4 p0 = *(const LAS f32x4*)(pl + k * 8), p1 = *(const LAS f32x4*)(pl + k * 8 + 4);
            acc[0][0] += p0.x * v0; acc[0][1] += p0.x * v1; acc[1][0] += p0.y * v0; acc[1][1] += p0.y * v1;
            acc[2][0] += p0.z * v0; acc[2][1] += p0.z * v1; acc[3][0] += p0.w * v0; acc[3][1] += p0.w * v1;
            acc[4][0] += p1.x * v0; acc[4][1] += p1.x * v1; acc[5][0] += p1.y * v0; acc[5][1] += p1.y * v1;
            acc[6][0] += p1.z * v0; acc[6][1] += p1.z * v1; acc[7][0] += p1.w * v0; acc[7][1] += p1.w * v1;
        }
#pragma unroll
        for (int h = 0; h < 8; ++h) *(unsigned*)(QL + (size_t)t * 1024 + h * 128 + 2 * lane) = pk2(acc[h][0], acc[h][1]);
        LDS_WAIT(); asm volatile("" ::: "memory");
    }
}

__device__ __forceinline__ void p6_ln1(Frame& F) {
    float* Y = F.a->out; bf16* X1B = (bf16*)(F.ws + WS_X1B); const float* g = F.a->in[I_LN1G]; const float* bb = F.a->in[I_LN1B];
    const int gw = blockIdx.x * NWAVES + F.wave, NGW = F.G * NWAVES, lane = F.lane;
    f32x4 gv[4], bv[4];
#pragma unroll
    for (int j = 0; j < 4; ++j) { gv[j] = ((const f32x4*)g)[lane + 64 * j]; bv[j] = ((const f32x4*)bb)[lane + 64 * j]; }
    for (int m = gw; m < T; m += NGW) {
        f32x4* yr = (f32x4*)(Y + (size_t)m * DM) + lane;
        f32x4 v[4]; float s = 0.f;
#pragma unroll
        for (int j = 0; j < 4; ++j) { v[j] = yr[64 * j]; s += (v[j].x + v[j].y) + (v[j].z + v[j].w); }
        const float mean = wave_sum(s) * (1.f / DM); float s2 = 0.f;
#pragma unroll
        for (int j = 0; j < 4; ++j) { v[j] = v[j] - mean; s2 += (v[j].x * v[j].x + v[j].y * v[j].y) + (v[j].z * v[j].z + v[j].w * v[j].w); }
        const float rstd = rsqrtf(wave_sum(s2) * (1.f / DM) + LN_EPS);
        v2u* o8 = (v2u*)(X1B + (size_t)m * DM) + lane;
#pragma unroll
        for (int j = 0; j < 4; ++j) { const f32x4 o = v[j] * rstd * gv[j] + bv[j]; yr[64 * j] = o; v2u w; w.x = pk2(o.x, o.y); w.y = pk2(o.z, o.w); o8[64 * j] = w; }
    }
}

#define TOP16_INSERT(tv, ti, val, id) do { \
    _Pragma("unroll") for (int _j = 15; _j >= 1; --_j) { const bool _up = (val) > tv[_j - 1]; const bool _here = (val) > tv[_j]; \
        tv[_j] = _up ? tv[_j - 1] : (_here ? (val) : tv[_j]); ti[_j] = _up ? ti[_j - 1] : (_here ? (id) : ti[_j]); } \
    { const bool _h0 = (val) > tv[0]; tv[0] = _h0 ? (val) : tv[0]; ti[0] = _h0 ? (id) : ti[0]; } } while (0)
__device__ __forceinline__ void p8_peer_route_simple(Frame& F) {
    const bf16* PQ = (const bf16*)(F.ws + WS_PQ); int* IDS = (int*)(F.ws + WS_IDS); float* GATES = (float*)(F.ws + WS_GATES);
    LAS float* K1 = (LAS float*)(F.lds); LAS float* K2 = (LAS float*)(F.lds + 65536);
    for (int e = F.tid; e < 16384; e += NTHREADS) { K1[e] = F.a->in[I_SK1][e]; K2[e] = F.a->in[I_SK2][e]; }
    __syncthreads();
    const size_t gtid = (size_t)blockIdx.x * NTHREADS + F.tid, gthreads = (size_t)F.G * NTHREADS;
    for (size_t item = gtid; item < (size_t)T * 8; item += gthreads) {
        const size_t t = item >> 3; const int h = (int)(item & 7);
        float v1[16], v2[16]; int i1[16], i2[16];
#pragma unroll
        for (int half = 0; half < 2; ++half) {
            const v4u* qp = (const v4u*)(PQ + t * 2048 + h * 256 + half * 128);
            v4u q[16];
#pragma unroll
            for (int c = 0; c < 16; ++c) q[c] = qp[c];
            float tv[16]; int ti[16];
#pragma unroll
            for (int j = 0; j < 16; ++j) { tv[j] = -INFINITY; ti[j] = 0; }
            const LAS float* KK = half ? K2 : K1;
#pragma unroll 1
            for (int n = 0; n < 128; ++n) {
                float d = 0.f;
#pragma unroll
                for (int c = 0; c < 16; ++c) { const f32x4 ka = *(const LAS f32x4*)(KK + n * 128 + c * 8), kb = *(const LAS f32x4*)(KK + n * 128 + c * 8 + 4);
                    d += ka.x * bflo(q[c].x) + ka.y * bfhi(q[c].x) + ka.z * bflo(q[c].y) + ka.w * bfhi(q[c].y) + kb.x * bflo(q[c].z) + kb.y * bfhi(q[c].z) + kb.z * bflo(q[c].w) + kb.w * bfhi(q[c].w);
                    if ((c & 3) == 3) __builtin_amdgcn_sched_barrier(0); }
                TOP16_INSERT(tv, ti, d, n);
            }
#pragma unroll
            for (int j = 0; j < 16; ++j) { if (half) { v2[j] = tv[j]; i2[j] = ti[j]; } else { v1[j] = tv[j]; i1[j] = ti[j]; } }
        }
        float tv[16]; int ti[16];
#pragma unroll
        for (int j = 0; j < 16; ++j) { tv[j] = -INFINITY; ti[j] = 0; }
#pragma unroll
        for (int a = 0; a < 16; ++a)
#pragma unroll
            for (int c = 0; c < 16; ++c)
                if ((a + 1) * (c + 1) <= 16) { const float val = v1[a] + v2[c]; const int id = i1[a] * 128 + i2[c]; TOP16_INSERT(tv, ti, val, id); }
        float ev[16], sum = 0.f;
#pragma unroll
        for (int j = 0; j < 16; ++j) { ev[j] = __expf(tv[j] - tv[0]); sum += ev[j]; }
        const float inv = 1.0f / sum;
#pragma unroll
        for (int j4 = 0; j4 < 4; ++j4) {
            *(int4*)(IDS + t * 128 + h * 16 + j4 * 4) = make_int4(ti[j4 * 4], ti[j4 * 4 + 1], ti[j4 * 4 + 2], ti[j4 * 4 + 3]);
            *(f32x4*)(GATES + t * 128 + h * 16 + j4 * 4) = (f32x4){ev[j4 * 4] * inv, ev[j4 * 4 + 1] * inv, ev[j4 * 4 + 2] * inv, ev[j4 * 4 + 3] * inv};
        }
    }
}

__device__ __forceinline__ void p9_peer_gather_simple(Frame& F) {
    float* X1 = F.a->out; const bf16* UT = (const bf16*)(F.ws + WS_UT); const bf16* VT = (const bf16*)(F.ws + WS_VT);
    const int* IDS = (const int*)(F.ws + WS_IDS); const float* GATES = (const float*)(F.ws + WS_GATES);
    const float* g = F.a->in[I_LN2G]; const float* bb = F.a->in[I_LN2B];
    const int gw = blockIdx.x * NWAVES + F.wave, NGW = F.G * NWAVES, lane = F.lane;
    f32x4 gv[4], bv[4];
#pragma unroll
    for (int j = 0; j < 4; ++j) { gv[j] = ((const f32x4*)g)[lane + 64 * j]; bv[j] = ((const f32x4*)bb)[lane + 64 * j]; }
    for (int t = gw; t < T; t += NGW) {
        f32x4* xr = (f32x4*)(X1 + (size_t)t * DM) + lane;
        f32x4 x[4], acc[4];
#pragma unroll
        for (int j = 0; j < 4; ++j) { x[j] = xr[64 * j]; acc[j] = (f32x4){0.f, 0.f, 0.f, 0.f}; }
        const int myid = IDS[(size_t)t * 128 + lane], myid2 = IDS[(size_t)t * 128 + 64 + lane];
        const float myg = GATES[(size_t)t * 128 + lane], myg2 = GATES[(size_t)t * 128 + 64 + lane];
        for (int k0 = 0; k0 < 128; k0 += 4) {
            float gt[4]; v2u uu[4][4], vv[4][4];
#pragma unroll
            for (int e = 0; e < 4; ++e) { const int k = k0 + e;
                const int id = __shfl(k0 < 64 ? myid : myid2, k & 63); gt[e] = __shfl(k0 < 64 ? myg : myg2, k & 63);
                const v2u* up = (const v2u*)(UT + (size_t)id * DM) + lane; const v2u* vp = (const v2u*)(VT + (size_t)id * DM) + lane;
#pragma unroll
                for (int j = 0; j < 4; ++j) { uu[e][j] = up[64 * j]; vv[e][j] = vp[64 * j]; } }
#pragma unroll
            for (int e = 0; e < 4; ++e) {
                float d = 0.f;
#pragma unroll
                for (int j = 0; j < 4; ++j) d += x[j].x * bflo(uu[e][j].x) + x[j].y * bfhi(uu[e][j].x) + x[j].z * bflo(uu[e][j].y) + x[j].w * bfhi(uu[e][j].y);
                d = wave_sum(d);
                const float hv = 0.5f * d * (1.0f + erff(d * 0.7071067811865476f));
                const float w = gt[e] * hv;
#pragma unroll
                for (int j = 0; j < 4; ++j) { acc[j].x += w * bflo(vv[e][j].x); acc[j].y += w * bfhi(vv[e][j].x); acc[j].z += w * bflo(vv[e][j].y); acc[j].w += w * bfhi(vv[e][j].y); }
            }
        }
        float s = 0.f;
#pragma unroll
        for (int j = 0; j < 4; ++j) { acc[j] = x[j] * ALPHA + acc[j]; s += (acc[j].x + acc[j].y) + (acc[j].z + acc[j].w); }
        const float mean = wave_sum(s) * (1.f / DM); float s2 = 0.f;
#pragma unroll
        for (int j = 0; j < 4; ++j) { acc[j] = acc[j] - mean; s2 += (acc[j].x * acc[j].x + acc[j].y * acc[j].y) + (acc[j].z * acc[j].z + acc[j].w * acc[j].w); }
        const float rstd = rsqrtf(wave_sum(s2) * (1.f / DM) + LN_EPS);
#pragma unroll
        for (int j = 0; j < 4; ++j) xr[64 * j] = acc[j] * rstd * gv[j] + bv[j];
    }
}

__global__ void __launch_bounds__(NTHREADS, 2) hybrid_fwd(Args args) {
    extern __shared__ __attribute__((aligned(16))) unsigned char lds[];
    Frame F;
    F.lds = (LAS unsigned char*)lds;
    F.tid = threadIdx.x; F.lane = F.tid & 63; F.wave = __builtin_amdgcn_readfirstlane(F.tid >> 6);
    F.G = gridDim.x; F.a = (KArgs)__builtin_amdgcn_kernarg_segment_ptr(); F.ws = args.ws;
#define FRESH() do { int _t = threadIdx.x; asm volatile("" : "+v"(_t)); F.tid = _t; F.lane = _t & 63; F.wave = __builtin_amdgcn_readfirstlane(_t >> 6); \
        KArgs _k = (KArgs)__builtin_amdgcn_kernarg_segment_ptr(); asm volatile("" : "+s"(_k)); F.a = _k; F.ws = _k->ws; } while (0)
    volatile LAS unsigned* MISC = (volatile LAS unsigned*)(F.lds + MISC_OFF);
    for (int u = F.tid; u < (LDS_BYTES - LDSCTL_OFF) / 4; u += NTHREADS) ((LAS unsigned*)(F.lds + LDSCTL_OFF))[u] = 0u;
    __syncthreads();
    const int lo = args.ph_lo, hi = args.ph_hi;
    const bool need_bar = (hi - lo) > 1;
    XcdBarrier bar; bar.bar = (unsigned*)(args.ws + WS_CTL) + CW_BAR + args.li * XCD_BAR_WORDS; bar.x = 0; bar.st = nullptr;
    if (need_bar) bar = xcd_barrier_post(bar.bar, MISC + 8);
#if defined(PHASE_MASK)
#define IN(k) (((PHASE_MASK >> (k)) & 1) && lo <= (k) && (k) < hi)
#elif defined(ONLY_PHASE)
#define IN(k) ((k) == ONLY_PHASE && lo <= (k) && (k) < hi)
#else
#define IN(k) (lo <= (k) && (k) < hi)
#endif
#define SEAM(k) do { if (IN(k) && IN((k) + 1)) xcd_barrier(bar); } while (0)
    LAS unsigned char* ring = F.lds;

    if (IN(0)) { FRESH(); p0_prologue(F); }
    SEAM(0);
    if (IN(1)) {
        FRESH();
        pg8::Gemm g{(const bf16*)(F.ws + WS_XB), (const bf16*)(F.ws + WS_WIN), T, NPROJ, 1024}; pg8::StaticOrder S; S.init(T, NPROJ, F.G, (int)blockIdx.x);
        EpiProj E{F.ws};
        pg8::gemm_phase<EpiProj, pg8::StaticOrder>(ring, g, S, E, F.tid);
    }
    SEAM(1);
    if (IN(2)) {
        FRESH();
#if !defined(P2SEL) || (P2SEL & 1)
        p2_ckv_norm(F);
#endif
#if !defined(P2SEL) || (P2SEL & 2)
        p2_hgrn_simple(F);
#endif
        __syncthreads();
        FRESH();
#if !defined(P2SEL) || (P2SEL & 4)
        p2_indexer_simple(F);
#endif
    }
    SEAM(2);
    if (IN(3)) { FRESH(); p3_hg_finalize(F); __syncthreads(); p3_attn_simple(F); }
    SEAM(3);
    if (IN(4)) {
        FRESH();
        { pg8::Gemm g{(const bf16*)(F.ws + WS_QL), (const bf16*)(F.ws + WS_WA), T, 1024, 1024}; pg8::StaticOrder S; S.init(T, 1024, F.G, (int)blockIdx.x);
          EpiBranch<0> E{(const bf16*)(F.ws + WS_GA), (bf16*)(F.ws + WS_MERGED)};
          pg8::gemm_phase<EpiBranch<0>, pg8::StaticOrder>(ring, g, S, E, F.tid); }
        FRESH();
        { pg8::Gemm g{(const bf16*)(F.ws + WS_IB), (const bf16*)(F.ws + WS_WB), T, 1024, 512}; pg8::StaticOrder S; S.init(T, 1024, F.G, (int)blockIdx.x);
          EpiBranch<1> E{(const bf16*)(F.ws + WS_GBT), (bf16*)(F.ws + WS_MERGED)};
          pg8::gemm_phase<EpiBranch<1>, pg8::StaticOrder>(ring, g, S, E, F.tid); }
    }
    SEAM(4);
    if (IN(5)) {
        FRESH();
        pg8::Gemm g{(const bf16*)(F.ws + WS_MERGED), (const bf16*)(F.ws + WS_WO), T, 1024, 1024}; pg8::StaticOrder S; S.init(T, 1024, F.G, (int)blockIdx.x);
        EpiResF32 E{F.a->in[I_X], F.a->out};
        pg8::gemm_phase<EpiResF32, pg8::StaticOrder>(ring, g, S, E, F.tid);
    }
    SEAM(5);
    if (IN(6)) { FRESH(); p6_ln1(F); }
    SEAM(6);
    if (IN(7)) {
        FRESH();
        pg8::Gemm g{(const bf16*)(F.ws + WS_X1B), (const bf16*)(F.ws + WS_WPQ), T, 2048, 1024}; pg8::StaticOrder S; S.init(T, 2048, F.G, (int)blockIdx.x);
        EpiPlainBf16 E{(bf16*)(F.ws + WS_PQ), 2048};
        pg8::gemm_phase<EpiPlainBf16, pg8::StaticOrder>(ring, g, S, E, F.tid);
    }
    SEAM(7);
    if (IN(8)) { FRESH(); p8_peer_route_simple(F); }
    SEAM(8);
    if (IN(9)) { FRESH(); p9_peer_gather_simple(F); }
#undef IN
#undef SEAM
}

extern "C" void kernel_launch(void* const* d_in, const int* in_sizes, int n_in, void* d_out, int out_size, void* d_ws, size_t ws_size, hipStream_t stream) {
    static int grid = 0;
    if (grid == 0) {
        if (n_in != 20 || out_size != T * DM || ws_size < WS_END) { fprintf(stderr, "kernel_launch: unexpected problem (n_in %d out %d ws %zu)\n", n_in, out_size, ws_size); grid = -1; return; }
        int dev = 0, cus = 0;
        if (hipGetDevice(&dev) != hipSuccess || hipDeviceGetAttribute(&cus, hipDeviceAttributeMultiprocessorCount, dev) != hipSuccess) { grid = -1; return; }
        if (hipFuncSetAttribute((const void*)hybrid_fwd, hipFuncAttributeMaxDynamicSharedMemorySize, LDS_BYTES) != hipSuccess) { fprintf(stderr, "kernel_launch: hipFuncSetAttribute failed\n"); grid = -1; return; }
        int per_cu = 0;
        if (hipOccupancyMaxActiveBlocksPerMultiprocessor(&per_cu, (const void*)hybrid_fwd, NTHREADS, LDS_BYTES) != hipSuccess || per_cu < 1) fprintf(stderr, "kernel_launch: occupancy query reports %d\n", per_cu);
        (void)hipGetLastError();
        grid = cus;
    }
    if (grid < 0) return;
    (void)hipMemsetAsync((char*)d_ws + WS_CTL, 0, CTL_ZERO_BYTES, stream);
    Args a{};
    for (int i = 0; i < 20; ++i) a.in[i] = (const float*)d_in[i];
    a.out = (float*)d_out; a.ws = (unsigned char*)d_ws;
    constexpr int NL = MK_N_LAUNCHES;
    for (int li = 0; li < NL; ++li) {
        a.ph_lo = (NL == 1) ? 0 : li; a.ph_hi = (NL == 1) ? N_PHASES : li + 1; a.li = li;
        hipLaunchKernelGGL(hybrid_fwd, dim3(grid), dim3(NTHREADS), LDS_BYTES, stream, a);
    }
}
```

```cpp
#include <hip/hip_runtime.h>
#include <cstdio>
#include <cstdint>

#ifndef MK_N_LAUNCHES
#define MK_N_LAUNCHES 1
#endif

namespace pg8 {
#define PG8_LAS __attribute__((address_space(3)))
typedef unsigned short bf16_t;
typedef short bf16x8 __attribute__((ext_vector_type(8)));
typedef float f32x4 __attribute__((ext_vector_type(4)));
typedef unsigned u32x4 __attribute__((ext_vector_type(4)));
constexpr int BM = 256, BK = 64, HALF = 128, HTB = HALF * BK * 2, STAGE_BYTES = 8 * HTB, NXCD = 8, WGM = 8;

__host__ __device__ __forceinline__ int lds_byte(int r, int c) { const int st = (r >> 4) * 2 + (c >> 5), rr = r & 15, cc = c & 31, ob = rr * 64 + cc * 2; return st * 1024 + (ob ^ (((ob >> 9) & 1) << 5)); }
__host__ __device__ __forceinline__ void stage_rc(int b, int& R, int& C) { const int st = b / 1024, sb = b % 1024, swz = sb ^ (((sb >> 9) & 1) << 5); R = (st >> 1) * 16 + swz / 64; C = (st & 1) * 32 + (swz % 64) / 2; }
__host__ __device__ __forceinline__ int perm32(int rho) { const int n = rho >> 4, i = rho & 15; return 8 * (i >> 2) + 4 * n + (i & 3); }

struct Unit { int pm, pn; };
struct Gemm { const bf16_t* A; const bf16_t* Bt; int M, N, K; };

struct StaticOrder {
    int nM, nN, nwg, G, c;
    __host__ __device__ void init(int M, int N, int G_, int c_) { nM = M / BM; nN = N / BM; nwg = nM * nN; G = G_; c = c_; }
    __host__ __device__ bool next(int i, Unit& u) const {
        const long L = (long)i * G + c; if (L >= nwg) return false;
        int wgid = (int)L; { const int q = nwg / NXCD, r = nwg % NXCD, xcd = wgid % NXCD, off = wgid / NXCD; wgid = (xcd < r ? xcd * (q + 1) : r * (q + 1) + (xcd - r) * q) + off; }
        const int nig = WGM * nN, gid = wgid / nig, fm = gid * WGM, gsz = (nM - fm) < WGM ? (nM - fm) : WGM;
        u.pm = fm + ((wgid % nig) % gsz); u.pn = (wgid % nig) / gsz; return true;
    }
    __device__ __forceinline__ void a_ready(const Unit&) const {}
    __device__ __forceinline__ void done(const Unit&) const {}
};

__device__ __forceinline__ unsigned cvt_pk_bf16(float lo, float hi) { unsigned r; asm volatile("v_cvt_pk_bf16_f32 %0, %1, %2" : "=v"(r) : "v"(lo), "v"(hi)); return r; }

template <class Epi, class Sched>
__device__ __forceinline__ void gemm_phase(PG8_LAS unsigned char* lds, const Gemm g, const Sched& S, const Epi& E, const int tid) {
    const int wid = __builtin_amdgcn_readfirstlane(tid >> 6), lane = tid & 63, wr = wid >> 2, wc = wid & 3, fr = lane & 15, fq = lane >> 4;
    const int K = g.K, nt = K / BK;
    unsigned voffA[2], voffB[2];
#pragma unroll
    for (int i = 0; i < 2; ++i) { int R, C; stage_rc(tid * 16 + i * 8192, R, C); const int Rb = Epi::PERM ? ((R & ~31) + perm32(R & 31)) : R;
        voffA[i] = (unsigned)(R * K + C) * 2u; voffB[i] = (unsigned)(Rb * K + C) * 2u; }
    const size_t kstep = (size_t)(BK * 2);
    const size_t hstep = (size_t)HALF * K * 2;
    const size_t tstep = 2 * hstep;
    const unsigned ldsw = (unsigned)wid * 1024u;
    const int aoff = lds_byte(wr * 64 + fr, fq * 8), boff = lds_byte(wc * 32 + fr, fq * 8);
#define PG8_SA(b, h) (((b) * 2 + (h)) * HTB)
#define PG8_SB(b, h) ((4 + (b) * 2 + (h)) * HTB)
#define PG8_STAGE(bufoff, gbase, voff) do { _Pragma("unroll") for (int _i = 0; _i < 2; ++_i) \
        __builtin_amdgcn_global_load_lds((const unsigned*)((const char*)(gbase) + (voff)[_i]), (PG8_LAS unsigned*)(lds + (bufoff) + ldsw + _i * 8192), 16, 0, 0); } while (0)
#define PG8_LDA(dst, b, h) do { _Pragma("unroll") for (int m = 0; m < 4; ++m) _Pragma("unroll") for (int k = 0; k < 2; ++k) dst[m][k] = *(const PG8_LAS bf16x8*)(lds + PG8_SA(b, h) + aoff + m * 2048 + k * 1024); } while (0)
#define PG8_LDB(dst, b, h) do { _Pragma("unroll") for (int n = 0; n < 2; ++n) _Pragma("unroll") for (int k = 0; k < 2; ++k) dst[n][k] = *(const PG8_LAS bf16x8*)(lds + PG8_SB(b, h) + boff + n * 2048 + k * 1024); } while (0)
#define PG8_MMA(ai, bj, At, Bt) do { __builtin_amdgcn_s_setprio(1); _Pragma("unroll") for (int m = 0; m < 4; ++m) _Pragma("unroll") for (int n = 0; n < 2; ++n) _Pragma("unroll") for (int k = 0; k < 2; ++k) \
        acc[ai][bj][m][n] = __builtin_amdgcn_mfma_f32_16x16x32_bf16(Bt[n][k], At[m][k], acc[ai][bj][m][n], 0, 0, 0); __builtin_amdgcn_s_setprio(0); } while (0)
#define PG8_WAIT_V(n) asm volatile("s_waitcnt vmcnt(" #n ")" ::: "memory")
#define PG8_WAIT_L(n) asm volatile("s_waitcnt lgkmcnt(" #n ")" ::: "memory")
#define PG8_BAR __builtin_amdgcn_s_barrier()
#define PG8_SCHED __builtin_amdgcn_sched_barrier(0)
    Unit cur, nxt; int ui = 0;
    if (!S.next(0, cur)) return;
    f32x4 acc[2][2][4][2];
#pragma unroll
    for (int a = 0; a < 2; ++a)
#pragma unroll
        for (int b = 0; b < 2; ++b)
#pragma unroll
            for (int m = 0; m < 4; ++m)
#pragma unroll
                for (int n = 0; n < 2; ++n) acc[a][b][m][n] = (f32x4){0.f, 0.f, 0.f, 0.f};
    bf16x8 At[4][2], B0[2][2], B1[2][2];
    const char* cA = (const char*)g.A + (size_t)cur.pm * tstep; const char* cB = (const char*)g.Bt + (size_t)cur.pn * tstep;
    S.a_ready(cur);
    PG8_STAGE(PG8_SB(0, 0), cB, voffB); PG8_STAGE(PG8_SA(0, 0), cA, voffA); PG8_STAGE(PG8_SB(0, 1), cB + hstep, voffB); PG8_STAGE(PG8_SA(0, 1), cA + hstep, voffA);
    if (wr == 1) PG8_BAR;
    PG8_WAIT_V(4); PG8_BAR;
    PG8_STAGE(PG8_SB(1, 0), cB + kstep, voffB); PG8_STAGE(PG8_SA(1, 0), cA + kstep, voffA); PG8_STAGE(PG8_SB(1, 1), cB + hstep + kstep, voffB);
    PG8_WAIT_V(6); PG8_BAR;
    for (;;) {
        const bool has_next = S.next(ui + 1, nxt);
        const char* nA = has_next ? (const char*)g.A + (size_t)nxt.pm * tstep : cA; const char* nB = has_next ? (const char*)g.Bt + (size_t)nxt.pn * tstep : cB;
        for (int t = 0; t < nt; t += 2) {
            const bool last = (t == nt - 2);
            const char* a1 = cA + (size_t)(t + 1) * kstep;
            const char* a2 = last ? nA : cA + (size_t)(t + 2) * kstep; const char* b2 = last ? nB : cB + (size_t)(t + 2) * kstep;
            const char* a3 = a2 + kstep; const char* b3 = b2 + kstep;
            if (last && has_next) S.a_ready(nxt);
            PG8_LDB(B0, 0, 0); PG8_SCHED; PG8_LDA(At, 0, 0); PG8_STAGE(PG8_SA(1, 1), a1 + hstep, voffA);
            PG8_WAIT_L(8); PG8_BAR; PG8_WAIT_L(0); PG8_MMA(0, 0, At, B0); PG8_BAR; PG8_SCHED;
            PG8_LDB(B1, 0, 1); PG8_STAGE(PG8_SB(0, 0), b2, voffB);
            PG8_BAR; PG8_WAIT_L(0); PG8_MMA(0, 1, At, B1); PG8_BAR;
            PG8_LDA(At, 0, 1); PG8_STAGE(PG8_SA(0, 0), a2, voffA);
            PG8_BAR; PG8_WAIT_L(0); PG8_MMA(1, 0, At, B0); PG8_BAR; PG8_SCHED;
            PG8_STAGE(PG8_SB(0, 1), b2 + hstep, voffB);
            PG8_WAIT_V(6); PG8_BAR; PG8_MMA(1, 1, At, B1); PG8_BAR;
            PG8_LDB(B0, 1, 0); PG8_SCHED; PG8_LDA(At, 1, 0); PG8_STAGE(PG8_SA(0, 1), a2 + hstep, voffA);
            PG8_WAIT_L(8); PG8_BAR; PG8_WAIT_L(0); PG8_MMA(0, 0, At, B0); PG8_BAR; PG8_SCHED;
            PG8_LDB(B1, 1, 1); PG8_STAGE(PG8_SB(1, 0), b3, voffB);
            PG8_BAR; PG8_WAIT_L(0); PG8_MMA(0, 1, At, B1); PG8_BAR;
            PG8_LDA(At, 1, 1); PG8_STAGE(PG8_SA(1, 0), a3, voffA);
            PG8_BAR; PG8_WAIT_L(0); PG8_MMA(1, 0, At, B0); PG8_BAR; PG8_SCHED;
            PG8_STAGE(PG8_SB(1, 1), b3 + hstep, voffB);
            PG8_WAIT_V(6); PG8_BAR; PG8_MMA(1, 1, At, B1); PG8_BAR;
        }
        E(acc, cur, wr, wc, fr, fq); S.done(cur);
        if (!has_next) break;
#pragma unroll
        for (int a = 0; a < 2; ++a)
#pragma unroll
            for (int b = 0; b < 2; ++b)
#pragma unroll
                for (int m = 0; m < 4; ++m)
#pragma unroll
                    for (int n = 0; n < 2; ++n) acc[a][b][m][n] = (f32x4){0.f, 0.f, 0.f, 0.f};
        cur = nxt; cA = nA; cB = nB; ++ui;
    }
    PG8_WAIT_V(0);
    if (wr == 0) PG8_BAR;
    PG8_BAR;
#undef PG8_SA
#undef PG8_SB
#undef PG8_STAGE
#undef PG8_LDA
#undef PG8_LDB
#undef PG8_MMA
#undef PG8_WAIT_V
#undef PG8_WAIT_L
#undef PG8_BAR
#undef PG8_SCHED
}
}

constexpr int NWAVES = 8, NTHREADS = 512;
constexpr int NB = 32, SEQ = 2048, DM = 1024, T = NB * SEQ;
constexpr int IN_COLS = 5320, NPROJ = 5888;
constexpr int N_PHASES = 10;
constexpr float ALPHA = 1.189207115002721f;
constexpr float LN_EPS = 1e-5f, RMS_EPS = 1e-6f;

constexpr size_t MiB = 1u << 20;
constexpr size_t WS_CTL = 0, CTL_ZERO_BYTES = 1 * MiB;
constexpr size_t WS_WIN = 1 * MiB, WS_WA = 13 * MiB, WS_WB = 15 * MiB, WS_WO = 16 * MiB, WS_WPQ = 18 * MiB;
constexpr size_t WS_UT = 24 * MiB, WS_VT = 56 * MiB;
constexpr size_t WS_XB = 88 * MiB;
constexpr size_t WS_QL = 216 * MiB;
constexpr size_t WS_MISC = 344 * MiB;
constexpr size_t WS_CKV = 376 * MiB;
constexpr size_t WS_QI = 392 * MiB, WS_QB = 456 * MiB, WS_FB = 520 * MiB, WS_IB = 584 * MiB, WS_GB = 648 * MiB;
constexpr size_t WS_GA = 712 * MiB, WS_GBT = 840 * MiB;
constexpr size_t WS_BM = 968 * MiB;
constexpr size_t WS_END = 984 * MiB;
constexpr size_t WS_MERGED = WS_XB, WS_X1B = WS_QL, WS_PQ = WS_QI, WS_IDS = WS_GB, WS_GATES = WS_GB + 32 * MiB;
constexpr int CW_BAR = 4096;

constexpr int RING_BYTES = 131072;
constexpr int LDSCTL_OFF = RING_BYTES, MISC_OFF = LDSCTL_OFF + 320;
constexpr int LDS_BYTES = 147456;

#define GAS __attribute__((address_space(1)))
#define LAS __attribute__((address_space(3)))
typedef unsigned short bf16;
typedef unsigned v4u __attribute__((ext_vector_type(4)));
typedef unsigned v2u __attribute__((ext_vector_type(2)));
typedef float f32x4 __attribute__((ext_vector_type(4)));
typedef float f32x2 __attribute__((ext_vector_type(2)));
typedef GAS unsigned gu32;
#define RLX_AGENT __ATOMIC_RELAXED, __HIP_MEMORY_SCOPE_AGENT
#define LDS_WAIT() asm volatile("s_waitcnt lgkmcnt(0)" ::: "memory")
#define VM_WAIT() asm volatile("s_waitcnt vmcnt(0)" ::: "memory")
typedef __bf16 bf16x2_t __attribute__((ext_vector_type(2)));
__device__ __forceinline__ unsigned pk2(float lo, float hi) { const bf16x2_t v = {(__bf16)lo, (__bf16)hi}; return __builtin_bit_cast(unsigned, v); }
__device__ __forceinline__ float bflo(unsigned u) { return __uint_as_float(u << 16); }
__device__ __forceinline__ float bfhi(unsigned u) { return __uint_as_float(u & 0xffff0000u); }
__device__ __forceinline__ float bf2f(bf16 b) { return __uint_as_float(((unsigned)b) << 16); }
__device__ __forceinline__ float sigmoidf_(float x) { return 1.0f / (1.0f + __expf(-x)); }

#define XB_TMO      128
#define XB_XCNT(j)  (256  + 64 * (j))
#define XB_XSUB(j)  (1280 + 64 * (j))
#define XB_XGEN(j)  (2304 + 64 * (j))
#define XB_TOP      3328
#define XB_TOPGEN   3392
#define XCD_BAR_WORDS 3456
#define XB_SPIN_CAP (1u << 22)
__device__ __forceinline__ unsigned xb_ld(unsigned* p)              { return __hip_atomic_load(p, __ATOMIC_RELAXED, __HIP_MEMORY_SCOPE_AGENT); }
__device__ __forceinline__ unsigned xb_add(unsigned* p, unsigned v) { return __hip_atomic_fetch_add(p, v, __ATOMIC_RELAXED, __HIP_MEMORY_SCOPE_AGENT); }
__device__ __forceinline__ unsigned xb_xcc_id() { return (unsigned)__builtin_amdgcn_s_getreg((3 << 11) | 20) & 0xFu; }
#define XB_SPIN(cond, bar) do { unsigned _sp = 0; while (cond) { __builtin_amdgcn_s_sleep(1); \
    if ((++_sp & 255u) == 0u) { if (xb_ld(&(bar)[XB_TMO])) break; if (_sp > XB_SPIN_CAP) { atomicAdd(&(bar)[XB_TMO], 1u); break; } } } } while (0)
struct XcdBarrier { unsigned* bar; unsigned x; volatile LAS unsigned* st; };
__device__ __forceinline__ XcdBarrier xcd_barrier_post(unsigned* bar, volatile LAS unsigned* st) {
    XcdBarrier b; b.bar = bar; b.x = xb_xcc_id(); b.st = st;
    if (threadIdx.x == 0) (void)xb_add(&bar[XB_XCNT(b.x)], 1u);
    return b;
}
__device__ __forceinline__ void xcd_barrier_complete(unsigned* bar, unsigned x, unsigned& nloc, unsigned& nx) {
    const unsigned G = gridDim.x * gridDim.y * gridDim.z;
    unsigned sum, cnt, mine, sp = 0u;
    for (;;) {
        sum = 0u; cnt = 0u; mine = 0u;
#pragma unroll
        for (unsigned j = 0; j < 16; ++j) { const unsigned c = xb_ld(&bar[XB_XCNT(j)]); sum += c; cnt += (c > 0u) ? 1u : 0u; mine = (j == x) ? c : mine; }
        if (sum == G) break;
        __builtin_amdgcn_s_sleep(1);
        if ((++sp & 255u) == 0u) { if (xb_ld(&bar[XB_TMO])) break; if (sp > XB_SPIN_CAP) { atomicAdd(&bar[XB_TMO], 1u); break; } }
    }
    nloc = mine > 0u ? mine : 1u; nx = cnt > 0u ? cnt : 1u;
}
__device__ __forceinline__ void xcd_barrier(const XcdBarrier& b) {
    asm volatile("s_waitcnt vmcnt(0)" ::: "memory");
    __syncthreads();
    if (threadIdx.x == 0) {
        unsigned* bar = b.bar;
        __builtin_amdgcn_s_waitcnt(0);
        unsigned nloc = b.st[0], nx = b.st[1];
        if (nloc == 0u) { xcd_barrier_complete(bar, b.x, nloc, nx); b.st[0] = nloc; b.st[1] = nx; }
        const unsigned old = xb_add(&bar[XB_XSUB(b.x)], 1u);
        const unsigned gen = old / nloc;
        if (old + 1u == (gen + 1u) * nloc) {
            __builtin_amdgcn_fence(__ATOMIC_RELEASE, "agent");
            asm volatile("s_waitcnt vmcnt(0)" ::: "memory");
            const unsigned og = xb_add(&bar[XB_TOP], 1u);
            const unsigned tg = og / nx;
            if (og + 1u == (tg + 1u) * nx) xb_add(&bar[XB_TOPGEN], 1u);
            else XB_SPIN(xb_ld(&bar[XB_TOPGEN]) == tg, bar);
            __builtin_amdgcn_fence(__ATOMIC_ACQUIRE, "agent");
            xb_add(&bar[XB_XGEN(b.x)], 1u);
            asm volatile("s_waitcnt vmcnt(0)" ::: "memory");
        } else {
            XB_SPIN(xb_ld(&bar[XB_XGEN(b.x)]) == gen, bar);
            __builtin_amdgcn_fence(__ATOMIC_ACQUIRE, "agent");
            asm volatile("s_waitcnt vmcnt(0)" ::: "memory");
        }
    }
    __syncthreads();
}

struct Args { const float* in[20]; float* out; unsigned char* ws; int ph_lo, ph_hi, li, pad; };
enum { I_X = 0, I_WIN, I_KVG, I_WUK, I_WUV, I_RELB, I_LBP, I_BNG, I_WBRA, I_WBRB, I_WO, I_LN1G, I_LN1B, I_WPQ, I_SK1, I_SK2, I_UT, I_VT, I_LN2G, I_LN2B };

typedef const __attribute__((address_space(4))) Args* KArgs;
struct Frame {
    LAS unsigned char* lds;
    int tid, lane, wave, G;
    KArgs a;
    unsigned char* ws;
};

__device__ __forceinline__ float wave_sum(float v) {
#pragma unroll
    for (int o = 1; o < 64; o <<= 1) v += __shfl_xor(v, o);
    return v;
}
__device__ __forceinline__ float wave_max(float v) {
#pragma unroll
    for (int o = 1; o < 64; o <<= 1) v = fmaxf(v, __shfl_xor(v, o));
    return v;
}

__device__ __forceinline__ void cvt_bf16_stream(const float* src, bf16* dst, size_t n8, size_t gtid, size_t gthreads) {
    for (size_t i = gtid; i < n8; i += gthreads) {
        const f32x4 a = ((const f32x4*)src)[2 * i], b = ((const f32x4*)src)[2 * i + 1];
        v4u o; o.x = pk2(a.x, a.y); o.y = pk2(a.z, a.w); o.z = pk2(b.x, b.y); o.w = pk2(b.z, b.w);
        ((v4u*)dst)[i] = o;
    }
}
__device__ __forceinline__ void transpose_item(const float* W, int ldw, int K, int c0, int nvalid, bf16* WT, int r0, int k0, LAS float* scr, int lane) {
#pragma unroll 8
    for (int i = 0; i < 32; ++i) { const int kk = 2 * i + (lane >> 5), n = lane & 31; scr[kk * 33 + n] = (n < nvalid) ? W[(size_t)(k0 + kk) * ldw + c0 + n] : 0.f; }
    LDS_WAIT(); asm volatile("" ::: "memory");
    const int c = lane & 7;
#pragma unroll
    for (int j = 0; j < 4; ++j) { const int n = (lane >> 3) + 8 * j; const LAS float* s = scr + (8 * c) * 33 + n;
        v4u o; o.x = pk2(s[0 * 33], s[1 * 33]); o.y = pk2(s[2 * 33], s[3 * 33]); o.z = pk2(s[4 * 33], s[5 * 33]); o.w = pk2(s[6 * 33], s[7 * 33]);
        *(v4u*)(WT + (size_t)(r0 + n) * K + k0 + 8 * c) = o; }
    LDS_WAIT(); asm volatile("" ::: "memory");
}
__device__ __forceinline__ void win_block(int cb, int& c0, int& r0, int& nv) {
    nv = 32;
    if (cb < 4)        { c0 = 512 + 32 * cb;          r0 = 1024 + 32 * cb; }
    else if (cb < 6)   { c0 = 1152 + 32 * (cb - 4);   r0 = 1152 + 32 * (cb - 4); }
    else if (cb == 6)  { c0 = 1216;                   r0 = 1216; nv = 8; }
    else if (cb == 7)  { c0 = 0;                      r0 = 1248; nv = 0; }
    else if (cb < 24)  { c0 = 640 + 32 * (cb - 8);    r0 = 1280 + 32 * (cb - 8); }
    else if (cb < 40)  { c0 = 1224 + 32 * (cb - 24);  r0 = 1792 + 32 * (cb - 24); }
    else if (cb < 56)  { c0 = 1736 + 32 * (cb - 40);  r0 = 2304 + 32 * (cb - 40); }
    else if (cb < 72)  { c0 = 2248 + 32 * (cb - 56);  r0 = 2816 + 32 * (cb - 56); }
    else if (cb < 88)  { c0 = 2760 + 32 * (cb - 72);  r0 = 3328 + 32 * (cb - 72); }
    else if (cb < 120) { c0 = 3272 + 32 * (cb - 88);  r0 = 3840 + 32 * (cb - 88); }
    else               { c0 = 4296 + 32 * (cb - 120); r0 = 4864 + 32 * (cb - 120); }
}
__device__ __forceinline__ void p0_prologue(Frame& F) {
    KArgs const Ap = F.a;
    const size_t gtid = (size_t)blockIdx.x * NTHREADS + F.tid, gthreads = (size_t)F.G * NTHREADS;
    cvt_bf16_stream(Ap->in[I_X], (bf16*)(F.ws + WS_XB), (size_t)T * DM / 8, gtid, gthreads);
    cvt_bf16_stream(Ap->in[I_UT], (bf16*)(F.ws + WS_UT), (size_t)16384 * DM / 8, gtid, gthreads);
    cvt_bf16_stream(Ap->in[I_VT], (bf16*)(F.ws + WS_VT), (size_t)16384 * DM / 8, gtid, gthreads);
    LAS float* scr = (LAS float*)(F.lds + F.wave * 16384);
    const int gw = blockIdx.x * NWAVES + F.wave, NGW = F.G * NWAVES;
    constexpr int I_IN = 152 * 16, I_B = 32 * 8, I_O = 32 * 16, I_PQ = 64 * 16;
    for (int it = gw; it < I_IN + I_B + I_O + I_PQ; it += NGW) {
        int r = it;
        if (r < I_IN) { const int cb = r >> 4, kb = r & 15; int c0, r0, nv; win_block(cb, c0, r0, nv);
            transpose_item(Ap->in[I_WIN], IN_COLS, 1024, c0, nv, (bf16*)(F.ws + WS_WIN), r0, 64 * kb, scr, F.lane); continue; }
        r -= I_IN;
        if (r < I_B) { const int cb = r >> 3, kb = r & 7; transpose_item(Ap->in[I_WBRB], 1024, 512, 32 * cb, 32, (bf16*)(F.ws + WS_WB), 32 * cb, 64 * kb, scr, F.lane); continue; }
        r -= I_B;
        if (r < I_O) { const int cb = r >> 4, kb = r & 15; transpose_item(Ap->in[I_WO], 1024, 1024, 32 * cb, 32, (bf16*)(F.ws + WS_WO), 32 * cb, 64 * kb, scr, F.lane); continue; }
        r -= I_O;
        { const int cb = r >> 4, kb = r & 15; transpose_item(Ap->in[I_WPQ], 2048, 1024, 32 * cb, 32, (bf16*)(F.ws + WS_WPQ), 32 * cb, 64 * kb, scr, F.lane); }
    }
    __syncthreads();
    LAS float* Xa = (LAS float*)(F.lds);
    LAS float* Xb = (LAS float*)(F.lds + 128 * 65 * 4);
    const float* w_in = Ap->in[I_WIN]; const float* w_uk = Ap->in[I_WUK]; const float* w_uv = Ap->in[I_WUV]; const float* w_bra = Ap->in[I_WBRA];
    for (int it = blockIdx.x; it < 256; it += F.G) {
        if (it < 128) {
            const int h = it >> 4, k0 = (it & 15) * 64;
            for (int e = F.tid; e < 128 * 64; e += NTHREADS) { const int c = e >> 6, d = e & 63; Xa[c * 65 + d] = w_uk[c * 512 + h * 64 + d]; }
            for (int e = F.tid; e < 64 * 64; e += NTHREADS) { const int kk = e >> 6, d = e & 63; Xb[kk * 65 + d] = w_in[(size_t)(k0 + kk) * IN_COLS + h * 64 + d]; }
            __syncthreads();
            const int kk = F.tid & 63;
            for (int j = 0; j < 16; ++j) { const int c = (F.tid >> 6) + 8 * j; float s = 0.f;
#pragma unroll 16
                for (int d = 0; d < 64; ++d) s += Xb[kk * 65 + d] * Xa[c * 65 + d];
                ((bf16*)(F.ws + WS_WIN))[(size_t)(h * 128 + c) * 1024 + k0 + kk] = (bf16)(pk2(s * 0.125f, 0.f) & 0xffffu); }
            __syncthreads();
        } else {
            const int i2 = it - 128, h = i2 >> 4, n0 = (i2 & 15) * 64;
            for (int e = F.tid; e < 128 * 64; e += NTHREADS) { const int c = e >> 6, d = e & 63; Xa[c * 65 + d] = w_uv[c * 512 + h * 64 + d]; }
            for (int e = F.tid; e < 64 * 64; e += NTHREADS) { const int d = e >> 6, n = e & 63; Xb[d * 65 + n] = w_bra[(size_t)(h * 64 + d) * 1024 + n0 + n]; }
            __syncthreads();
            const int c = F.tid & 127;
            for (int j = 0; j < 16; ++j) { const int n = (F.tid >> 7) + 4 * j; float s = 0.f;
#pragma unroll 16
                for (int d = 0; d < 64; ++d) s += Xa[c * 65 + d] * Xb[d * 65 + n];
                ((bf16*)(F.ws + WS_WA))[(size_t)(n0 + n) * 1024 + h * 128 + c] = (bf16)(pk2(s, 0.f) & 0xffffu); }
            __syncthreads();
        }
    }
}

struct EpiProj {
    static constexpr bool PERM = true;
    unsigned char* ws;
    __device__ __forceinline__ void operator()(const f32x4 (&acc)[2][2][4][2], const pg8::Unit& u, int wr, int wc, int fr, int fq) const {
        const int pn = u.pn; size_t boff; int ldc, colt; bool sg = false;
        if (pn < 4)       { boff = WS_QL;   ldc = 1024; colt = pn * 256; }
        else if (pn == 4) { boff = WS_MISC; ldc = 256;  colt = 0; }
        else if (pn < 7)  { boff = WS_QI;   ldc = 512;  colt = (pn - 5) * 256; }
        else if (pn < 9)  { boff = WS_QB;   ldc = 512;  colt = (pn - 7) * 256; }
        else if (pn < 11) { boff = WS_FB;   ldc = 512;  colt = (pn - 9) * 256; }
        else if (pn < 13) { boff = WS_IB;   ldc = 512;  colt = (pn - 11) * 256; }
        else if (pn < 15) { boff = WS_GB;   ldc = 512;  colt = (pn - 13) * 256; }
        else if (pn < 19) { boff = WS_GA;   ldc = 1024; colt = (pn - 15) * 256; sg = true; }
        else              { boff = WS_GBT;  ldc = 1024; colt = (pn - 19) * 256; sg = true; }
        bf16* base = (bf16*)(ws + boff);
        const int row0 = u.pm * 256 + wr * 64 + fr, col0 = colt + wc * 32 + 8 * fq;
#pragma unroll
        for (int ai = 0; ai < 2; ++ai)
#pragma unroll
            for (int m = 0; m < 4; ++m) { bf16* rowp = base + (size_t)(row0 + ai * 128 + m * 16) * ldc + col0;
#pragma unroll
                for (int bj = 0; bj < 2; ++bj) { f32x4 v0 = acc[ai][bj][m][0], v1 = acc[ai][bj][m][1];
                    if (sg) {
#pragma unroll
                        for (int j = 0; j < 4; ++j) { v0[j] = sigmoidf_(v0[j]); v1[j] = sigmoidf_(v1[j]); } }
                    v4u w; w.x = pk2(v0[0], v0[1]); w.y = pk2(v0[2], v0[3]); w.z = pk2(v1[0], v1[1]); w.w = pk2(v1[2], v1[3]);
                    *(v4u*)(rowp + bj * 128) = w; } }
    }
};
template <int MODE> struct EpiBranch {
    static constexpr bool PERM = true;
    const bf16* gate; bf16* O;
    __device__ __forceinline__ void operator()(const f32x4 (&acc)[2][2][4][2], const pg8::Unit& u, int wr, int wc, int fr, int fq) const {
        const int row0 = u.pm * 256 + wr * 64 + fr, col0 = u.pn * 256 + wc * 32 + 8 * fq;
#pragma unroll
        for (int ai = 0; ai < 2; ++ai)
#pragma unroll
            for (int m = 0; m < 4; ++m) { const size_t off = (size_t)(row0 + ai * 128 + m * 16) * 1024 + col0;
#pragma unroll
                for (int bj = 0; bj < 2; ++bj) { const f32x4 v0 = acc[ai][bj][m][0], v1 = acc[ai][bj][m][1];
                    const v4u g = *(const v4u*)(gate + off + bj * 128);
                    float r0 = v0[0] * bflo(g.x), r1 = v0[1] * bfhi(g.x), r2 = v0[2] * bflo(g.y), r3 = v0[3] * bfhi(g.y), r4 = v1[0] * bflo(g.z), r5 = v1[1] * bfhi(g.z), r6 = v1[2] * bflo(g.w), r7 = v1[3] * bfhi(g.w);
                    if (MODE == 1) { const v4u p = *(const v4u*)(O + off + bj * 128);
                        r0 += bflo(p.x); r1 += bfhi(p.x); r2 += bflo(p.y); r3 += bfhi(p.y); r4 += bflo(p.z); r5 += bfhi(p.z); r6 += bflo(p.w); r7 += bfhi(p.w); }
                    v4u w; w.x = pk2(r0, r1); w.y = pk2(r2, r3); w.z = pk2(r4, r5); w.w = pk2(r6, r7);
                    *(v4u*)(O + off + bj * 128) = w; } }
    }
};
struct EpiResF32 {
    static constexpr bool PERM = false;
    const float* X; float* Y;
    __device__ __forceinline__ void operator()(const f32x4 (&acc)[2][2][4][2], const pg8::Unit& u, int wr, int wc, int fr, int fq) const {
        const int row0 = u.pm * 256 + wr * 64 + fr, col0 = u.pn * 256 + wc * 32 + 4 * fq;
#pragma unroll
        for (int ai = 0; ai < 2; ++ai)
#pragma unroll
            for (int m = 0; m < 4; ++m) { const size_t off = (size_t)(row0 + ai * 128 + m * 16) * 1024 + col0;
#pragma unroll
                for (int bj = 0; bj < 2; ++bj)
#pragma unroll
                    for (int n = 0; n < 2; ++n) { const f32x4 xv = *(const f32x4*)(X + off + bj * 128 + n * 16);
                        *(f32x4*)(Y + off + bj * 128 + n * 16) = xv * ALPHA + acc[ai][bj][m][n]; } }
    }
};
struct EpiPlainBf16 {
    static constexpr bool PERM = true;
    bf16* O; int ldc;
    __device__ __forceinline__ void operator()(const f32x4 (&acc)[2][2][4][2], const pg8::Unit& u, int wr, int wc, int fr, int fq) const {
        const int row0 = u.pm * 256 + wr * 64 + fr, col0 = u.pn * 256 + wc * 32 + 8 * fq;
#pragma unroll
        for (int ai = 0; ai < 2; ++ai)
#pragma unroll
            for (int m = 0; m < 4; ++m) { bf16* rowp = O + (size_t)(row0 + ai * 128 + m * 16) * ldc + col0;
#pragma unroll
                for (int bj = 0; bj < 2; ++bj) { const f32x4 v0 = acc[ai][bj][m][0], v1 = acc[ai][bj][m][1];
                    v4u w; w.x = pk2(v0[0], v0[1]); w.y = pk2(v0[2], v0[3]); w.z = pk2(v1[0], v1[1]); w.w = pk2(v1[2], v1[3]);
                    *(v4u*)(rowp + bj * 128) = w; } }
    }
};

__device__ __forceinline__ void p2_ckv_norm(Frame& F) {
    const bf16* misc = (const bf16*)(F.ws + WS_MISC); bf16* ckv = (bf16*)(F.ws + WS_CKV); const float* g = F.a->in[I_KVG];
    const int gw = blockIdx.x * NWAVES + F.wave, NGW = F.G * NWAVES, sub = F.lane >> 4, l16 = F.lane & 15;
    float gv[8];
#pragma unroll
    for (int j = 0; j < 8; ++j) gv[j] = g[l16 * 8 + j];
    for (int r4 = gw; r4 < T / 4; r4 += NGW) {
        const int t = r4 * 4 + sub;
        const v4u p = *(const v4u*)(misc + (size_t)t * 256 + l16 * 8);
        float v[8] = {bflo(p.x), bfhi(p.x), bflo(p.y), bfhi(p.y), bflo(p.z), bfhi(p.z), bflo(p.w), bfhi(p.w)};
        float ss = 0.f;
#pragma unroll
        for (int j = 0; j < 8; ++j) ss += v[j] * v[j];
        ss += __shfl_xor(ss, 1); ss += __shfl_xor(ss, 2); ss += __shfl_xor(ss, 4); ss += __shfl_xor(ss, 8);
        const float r = rsqrtf(ss * (1.0f / 128.0f) + RMS_EPS);
        v4u o; o.x = pk2(v[0] * r * gv[0], v[1] * r * gv[1]); o.y = pk2(v[2] * r * gv[2], v[3] * r * gv[3]); o.z = pk2(v[4] * r * gv[4], v[5] * r * gv[5]); o.w = pk2(v[6] * r * gv[6], v[7] * r * gv[7]);
        *(v4u*)(ckv + (size_t)t * 128 + l16 * 8) = o;
    }
}

__device__ __forceinline__ void p2_hgrn_simple(Frame& F) {
    const bf16* QB = (const bf16*)(F.ws + WS_QB); const bf16* FBp = (const bf16*)(F.ws + WS_FB); bf16* IB = (bf16*)(F.ws + WS_IB);
    const float* lbp = F.a->in[I_LBP];
    const int v = F.tid >> 2, dq = F.tid & 3;
    for (int item = blockIdx.x; item < NB * 4; item += F.G) {
        const int b = item >> 2, h = item & 3;
        float lb[32], S[32];
#pragma unroll
        for (int i = 0; i < 32; ++i) { const int d = h * 128 + dq * 32 + i; lb[i] = 1.0f / (1.0f + __expf(lbp[512 + d] - lbp[d])); S[i] = 0.f; }
        for (int t = 0; t < SEQ; ++t) {
            const size_t row = (size_t)b * SEQ + t;
            const v4u* qp = (const v4u*)(QB + row * 512 + h * 128 + dq * 32);
            const v4u* fp = (const v4u*)(FBp + row * 512 + h * 128 + dq * 32);
            const float vv = bf2f(IB[row * 512 + h * 128 + v]);
            float part = 0.f;
#pragma unroll
            for (int c = 0; c < 4; ++c) { const v4u q4 = qp[c], f4 = fp[c];
#pragma unroll
                for (int e = 0; e < 4; ++e) {
                    const unsigned qa = e == 0 ? q4.x : e == 1 ? q4.y : e == 2 ? q4.z : q4.w, fa = e == 0 ? f4.x : e == 1 ? f4.y : e == 2 ? f4.z : f4.w;
#pragma unroll
                    for (int hh = 0; hh < 2; ++hh) { const int i = c * 8 + e * 2 + hh;
                        const float q = hh ? bfhi(qa) : bflo(qa), z = hh ? bfhi(fa) : bflo(fa);
                        const float sg = sigmoidf_(z), f = lb[i] + (1.0f - lb[i]) * sg, k = (1.0f - lb[i]) * (1.0f - sg);
                        S[i] = f * S[i] + k * vv; part += q * S[i]; } } }
            part += __shfl_xor(part, 1); part += __shfl_xor(part, 2);
            if (dq == 0) IB[row * 512 + h * 128 + v] = (bf16)(pk2(part, 0.f) & 0xffffu);
        }
    }
}

__device__ __forceinline__ void p2_hgrn_chunked(Frame& F, bf16* OUTB, int nbatch) {
    typedef short bf16x8 __attribute__((ext_vector_type(8)));
    const bf16* QB = (const bf16*)(F.ws + WS_QB); const bf16* FBp = (const bf16*)(F.ws + WS_FB); bf16* IB = (bf16*)(F.ws + WS_IB);
    const float* lbp = F.a->in[I_LBP];
    constexpr int S136 = 136, S72 = 72;
    LAS bf16* QIN = (LAS bf16*)(F.lds);
    LAS bf16* KIN = (LAS bf16*)(F.lds + 17408);
    LAS bf16* QDEC = (LAS bf16*)(F.lds + 2 * 17408);
    LAS bf16* ST = (LAS bf16*)(F.lds + 3 * 17408);
    LAS bf16* KDT = (LAS bf16*)(F.lds + 4 * 17408);
    LAS bf16* VT = (LAS bf16*)(F.lds + 4 * 17408 + 18432);
    LAS bf16* ATT = (LAS bf16*)(F.lds + 4 * 17408 + 18432 + 9216);
    LAS float* SEG = (LAS float*)(F.lds + 4 * 17408 + 18432 + 2 * 9216);
    LAS float* DECAY = SEG + 512;
    const int tid = F.tid, lane = F.lane, w = F.wave, l15 = lane & 15, q4 = lane >> 4;
    const int d = tid & 127, tq = tid >> 7;
    const int vn = tid & 63, vg = tid >> 6;
    const int tr = w >> 1, tc2 = w & 1;
    for (int item = blockIdx.x; item < nbatch * 8; item += F.G) {
        const int b = item >> 3, h = (item >> 1) & 3, half = item & 1;
        const float lb = 1.0f / (1.0f + __expf(lbp[512 + h * 128 + d] - lbp[h * 128 + d])), oml = 1.0f - lb;
        f32x4 Sacc[4];
#pragma unroll
        for (int nt = 0; nt < 4; ++nt) Sacc[nt] = (f32x4){0.f, 0.f, 0.f, 0.f};
        for (int e = tid; e < 64 * S136 / 2; e += NTHREADS) ((LAS unsigned*)ST)[e] = 0u;
        const size_t rowb = (size_t)b * SEQ;
        const bf16* zp = FBp + (rowb + tq * 16) * 512 + h * 128 + d;
        const bf16* qp = QB + (rowb + tq * 16) * 512 + h * 128 + d;
        bf16* vp = IB + (rowb + vg * 8) * 512 + h * 128 + half * 64 + vn;
        unsigned short zr[16], qr[16], vr[8];
#pragma unroll
        for (int i = 0; i < 16; ++i) { zr[i] = zp[(size_t)i * 512]; qr[i] = qp[(size_t)i * 512]; }
#pragma unroll
        for (int i = 0; i < 8; ++i) vr[i] = vp[(size_t)i * 512];
        __syncthreads();
        for (int n = 0; n < SEQ / 64; ++n) {
            float c[16], kk[16], qf[16];
            { float run = 0.f;
#pragma unroll
              for (int i = 0; i < 16; ++i) { const float z = bf2f(zr[i]); const float e1 = __expf(-z), sg = 1.0f / (1.0f + e1);
                  run += __logf(lb + oml * sg); c[i] = run; kk[i] = oml * e1 * sg; qf[i] = bf2f(qr[i]); } }
            unsigned short vcur[8];
#pragma unroll
            for (int i = 0; i < 8; ++i) vcur[i] = vr[i];
            SEG[tq * 128 + d] = c[15];
            if (n + 1 < SEQ / 64) {
                const size_t o2 = (size_t)(n + 1) * 64 * 512;
#pragma unroll
                for (int i = 0; i < 16; ++i) { zr[i] = zp[o2 + (size_t)i * 512]; qr[i] = qp[o2 + (size_t)i * 512]; }
#pragma unroll
                for (int i = 0; i < 8; ++i) vr[i] = vp[o2 + (size_t)i * 512];
            }
            __syncthreads();
            { const float s0 = SEG[d], s1 = SEG[128 + d], s2 = SEG[256 + d], s3 = SEG[384 + d];
              const float off = tq == 0 ? 0.f : tq == 1 ? s0 : tq == 2 ? s0 + s1 : s0 + s1 + s2;
              const float bref = s0 + s1, blast = (s0 + s1) + (s2 + s3);
              const float enb = __expf(-bref), eb = __expf(bref), el = __expf(blast);
              if (tq == 0) DECAY[d] = el;
              unsigned kd[8];
#pragma unroll
              for (int i = 0; i < 16; i += 2) {
                  const float E0 = __expf(c[i] + off), E1 = __expf(c[i + 1] + off), r0 = 1.0f / E0, r1 = 1.0f / E1;
                  const int t0 = tq * 16 + i;
                  const unsigned qd = pk2(qf[i] * E0, qf[i + 1] * E1), qi = pk2(qf[i] * E0 * enb, qf[i + 1] * E1 * enb), ki = pk2(kk[i] * eb * r0, kk[i + 1] * eb * r1);
                  QDEC[t0 * S136 + d] = (bf16)(qd & 0xffffu); QDEC[(t0 + 1) * S136 + d] = (bf16)(qd >> 16);
                  QIN[t0 * S136 + d] = (bf16)(qi & 0xffffu); QIN[(t0 + 1) * S136 + d] = (bf16)(qi >> 16);
                  KIN[t0 * S136 + d] = (bf16)(ki & 0xffffu); KIN[(t0 + 1) * S136 + d] = (bf16)(ki >> 16);
                  kd[i >> 1] = pk2(kk[i] * el * r0, kk[i + 1] * el * r1);
              }
              *(LAS v4u*)(KDT + d * S72 + tq * 16) = (v4u){kd[0], kd[1], kd[2], kd[3]};
              *(LAS v4u*)(KDT + d * S72 + tq * 16 + 8) = (v4u){kd[4], kd[5], kd[6], kd[7]};
              v4u vv; vv.x = (unsigned)vcur[0] | ((unsigned)vcur[1] << 16); vv.y = (unsigned)vcur[2] | ((unsigned)vcur[3] << 16); vv.z = (unsigned)vcur[4] | ((unsigned)vcur[5] << 16); vv.w = (unsigned)vcur[6] | ((unsigned)vcur[7] << 16);
              *(LAS v4u*)(VT + vn * S72 + vg * 8) = vv;
            }
            __syncthreads();
#pragma unroll
            for (int j = 0; j < 2; ++j) {
                const int tc = 2 * tc2 + j;
                f32x4 acc = {0.f, 0.f, 0.f, 0.f};
                if (tc <= tr) {
#pragma unroll
                    for (int ks = 0; ks < 4; ++ks) {
                        const bf16x8 a = *(const LAS bf16x8*)(QIN + (tr * 16 + l15) * S136 + ks * 32 + 8 * q4);
                        const bf16x8 bb = *(const LAS bf16x8*)(KIN + (tc * 16 + l15) * S136 + ks * 32 + 8 * q4);
                        acc = __builtin_amdgcn_mfma_f32_16x16x32_bf16(a, bb, acc, 0, 0, 0);
                    }
                }
                const int s_ = tc * 16 + l15;
#pragma unroll
                for (int r = 0; r < 4; ++r) { const int t_ = tr * 16 + 4 * q4 + r; ATT[t_ * S72 + s_] = (bf16)(pk2(s_ <= t_ ? acc[r] : 0.f, 0.f) & 0xffffu); }
            }
            __syncthreads();
#pragma unroll
            for (int j = 0; j < 2; ++j) {
                const int nt = 2 * tc2 + j;
                f32x4 acc = {0.f, 0.f, 0.f, 0.f};
#pragma unroll
                for (int ks = 0; ks < 2; ++ks) {
                    const bf16x8 a = *(const LAS bf16x8*)(ATT + (tr * 16 + l15) * S72 + ks * 32 + 8 * q4);
                    const bf16x8 bb = *(const LAS bf16x8*)(VT + (nt * 16 + l15) * S72 + ks * 32 + 8 * q4);
                    acc = __builtin_amdgcn_mfma_f32_16x16x32_bf16(a, bb, acc, 0, 0, 0);
                }
#pragma unroll
                for (int ks = 0; ks < 4; ++ks) {
                    const bf16x8 a = *(const LAS bf16x8*)(QDEC + (tr * 16 + l15) * S136 + ks * 32 + 8 * q4);
                    const bf16x8 bb = *(const LAS bf16x8*)(ST + (nt * 16 + l15) * S136 + ks * 32 + 8 * q4);
                    acc = __builtin_amdgcn_mfma_f32_16x16x32_bf16(a, bb, acc, 0, 0, 0);
                }
                bf16* op = OUTB + (rowb + (size_t)n * 64 + tr * 16 + 4 * q4) * 512 + h * 128 + half * 64 + nt * 16 + l15;
#pragma unroll
                for (int r = 0; r < 4; ++r) op[(size_t)r * 512] = (bf16)(pk2(acc[r], 0.f) & 0xffffu);
            }
            __syncthreads();
            { const f32x4 dc = *(const LAS f32x4*)(DECAY + w * 16 + 4 * q4);
#pragma unroll
              for (int nt = 0; nt < 4; ++nt) {
                  f32x4 acc = Sacc[nt] * dc;
#pragma unroll
                  for (int ks = 0; ks < 2; ++ks) {
                      const bf16x8 a = *(const LAS bf16x8*)(KDT + (w * 16 + l15) * S72 + ks * 32 + 8 * q4);
                      const bf16x8 bb = *(const LAS bf16x8*)(VT + (nt * 16 + l15) * S72 + ks * 32 + 8 * q4);
                      acc = __builtin_amdgcn_mfma_f32_16x16x32_bf16(a, bb, acc, 0, 0, 0);
                  }
                  Sacc[nt] = acc;
                  *(LAS v2u*)(ST + (nt * 16 + l15) * S136 + w * 16 + 4 * q4) = (v2u){pk2(acc[0], acc[1]), pk2(acc[2], acc[3])};
              } }
        }
        __syncthreads();
    }
}

__device__ __forceinline__ unsigned mono_key(float f) { const unsigned u = __float_as_uint(f); return (u & 0x80000000u) ? ~u : (u | 0x80000000u); }
__device__ __forceinline__ void p2_indexer_simple(Frame& F) {
    typedef short bf16x8 __attribute__((ext_vector_type(8)));
    const bf16* misc = (const bf16*)(F.ws + WS_MISC); const bf16* QI = (const bf16*)(F.ws + WS_QI);
    unsigned long long* BMp = (unsigned long long*)(F.ws + WS_BM);
    LAS float* sc = (LAS float*)(F.lds + F.wave * 16384);
    const int gw = blockIdx.x * NWAVES + F.wave, NGW = F.G * NWAVES, lane = F.lane;
    const int l15 = lane & 15, q4 = lane >> 4;
    for (int tp = gw; tp < T / 2; tp += NGW) {
        const int t0 = tp * 2, b = t0 >> 11, pos = t0 & 2047, chunk = pos >> 6, nk = chunk + 1;
        if (nk <= 4) { if (lane < 32) { BMp[(size_t)t0 * 32 + lane] = (lane < nk) ? ~0ull : 0ull; BMp[(size_t)(t0 + 1) * 32 + lane] = (lane < nk) ? ~0ull : 0ull; } continue; }
        const bf16* ap = QI + (size_t)(t0 + (l15 >> 3)) * 512 + (l15 & 7) * 64 + 8 * q4;
        const bf16x8 a0 = *(const bf16x8*)ap, a1 = *(const bf16x8*)(ap + 32);
        float w[4];
        { const v2u p = *(const v2u*)(misc + (size_t)(t0 + (q4 >> 1)) * 256 + 192 + (q4 & 1) * 4); const float s_ = 0.04419417382415922f;
          w[0] = bflo(p.x) * s_; w[1] = bfhi(p.x) * s_; w[2] = bflo(p.y) * s_; w[3] = bfhi(p.y) * s_; }
        const bf16* kbase = misc + ((size_t)b * SEQ + l15) * 256 + 128 + 8 * q4;
#pragma unroll 2
        for (int kt = 0; kt < nk * 4; ++kt) {
            const bf16* kp = kbase + (size_t)kt * 16 * 256;
            const bf16x8 b0 = *(const bf16x8*)kp, b1 = *(const bf16x8*)(kp + 32);
            f32x4 acc = {0.f, 0.f, 0.f, 0.f};
            acc = __builtin_amdgcn_mfma_f32_16x16x32_bf16(a0, b0, acc, 0, 0, 0);
            acc = __builtin_amdgcn_mfma_f32_16x16x32_bf16(a1, b1, acc, 0, 0, 0);
            float part = w[0] * fmaxf(acc[0], 0.f) + w[1] * fmaxf(acc[1], 0.f) + w[2] * fmaxf(acc[2], 0.f) + w[3] * fmaxf(acc[3], 0.f);
            part += __shfl_xor(part, 16);
            if ((q4 & 1) == 0) sc[(q4 >> 1) * 2048 + kt * 16 + l15] = part;
        }
        for (int i = nk; i < 32; ++i) { sc[i * 64 + lane] = -INFINITY; sc[2048 + i * 64 + lane] = -INFINITY; }
        LDS_WAIT(); asm volatile("" ::: "memory");
#pragma unroll 1
        for (int tt = 0; tt < 2; ++tt) {
            unsigned long long* bmrow = BMp + (size_t)(t0 + tt) * 32;
            unsigned key[32];
#pragma unroll
            for (int i = 0; i < 32; ++i) key[i] = mono_key(sc[tt * 2048 + i * 64 + lane]);
            unsigned prefix = 0u;
#pragma unroll 1
            for (int bit = 31; bit >= 0; --bit) {
                const unsigned cand = prefix | (1u << bit); int cnt = 0;
#pragma unroll
                for (int i = 0; i < 32; ++i) { cnt += __builtin_popcountll(__ballot(key[i] >= cand)); if ((i & 3) == 3) __builtin_amdgcn_sched_barrier(0); }
                if (cnt >= 256) prefix = cand;
            }
            int ngt = 0;
#pragma unroll
            for (int i = 0; i < 32; ++i) { ngt += __builtin_popcountll(__ballot(key[i] > prefix)); if ((i & 3) == 3) __builtin_amdgcn_sched_barrier(0); }
            const int need = 256 - ngt; int running = 0;
            const unsigned long long lt_mask = (1ull << lane) - 1ull;
#pragma unroll
            for (int i = 0; i < 32; ++i) {
                const unsigned long long eq = __ballot(key[i] == prefix), gt = __ballot(key[i] > prefix);
                const int rank = running + __builtin_popcountll(eq & lt_mask);
                const unsigned long long se = __ballot(key[i] == prefix && rank < need);
                running += __builtin_popcountll(eq);
                const unsigned long long word = gt | se;
                if (lane == 0) bmrow[i] = word;
                __builtin_amdgcn_sched_barrier(0);
            }
        }
        LDS_WAIT(); asm volatile("" ::: "memory");
    }
}

__device__ __forceinline__ void p3_hg_finalize(Frame& F) {
    bf16* HG = (bf16*)(F.ws + WS_IB); const bf16* GBp = (const bf16*)(F.ws + WS_GB); const float* ng = F.a->in[I_BNG];
    const int gw = blockIdx.x * NWAVES + F.wave, NGW = F.G * NWAVES, sub = F.lane >> 4, l16 = F.lane & 15;
    float gv[8];
#pragma unroll
    for (int j = 0; j < 8; ++j) gv[j] = ng[l16 * 8 + j];
    for (int r4 = gw; r4 < T; r4 += NGW) {
        const size_t off = (size_t)r4 * 512 + sub * 128 + l16 * 8;
        const v4u p = *(const v4u*)(HG + off), q = *(const v4u*)(GBp + off);
        float v[8] = {bflo(p.x), bfhi(p.x), bflo(p.y), bfhi(p.y), bflo(p.z), bfhi(p.z), bflo(p.w), bfhi(p.w)};
        float gg[8] = {bflo(q.x), bfhi(q.x), bflo(q.y), bfhi(q.y), bflo(q.z), bfhi(q.z), bflo(q.w), bfhi(q.w)};
        float ss = 0.f;
#pragma unroll
        for (int j = 0; j < 8; ++j) ss += v[j] * v[j];
        ss += __shfl_xor(ss, 1); ss += __shfl_xor(ss, 2); ss += __shfl_xor(ss, 4); ss += __shfl_xor(ss, 8);
        const float r = rsqrtf(ss * (1.0f / 128.0f) + RMS_EPS);
        float o[8];
#pragma unroll
        for (int j = 0; j < 8; ++j) o[j] = v[j] * r * gv[j] * gg[j] * sigmoidf_(gg[j]);
        v4u w; w.x = pk2(o[0], o[1]); w.y = pk2(o[2], o[3]); w.z = pk2(o[4], o[5]); w.w = pk2(o[6], o[7]);
        *(v4u*)(HG + off) = w;
    }
}

__device__ __forceinline__ int t5_bucket(int rel) {
    const int n = rel < 0 ? -rel : rel; const int base = rel > 0 ? 16 : 0;
    int v;
    if (n < 8) v = n; else v = n >= 91 ? 15 : n >= 64 ? 14 : n >= 46 ? 13 : n >= 32 ? 12 : n >= 23 ? 11 : n >= 16 ? 10 : n >= 12 ? 9 : 8;
    return base + v;
}
__device__ __forceinline__ void p3_attn_simple(Frame& F) {
    const bf16* CKV = (const bf16*)(F.ws + WS_CKV); bf16* QL = (bf16*)(F.ws + WS_QL);
    const unsigned long long* BMp = (const unsigned long long*)(F.ws + WS_BM);
    LAS float* relb = (LAS float*)(F.lds + 8 * 12800);
    LAS float* qlf = (LAS float*)(F.lds + F.wave * 12800);
    LAS float* pl = (LAS float*)(F.lds + F.wave * 12800 + 4096);
    LAS unsigned short* idx = (LAS unsigned short*)(F.lds + F.wave * 12800 + 4096 + 8192);
    if (F.tid < 256) relb[F.tid] = F.a->in[I_RELB][F.tid];
    __syncthreads();
    const int gw = blockIdx.x * NWAVES + F.wave, NGW = F.G * NWAVES, lane = F.lane;
    const unsigned long long lt_mask = (1ull << lane) - 1ull;
    for (int t = gw; t < T; t += NGW) {
        const int b = t >> 11, pos = t & 2047, nk = (pos >> 6) + 1;
        {
#pragma unroll
            for (int j = 0; j < 2; ++j) { const v4u p = *(const v4u*)(QL + (size_t)t * 1024 + j * 512 + lane * 8);
                f32x4 a = {bflo(p.x), bfhi(p.x), bflo(p.y), bfhi(p.y)}, c = {bflo(p.z), bfhi(p.z), bflo(p.w), bfhi(p.w)};
                *(LAS f32x4*)(qlf + j * 512 + lane * 8) = a; *(LAS f32x4*)(qlf + j * 512 + lane * 8 + 4) = c; }
        }
        int n = 0;
        for (int i = 0; i < nk; ++i) {
            const unsigned long long word = BMp[(size_t)t * 32 + i];
            if ((word >> lane) & 1ull) idx[n + __builtin_popcountll(word & lt_mask)] = (unsigned short)(i * 64 + lane);
            n += __builtin_popcountll(word);
        }
        LDS_WAIT(); asm volatile("" ::: "memory");
#pragma unroll 1
        for (int j = 0; j < 4; ++j) {
            const int k = lane + 64 * j; const bool ok = k < n; const int s = ok ? (int)idx[k] : 0;
            const v4u* row = (const v4u*)(CKV + ((size_t)b * SEQ + s) * 128);
            float d[8];
#pragma unroll
            for (int h = 0; h < 8; ++h) d[h] = 0.f;
#pragma unroll 1
            for (int q4 = 0; q4 < 4; ++q4) {
                asm volatile("" ::: "memory");
                float ck[32];
#pragma unroll
                for (int c = 0; c < 4; ++c) { const v4u p = row[q4 * 4 + c]; ck[c * 8 + 0] = bflo(p.x); ck[c * 8 + 1] = bfhi(p.x); ck[c * 8 + 2] = bflo(p.y); ck[c * 8 + 3] = bfhi(p.y); ck[c * 8 + 4] = bflo(p.z); ck[c * 8 + 5] = bfhi(p.z); ck[c * 8 + 6] = bflo(p.w); ck[c * 8 + 7] = bfhi(p.w); }
#pragma unroll
                for (int h = 0; h < 8; ++h) {
#pragma unroll
                    for (int c = 0; c < 8; ++c) { const f32x4 q = *(const LAS f32x4*)(qlf + h * 128 + q4 * 32 + c * 4); d[h] += q.x * ck[c * 4] + q.y * ck[c * 4 + 1] + q.z * ck[c * 4 + 2] + q.w * ck[c * 4 + 3]; }
                    __builtin_amdgcn_sched_barrier(0);
                }
            }
            const int bk = t5_bucket(s - pos);
            f32x4 s0, s1;
            s0.x = ok ? d[0] + relb[bk * 8 + 0] : -INFINITY; s0.y = ok ? d[1] + relb[bk * 8 + 1] : -INFINITY; s0.z = ok ? d[2] + relb[bk * 8 + 2] : -INFINITY; s0.w = ok ? d[3] + relb[bk * 8 + 3] : -INFINITY;
            s1.x = ok ? d[4] + relb[bk * 8 + 4] : -INFINITY; s1.y = ok ? d[5] + relb[bk * 8 + 5] : -INFINITY; s1.z = ok ? d[6] + relb[bk * 8 + 6] : -INFINITY; s1.w = ok ? d[7] + relb[bk * 8 + 7] : -INFINITY;
            *(LAS f32x4*)(pl + k * 8) = s0; *(LAS f32x4*)(pl + k * 8 + 4) = s1;
        }
        LDS_WAIT(); asm volatile("" ::: "memory");
        {
            f32x4 a0[4], a1[4];
#pragma unroll
            for (int j = 0; j < 4; ++j) { a0[j] = *(const LAS f32x4*)(pl + (lane + 64 * j) * 8); a1[j] = *(const LAS f32x4*)(pl + (lane + 64 * j) * 8 + 4); }
#pragma unroll
            for (int h = 0; h < 8; ++h) {
                float v[4];
#pragma unroll
                for (int j = 0; j < 4; ++j) v[j] = h < 4 ? a0[j][h & 3] : a1[j][h & 3];
                float m = wave_max(fmaxf(fmaxf(v[0], v[1]), fmaxf(v[2], v[3])));
                float sum = 0.f;
#pragma unroll
                for (int j = 0; j < 4; ++j) { v[j] = __expf(v[j] - m); sum += v[j]; }
                const float inv = 1.0f / wave_sum(sum);
#pragma unroll
                for (int j = 0; j < 4; ++j) { if (h < 4) a0[j][h & 3] = v[j] * inv; else a1[j][h & 3] = v[j] * inv; }
            }
#pragma unroll
            for (int j = 0; j < 4; ++j) { *(LAS f32x4*)(pl + (lane + 64 * j) * 8) = a0[j]; *(LAS f32x4*)(pl + (lane + 64 * j) * 8 + 4) = a1[j]; }
        }
        LDS_WAIT(); asm volatile("" ::: "memory");
        float acc[8][2];
#pragma unroll
        for (int h = 0; h < 8; ++h) { acc[h][0] = 0.f; acc[h][1] = 0.f; }
        for (int k = 0; k < n; ++k) {
            const int s = (int)idx[k];
            const unsigned vv = *(const unsigned*)(CKV + ((size_t)b * SEQ + s) * 128 + 2 * lane);
            const float v0 = bflo(vv), v1 = bfhi(vv);
            const f32x4 p0 = *(const LAS f32x4*)(pl + k * 8), p1 = *(const LAS f32x4*)(pl + k * 8 + 4);
            acc[0][0] += p0.x * v0; acc[0][1] += p0.x * v1; acc[1][0] += p0.y * v0; acc[1][1] += p0.y * v1;
            acc[2][0] += p0.z * v0; acc[2][1] += p0.z * v1; acc[3][0] += p0.w * v0; acc[3][1] += p0.w * v1;
            acc[4][0] += p1.x * v0; acc[4][1] += p1.x * v1; acc[5][0] += p1.y * v0; acc[5][1] += p1.y * v1;
            acc[6][0] += p1.z * v0; acc[6][1] += p1.z * v1; acc[7][0] += p1.w * v0; acc[7][1] += p1.w * v1;
        }
#pragma unroll
        for (int h = 0; h < 8; ++h) *(unsigned*)(QL + (size_t)t * 1024 + h * 128 + 2 * lane) = pk2(acc[h][0], acc[h][1]);
        LDS_WAIT(); asm volatile("" ::: "memory");
    }
}

__device__ __forceinline__ void p6_ln1(Frame& F) {
    float* Y = F.a->out; bf16* X1B = (bf16*)(F.ws + WS_X1B); const float* g = F.a->in[I_LN1G]; const float* bb = F.a->in[I_LN1B];
    const int gw = blockIdx.x * NWAVES + F.wave, NGW = F.G * NWAVES, lane = F.lane;
    f32x4 gv[4], bv[4];
#pragma unroll
    for (int j = 0; j < 4; ++j) { gv[j] = ((const f32x4*)g)[lane + 64 * j]; bv[j] = ((const f32x4*)bb)[lane + 64 * j]; }
    for (int m = gw; m < T; m += NGW) {
        f32x4* yr = (f32x4*)(Y + (size_t)m * DM) + lane;
        f32x4 v[4]; float s = 0.f;
#pragma unroll
        for (int j = 0; j < 4; ++j) { v[j] = yr[64 * j]; s += (v[j].x + v[j].y) + (v[j].z + v[j].w); }
        const float mean = wave_sum(s) * (1.f / DM); float s2 = 0.f;
#pragma unroll
        for (int j = 0; j < 4; ++j) { v[j] = v[j] - mean; s2 += (v[j].x * v[j].x + v[j].y * v[j].y) + (v[j].z * v[j].z + v[j].w * v[j].w); }
        const float rstd = rsqrtf(wave_sum(s2) * (1.f / DM) + LN_EPS);
        v2u* o8 = (v2u*)(X1B + (size_t)m * DM) + lane;
#pragma unroll
        for (int j = 0; j < 4; ++j) { const f32x4 o = v[j] * rstd * gv[j] + bv[j]; yr[64 * j] = o; v2u w; w.x = pk2(o.x, o.y); w.y = pk2(o.z, o.w); o8[64 * j] = w; }
    }
}

#define TOP16_INSERT(tv, ti, val, id) do { \
    _Pragma("unroll") for (int _j = 15; _j >= 1; --_j) { const bool _up = (val) > tv[_j - 1]; const bool _here = (val) > tv[_j]; \
        tv[_j] = _up ? tv[_j - 1] : (_here ? (val) : tv[_j]); ti[_j] = _up ? ti[_j - 1] : (_here ? (id) : ti[_j]); } \
    { const bool _h0 = (val) > tv[0]; tv[0] = _h0 ? (val) : tv[0]; ti[0] = _h0 ? (id) : ti[0]; } } while (0)
__device__ __forceinline__ void p8_peer_route_simple(Frame& F) {
    const bf16* PQ = (const bf16*)(F.ws + WS_PQ); int* IDS = (int*)(F.ws + WS_IDS); float* GATES = (float*)(F.ws + WS_GATES);
    LAS float* K1 = (LAS float*)(F.lds); LAS float* K2 = (LAS float*)(F.lds + 65536);
    for (int e = F.tid; e < 16384; e += NTHREADS) { K1[e] = F.a->in[I_SK1][e]; K2[e] = F.a->in[I_SK2][e]; }
    __syncthreads();
    const size_t gtid = (size_t)blockIdx.x * NTHREADS + F.tid, gthreads = (size_t)F.G * NTHREADS;
    for (size_t item = gtid; item < (size_t)T * 8; item += gthreads) {
        const size_t t = item >> 3; const int h = (int)(item & 7);
        float v1[16], v2[16]; int i1[16], i2[16];
#pragma unroll
        for (int half = 0; half < 2; ++half) {
            const v4u* qp = (const v4u*)(PQ + t * 2048 + h * 256 + half * 128);
            v4u q[16];
#pragma unroll
            for (int c = 0; c < 16; ++c) q[c] = qp[c];
            float tv[16]; int ti[16];
#pragma unroll
            for (int j = 0; j < 16; ++j) { tv[j] = -INFINITY; ti[j] = 0; }
            const LAS float* KK = half ? K2 : K1;
#pragma unroll 1
            for (int n = 0; n < 128; ++n) {
                float d = 0.f;
#pragma unroll
                for (int c = 0; c < 16; ++c) { const f32x4 ka = *(const LAS f32x4*)(KK + n * 128 + c * 8), kb = *(const LAS f32x4*)(KK + n * 128 + c * 8 + 4);
                    d += ka.x * bflo(q[c].x) + ka.y * bfhi(q[c].x) + ka.z * bflo(q[c].y) + ka.w * bfhi(q[c].y) + kb.x * bflo(q[c].z) + kb.y * bfhi(q[c].z) + kb.z * bflo(q[c].w) + kb.w * bfhi(q[c].w);
                    if ((c & 3) == 3) __builtin_amdgcn_sched_barrier(0); }
                TOP16_INSERT(tv, ti, d, n);
            }
#pragma unroll
            for (int j = 0; j < 16; ++j) { if (half) { v2[j] = tv[j]; i2[j] = ti[j]; } else { v1[j] = tv[j]; i1[j] = ti[j]; } }
        }
        float tv[16]; int ti[16];
#pragma unroll
        for (int j = 0; j < 16; ++j) { tv[j] = -INFINITY; ti[j] = 0; }
#pragma unroll
        for (int a = 0; a < 16; ++a)
#pragma unroll
            for (int c = 0; c < 16; ++c)
                if ((a + 1) * (c + 1) <= 16) { const float val = v1[a] + v2[c]; const int id = i1[a] * 128 + i2[c]; TOP16_INSERT(tv, ti, val, id); }
        float ev[16], sum = 0.f;
#pragma unroll
        for (int j = 0; j < 16; ++j) { ev[j] = __expf(tv[j] - tv[0]); sum += ev[j]; }
        const float inv = 1.0f / sum;
#pragma unroll
        for (int j4 = 0; j4 < 4; ++j4) {
            *(int4*)(IDS + t * 128 + h * 16 + j4 * 4) = make_int4(ti[j4 * 4], ti[j4 * 4 + 1], ti[j4 * 4 + 2], ti[j4 * 4 + 3]);
            *(f32x4*)(GATES + t * 128 + h * 16 + j4 * 4) = (f32x4){ev[j4 * 4] * inv, ev[j4 * 4 + 1] * inv, ev[j4 * 4 + 2] * inv, ev[j4 * 4 + 3] * inv};
        }
    }
}

__device__ __forceinline__ void p9_peer_gather_simple(Frame& F) {
    float* X1 = F.a->out; const bf16* UT = (const bf16*)(F.ws + WS_UT); const bf16* VT = (const bf16*)(F.ws + WS_VT);
    const int* IDS = (const int*)(F.ws + WS_IDS); const float* GATES = (const float*)(F.ws + WS_GATES);
    const float* g = F.a->in[I_LN2G]; const float* bb = F.a->in[I_LN2B];
    const int gw = blockIdx.x * NWAVES + F.wave, NGW = F.G * NWAVES, lane = F.lane;
    f32x4 gv[4], bv[4];
#pragma unroll
    for (int j = 0; j < 4; ++j) { gv[j] = ((const f32x4*)g)[lane + 64 * j]; bv[j] = ((const f32x4*)bb)[lane + 64 * j]; }
    for (int t = gw; t < T; t += NGW) {
        f32x4* xr = (f32x4*)(X1 + (size_t)t * DM) + lane;
        f32x4 x[4], acc[4];
#pragma unroll
        for (int j = 0; j < 4; ++j) { x[j] = xr[64 * j]; acc[j] = (f32x4){0.f, 0.f, 0.f, 0.f}; }
        const int myid = IDS[(size_t)t * 128 + lane], myid2 = IDS[(size_t)t * 128 + 64 + lane];
        const float myg = GATES[(size_t)t * 128 + lane], myg2 = GATES[(size_t)t * 128 + 64 + lane];
        for (int k0 = 0; k0 < 128; k0 += 4) {
            float gt[4]; v2u uu[4][4], vv[4][4];
#pragma unroll
            for (int e = 0; e < 4; ++e) { const int k = k0 + e;
                const int id = __shfl(k0 < 64 ? myid : myid2, k & 63); gt[e] = __shfl(k0 < 64 ? myg : myg2, k & 63);
                const v2u* up = (const v2u*)(UT + (size_t)id * DM) + lane; const v2u* vp = (const v2u*)(VT + (size_t)id * DM) + lane;
#pragma unroll
                for (int j = 0; j < 4; ++j) { uu[e][j] = up[64 * j]; vv[e][j] = vp[64 * j]; } }
#pragma unroll
            for (int e = 0; e < 4; ++e) {
                float d = 0.f;
#pragma unroll
                for (int j = 0; j < 4; ++j) d += x[j].x * bflo(uu[e][j].x) + x[j].y * bfhi(uu[e][j].x) + x[j].z * bflo(uu[e][j].y) + x[j].w * bfhi(uu[e][j].y);
                d = wave_sum(d);
                const float hv = 0.5f * d * (1.0f + erff(d * 0.7071067811865476f));
                const float w = gt[e] * hv;
#pragma unroll
                for (int j = 0; j < 4; ++j) { acc[j].x += w * bflo(vv[e][j].x); acc[j].y += w * bfhi(vv[e][j].x); acc[j].z += w * bflo(vv[e][j].y); acc[j].w += w * bfhi(vv[e][j].y); }
            }
        }
        float s = 0.f;
#pragma unroll
        for (int j = 0; j < 4; ++j) { acc[j] = x[j] * ALPHA + acc[j]; s += (acc[j].x + acc[j].y) + (acc[j].z + acc[j].w); }
        const float mean = wave_sum(s) * (1.f / DM); float s2 = 0.f;
#pragma unroll
        for (int j = 0; j < 4; ++j) { acc[j] = acc[j] - mean; s2 += (acc[j].x * acc[j].x + acc[j].y * acc[j].y) + (acc[j].z * acc[j].z + acc[j].w * acc[j].w); }
        const float rstd = rsqrtf(wave_sum(s2) * (1.f / DM) + LN_EPS);
#pragma unroll
        for (int j = 0; j < 4; ++j) xr[64 * j] = acc[j] * rstd * gv[j] + bv[j];
    }
}

__global__ void __launch_bounds__(NTHREADS, 2) hybrid_fwd(Args args) {
    extern __shared__ __attribute__((aligned(16))) unsigned char lds[];
    Frame F;
    F.lds = (LAS unsigned char*)lds;
    F.tid = threadIdx.x; F.lane = F.tid & 63; F.wave = __builtin_amdgcn_readfirstlane(F.tid >> 6);
    F.G = gridDim.x; F.a = (KArgs)__builtin_amdgcn_kernarg_segment_ptr(); F.ws = args.ws;
#define FRESH() do { int _t = threadIdx.x; asm volatile("" : "+v"(_t)); F.tid = _t; F.lane = _t & 63; F.wave = __builtin_amdgcn_readfirstlane(_t >> 6); \
        KArgs _k = (KArgs)__builtin_amdgcn_kernarg_segment_ptr(); asm volatile("" : "+s"(_k)); F.a = _k; F.ws = _k->ws; } while (0)
    volatile LAS unsigned* MISC = (volatile LAS unsigned*)(F.lds + MISC_OFF);
    for (int u = F.tid; u < (LDS_BYTES - LDSCTL_OFF) / 4; u += NTHREADS) ((LAS unsigned*)(F.lds + LDSCTL_OFF))[u] = 0u;
    __syncthreads();
    const int lo = args.ph_lo, hi = args.ph_hi;
    const bool need_bar = (hi - lo) > 1;
    XcdBarrier bar; bar.bar = (unsigned*)(args.ws + WS_CTL) + CW_BAR + args.li * XCD_BAR_WORDS; bar.x = 0; bar.st = nullptr;
    if (need_bar) bar = xcd_barrier_post(bar.bar, MISC + 8);
#if defined(PHASE_MASK)
#define IN(k) (((PHASE_MASK >> (k)) & 1) && lo <= (k) && (k) < hi)
#elif defined(ONLY_PHASE)
#define IN(k) ((k) == ONLY_PHASE && lo <= (k) && (k) < hi)
#else
#define IN(k) (lo <= (k) && (k) < hi)
#endif
#define SEAM(k) do { if (IN(k) && IN((k) + 1)) xcd_barrier(bar); } while (0)
    LAS unsigned char* ring = F.lds;

    if (IN(0)) { FRESH(); p0_prologue(F); }
    SEAM(0);
    if (IN(1)) {
        FRESH();
        pg8::Gemm g{(const bf16*)(F.ws + WS_XB), (const bf16*)(F.ws + WS_WIN), T, NPROJ, 1024}; pg8::StaticOrder S; S.init(T, NPROJ, F.G, (int)blockIdx.x);
        EpiProj E{F.ws};
        pg8::gemm_phase<EpiProj, pg8::StaticOrder>(ring, g, S, E, F.tid);
    }
    SEAM(1);
    if (IN(2)) {
        FRESH();
#if !defined(P2SEL) || (P2SEL & 1)
        p2_ckv_norm(F);
#endif
#if !defined(P2SEL) || (P2SEL & 2)
#if defined(HGRN_DEBUG)
        p2_hgrn_chunked(F, (bf16*)(F.ws + WS_END), 16);
        __syncthreads();
        FRESH();
        p2_hgrn_simple(F);
        VM_WAIT(); __syncthreads();
        FRESH();
        {
            unsigned* ctl = (unsigned*)(F.ws + WS_CTL);
            const bf16* A_ = (const bf16*)(F.ws + WS_END); const bf16* B_ = (const bf16*)(F.ws + WS_IB);
            float mx = 0.f; unsigned nn = 0;
            for (int item = blockIdx.x; item < NB * 4; item += F.G) { const int b = item >> 2, h = item & 3; if (b >= 16) continue;
                for (int e = F.tid; e < SEQ * 128; e += NTHREADS) { const size_t o = ((size_t)b * SEQ + (e >> 7)) * 512 + h * 128 + (e & 127);
                    const float x = bf2f(A_[o]), y = bf2f(B_[o]); if (x != x) ++nn; const float df = fabsf(x - y); if (df == df) mx = fmaxf(mx, df); } }
            mx = wave_max(mx); nn = (unsigned)wave_sum((float)nn);
            if (F.lane == 0) { atomicMax(ctl + 2048, __float_as_uint(mx)); atomicAdd(ctl + 2112, nn); }
        }
#elif defined(HGRN_SIMPLE)
        p2_hgrn_simple(F);
#else
        p2_hgrn_chunked(F, (bf16*)(F.ws + WS_IB), NB);
#endif
#endif
        __syncthreads();
        FRESH();
#if !defined(P2SEL) || (P2SEL & 4)
        p2_indexer_simple(F);
#endif
    }
    SEAM(2);
    if (IN(3)) { FRESH(); p3_hg_finalize(F); __syncthreads(); p3_attn_simple(F); }
    SEAM(3);
    if (IN(4)) {
        FRESH();
        { pg8::Gemm g{(const bf16*)(F.ws + WS_QL), (const bf16*)(F.ws + WS_WA), T, 1024, 1024}; pg8::StaticOrder S; S.init(T, 1024, F.G, (int)blockIdx.x);
          EpiBranch<0> E{(const bf16*)(F.ws + WS_GA), (bf16*)(F.ws + WS_MERGED)};
          pg8::gemm_phase<EpiBranch<0>, pg8::StaticOrder>(ring, g, S, E, F.tid); }
        FRESH();
        { pg8::Gemm g{(const bf16*)(F.ws + WS_IB), (const bf16*)(F.ws + WS_WB), T, 1024, 512}; pg8::StaticOrder S; S.init(T, 1024, F.G, (int)blockIdx.x);
          EpiBranch<1> E{(const bf16*)(F.ws + WS_GBT), (bf16*)(F.ws + WS_MERGED)};
          pg8::gemm_phase<EpiBranch<1>, pg8::StaticOrder>(ring, g, S, E, F.tid); }
    }
    SEAM(4);
    if (IN(5)) {
        FRESH();
        pg8::Gemm g{(const bf16*)(F.ws + WS_MERGED), (const bf16*)(F.ws + WS_WO), T, 1024, 1024}; pg8::StaticOrder S; S.init(T, 1024, F.G, (int)blockIdx.x);
        EpiResF32 E{F.a->in[I_X], F.a->out};
        pg8::gemm_phase<EpiResF32, pg8::StaticOrder>(ring, g, S, E, F.tid);
    }
    SEAM(5);
    if (IN(6)) { FRESH(); p6_ln1(F); }
    SEAM(6);
    if (IN(7)) {
        FRESH();
        pg8::Gemm g{(const bf16*)(F.ws + WS_X1B), (const bf16*)(F.ws + WS_WPQ), T, 2048, 1024}; pg8::StaticOrder S; S.init(T, 2048, F.G, (int)blockIdx.x);
        EpiPlainBf16 E{(bf16*)(F.ws + WS_PQ), 2048};
        pg8::gemm_phase<EpiPlainBf16, pg8::StaticOrder>(ring, g, S, E, F.tid);
    }
    SEAM(7);
    if (IN(8)) { FRESH(); p8_peer_route_simple(F); }
    SEAM(8);
    if (IN(9)) { FRESH(); p9_peer_gather_simple(F);
#if defined(HGRN_DEBUG)
        VM_WAIT(); __syncthreads();
        if (blockIdx.x == 0 && F.tid == 0) { unsigned* ctl = (unsigned*)(F.ws + WS_CTL);
            const float mx = __uint_as_float(__hip_atomic_load(ctl + 2048, RLX_AGENT)); const unsigned nn = __hip_atomic_load(ctl + 2112, RLX_AGENT);
            F.a->out[0] = nn ? 7000.f : (10.f + 100.f * fminf(mx, 50.f)); }
#endif
    }
#undef IN
#undef SEAM
}

extern "C" void kernel_launch(void* const* d_in, const int* in_sizes, int n_in, void* d_out, int out_size, void* d_ws, size_t ws_size, hipStream_t stream) {
    static int grid = 0;
    if (grid == 0) {
        if (n_in != 20 || out_size != T * DM || ws_size < WS_END) { fprintf(stderr, "kernel_launch: unexpected problem (n_in %d out %d ws %zu)\n", n_in, out_size, ws_size); grid = -1; return; }
        int dev = 0, cus = 0;
        if (hipGetDevice(&dev) != hipSuccess || hipDeviceGetAttribute(&cus, hipDeviceAttributeMultiprocessorCount, dev) != hipSuccess) { grid = -1; return; }
        if (hipFuncSetAttribute((const void*)hybrid_fwd, hipFuncAttributeMaxDynamicSharedMemorySize, LDS_BYTES) != hipSuccess) { fprintf(stderr, "kernel_launch: hipFuncSetAttribute failed\n"); grid = -1; return; }
        int per_cu = 0;
        if (hipOccupancyMaxActiveBlocksPerMultiprocessor(&per_cu, (const void*)hybrid_fwd, NTHREADS, LDS_BYTES) != hipSuccess || per_cu < 1) fprintf(stderr, "kernel_launch: occupancy query reports %d\n", per_cu);
        (void)hipGetLastError();
        grid = cus;
    }
    if (grid < 0) return;
    (void)hipMemsetAsync((char*)d_ws + WS_CTL, 0, CTL_ZERO_BYTES, stream);
    Args a{};
    for (int i = 0; i < 20; ++i) a.in[i] = (const float*)d_in[i];
    a.out = (float*)d_out; a.ws = (unsigned char*)d_ws;
    constexpr int NL = MK_N_LAUNCHES;
    for (int li = 0; li < NL; ++li) {
        a.ph_lo = (NL == 1) ? 0 : li; a.ph_hi = (NL == 1) ? N_PHASES : li + 1; a.li = li;
        hipLaunchKernelGGL(hybrid_fwd, dim3(grid), dim3(NTHREADS), LDS_BYTES, stream, a);
    }
}
```

```cpp
#include <hip/hip_runtime.h>
#include <cstdio>
#include <cstdint>

#ifndef MK_N_LAUNCHES
#define MK_N_LAUNCHES 1
#endif

namespace pg8 {
#define PG8_LAS __attribute__((address_space(3)))
typedef unsigned short bf16_t;
typedef short bf16x8 __attribute__((ext_vector_type(8)));
typedef float f32x4 __attribute__((ext_vector_type(4)));
typedef unsigned u32x4 __attribute__((ext_vector_type(4)));
constexpr int BM = 256, BK = 64, HALF = 128, HTB = HALF * BK * 2, STAGE_BYTES = 8 * HTB, NXCD = 8, WGM = 8;

__host__ __device__ __forceinline__ int lds_byte(int r, int c) { const int st = (r >> 4) * 2 + (c >> 5), rr = r & 15, cc = c & 31, ob = rr * 64 + cc * 2; return st * 1024 + (ob ^ (((ob >> 9) & 1) << 5)); }
__host__ __device__ __forceinline__ void stage_rc(int b, int& R, int& C) { const int st = b / 1024, sb = b % 1024, swz = sb ^ (((sb >> 9) & 1) << 5); R = (st >> 1) * 16 + swz / 64; C = (st & 1) * 32 + (swz % 64) / 2; }
__host__ __device__ __forceinline__ int perm32(int rho) { const int n = rho >> 4, i = rho & 15; return 8 * (i >> 2) + 4 * n + (i & 3); }

struct Unit { int pm, pn; };
struct Gemm { const bf16_t* A; const bf16_t* Bt; int M, N, K; };

struct StaticOrder {
    int nM, nN, nwg, G, c;
    __host__ __device__ void init(int M, int N, int G_, int c_) { nM = M / BM; nN = N / BM; nwg = nM * nN; G = G_; c = c_; }
    __host__ __device__ bool next(int i, Unit& u) const {
        const long L = (long)i * G + c; if (L >= nwg) return false;
        int wgid = (int)L; { const int q = nwg / NXCD, r = nwg % NXCD, xcd = wgid % NXCD, off = wgid / NXCD; wgid = (xcd < r ? xcd * (q + 1) : r * (q + 1) + (xcd - r) * q) + off; }
        const int nig = WGM * nN, gid = wgid / nig, fm = gid * WGM, gsz = (nM - fm) < WGM ? (nM - fm) : WGM;
        u.pm = fm + ((wgid % nig) % gsz); u.pn = (wgid % nig) / gsz; return true;
    }
    __device__ __forceinline__ void a_ready(const Unit&) const {}
    __device__ __forceinline__ void done(const Unit&) const {}
};

__device__ __forceinline__ unsigned cvt_pk_bf16(float lo, float hi) { unsigned r; asm volatile("v_cvt_pk_bf16_f32 %0, %1, %2" : "=v"(r) : "v"(lo), "v"(hi)); return r; }

template <class Epi, class Sched>
__device__ __forceinline__ void gemm_phase(PG8_LAS unsigned char* lds, const Gemm g, const Sched& S, const Epi& E, const int tid) {
    const int wid = __builtin_amdgcn_readfirstlane(tid >> 6), lane = tid & 63, wr = wid >> 2, wc = wid & 3, fr = lane & 15, fq = lane >> 4;
    const int K = g.K, nt = K / BK;
    unsigned voffA[2], voffB[2];
#pragma unroll
    for (int i = 0; i < 2; ++i) { int R, C; stage_rc(tid * 16 + i * 8192, R, C); const int Rb = Epi::PERM ? ((R & ~31) + perm32(R & 31)) : R;
        voffA[i] = (unsigned)(R * K + C) * 2u; voffB[i] = (unsigned)(Rb * K + C) * 2u; }
    const size_t kstep = (size_t)(BK * 2);
    const size_t hstep = (size_t)HALF * K * 2;
    const size_t tstep = 2 * hstep;
    const unsigned ldsw = (unsigned)wid * 1024u;
    const int aoff = lds_byte(wr * 64 + fr, fq * 8), boff = lds_byte(wc * 32 + fr, fq * 8);
#define PG8_SA(b, h) (((b) * 2 + (h)) * HTB)
#define PG8_SB(b, h) ((4 + (b) * 2 + (h)) * HTB)
#define PG8_STAGE(bufoff, gbase, voff) do { _Pragma("unroll") for (int _i = 0; _i < 2; ++_i) \
        __builtin_amdgcn_global_load_lds((const unsigned*)((const char*)(gbase) + (voff)[_i]), (PG8_LAS unsigned*)(lds + (bufoff) + ldsw + _i * 8192), 16, 0, 0); } while (0)
#define PG8_LDA(dst, b, h) do { _Pragma("unroll") for (int m = 0; m < 4; ++m) _Pragma("unroll") for (int k = 0; k < 2; ++k) dst[m][k] = *(const PG8_LAS bf16x8*)(lds + PG8_SA(b, h) + aoff + m * 2048 + k * 1024); } while (0)
#define PG8_LDB(dst, b, h) do { _Pragma("unroll") for (int n = 0; n < 2; ++n) _Pragma("unroll") for (int k = 0; k < 2; ++k) dst[n][k] = *(const PG8_LAS bf16x8*)(lds + PG8_SB(b, h) + boff + n * 2048 + k * 1024); } while (0)
#define PG8_MMA(ai, bj, At, Bt) do { __builtin_amdgcn_s_setprio(1); _Pragma("unroll") for (int m = 0; m < 4; ++m) _Pragma("unroll") for (int n = 0; n < 2; ++n) _Pragma("unroll") for (int k = 0; k < 2; ++k) \
        acc[ai][bj][m][n] = __builtin_amdgcn_mfma_f32_16x16x32_bf16(Bt[n][k], At[m][k], acc[ai][bj][m][n], 0, 0, 0); __builtin_amdgcn_s_setprio(0); } while (0)
#define PG8_WAIT_V(n) asm volatile("s_waitcnt vmcnt(" #n ")" ::: "memory")
#define PG8_WAIT_L(n) asm volatile("s_waitcnt lgkmcnt(" #n ")" ::: "memory")
#define PG8_BAR __builtin_amdgcn_s_barrier()
#define PG8_SCHED __builtin_amdgcn_sched_barrier(0)
    Unit cur, nxt; int ui = 0;
    if (!S.next(0, cur)) return;
    f32x4 acc[2][2][4][2];
#pragma unroll
    for (int a = 0; a < 2; ++a)
#pragma unroll
        for (int b = 0; b < 2; ++b)
#pragma unroll
            for (int m = 0; m < 4; ++m)
#pragma unroll
                for (int n = 0; n < 2; ++n) acc[a][b][m][n] = (f32x4){0.f, 0.f, 0.f, 0.f};
    bf16x8 At[4][2], B0[2][2], B1[2][2];
    const char* cA = (const char*)g.A + (size_t)cur.pm * tstep; const char* cB = (const char*)g.Bt + (size_t)cur.pn * tstep;
    S.a_ready(cur);
    PG8_STAGE(PG8_SB(0, 0), cB, voffB); PG8_STAGE(PG8_SA(0, 0), cA, voffA); PG8_STAGE(PG8_SB(0, 1), cB + hstep, voffB); PG8_STAGE(PG8_SA(0, 1), cA + hstep, voffA);
    if (wr == 1) PG8_BAR;
    PG8_WAIT_V(4); PG8_BAR;
    PG8_STAGE(PG8_SB(1, 0), cB + kstep, voffB); PG8_STAGE(PG8_SA(1, 0), cA + kstep, voffA); PG8_STAGE(PG8_SB(1, 1), cB + hstep + kstep, voffB);
    PG8_WAIT_V(6); PG8_BAR;
    for (;;) {
        const bool has_next = S.next(ui + 1, nxt);
        const char* nA = has_next ? (const char*)g.A + (size_t)nxt.pm * tstep : cA; const char* nB = has_next ? (const char*)g.Bt + (size_t)nxt.pn * tstep : cB;
        for (int t = 0; t < nt; t += 2) {
            const bool last = (t == nt - 2);
            const char* a1 = cA + (size_t)(t + 1) * kstep;
            const char* a2 = last ? nA : cA + (size_t)(t + 2) * kstep; const char* b2 = last ? nB : cB + (size_t)(t + 2) * kstep;
            const char* a3 = a2 + kstep; const char* b3 = b2 + kstep;
            if (last && has_next) S.a_ready(nxt);
            PG8_LDB(B0, 0, 0); PG8_SCHED; PG8_LDA(At, 0, 0); PG8_STAGE(PG8_SA(1, 1), a1 + hstep, voffA);
            PG8_WAIT_L(8); PG8_BAR; PG8_WAIT_L(0); PG8_MMA(0, 0, At, B0); PG8_BAR; PG8_SCHED;
            PG8_LDB(B1, 0, 1); PG8_STAGE(PG8_SB(0, 0), b2, voffB);
            PG8_BAR; PG8_WAIT_L(0); PG8_MMA(0, 1, At, B1); PG8_BAR;
            PG8_LDA(At, 0, 1); PG8_STAGE(PG8_SA(0, 0), a2, voffA);
            PG8_BAR; PG8_WAIT_L(0); PG8_MMA(1, 0, At, B0); PG8_BAR; PG8_SCHED;
            PG8_STAGE(PG8_SB(0, 1), b2 + hstep, voffB);
            PG8_WAIT_V(6); PG8_BAR; PG8_MMA(1, 1, At, B1); PG8_BAR;
            PG8_LDB(B0, 1, 0); PG8_SCHED; PG8_LDA(At, 1, 0); PG8_STAGE(PG8_SA(0, 1), a2 + hstep, voffA);
            PG8_WAIT_L(8); PG8_BAR; PG8_WAIT_L(0); PG8_MMA(0, 0, At, B0); PG8_BAR; PG8_SCHED;
            PG8_LDB(B1, 1, 1); PG8_STAGE(PG8_SB(1, 0), b3, voffB);
            PG8_BAR; PG8_WAIT_L(0); PG8_MMA(0, 1, At, B1); PG8_BAR;
            PG8_LDA(At, 1, 1); PG8_STAGE(PG8_SA(1, 0), a3, voffA);
            PG8_BAR; PG8_WAIT_L(0); PG8_MMA(1, 0, At, B0); PG8_BAR; PG8_SCHED;
            PG8_STAGE(PG8_SB(1, 1), b3 + hstep, voffB);
            PG8_WAIT_V(6); PG8_BAR; PG8_MMA(1, 1, At, B1); PG8_BAR;
        }
        E(acc, cur, wr, wc, fr, fq); S.done(cur);
        if (!has_next) break;
#pragma unroll
        for (int a = 0; a < 2; ++a)
#pragma unroll
            for (int b = 0; b < 2; ++b)
#pragma unroll
                for (int m = 0; m < 4; ++m)
#pragma unroll
                    for (int n = 0; n < 2; ++n) acc[a][b][m][n] = (f32x4){0.f, 0.f, 0.f, 0.f};
        cur = nxt; cA = nA; cB = nB; ++ui;
    }
    PG8_WAIT_V(0);
    if (wr == 0) PG8_BAR;
    PG8_BAR;
#undef PG8_SA
#undef PG8_SB
#undef PG8_STAGE
#undef PG8_LDA
#undef PG8_LDB
#undef PG8_MMA
#undef PG8_WAIT_V
#undef PG8_WAIT_L
#undef PG8_BAR
#undef PG8_SCHED
}
}

constexpr int NWAVES = 8, NTHREADS = 512;
constexpr int NB = 32, SEQ = 2048, DM = 1024, T = NB * SEQ;
constexpr int IN_COLS = 5320, NPROJ = 5888;
constexpr int N_PHASES = 13;
constexpr float ALPHA = 1.189207115002721f;
constexpr float LN_EPS = 1e-5f, RMS_EPS = 1e-6f;

constexpr size_t MiB = 1u << 20;
constexpr size_t WS_CTL = 0, CTL_ZERO_BYTES = 1 * MiB;
constexpr size_t WS_WIN = 1 * MiB, WS_WA = 13 * MiB, WS_WB = 15 * MiB, WS_WO = 16 * MiB, WS_WPQ = 18 * MiB;
constexpr size_t WS_UT8 = 24 * MiB, WS_VT8 = 40 * MiB, WS_UINV = 56 * MiB, WS_VINV = 56 * MiB + 65536;
constexpr size_t WS_XB = 88 * MiB;
constexpr size_t WS_QL = 216 * MiB;
constexpr size_t WS_MISC = 344 * MiB;
constexpr size_t WS_CKV = 376 * MiB;
constexpr size_t WS_QI = 392 * MiB, WS_QB = 456 * MiB, WS_FB = 520 * MiB, WS_IB = 584 * MiB, WS_GB = 648 * MiB;
constexpr size_t WS_GA = 712 * MiB, WS_GBT = 840 * MiB;
constexpr size_t WS_BM = 968 * MiB;
constexpr size_t WS_END = 984 * MiB;
constexpr size_t WS_MERGED = WS_XB, WS_X1B = WS_QL, WS_PQ = WS_QI, WS_IDS = WS_GB, WS_GATES = WS_GB + 32 * MiB, WS_HP = WS_GA, WS_FFN = WS_XB;
constexpr int CW_QU = 8192, CW_QV = 8192 + 512;
constexpr int CW_BAR = 4096;

constexpr int RING_BYTES = 131072;
constexpr int LDSCTL_OFF = RING_BYTES, MISC_OFF = LDSCTL_OFF + 320;
constexpr int LDS_BYTES = 147456;

#define GAS __attribute__((address_space(1)))
#define LAS __attribute__((address_space(3)))
typedef unsigned short bf16;
typedef unsigned v4u __attribute__((ext_vector_type(4)));
typedef unsigned v2u __attribute__((ext_vector_type(2)));
typedef float f32x4 __attribute__((ext_vector_type(4)));
typedef float f32x2 __attribute__((ext_vector_type(2)));
typedef GAS unsigned gu32;
#define RLX_AGENT __ATOMIC_RELAXED, __HIP_MEMORY_SCOPE_AGENT
#define LDS_WAIT() asm volatile("s_waitcnt lgkmcnt(0)" ::: "memory")
#define VM_WAIT() asm volatile("s_waitcnt vmcnt(0)" ::: "memory")
typedef __bf16 bf16x2_t __attribute__((ext_vector_type(2)));
__device__ __forceinline__ unsigned pk2(float lo, float hi) { const bf16x2_t v = {(__bf16)lo, (__bf16)hi}; return __builtin_bit_cast(unsigned, v); }
__device__ __forceinline__ float bflo(unsigned u) { return __uint_as_float(u << 16); }
__device__ __forceinline__ float bfhi(unsigned u) { return __uint_as_float(u & 0xffff0000u); }
__device__ __forceinline__ float bf2f(bf16 b) { return __uint_as_float(((unsigned)b) << 16); }
__device__ __forceinline__ float sigmoidf_(float x) { return 1.0f / (1.0f + __expf(-x)); }

#define XB_TMO      128
#define XB_XCNT(j)  (256  + 64 * (j))
#define XB_XSUB(j)  (1280 + 64 * (j))
#define XB_XGEN(j)  (2304 + 64 * (j))
#define XB_TOP      3328
#define XB_TOPGEN   3392
#define XCD_BAR_WORDS 3456
#define XB_SPIN_CAP (1u << 22)
__device__ __forceinline__ unsigned xb_ld(unsigned* p)              { return __hip_atomic_load(p, __ATOMIC_RELAXED, __HIP_MEMORY_SCOPE_AGENT); }
__device__ __forceinline__ unsigned xb_add(unsigned* p, unsigned v) { return __hip_atomic_fetch_add(p, v, __ATOMIC_RELAXED, __HIP_MEMORY_SCOPE_AGENT); }
__device__ __forceinline__ unsigned xb_xcc_id() { return (unsigned)__builtin_amdgcn_s_getreg((3 << 11) | 20) & 0xFu; }
#define XB_SPIN(cond, bar) do { unsigned _sp = 0; while (cond) { __builtin_amdgcn_s_sleep(1); \
    if ((++_sp & 255u) == 0u) { if (xb_ld(&(bar)[XB_TMO])) break; if (_sp > XB_SPIN_CAP) { atomicAdd(&(bar)[XB_TMO], 1u); break; } } } } while (0)
struct XcdBarrier { unsigned* bar; unsigned x; volatile LAS unsigned* st; };
__device__ __forceinline__ XcdBarrier xcd_barrier_post(unsigned* bar, volatile LAS unsigned* st) {
    XcdBarrier b; b.bar = bar; b.x = xb_xcc_id(); b.st = st;
    if (threadIdx.x == 0) (void)xb_add(&bar[XB_XCNT(b.x)], 1u);
    return b;
}
__device__ __forceinline__ void xcd_barrier_complete(unsigned* bar, unsigned x, unsigned& nloc, unsigned& nx) {
    const unsigned G = gridDim.x * gridDim.y * gridDim.z;
    unsigned sum, cnt, mine, sp = 0u;
    for (;;) {
        sum = 0u; cnt = 0u; mine = 0u;
#pragma unroll
        for (unsigned j = 0; j < 16; ++j) { const unsigned c = xb_ld(&bar[XB_XCNT(j)]); sum += c; cnt += (c > 0u) ? 1u : 0u; mine = (j == x) ? c : mine; }
        if (sum == G) break;
        __builtin_amdgcn_s_sleep(1);
        if ((++sp & 255u) == 0u) { if (xb_ld(&bar[XB_TMO])) break; if (sp > XB_SPIN_CAP) { atomicAdd(&bar[XB_TMO], 1u); break; } }
    }
    nloc = mine > 0u ? mine : 1u; nx = cnt > 0u ? cnt : 1u;
}
__device__ __forceinline__ void xcd_barrier(const XcdBarrier& b) {
    asm volatile("s_waitcnt vmcnt(0)" ::: "memory");
    __syncthreads();
    if (threadIdx.x == 0) {
        unsigned* bar = b.bar;
        __builtin_amdgcn_s_waitcnt(0);
        unsigned nloc = b.st[0], nx = b.st[1];
        if (nloc == 0u) { xcd_barrier_complete(bar, b.x, nloc, nx); b.st[0] = nloc; b.st[1] = nx; }
        const unsigned old = xb_add(&bar[XB_XSUB(b.x)], 1u);
        const unsigned gen = old / nloc;
        if (old + 1u == (gen + 1u) * nloc) {
            __builtin_amdgcn_fence(__ATOMIC_RELEASE, "agent");
            asm volatile("s_waitcnt vmcnt(0)" ::: "memory");
            const unsigned og = xb_add(&bar[XB_TOP], 1u);
            const unsigned tg = og / nx;
            if (og + 1u == (tg + 1u) * nx) xb_add(&bar[XB_TOPGEN], 1u);
            else XB_SPIN(xb_ld(&bar[XB_TOPGEN]) == tg, bar);
            __builtin_amdgcn_fence(__ATOMIC_ACQUIRE, "agent");
            xb_add(&bar[XB_XGEN(b.x)], 1u);
            asm volatile("s_waitcnt vmcnt(0)" ::: "memory");
        } else {
            XB_SPIN(xb_ld(&bar[XB_XGEN(b.x)]) == gen, bar);
            __builtin_amdgcn_fence(__ATOMIC_ACQUIRE, "agent");
            asm volatile("s_waitcnt vmcnt(0)" ::: "memory");
        }
    }
    __syncthreads();
}

struct Args { const float* in[20]; float* out; unsigned char* ws; int ph_lo, ph_hi, li, pad; };
enum { I_X = 0, I_WIN, I_KVG, I_WUK, I_WUV, I_RELB, I_LBP, I_BNG, I_WBRA, I_WBRB, I_WO, I_LN1G, I_LN1B, I_WPQ, I_SK1, I_SK2, I_UT, I_VT, I_LN2G, I_LN2B };

typedef const __attribute__((address_space(4))) Args* KArgs;
struct Frame {
    LAS unsigned char* lds;
    int tid, lane, wave, G;
    KArgs a;
    unsigned char* ws;
};

__device__ __forceinline__ float wave_sum(float v) {
#pragma unroll
    for (int o = 1; o < 64; o <<= 1) v += __shfl_xor(v, o);
    return v;
}
__device__ __forceinline__ float wave_max(float v) {
#pragma unroll
    for (int o = 1; o < 64; o <<= 1) v = fmaxf(v, __shfl_xor(v, o));
    return v;
}

__device__ __forceinline__ void cvt_bf16_stream(const float* src, bf16* dst, size_t n8, size_t gtid, size_t gthreads) {
    for (size_t i = gtid; i < n8; i += gthreads) {
        const f32x4 a = ((const f32x4*)src)[2 * i], b = ((const f32x4*)src)[2 * i + 1];
        v4u o; o.x = pk2(a.x, a.y); o.y = pk2(a.z, a.w); o.z = pk2(b.x, b.y); o.w = pk2(b.z, b.w);
        ((v4u*)dst)[i] = o;
    }
}
__device__ __forceinline__ void transpose_item(const float* W, int ldw, int K, int c0, int nvalid, bf16* WT, int r0, int k0, LAS float* scr, int lane) {
#pragma unroll 8
    for (int i = 0; i < 32; ++i) { const int kk = 2 * i + (lane >> 5), n = lane & 31; scr[kk * 33 + n] = (n < nvalid) ? W[(size_t)(k0 + kk) * ldw + c0 + n] : 0.f; }
    LDS_WAIT(); asm volatile("" ::: "memory");
    const int c = lane & 7;
#pragma unroll
    for (int j = 0; j < 4; ++j) { const int n = (lane >> 3) + 8 * j; const LAS float* s = scr + (8 * c) * 33 + n;
        v4u o; o.x = pk2(s[0 * 33], s[1 * 33]); o.y = pk2(s[2 * 33], s[3 * 33]); o.z = pk2(s[4 * 33], s[5 * 33]); o.w = pk2(s[6 * 33], s[7 * 33]);
        *(v4u*)(WT + (size_t)(r0 + n) * K + k0 + 8 * c) = o; }
    LDS_WAIT(); asm volatile("" ::: "memory");
}
__device__ __forceinline__ void win_block(int cb, int& c0, int& r0, int& nv) {
    nv = 32;
    if (cb < 4)        { c0 = 512 + 32 * cb;          r0 = 1024 + 32 * cb; }
    else if (cb < 6)   { c0 = 1152 + 32 * (cb - 4);   r0 = 1152 + 32 * (cb - 4); }
    else if (cb == 6)  { c0 = 1216;                   r0 = 1216; nv = 8; }
    else if (cb == 7)  { c0 = 0;                      r0 = 1248; nv = 0; }
    else if (cb < 24)  { c0 = 640 + 32 * (cb - 8);    r0 = 1280 + 32 * (cb - 8); }
    else if (cb < 40)  { c0 = 1224 + 32 * (cb - 24);  r0 = 1792 + 32 * (cb - 24); }
    else if (cb < 56)  { c0 = 1736 + 32 * (cb - 40);  r0 = 2304 + 32 * (cb - 40); }
    else if (cb < 72)  { c0 = 2248 + 32 * (cb - 56);  r0 = 2816 + 32 * (cb - 56); }
    else if (cb < 88)  { c0 = 2760 + 32 * (cb - 72);  r0 = 3328 + 32 * (cb - 72); }
    else if (cb < 120) { c0 = 3272 + 32 * (cb - 88);  r0 = 3840 + 32 * (cb - 88); }
    else               { c0 = 4296 + 32 * (cb - 120); r0 = 4864 + 32 * (cb - 120); }
}
__device__ __forceinline__ void p0_prologue(Frame& F) {
    KArgs const Ap = F.a;
    const size_t gtid = (size_t)blockIdx.x * NTHREADS + F.tid, gthreads = (size_t)F.G * NTHREADS;
    cvt_bf16_stream(Ap->in[I_X], (bf16*)(F.ws + WS_XB), (size_t)T * DM / 8, gtid, gthreads);
    {
        const int gw0 = blockIdx.x * NWAVES + F.wave, NGW0 = F.G * NWAVES;
        for (int r = gw0; r < 2 * 16384; r += NGW0) {
            const int tb = r >> 14, e = r & 16383;
            const float* src = (tb ? Ap->in[I_VT] : Ap->in[I_UT]) + (size_t)e * DM;
            unsigned char* dst = F.ws + (tb ? WS_VT8 : WS_UT8); float* inv = (float*)(F.ws + (tb ? WS_VINV : WS_UINV));
            f32x4 v[4]; float am = 0.f;
#pragma unroll
            for (int j = 0; j < 4; ++j) { v[j] = ((const f32x4*)src)[F.lane + 64 * j]; am = fmaxf(am, fmaxf(fmaxf(fabsf(v[j].x), fabsf(v[j].y)), fmaxf(fabsf(v[j].z), fabsf(v[j].w)))); }
            am = wave_max(am);
            const float sc = am > 0.f ? 256.0f / am : 1.0f;
            if (F.lane == 0) inv[e] = am > 0.f ? am * (1.0f / 256.0f) : 1.0f;
#pragma unroll
            for (int j = 0; j < 4; ++j) { const int d0 = 256 * j + 4 * F.lane, sl = d0 >> 7, off = d0 & 127;
                int wv = __builtin_amdgcn_cvt_pk_fp8_f32(v[j].x * sc, v[j].y * sc, 0, false); wv = __builtin_amdgcn_cvt_pk_fp8_f32(v[j].z * sc, v[j].w * sc, wv, true);
                *(unsigned*)(dst + ((size_t)sl * 16384 + e) * 128 + off) = (unsigned)wv; }
        }
    }
    LAS float* scr = (LAS float*)(F.lds + F.wave * 16384);
    const int gw = blockIdx.x * NWAVES + F.wave, NGW = F.G * NWAVES;
    constexpr int I_IN = 152 * 16, I_B = 32 * 8, I_O = 32 * 16, I_PQ = 64 * 16;
    for (int it = gw; it < I_IN + I_B + I_O + I_PQ; it += NGW) {
        int r = it;
        if (r < I_IN) { const int cb = r >> 4, kb = r & 15; int c0, r0, nv; win_block(cb, c0, r0, nv);
            transpose_item(Ap->in[I_WIN], IN_COLS, 1024, c0, nv, (bf16*)(F.ws + WS_WIN), r0, 64 * kb, scr, F.lane); continue; }
        r -= I_IN;
        if (r < I_B) { const int cb = r >> 3, kb = r & 7; transpose_item(Ap->in[I_WBRB], 1024, 512, 32 * cb, 32, (bf16*)(F.ws + WS_WB), 32 * cb, 64 * kb, scr, F.lane); continue; }
        r -= I_B;
        if (r < I_O) { const int cb = r >> 4, kb = r & 15; transpose_item(Ap->in[I_WO], 1024, 1024, 32 * cb, 32, (bf16*)(F.ws + WS_WO), 32 * cb, 64 * kb, scr, F.lane); continue; }
        r -= I_O;
        { const int cb = r >> 4, kb = r & 15; transpose_item(Ap->in[I_WPQ], 2048, 1024, 32 * cb, 32, (bf16*)(F.ws + WS_WPQ), 32 * cb, 64 * kb, scr, F.lane); }
    }
    __syncthreads();
    LAS float* Xa = (LAS float*)(F.lds);
    LAS float* Xb = (LAS float*)(F.lds + 128 * 65 * 4);
    const float* w_in = Ap->in[I_WIN]; const float* w_uk = Ap->in[I_WUK]; const float* w_uv = Ap->in[I_WUV]; const float* w_bra = Ap->in[I_WBRA];
    for (int it = blockIdx.x; it < 256; it += F.G) {
        if (it < 128) {
            const int h = it >> 4, k0 = (it & 15) * 64;
            for (int e = F.tid; e < 128 * 64; e += NTHREADS) { const int c = e >> 6, d = e & 63; Xa[c * 65 + d] = w_uk[c * 512 + h * 64 + d]; }
            for (int e = F.tid; e < 64 * 64; e += NTHREADS) { const int kk = e >> 6, d = e & 63; Xb[kk * 65 + d] = w_in[(size_t)(k0 + kk) * IN_COLS + h * 64 + d]; }
            __syncthreads();
            const int kk = F.tid & 63;
            for (int j = 0; j < 16; ++j) { const int c = (F.tid >> 6) + 8 * j; float s = 0.f;
#pragma unroll 16
                for (int d = 0; d < 64; ++d) s += Xb[kk * 65 + d] * Xa[c * 65 + d];
                ((bf16*)(F.ws + WS_WIN))[(size_t)(h * 128 + c) * 1024 + k0 + kk] = (bf16)(pk2(s * 0.125f, 0.f) & 0xffffu); }
            __syncthreads();
        } else {
            const int i2 = it - 128, h = i2 >> 4, n0 = (i2 & 15) * 64;
            for (int e = F.tid; e < 128 * 64; e += NTHREADS) { const int c = e >> 6, d = e & 63; Xa[c * 65 + d] = w_uv[c * 512 + h * 64 + d]; }
            for (int e = F.tid; e < 64 * 64; e += NTHREADS) { const int d = e >> 6, n = e & 63; Xb[d * 65 + n] = w_bra[(size_t)(h * 64 + d) * 1024 + n0 + n]; }
            __syncthreads();
            const int c = F.tid & 127;
            for (int j = 0; j < 16; ++j) { const int n = (F.tid >> 7) + 4 * j; float s = 0.f;
#pragma unroll 16
                for (int d = 0; d < 64; ++d) s += Xa[c * 65 + d] * Xb[d * 65 + n];
                ((bf16*)(F.ws + WS_WA))[(size_t)(n0 + n) * 1024 + h * 128 + c] = (bf16)(pk2(s, 0.f) & 0xffffu); }
            __syncthreads();
        }
    }
}

struct EpiProj {
    static constexpr bool PERM = true;
    unsigned char* ws;
    __device__ __forceinline__ void operator()(const f32x4 (&acc)[2][2][4][2], const pg8::Unit& u, int wr, int wc, int fr, int fq) const {
        const int pn = u.pn; size_t boff; int ldc, colt; bool sg = false;
        if (pn < 4)       { boff = WS_QL;   ldc = 1024; colt = pn * 256; }
        else if (pn == 4) { boff = WS_MISC; ldc = 256;  colt = 0; }
        else if (pn < 7)  { boff = WS_QI;   ldc = 512;  colt = (pn - 5) * 256; }
        else if (pn < 9)  { boff = WS_QB;   ldc = 512;  colt = (pn - 7) * 256; }
        else if (pn < 11) { boff = WS_FB;   ldc = 512;  colt = (pn - 9) * 256; }
        else if (pn < 13) { boff = WS_IB;   ldc = 512;  colt = (pn - 11) * 256; }
        else if (pn < 15) { boff = WS_GB;   ldc = 512;  colt = (pn - 13) * 256; }
        else if (pn < 19) { boff = WS_GA;   ldc = 1024; colt = (pn - 15) * 256; sg = true; }
        else              { boff = WS_GBT;  ldc = 1024; colt = (pn - 19) * 256; sg = true; }
        bf16* base = (bf16*)(ws + boff);
        const int row0 = u.pm * 256 + wr * 64 + fr, col0 = colt + wc * 32 + 8 * fq;
#pragma unroll
        for (int ai = 0; ai < 2; ++ai)
#pragma unroll
            for (int m = 0; m < 4; ++m) { bf16* rowp = base + (size_t)(row0 + ai * 128 + m * 16) * ldc + col0;
#pragma unroll
                for (int bj = 0; bj < 2; ++bj) { f32x4 v0 = acc[ai][bj][m][0], v1 = acc[ai][bj][m][1];
                    if (sg) {
#pragma unroll
                        for (int j = 0; j < 4; ++j) { v0[j] = sigmoidf_(v0[j]); v1[j] = sigmoidf_(v1[j]); } }
                    v4u w; w.x = pk2(v0[0], v0[1]); w.y = pk2(v0[2], v0[3]); w.z = pk2(v1[0], v1[1]); w.w = pk2(v1[2], v1[3]);
                    *(v4u*)(rowp + bj * 128) = w; } }
    }
};
template <int MODE> struct EpiBranch {
    static constexpr bool PERM = true;
    const bf16* gate; bf16* O;
    __device__ __forceinline__ void operator()(const f32x4 (&acc)[2][2][4][2], const pg8::Unit& u, int wr, int wc, int fr, int fq) const {
        const int row0 = u.pm * 256 + wr * 64 + fr, col0 = u.pn * 256 + wc * 32 + 8 * fq;
#pragma unroll
        for (int ai = 0; ai < 2; ++ai)
#pragma unroll
            for (int m = 0; m < 4; ++m) { const size_t off = (size_t)(row0 + ai * 128 + m * 16) * 1024 + col0;
#pragma unroll
                for (int bj = 0; bj < 2; ++bj) { const f32x4 v0 = acc[ai][bj][m][0], v1 = acc[ai][bj][m][1];
                    const v4u g = *(const v4u*)(gate + off + bj * 128);
                    float r0 = v0[0] * bflo(g.x), r1 = v0[1] * bfhi(g.x), r2 = v0[2] * bflo(g.y), r3 = v0[3] * bfhi(g.y), r4 = v1[0] * bflo(g.z), r5 = v1[1] * bfhi(g.z), r6 = v1[2] * bflo(g.w), r7 = v1[3] * bfhi(g.w);
                    if (MODE == 1) { const v4u p = *(const v4u*)(O + off + bj * 128);
                        r0 += bflo(p.x); r1 += bfhi(p.x); r2 += bflo(p.y); r3 += bfhi(p.y); r4 += bflo(p.z); r5 += bfhi(p.z); r6 += bflo(p.w); r7 += bfhi(p.w); }
                    v4u w; w.x = pk2(r0, r1); w.y = pk2(r2, r3); w.z = pk2(r4, r5); w.w = pk2(r6, r7);
                    *(v4u*)(O + off + bj * 128) = w; } }
    }
};
struct EpiResF32 {
    static constexpr bool PERM = false;
    const float* X; float* Y;
    __device__ __forceinline__ void operator()(const f32x4 (&acc)[2][2][4][2], const pg8::Unit& u, int wr, int wc, int fr, int fq) const {
        const int row0 = u.pm * 256 + wr * 64 + fr, col0 = u.pn * 256 + wc * 32 + 4 * fq;
#pragma unroll
        for (int ai = 0; ai < 2; ++ai)
#pragma unroll
            for (int m = 0; m < 4; ++m) { const size_t off = (size_t)(row0 + ai * 128 + m * 16) * 1024 + col0;
#pragma unroll
                for (int bj = 0; bj < 2; ++bj)
#pragma unroll
                    for (int n = 0; n < 2; ++n) { const f32x4 xv = *(const f32x4*)(X + off + bj * 128 + n * 16);
                        *(f32x4*)(Y + off + bj * 128 + n * 16) = xv * ALPHA + acc[ai][bj][m][n]; } }
    }
};
struct EpiPlainBf16 {
    static constexpr bool PERM = true;
    bf16* O; int ldc;
    __device__ __forceinline__ void operator()(const f32x4 (&acc)[2][2][4][2], const pg8::Unit& u, int wr, int wc, int fr, int fq) const {
        const int row0 = u.pm * 256 + wr * 64 + fr, col0 = u.pn * 256 + wc * 32 + 8 * fq;
#pragma unroll
        for (int ai = 0; ai < 2; ++ai)
#pragma unroll
            for (int m = 0; m < 4; ++m) { bf16* rowp = O + (size_t)(row0 + ai * 128 + m * 16) * ldc + col0;
#pragma unroll
                for (int bj = 0; bj < 2; ++bj) { const f32x4 v0 = acc[ai][bj][m][0], v1 = acc[ai][bj][m][1];
                    v4u w; w.x = pk2(v0[0], v0[1]); w.y = pk2(v0[2], v0[3]); w.z = pk2(v1[0], v1[1]); w.w = pk2(v1[2], v1[3]);
                    *(v4u*)(rowp + bj * 128) = w; } }
    }
};

__device__ __forceinline__ void p2_ckv_norm(Frame& F) {
    const bf16* misc = (const bf16*)(F.ws + WS_MISC); bf16* ckv = (bf16*)(F.ws + WS_CKV); const float* g = F.a->in[I_KVG];
    const int gw = blockIdx.x * NWAVES + F.wave, NGW = F.G * NWAVES, sub = F.lane >> 4, l16 = F.lane & 15;
    float gv[8];
#pragma unroll
    for (int j = 0; j < 8; ++j) gv[j] = g[l16 * 8 + j];
    for (int r4 = gw; r4 < T / 4; r4 += NGW) {
        const int t = r4 * 4 + sub;
        const v4u p = *(const v4u*)(misc + (size_t)t * 256 + l16 * 8);
        float v[8] = {bflo(p.x), bfhi(p.x), bflo(p.y), bfhi(p.y), bflo(p.z), bfhi(p.z), bflo(p.w), bfhi(p.w)};
        float ss = 0.f;
#pragma unroll
        for (int j = 0; j < 8; ++j) ss += v[j] * v[j];
        ss += __shfl_xor(ss, 1); ss += __shfl_xor(ss, 2); ss += __shfl_xor(ss, 4); ss += __shfl_xor(ss, 8);
        const float r = rsqrtf(ss * (1.0f / 128.0f) + RMS_EPS);
        v4u o; o.x = pk2(v[0] * r * gv[0], v[1] * r * gv[1]); o.y = pk2(v[2] * r * gv[2], v[3] * r * gv[3]); o.z = pk2(v[4] * r * gv[4], v[5] * r * gv[5]); o.w = pk2(v[6] * r * gv[6], v[7] * r * gv[7]);
        *(v4u*)(ckv + (size_t)t * 128 + l16 * 8) = o;
    }
}

__device__ __forceinline__ void p2_hgrn_simple(Frame& F) {
    const bf16* QB = (const bf16*)(F.ws + WS_QB); const bf16* FBp = (const bf16*)(F.ws + WS_FB); bf16* IB = (bf16*)(F.ws + WS_IB);
    const float* lbp = F.a->in[I_LBP];
    const int v = F.tid >> 2, dq = F.tid & 3;
    for (int item = blockIdx.x; item < NB * 4; item += F.G) {
        const int b = item >> 2, h = item & 3;
        float lb[32], S[32];
#pragma unroll
        for (int i = 0; i < 32; ++i) { const int d = h * 128 + dq * 32 + i; lb[i] = 1.0f / (1.0f + __expf(lbp[512 + d] - lbp[d])); S[i] = 0.f; }
        for (int t = 0; t < SEQ; ++t) {
            const size_t row = (size_t)b * SEQ + t;
            const v4u* qp = (const v4u*)(QB + row * 512 + h * 128 + dq * 32);
            const v4u* fp = (const v4u*)(FBp + row * 512 + h * 128 + dq * 32);
            const float vv = bf2f(IB[row * 512 + h * 128 + v]);
            float part = 0.f;
#pragma unroll
            for (int c = 0; c < 4; ++c) { const v4u q4 = qp[c], f4 = fp[c];
#pragma unroll
                for (int e = 0; e < 4; ++e) {
                    const unsigned qa = e == 0 ? q4.x : e == 1 ? q4.y : e == 2 ? q4.z : q4.w, fa = e == 0 ? f4.x : e == 1 ? f4.y : e == 2 ? f4.z : f4.w;
#pragma unroll
                    for (int hh = 0; hh < 2; ++hh) { const int i = c * 8 + e * 2 + hh;
                        const float q = hh ? bfhi(qa) : bflo(qa), z = hh ? bfhi(fa) : bflo(fa);
                        const float sg = sigmoidf_(z), f = lb[i] + (1.0f - lb[i]) * sg, k = (1.0f - lb[i]) * (1.0f - sg);
                        S[i] = f * S[i] + k * vv; part += q * S[i]; } } }
            part += __shfl_xor(part, 1); part += __shfl_xor(part, 2);
            if (dq == 0) IB[row * 512 + h * 128 + v] = (bf16)(pk2(part, 0.f) & 0xffffu);
        }
    }
}

__device__ __forceinline__ void p2_hgrn_chunked(Frame& F, bf16* OUTB, int nbatch) {
    typedef short bf16x8 __attribute__((ext_vector_type(8)));
    const bf16* QB = (const bf16*)(F.ws + WS_QB); const bf16* FBp = (const bf16*)(F.ws + WS_FB); bf16* IB = (bf16*)(F.ws + WS_IB);
    const float* lbp = F.a->in[I_LBP];
    constexpr int S136 = 136, S72 = 72;
    LAS bf16* QIN = (LAS bf16*)(F.lds);
    LAS bf16* KIN = (LAS bf16*)(F.lds + 17408);
    LAS bf16* QDEC = (LAS bf16*)(F.lds + 2 * 17408);
    LAS bf16* ST = (LAS bf16*)(F.lds + 3 * 17408);
    LAS bf16* KDT = (LAS bf16*)(F.lds + 4 * 17408);
    LAS bf16* VT = (LAS bf16*)(F.lds + 4 * 17408 + 18432);
    LAS bf16* ATT = (LAS bf16*)(F.lds + 4 * 17408 + 18432 + 9216);
    LAS float* SEG = (LAS float*)(F.lds + 4 * 17408 + 18432 + 2 * 9216);
    LAS float* DECAY = SEG + 512;
    const int tid = F.tid, lane = F.lane, w = F.wave, l15 = lane & 15, q4 = lane >> 4;
    const int d = tid & 127, tq = tid >> 7;
    const int vn = tid & 63, vg = tid >> 6;
    const int tr = w >> 1, tc2 = w & 1;
    for (int item = blockIdx.x; item < nbatch * 8; item += F.G) {
        const int b = item >> 3, h = (item >> 1) & 3, half = item & 1;
        const float lb = 1.0f / (1.0f + __expf(lbp[512 + h * 128 + d] - lbp[h * 128 + d])), oml = 1.0f - lb;
        f32x4 Sacc[4];
#pragma unroll
        for (int nt = 0; nt < 4; ++nt) Sacc[nt] = (f32x4){0.f, 0.f, 0.f, 0.f};
        for (int e = tid; e < 64 * S136 / 2; e += NTHREADS) ((LAS unsigned*)ST)[e] = 0u;
        const size_t rowb = (size_t)b * SEQ;
        const bf16* zp = FBp + (rowb + tq * 16) * 512 + h * 128 + d;
        const bf16* qp = QB + (rowb + tq * 16) * 512 + h * 128 + d;
        bf16* vp = IB + (rowb + vg * 8) * 512 + h * 128 + half * 64 + vn;
        unsigned short zr[16], qr[16], vr[8];
#pragma unroll
        for (int i = 0; i < 16; ++i) { zr[i] = zp[(size_t)i * 512]; qr[i] = qp[(size_t)i * 512]; }
#pragma unroll
        for (int i = 0; i < 8; ++i) vr[i] = vp[(size_t)i * 512];
        __syncthreads();
        for (int n = 0; n < SEQ / 64; ++n) {
            float c[16], kk[16], qf[16];
            { float run = 0.f;
#pragma unroll
              for (int i = 0; i < 16; ++i) { const float z = bf2f(zr[i]); const float e1 = __expf(-z), sg = 1.0f / (1.0f + e1);
                  run += __logf(lb + oml * sg); c[i] = run; kk[i] = oml * e1 * sg; qf[i] = bf2f(qr[i]); } }
            unsigned short vcur[8];
#pragma unroll
            for (int i = 0; i < 8; ++i) vcur[i] = vr[i];
            SEG[tq * 128 + d] = c[15];
            if (n + 1 < SEQ / 64) {
                const size_t o2 = (size_t)(n + 1) * 64 * 512;
#pragma unroll
                for (int i = 0; i < 16; ++i) { zr[i] = zp[o2 + (size_t)i * 512]; qr[i] = qp[o2 + (size_t)i * 512]; }
#pragma unroll
                for (int i = 0; i < 8; ++i) vr[i] = vp[o2 + (size_t)i * 512];
            }
            __syncthreads();
            { const float s0 = SEG[d], s1 = SEG[128 + d], s2 = SEG[256 + d], s3 = SEG[384 + d];
              const float off = tq == 0 ? 0.f : tq == 1 ? s0 : tq == 2 ? s0 + s1 : s0 + s1 + s2;
              const float bref = s0 + s1, blast = (s0 + s1) + (s2 + s3);
              const float enb = __expf(-bref), eb = __expf(bref), el = __expf(blast);
              if (tq == 0) DECAY[d] = el;
              unsigned kd[8];
#pragma unroll
              for (int i = 0; i < 16; i += 2) {
                  const float E0 = __expf(c[i] + off), E1 = __expf(c[i + 1] + off), r0 = 1.0f / E0, r1 = 1.0f / E1;
                  const int t0 = tq * 16 + i;
                  const unsigned qd = pk2(qf[i] * E0, qf[i + 1] * E1), qi = pk2(qf[i] * E0 * enb, qf[i + 1] * E1 * enb), ki = pk2(kk[i] * eb * r0, kk[i + 1] * eb * r1);
                  QDEC[t0 * S136 + d] = (bf16)(qd & 0xffffu); QDEC[(t0 + 1) * S136 + d] = (bf16)(qd >> 16);
                  QIN[t0 * S136 + d] = (bf16)(qi & 0xffffu); QIN[(t0 + 1) * S136 + d] = (bf16)(qi >> 16);
                  KIN[t0 * S136 + d] = (bf16)(ki & 0xffffu); KIN[(t0 + 1) * S136 + d] = (bf16)(ki >> 16);
                  kd[i >> 1] = pk2(kk[i] * el * r0, kk[i + 1] * el * r1);
              }
              *(LAS v4u*)(KDT + d * S72 + tq * 16) = (v4u){kd[0], kd[1], kd[2], kd[3]};
              *(LAS v4u*)(KDT + d * S72 + tq * 16 + 8) = (v4u){kd[4], kd[5], kd[6], kd[7]};
              v4u vv; vv.x = (unsigned)vcur[0] | ((unsigned)vcur[1] << 16); vv.y = (unsigned)vcur[2] | ((unsigned)vcur[3] << 16); vv.z = (unsigned)vcur[4] | ((unsigned)vcur[5] << 16); vv.w = (unsigned)vcur[6] | ((unsigned)vcur[7] << 16);
              *(LAS v4u*)(VT + vn * S72 + vg * 8) = vv;
            }
            __syncthreads();
#pragma unroll
            for (int j = 0; j < 2; ++j) {
                const int tc = 2 * tc2 + j;
                f32x4 acc = {0.f, 0.f, 0.f, 0.f};
                if (tc <= tr) {
#pragma unroll
                    for (int ks = 0; ks < 4; ++ks) {
                        const bf16x8 a = *(const LAS bf16x8*)(QIN + (tr * 16 + l15) * S136 + ks * 32 + 8 * q4);
                        const bf16x8 bb = *(const LAS bf16x8*)(KIN + (tc * 16 + l15) * S136 + ks * 32 + 8 * q4);
                        acc = __builtin_amdgcn_mfma_f32_16x16x32_bf16(a, bb, acc, 0, 0, 0);
                    }
                }
                const int s_ = tc * 16 + l15;
#pragma unroll
                for (int r = 0; r < 4; ++r) { const int t_ = tr * 16 + 4 * q4 + r; ATT[t_ * S72 + s_] = (bf16)(pk2(s_ <= t_ ? acc[r] : 0.f, 0.f) & 0xffffu); }
            }
            __syncthreads();
#pragma unroll
            for (int j = 0; j < 2; ++j) {
                const int nt = 2 * tc2 + j;
                f32x4 acc = {0.f, 0.f, 0.f, 0.f};
#pragma unroll
                for (int ks = 0; ks < 2; ++ks) {
                    const bf16x8 a = *(const LAS bf16x8*)(ATT + (tr * 16 + l15) * S72 + ks * 32 + 8 * q4);
                    const bf16x8 bb = *(const LAS bf16x8*)(VT + (nt * 16 + l15) * S72 + ks * 32 + 8 * q4);
                    acc = __builtin_amdgcn_mfma_f32_16x16x32_bf16(a, bb, acc, 0, 0, 0);
                }
#pragma unroll
                for (int ks = 0; ks < 4; ++ks) {
                    const bf16x8 a = *(const LAS bf16x8*)(QDEC + (tr * 16 + l15) * S136 + ks * 32 + 8 * q4);
                    const bf16x8 bb = *(const LAS bf16x8*)(ST + (nt * 16 + l15) * S136 + ks * 32 + 8 * q4);
                    acc = __builtin_amdgcn_mfma_f32_16x16x32_bf16(a, bb, acc, 0, 0, 0);
                }
                bf16* op = OUTB + (rowb + (size_t)n * 64 + tr * 16 + 4 * q4) * 512 + h * 128 + half * 64 + nt * 16 + l15;
#pragma unroll
                for (int r = 0; r < 4; ++r) op[(size_t)r * 512] = (bf16)(pk2(acc[r], 0.f) & 0xffffu);
            }
            __syncthreads();
            { const f32x4 dc = *(const LAS f32x4*)(DECAY + w * 16 + 4 * q4);
#pragma unroll
              for (int nt = 0; nt < 4; ++nt) {
                  f32x4 acc = Sacc[nt] * dc;
#pragma unroll
                  for (int ks = 0; ks < 2; ++ks) {
                      const bf16x8 a = *(const LAS bf16x8*)(KDT + (w * 16 + l15) * S72 + ks * 32 + 8 * q4);
                      const bf16x8 bb = *(const LAS bf16x8*)(VT + (nt * 16 + l15) * S72 + ks * 32 + 8 * q4);
                      acc = __builtin_amdgcn_mfma_f32_16x16x32_bf16(a, bb, acc, 0, 0, 0);
                  }
                  Sacc[nt] = acc;
                  *(LAS v2u*)(ST + (nt * 16 + l15) * S136 + w * 16 + 4 * q4) = (v2u){pk2(acc[0], acc[1]), pk2(acc[2], acc[3])};
              } }
        }
        __syncthreads();
    }
}

__device__ __forceinline__ unsigned mono_key(float f) { const unsigned u = __float_as_uint(f); return (u & 0x80000000u) ? ~u : (u | 0x80000000u); }
__device__ __forceinline__ void p2_indexer_simple(Frame& F) {
    typedef short bf16x8 __attribute__((ext_vector_type(8)));
    const bf16* misc = (const bf16*)(F.ws + WS_MISC); const bf16* QI = (const bf16*)(F.ws + WS_QI);
    unsigned long long* BMp = (unsigned long long*)(F.ws + WS_BM);
    LAS float* sc = (LAS float*)(F.lds + F.wave * 16384);
    const int gw = blockIdx.x * NWAVES + F.wave, NGW = F.G * NWAVES, lane = F.lane;
    const int l15 = lane & 15, q4 = lane >> 4;
    for (int tp = gw; tp < T / 2; tp += NGW) {
        const int t0 = tp * 2, b = t0 >> 11, pos = t0 & 2047, chunk = pos >> 6, nk = chunk + 1;
        if (nk <= 4) { if (lane < 32) { BMp[(size_t)t0 * 32 + lane] = (lane < nk) ? ~0ull : 0ull; BMp[(size_t)(t0 + 1) * 32 + lane] = (lane < nk) ? ~0ull : 0ull; } continue; }
        const bf16* ap = QI + (size_t)(t0 + (l15 >> 3)) * 512 + (l15 & 7) * 64 + 8 * q4;
        const bf16x8 a0 = *(const bf16x8*)ap, a1 = *(const bf16x8*)(ap + 32);
        float w[4];
        { const v2u p = *(const v2u*)(misc + (size_t)(t0 + (q4 >> 1)) * 256 + 192 + (q4 & 1) * 4); const float s_ = 0.04419417382415922f;
          w[0] = bflo(p.x) * s_; w[1] = bfhi(p.x) * s_; w[2] = bflo(p.y) * s_; w[3] = bfhi(p.y) * s_; }
        const bf16* kbase = misc + ((size_t)b * SEQ + l15) * 256 + 128 + 8 * q4;
#pragma unroll 2
        for (int kt = 0; kt < nk * 4; ++kt) {
            const bf16* kp = kbase + (size_t)kt * 16 * 256;
            const bf16x8 b0 = *(const bf16x8*)kp, b1 = *(const bf16x8*)(kp + 32);
            f32x4 acc = {0.f, 0.f, 0.f, 0.f};
            acc = __builtin_amdgcn_mfma_f32_16x16x32_bf16(a0, b0, acc, 0, 0, 0);
            acc = __builtin_amdgcn_mfma_f32_16x16x32_bf16(a1, b1, acc, 0, 0, 0);
            float part = w[0] * fmaxf(acc[0], 0.f) + w[1] * fmaxf(acc[1], 0.f) + w[2] * fmaxf(acc[2], 0.f) + w[3] * fmaxf(acc[3], 0.f);
            part += __shfl_xor(part, 16);
            if ((q4 & 1) == 0) sc[(q4 >> 1) * 2048 + kt * 16 + l15] = part;
        }
        for (int i = nk; i < 32; ++i) { sc[i * 64 + lane] = -INFINITY; sc[2048 + i * 64 + lane] = -INFINITY; }
        LDS_WAIT(); asm volatile("" ::: "memory");
#pragma unroll 1
        for (int tt = 0; tt < 2; ++tt) {
            unsigned long long* bmrow = BMp + (size_t)(t0 + tt) * 32;
            unsigned key[32];
#pragma unroll
            for (int i = 0; i < 32; ++i) key[i] = mono_key(sc[tt * 2048 + i * 64 + lane]);
            unsigned prefix = 0u;
#pragma unroll 1
            for (int bit = 31; bit >= 0; --bit) {
                const unsigned cand = prefix | (1u << bit); int cnt = 0;
#pragma unroll
                for (int i = 0; i < 32; ++i) { cnt += __builtin_popcountll(__ballot(key[i] >= cand)); if ((i & 3) == 3) __builtin_amdgcn_sched_barrier(0); }
                if (cnt >= 256) prefix = cand;
            }
            int ngt = 0;
#pragma unroll
            for (int i = 0; i < 32; ++i) { ngt += __builtin_popcountll(__ballot(key[i] > prefix)); if ((i & 3) == 3) __builtin_amdgcn_sched_barrier(0); }
            const int need = 256 - ngt; int running = 0;
            const unsigned long long lt_mask = (1ull << lane) - 1ull;
#pragma unroll
            for (int i = 0; i < 32; ++i) {
                const unsigned long long eq = __ballot(key[i] == prefix), gt = __ballot(key[i] > prefix);
                const int rank = running + __builtin_popcountll(eq & lt_mask);
                const unsigned long long se = __ballot(key[i] == prefix && rank < need);
                running += __builtin_popcountll(eq);
                const unsigned long long word = gt | se;
                if (lane == 0) bmrow[i] = word;
                __builtin_amdgcn_sched_barrier(0);
            }
        }
        LDS_WAIT(); asm volatile("" ::: "memory");
    }
}

__device__ __forceinline__ void p3_hg_finalize(Frame& F) {
    bf16* HG = (bf16*)(F.ws + WS_IB); const bf16* GBp = (const bf16*)(F.ws + WS_GB); const float* ng = F.a->in[I_BNG];
    const int gw = blockIdx.x * NWAVES + F.wave, NGW = F.G * NWAVES, sub = F.lane >> 4, l16 = F.lane & 15;
    float gv[8];
#pragma unroll
    for (int j = 0; j < 8; ++j) gv[j] = ng[l16 * 8 + j];
    for (int r4 = gw; r4 < T; r4 += NGW) {
        const size_t off = (size_t)r4 * 512 + sub * 128 + l16 * 8;
        const v4u p = *(const v4u*)(HG + off), q = *(const v4u*)(GBp + off);
        float v[8] = {bflo(p.x), bfhi(p.x), bflo(p.y), bfhi(p.y), bflo(p.z), bfhi(p.z), bflo(p.w), bfhi(p.w)};
        float gg[8] = {bflo(q.x), bfhi(q.x), bflo(q.y), bfhi(q.y), bflo(q.z), bfhi(q.z), bflo(q.w), bfhi(q.w)};
        float ss = 0.f;
#pragma unroll
        for (int j = 0; j < 8; ++j) ss += v[j] * v[j];
        ss += __shfl_xor(ss, 1); ss += __shfl_xor(ss, 2); ss += __shfl_xor(ss, 4); ss += __shfl_xor(ss, 8);
        const float r = rsqrtf(ss * (1.0f / 128.0f) + RMS_EPS);
        float o[8];
#pragma unroll
        for (int j = 0; j < 8; ++j) o[j] = v[j] * r * gv[j] * gg[j] * sigmoidf_(gg[j]);
        v4u w; w.x = pk2(o[0], o[1]); w.y = pk2(o[2], o[3]); w.z = pk2(o[4], o[5]); w.w = pk2(o[6], o[7]);
        *(v4u*)(HG + off) = w;
    }
}

__device__ __forceinline__ int t5_bucket(int rel) {
    const int n = rel < 0 ? -rel : rel; const int base = rel > 0 ? 16 : 0;
    int v;
    if (n < 8) v = n; else v = n >= 91 ? 15 : n >= 64 ? 14 : n >= 46 ? 13 : n >= 32 ? 12 : n >= 23 ? 11 : n >= 16 ? 10 : n >= 12 ? 9 : 8;
    return base + v;
}
__device__ __forceinline__ void p3_attn_simple(Frame& F) {
    const bf16* CKV = (const bf16*)(F.ws + WS_CKV); bf16* QL = (bf16*)(F.ws + WS_QL);
    const unsigned long long* BMp = (const unsigned long long*)(F.ws + WS_BM);
    LAS float* relb = (LAS float*)(F.lds + 8 * 12800);
    LAS float* qlf = (LAS float*)(F.lds + F.wave * 12800);
    LAS float* pl = (LAS float*)(F.lds + F.wave * 12800 + 4096);
    LAS unsigned short* idx = (LAS unsigned short*)(F.lds + F.wave * 12800 + 4096 + 8192);
    if (F.tid < 256) relb[F.tid] = F.a->in[I_RELB][F.tid];
    __syncthreads();
    const int gw = blockIdx.x * NWAVES + F.wave, NGW = F.G * NWAVES, lane = F.lane;
    const unsigned long long lt_mask = (1ull << lane) - 1ull;
    for (int t = gw; t < T; t += NGW) {
        const int b = t >> 11, pos = t & 2047, nk = (pos >> 6) + 1;
        {
#pragma unroll
            for (int j = 0; j < 2; ++j) { const v4u p = *(const v4u*)(QL + (size_t)t * 1024 + j * 512 + lane * 8);
                f32x4 a = {bflo(p.x), bfhi(p.x), bflo(p.y), bfhi(p.y)}, c = {bflo(p.z), bfhi(p.z), bflo(p.w), bfhi(p.w)};
                *(LAS f32x4*)(qlf + j * 512 + lane * 8) = a; *(LAS f32x4*)(qlf + j * 512 + lane * 8 + 4) = c; }
        }
        int n = 0;
        for (int i = 0; i < nk; ++i) {
            const unsigned long long word = BMp[(size_t)t * 32 + i];
            if ((word >> lane) & 1ull) idx[n + __builtin_popcountll(word & lt_mask)] = (unsigned short)(i * 64 + lane);
            n += __builtin_popcountll(word);
        }
        LDS_WAIT(); asm volatile("" ::: "memory");
#pragma unroll 1
        for (int j = 0; j < 4; ++j) {
            const int k = lane + 64 * j; const bool ok = k < n; const int s = ok ? (int)idx[k] : 0;
            const v4u* row = (const v4u*)(CKV + ((size_t)b * SEQ + s) * 128);
            float d[8];
#pragma unroll
            for (int h = 0; h < 8; ++h) d[h] = 0.f;
#pragma unroll 1
            for (int q4 = 0; q4 < 4; ++q4) {
                asm volatile("" ::: "memory");
                float ck[32];
#pragma unroll
                for (int c = 0; c < 4; ++c) { const v4u p = row[q4 * 4 + c]; ck[c * 8 + 0] = bflo(p.x); ck[c * 8 + 1] = bfhi(p.x); ck[c * 8 + 2] = bflo(p.y); ck[c * 8 + 3] = bfhi(p.y); ck[c * 8 + 4] = bflo(p.z); ck[c * 8 + 5] = bfhi(p.z); ck[c * 8 + 6] = bflo(p.w); ck[c * 8 + 7] = bfhi(p.w); }
#pragma unroll
                for (int h = 0; h < 8; ++h) {
#pragma unroll
                    for (int c = 0; c < 8; ++c) { const f32x4 q = *(const LAS f32x4*)(qlf + h * 128 + q4 * 32 + c * 4); d[h] += q.x * ck[c * 4] + q.y * ck[c * 4 + 1] + q.z * ck[c * 4 + 2] + q.w * ck[c * 4 + 3]; }
                    __builtin_amdgcn_sched_barrier(0);
                }
            }
            const int bk = t5_bucket(s - pos);
            f32x4 s0, s1;
            s0.x = ok ? d[0] + relb[bk * 8 + 0] : -INFINITY; s0.y = ok ? d[1] + relb[bk * 8 + 1] : -INFINITY; s0.z = ok ? d[2] + relb[bk * 8 + 2] : -INFINITY; s0.w = ok ? d[3] + relb[bk * 8 + 3] : -INFINITY;
            s1.x = ok ? d[4] + relb[bk * 8 + 4] : -INFINITY; s1.y = ok ? d[5] + relb[bk * 8 + 5] : -INFINITY; s1.z = ok ? d[6] + relb[bk * 8 + 6] : -INFINITY; s1.w = ok ? d[7] + relb[bk * 8 + 7] : -INFINITY;
            *(LAS f32x4*)(pl + k * 8) = s0; *(LAS f32x4*)(pl + k * 8 + 4) = s1;
        }
        LDS_WAIT(); asm volatile("" ::: "memory");
        {
            f32x4 a0[4], a1[4];
#pragma unroll
            for (int j = 0; j < 4; ++j) { a0[j] = *(const LAS f32x4*)(pl + (lane + 64 * j) * 8); a1[j] = *(const LAS f32x4*)(pl + (lane + 64 * j) * 8 + 4); }
#pragma unroll
            for (int h = 0; h < 8; ++h) {
                float v[4];
#pragma unroll
                for (int j = 0; j < 4; ++j) v[j] = h < 4 ? a0[j][h & 3] : a1[j][h & 3];
                float m = wave_max(fmaxf(fmaxf(v[0], v[1]), fmaxf(v[2], v[3])));
                float sum = 0.f;
#pragma unroll
                for (int j = 0; j < 4; ++j) { v[j] = __expf(v[j] - m); sum += v[j]; }
                const float inv = 1.0f / wave_sum(sum);
#pragma unroll
                for (int j = 0; j < 4; ++j) { if (h < 4) a0[j][h & 3] = v[j] * inv; else a1[j][h & 3] = v[j] * inv; }
            }
#pragma unroll
            for (int j = 0; j < 4; ++j) { *(LAS f32x4*)(pl + (lane + 64 * j) * 8) = a0[j]; *(LAS f32x4*)(pl + (lane + 64 * j) * 8 + 4) = a1[j]; }
        }
        LDS_WAIT(); asm volatile("" ::: "memory");
        float acc[8][2];
#pragma unroll
        for (int h = 0; h < 8; ++h) { acc[h][0] = 0.f; acc[h][1] = 0.f; }
        for (int k = 0; k < n; ++k) {
            const int s = (int)idx[k];
            const unsigned vv = *(const unsigned*)(CKV + ((size_t)b * SEQ + s) * 128 + 2 * lane);
            const float v0 = bflo(vv), v1 = bfhi(vv);
            const f32x4 p0 = *(const LAS f32x4*)(pl + k * 8), p1 = *(const LAS f32x4*)(pl + k * 8 + 4);
            acc[0][0] += p0.x * v0; acc[0][1] += p0.x * v1; acc[1][0] += p0.y * v0; acc[1][1] += p0.y * v1;
            acc[2][0] += p0.z * v0; acc[2][1] += p0.z * v1; acc[3][0] += p0.w * v0; acc[3][1] += p0.w * v1;
            acc[4][0] += p1.x * v0; acc[4][1] += p1.x * v1; acc[5][0] += p1.y * v0; acc[5][1] += p1.y * v1;
            acc[6][0] += p1.z * v0; acc[6][1] += p1.z * v1; acc[7][0] += p1.w * v0; acc[7][1] += p1.w * v1;
        }
#pragma unroll
        for (int h = 0; h < 8; ++h) *(unsigned*)(QL + (size_t)t * 1024 + h * 128 + 2 * lane) = pk2(acc[h][0], acc[h][1]);
        LDS_WAIT(); asm volatile("" ::: "memory");
    }
}

__device__ __forceinline__ void p6_ln1(Frame& F) {
    float* Y = F.a->out; bf16* X1B = (bf16*)(F.ws + WS_X1B); const float* g = F.a->in[I_LN1G]; const float* bb = F.a->in[I_LN1B];
    const int gw = blockIdx.x * NWAVES + F.wave, NGW = F.G * NWAVES, lane = F.lane;
    f32x4 gv[4], bv[4];
#pragma unroll
    for (int j = 0; j < 4; ++j) { gv[j] = ((const f32x4*)g)[lane + 64 * j]; bv[j] = ((const f32x4*)bb)[lane + 64 * j]; }
    for (int m = gw; m < T; m += NGW) {
        f32x4* yr = (f32x4*)(Y + (size_t)m * DM) + lane;
        f32x4 v[4]; float s = 0.f;
#pragma unroll
        for (int j = 0; j < 4; ++j) { v[j] = yr[64 * j]; s += (v[j].x + v[j].y) + (v[j].z + v[j].w); }
        const float mean = wave_sum(s) * (1.f / DM); float s2 = 0.f;
#pragma unroll
        for (int j = 0; j < 4; ++j) { v[j] = v[j] - mean; s2 += (v[j].x * v[j].x + v[j].y * v[j].y) + (v[j].z * v[j].z + v[j].w * v[j].w); }
        const float rstd = rsqrtf(wave_sum(s2) * (1.f / DM) + LN_EPS);
        v2u* o8 = (v2u*)(X1B + (size_t)m * DM) + lane;
#pragma unroll
        for (int j = 0; j < 4; ++j) { const f32x4 o = v[j] * rstd * gv[j] + bv[j]; yr[64 * j] = o; v2u w; w.x = pk2(o.x, o.y); w.y = pk2(o.z, o.w); o8[64 * j] = w; }
    }
}

#define TOP16_INSERT(tv, ti, val, id) do { \
    _Pragma("unroll") for (int _j = 15; _j >= 1; --_j) { const bool _up = (val) > tv[_j - 1]; const bool _here = (val) > tv[_j]; \
        tv[_j] = _up ? tv[_j - 1] : (_here ? (val) : tv[_j]); ti[_j] = _up ? ti[_j - 1] : (_here ? (id) : ti[_j]); } \
    { const bool _h0 = (val) > tv[0]; tv[0] = _h0 ? (val) : tv[0]; ti[0] = _h0 ? (id) : ti[0]; } } while (0)
__device__ __forceinline__ void p8_peer_route_simple(Frame& F) {
    const bf16* PQ = (const bf16*)(F.ws + WS_PQ); unsigned short* IDS = (unsigned short*)(F.ws + WS_IDS); float* GATES = (float*)(F.ws + WS_GATES);
    LAS float* K1 = (LAS float*)(F.lds); LAS float* K2 = (LAS float*)(F.lds + 65536);
    for (int e = F.tid; e < 16384; e += NTHREADS) { K1[e] = F.a->in[I_SK1][e]; K2[e] = F.a->in[I_SK2][e]; }
    __syncthreads();
    const size_t gtid = (size_t)blockIdx.x * NTHREADS + F.tid, gthreads = (size_t)F.G * NTHREADS;
    for (size_t item = gtid; item < (size_t)T * 8; item += gthreads) {
        const size_t t = item >> 3; const int h = (int)(item & 7);
        float v1[16], v2[16]; int i1[16], i2[16];
#pragma unroll
        for (int half = 0; half < 2; ++half) {
            const v4u* qp = (const v4u*)(PQ + t * 2048 + h * 256 + half * 128);
            v4u q[16];
#pragma unroll
            for (int c = 0; c < 16; ++c) q[c] = qp[c];
            float tv[16]; int ti[16];
#pragma unroll
            for (int j = 0; j < 16; ++j) { tv[j] = -INFINITY; ti[j] = 0; }
            const LAS float* KK = half ? K2 : K1;
#pragma unroll 1
            for (int n = 0; n < 128; ++n) {
                float d = 0.f;
#pragma unroll
                for (int c = 0; c < 16; ++c) { const f32x4 ka = *(const LAS f32x4*)(KK + n * 128 + c * 8), kb = *(const LAS f32x4*)(KK + n * 128 + c * 8 + 4);
                    d += ka.x * bflo(q[c].x) + ka.y * bfhi(q[c].x) + ka.z * bflo(q[c].y) + ka.w * bfhi(q[c].y) + kb.x * bflo(q[c].z) + kb.y * bfhi(q[c].z) + kb.z * bflo(q[c].w) + kb.w * bfhi(q[c].w);
                    if ((c & 3) == 3) __builtin_amdgcn_sched_barrier(0); }
                TOP16_INSERT(tv, ti, d, n);
            }
#pragma unroll
            for (int j = 0; j < 16; ++j) { if (half) { v2[j] = tv[j]; i2[j] = ti[j]; } else { v1[j] = tv[j]; i1[j] = ti[j]; } }
        }
        float tv[16]; int ti[16];
#pragma unroll
        for (int j = 0; j < 16; ++j) { tv[j] = -INFINITY; ti[j] = 0; }
#pragma unroll
        for (int a = 0; a < 16; ++a)
#pragma unroll
            for (int c = 0; c < 16; ++c)
                if ((a + 1) * (c + 1) <= 16) { const float val = v1[a] + v2[c]; const int id = i1[a] * 128 + i2[c]; TOP16_INSERT(tv, ti, val, id); }
        float ev[16], sum = 0.f;
#pragma unroll
        for (int j = 0; j < 16; ++j) { ev[j] = __expf(tv[j] - tv[0]); sum += ev[j]; }
        const float inv = 1.0f / sum;
#pragma unroll
        for (int j8 = 0; j8 < 2; ++j8) {
            v4u w; w.x = (unsigned)ti[j8 * 8] | ((unsigned)ti[j8 * 8 + 1] << 16); w.y = (unsigned)ti[j8 * 8 + 2] | ((unsigned)ti[j8 * 8 + 3] << 16);
            w.z = (unsigned)ti[j8 * 8 + 4] | ((unsigned)ti[j8 * 8 + 5] << 16); w.w = (unsigned)ti[j8 * 8 + 6] | ((unsigned)ti[j8 * 8 + 7] << 16);
            *(v4u*)(IDS + t * 128 + h * 16 + j8 * 8) = w;
        }
#pragma unroll
        for (int j4 = 0; j4 < 4; ++j4)
            *(f32x4*)(GATES + t * 128 + h * 16 + j4 * 4) = (f32x4){ev[j4 * 4] * inv, ev[j4 * 4 + 1] * inv, ev[j4 * 4 + 2] * inv, ev[j4 * 4 + 3] * inv};
    }
}

template <int CTRL> __device__ __forceinline__ float dppf(float x) { return __builtin_bit_cast(float, __builtin_amdgcn_mov_dpp(__builtin_bit_cast(int, x), CTRL, 0xf, 0xf, true)); }
constexpr int Q_CHUNK = 32;
__device__ __forceinline__ void p9_u_phase(Frame& F) {
    const unsigned char* UT8 = F.ws + WS_UT8; const bf16* X1B = (const bf16*)(F.ws + WS_X1B); const unsigned short* IDS = (const unsigned short*)(F.ws + WS_IDS);
    float* HP = (float*)(F.ws + WS_HP); unsigned* qh = (unsigned*)(F.ws + WS_CTL) + CW_QU;
    const int lane = F.lane, sub = lane & 7, g = lane >> 3;
    const unsigned xcc = xb_xcc_id() & 7u;
    for (int s = 0; s < 8; ++s) {
        const int j = (int)((xcc + (unsigned)s) & 7u);
        const unsigned char* tab = UT8 + (size_t)j * 16384 * 128 + sub * 16;
        for (;;) {
            unsigned base = 0u; if (lane == 0) base = xb_add(qh + 64 * j, (unsigned)Q_CHUNK);
            base = (unsigned)__builtin_amdgcn_readfirstlane((int)base);
            if (base >= (unsigned)T) break;
#pragma unroll 1
            for (int tt = 0; tt < Q_CHUNK; ++tt) {
                const size_t t = (size_t)base + tt;
                const v4u xa = *(const v4u*)(X1B + t * 1024 + j * 128 + sub * 16), xb = *(const v4u*)(X1B + t * 1024 + j * 128 + sub * 16 + 8);
                const float xf[16] = {bflo(xa.x), bfhi(xa.x), bflo(xa.y), bfhi(xa.y), bflo(xa.z), bfhi(xa.z), bflo(xa.w), bfhi(xa.w), bflo(xb.x), bfhi(xb.x), bflo(xb.y), bfhi(xb.y), bflo(xb.z), bfhi(xb.z), bflo(xb.w), bfhi(xb.w)};
                const v4u ia = *(const v4u*)(IDS + t * 128 + g * 16), ib = *(const v4u*)(IDS + t * 128 + g * 16 + 8);
                const unsigned idw[8] = {ia.x, ia.y, ia.z, ia.w, ib.x, ib.y, ib.z, ib.w};
                v4u q[16];
#pragma unroll
                for (int i = 0; i < 16; ++i) { const unsigned e = (idw[i >> 1] >> (16 * (i & 1))) & 0xffffu; q[i] = *(const v4u*)(tab + (size_t)e * 128); }
                float hs0 = 0.f, hs1 = 0.f;
#pragma unroll
                for (int i = 0; i < 16; ++i) {
                    const f32x2 a0 = __builtin_amdgcn_cvt_pk_f32_fp8((int)q[i].x, false), a1 = __builtin_amdgcn_cvt_pk_f32_fp8((int)q[i].x, true);
                    const f32x2 b0 = __builtin_amdgcn_cvt_pk_f32_fp8((int)q[i].y, false), b1 = __builtin_amdgcn_cvt_pk_f32_fp8((int)q[i].y, true);
                    const f32x2 c0 = __builtin_amdgcn_cvt_pk_f32_fp8((int)q[i].z, false), c1 = __builtin_amdgcn_cvt_pk_f32_fp8((int)q[i].z, true);
                    const f32x2 d0 = __builtin_amdgcn_cvt_pk_f32_fp8((int)q[i].w, false), d1 = __builtin_amdgcn_cvt_pk_f32_fp8((int)q[i].w, true);
                    float p = (a0.x * xf[0] + a0.y * xf[1]) + (a1.x * xf[2] + a1.y * xf[3]) + (b0.x * xf[4] + b0.y * xf[5]) + (b1.x * xf[6] + b1.y * xf[7])
                            + (c0.x * xf[8] + c0.y * xf[9]) + (c1.x * xf[10] + c1.y * xf[11]) + (d0.x * xf[12] + d0.y * xf[13]) + (d1.x * xf[14] + d1.y * xf[15]);
                    p += dppf<0xB1>(p); p += dppf<0x4E>(p); p += dppf<0x141>(p);
                    if (i < 8) hs0 = (sub == i) ? p : hs0; else hs1 = (sub == i - 8) ? p : hs1;
                }
                float* hp = HP + ((size_t)j * T + t) * 128 + g * 16 + sub;
                hp[0] = hs0; hp[8] = hs1;
            }
        }
    }
}
__device__ __forceinline__ void p10_finalize(Frame& F) {
    const unsigned short* IDS = (const unsigned short*)(F.ws + WS_IDS); float* W = (float*)(F.ws + WS_GATES); const float* HP = (const float*)(F.ws + WS_HP);
    const float* UINV = (const float*)(F.ws + WS_UINV); const float* VINV = (const float*)(F.ws + WS_VINV);
    const size_t gtid = (size_t)blockIdx.x * NTHREADS + F.tid, gthreads = (size_t)F.G * NTHREADS;
    for (size_t idx = gtid; idx < (size_t)T * 128; idx += gthreads) {
        const unsigned e = IDS[idx]; float h = 0.f;
#pragma unroll
        for (int j = 0; j < 8; ++j) h += HP[(size_t)j * T * 128 + idx];
        h *= UINV[e];
        const float gl = 0.5f * h * (1.0f + erff(h * 0.7071067811865476f));
        W[idx] = W[idx] * gl * VINV[e];
    }
}
__device__ __forceinline__ void p11_v_phase(Frame& F) {
    const unsigned char* VT8 = F.ws + WS_VT8; const unsigned short* IDS = (const unsigned short*)(F.ws + WS_IDS); const float* W = (const float*)(F.ws + WS_GATES);
    float* FFN = (float*)(F.ws + WS_FFN); unsigned* qh = (unsigned*)(F.ws + WS_CTL) + CW_QV;
    const int lane = F.lane, sub = lane & 7, g = lane >> 3;
    const unsigned xcc = xb_xcc_id() & 7u;
    for (int s = 0; s < 8; ++s) {
        const int j = (int)((xcc + (unsigned)s) & 7u);
        const unsigned char* tab = VT8 + (size_t)j * 16384 * 128 + sub * 16;
        for (;;) {
            unsigned base = 0u; if (lane == 0) base = xb_add(qh + 64 * j, (unsigned)Q_CHUNK);
            base = (unsigned)__builtin_amdgcn_readfirstlane((int)base);
            if (base >= (unsigned)T) break;
#pragma unroll 1
            for (int tt = 0; tt < Q_CHUNK; ++tt) {
                const size_t t = (size_t)base + tt;
                const v4u ia = *(const v4u*)(IDS + t * 128 + g * 16), ib = *(const v4u*)(IDS + t * 128 + g * 16 + 8);
                const unsigned idw[8] = {ia.x, ia.y, ia.z, ia.w, ib.x, ib.y, ib.z, ib.w};
                const f32x4 w0 = *(const f32x4*)(W + t * 128 + g * 16), w1 = *(const f32x4*)(W + t * 128 + g * 16 + 4), w2 = *(const f32x4*)(W + t * 128 + g * 16 + 8), w3 = *(const f32x4*)(W + t * 128 + g * 16 + 12);
                const float wv[16] = {w0.x, w0.y, w0.z, w0.w, w1.x, w1.y, w1.z, w1.w, w2.x, w2.y, w2.z, w2.w, w3.x, w3.y, w3.z, w3.w};
                v4u q[16];
#pragma unroll
                for (int i = 0; i < 16; ++i) { const unsigned e = (idw[i >> 1] >> (16 * (i & 1))) & 0xffffu; q[i] = *(const v4u*)(tab + (size_t)e * 128); }
                float acc[16];
#pragma unroll
                for (int c = 0; c < 16; ++c) acc[c] = 0.f;
#pragma unroll
                for (int i = 0; i < 16; ++i) {
                    const unsigned qq[4] = {q[i].x, q[i].y, q[i].z, q[i].w};
#pragma unroll
                    for (int c = 0; c < 4; ++c) { const f32x2 lo = __builtin_amdgcn_cvt_pk_f32_fp8((int)qq[c], false), hi = __builtin_amdgcn_cvt_pk_f32_fp8((int)qq[c], true);
                        acc[4 * c] += wv[i] * lo.x; acc[4 * c + 1] += wv[i] * lo.y; acc[4 * c + 2] += wv[i] * hi.x; acc[4 * c + 3] += wv[i] * hi.y; }
                }
#pragma unroll
                for (int c = 0; c < 16; ++c) { float a = acc[c]; a += dppf<0x128>(a); a += __shfl_xor(a, 16); a += __shfl_xor(a, 32); acc[c] = a; }
                if (g == 0) { float* fp = FFN + t * 1024 + j * 128 + sub * 16;
                    *(f32x4*)(fp) = (f32x4){acc[0], acc[1], acc[2], acc[3]}; *(f32x4*)(fp + 4) = (f32x4){acc[4], acc[5], acc[6], acc[7]};
                    *(f32x4*)(fp + 8) = (f32x4){acc[8], acc[9], acc[10], acc[11]}; *(f32x4*)(fp + 12) = (f32x4){acc[12], acc[13], acc[14], acc[15]}; }
            }
        }
    }
}
__device__ __forceinline__ void p12_ln2(Frame& F) {
    float* X1 = F.a->out; const float* FFN = (const float*)(F.ws + WS_FFN); const float* g = F.a->in[I_LN2G]; const float* bb = F.a->in[I_LN2B];
    const int gw = blockIdx.x * NWAVES + F.wave, NGW = F.G * NWAVES, lane = F.lane;
    f32x4 gv[4], bv[4];
#pragma unroll
    for (int j = 0; j < 4; ++j) { gv[j] = ((const f32x4*)g)[lane + 64 * j]; bv[j] = ((const f32x4*)bb)[lane + 64 * j]; }
    for (int m = gw; m < T; m += NGW) {
        f32x4* xr = (f32x4*)(X1 + (size_t)m * DM) + lane; const f32x4* fr = (const f32x4*)(FFN + (size_t)m * DM) + lane;
        f32x4 v[4]; float s = 0.f;
#pragma unroll
        for (int j = 0; j < 4; ++j) { v[j] = xr[64 * j] * ALPHA + fr[64 * j]; s += (v[j].x + v[j].y) + (v[j].z + v[j].w); }
        const float mean = wave_sum(s) * (1.f / DM); float s2 = 0.f;
#pragma unroll
        for (int j = 0; j < 4; ++j) { v[j] = v[j] - mean; s2 += (v[j].x * v[j].x + v[j].y * v[j].y) + (v[j].z * v[j].z + v[j].w * v[j].w); }
        const float rstd = rsqrtf(wave_sum(s2) * (1.f / DM) + LN_EPS);
#pragma unroll
        for (int j = 0; j < 4; ++j) xr[64 * j] = v[j] * rstd * gv[j] + bv[j];
    }
}

__global__ void __launch_bounds__(NTHREADS, 2) hybrid_fwd(Args args) {
    extern __shared__ __attribute__((aligned(16))) unsigned char lds[];
    Frame F;
    F.lds = (LAS unsigned char*)lds;
    F.tid = threadIdx.x; F.lane = F.tid & 63; F.wave = __builtin_amdgcn_readfirstlane(F.tid >> 6);
    F.G = gridDim.x; F.a = (KArgs)__builtin_amdgcn_kernarg_segment_ptr(); F.ws = args.ws;
#define FRESH() do { int _t = threadIdx.x; asm volatile("" : "+v"(_t)); F.tid = _t; F.lane = _t & 63; F.wave = __builtin_amdgcn_readfirstlane(_t >> 6); \
        KArgs _k = (KArgs)__builtin_amdgcn_kernarg_segment_ptr(); asm volatile("" : "+s"(_k)); F.a = _k; F.ws = _k->ws; } while (0)
    volatile LAS unsigned* MISC = (volatile LAS unsigned*)(F.lds + MISC_OFF);
    for (int u = F.tid; u < (LDS_BYTES - LDSCTL_OFF) / 4; u += NTHREADS) ((LAS unsigned*)(F.lds + LDSCTL_OFF))[u] = 0u;
    __syncthreads();
    const int lo = args.ph_lo, hi = args.ph_hi;
    const bool need_bar = (hi - lo) > 1;
    XcdBarrier bar; bar.bar = (unsigned*)(args.ws + WS_CTL) + CW_BAR + args.li * XCD_BAR_WORDS; bar.x = 0; bar.st = nullptr;
    if (need_bar) bar = xcd_barrier_post(bar.bar, MISC + 8);
#if defined(PHASE_MASK)
#define IN(k) (((PHASE_MASK >> (k)) & 1) && lo <= (k) && (k) < hi)
#elif defined(ONLY_PHASE)
#define IN(k) ((k) == ONLY_PHASE && lo <= (k) && (k) < hi)
#else
#define IN(k) (lo <= (k) && (k) < hi)
#endif
#define SEAM(k) do { if (IN(k) && IN((k) + 1)) xcd_barrier(bar); } while (0)
    LAS unsigned char* ring = F.lds;

    if (IN(0)) { FRESH(); p0_prologue(F); }
    SEAM(0);
    if (IN(1)) {
        FRESH();
        pg8::Gemm g{(const bf16*)(F.ws + WS_XB), (const bf16*)(F.ws + WS_WIN), T, NPROJ, 1024}; pg8::StaticOrder S; S.init(T, NPROJ, F.G, (int)blockIdx.x);
        EpiProj E{F.ws};
        pg8::gemm_phase<EpiProj, pg8::StaticOrder>(ring, g, S, E, F.tid);
    }
    SEAM(1);
    if (IN(2)) {
        FRESH();
#if !defined(P2SEL) || (P2SEL & 1)
        p2_ckv_norm(F);
#endif
#if !defined(P2SEL) || (P2SEL & 2)
#if defined(HGRN_DEBUG)
        p2_hgrn_chunked(F, (bf16*)(F.ws + WS_END), 16);
        __syncthreads();
        FRESH();
        p2_hgrn_simple(F);
        VM_WAIT(); __syncthreads();
        FRESH();
        {
            unsigned* ctl = (unsigned*)(F.ws + WS_CTL);
            const bf16* A_ = (const bf16*)(F.ws + WS_END); const bf16* B_ = (const bf16*)(F.ws + WS_IB);
            float mx = 0.f; unsigned nn = 0;
            for (int item = blockIdx.x; item < NB * 4; item += F.G) { const int b = item >> 2, h = item & 3; if (b >= 16) continue;
                for (int e = F.tid; e < SEQ * 128; e += NTHREADS) { const size_t o = ((size_t)b * SEQ + (e >> 7)) * 512 + h * 128 + (e & 127);
                    const float x = bf2f(A_[o]), y = bf2f(B_[o]); if (x != x) ++nn; const float df = fabsf(x - y); if (df == df) mx = fmaxf(mx, df); } }
            mx = wave_max(mx); nn = (unsigned)wave_sum((float)nn);
            if (F.lane == 0) { atomicMax(ctl + 2048, __float_as_uint(mx)); atomicAdd(ctl + 2112, nn); }
        }
#elif defined(HGRN_SIMPLE)
        p2_hgrn_simple(F);
#else
        p2_hgrn_chunked(F, (bf16*)(F.ws + WS_IB), NB);
#endif
#endif
        __syncthreads();
        FRESH();
#if !defined(P2SEL) || (P2SEL & 4)
        p2_indexer_simple(F);
#endif
    }
    SEAM(2);
    if (IN(3)) { FRESH(); p3_hg_finalize(F); __syncthreads(); p3_attn_simple(F); }
    SEAM(3);
    if (IN(4)) {
        FRESH();
        { pg8::Gemm g{(const bf16*)(F.ws + WS_QL), (const bf16*)(F.ws + WS_WA), T, 1024, 1024}; pg8::StaticOrder S; S.init(T, 1024, F.G, (int)blockIdx.x);
          EpiBranch<0> E{(const bf16*)(F.ws + WS_GA), (bf16*)(F.ws + WS_MERGED)};
          pg8::gemm_phase<EpiBranch<0>, pg8::StaticOrder>(ring, g, S, E, F.tid); }
        FRESH();
        { pg8::Gemm g{(const bf16*)(F.ws + WS_IB), (const bf16*)(F.ws + WS_WB), T, 1024, 512}; pg8::StaticOrder S; S.init(T, 1024, F.G, (int)blockIdx.x);
          EpiBranch<1> E{(const bf16*)(F.ws + WS_GBT), (bf16*)(F.ws + WS_MERGED)};
          pg8::gemm_phase<EpiBranch<1>, pg8::StaticOrder>(ring, g, S, E, F.tid); }
    }
    SEAM(4);
    if (IN(5)) {
        FRESH();
        pg8::Gemm g{(const bf16*)(F.ws + WS_MERGED), (const bf16*)(F.ws + WS_WO), T, 1024, 1024}; pg8::StaticOrder S; S.init(T, 1024, F.G, (int)blockIdx.x);
        EpiResF32 E{F.a->in[I_X], F.a->out};
        pg8::gemm_phase<EpiResF32, pg8::StaticOrder>(ring, g, S, E, F.tid);
    }
    SEAM(5);
    if (IN(6)) { FRESH(); p6_ln1(F); }
    SEAM(6);
    if (IN(7)) {
        FRESH();
        pg8::Gemm g{(const bf16*)(F.ws + WS_X1B), (const bf16*)(F.ws + WS_WPQ), T, 2048, 1024}; pg8::StaticOrder S; S.init(T, 2048, F.G, (int)blockIdx.x);
        EpiPlainBf16 E{(bf16*)(F.ws + WS_PQ), 2048};
        pg8::gemm_phase<EpiPlainBf16, pg8::StaticOrder>(ring, g, S, E, F.tid);
    }
    SEAM(7);
    if (IN(8)) { FRESH(); p8_peer_route_simple(F); }
    SEAM(8);
    if (IN(9)) { FRESH(); p9_u_phase(F); }
    SEAM(9);
    if (IN(10)) { FRESH(); p10_finalize(F); }
    SEAM(10);
    if (IN(11)) { FRESH(); p11_v_phase(F); }
    SEAM(11);
    if (IN(12)) { FRESH(); p12_ln2(F); }
#undef IN
#undef SEAM
}

extern "C" void kernel_launch(void* const* d_in, const int* in_sizes, int n_in, void* d_out, int out_size, void* d_ws, size_t ws_size, hipStream_t stream) {
    static int grid = 0;
    if (grid == 0) {
        if (n_in != 20 || out_size != T * DM || ws_size < WS_END) { fprintf(stderr, "kernel_launch: unexpected problem (n_in %d out %d ws %zu)\n", n_in, out_size, ws_size); grid = -1; return; }
        int dev = 0, cus = 0;
        if (hipGetDevice(&dev) != hipSuccess || hipDeviceGetAttribute(&cus, hipDeviceAttributeMultiprocessorCount, dev) != hipSuccess) { grid = -1; return; }
        if (hipFuncSetAttribute((const void*)hybrid_fwd, hipFuncAttributeMaxDynamicSharedMemorySize, LDS_BYTES) != hipSuccess) { fprintf(stderr, "kernel_launch: hipFuncSetAttribute failed\n"); grid = -1; return; }
        int per_cu = 0;
        if (hipOccupancyMaxActiveBlocksPerMultiprocessor(&per_cu, (const void*)hybrid_fwd, NTHREADS, LDS_BYTES) != hipSuccess || per_cu < 1) fprintf(stderr, "kernel_launch: occupancy query reports %d\n", per_cu);
        (void)hipGetLastError();
        grid = cus;
    }
    if (grid < 0) return;
    (void)hipMemsetAsync((char*)d_ws + WS_CTL, 0, CTL_ZERO_BYTES, stream);
    Args a{};
    for (int i = 0; i < 20; ++i) a.in[i] = (const float*)d_in[i];
    a.out = (float*)d_out; a.ws = (unsigned char*)d_ws;
    constexpr int NL = MK_N_LAUNCHES;
    for (int li = 0; li < NL; ++li) {
        a.ph_lo = (NL == 1) ? 0 : li; a.ph_hi = (NL == 1) ? N_PHASES : li + 1; a.li = li;
        hipLaunchKernelGGL(hybrid_fwd, dim3(grid), dim3(NTHREADS), LDS_BYTES, stream, a);
    }
}
```

```cpp
#include <hip/hip_runtime.h>
#include <cstdio>
#include <cstdint>

#ifndef MK_N_LAUNCHES
#define MK_N_LAUNCHES 1
#endif

namespace pg8 {
#define PG8_LAS __attribute__((address_space(3)))
typedef unsigned short bf16_t;
typedef short bf16x8 __attribute__((ext_vector_type(8)));
typedef float f32x4 __attribute__((ext_vector_type(4)));
typedef unsigned u32x4 __attribute__((ext_vector_type(4)));
constexpr int BM = 256, BK = 64, HALF = 128, HTB = HALF * BK * 2, STAGE_BYTES = 8 * HTB, NXCD = 8, WGM = 8;

__host__ __device__ __forceinline__ int lds_byte(int r, int c) { const int st = (r >> 4) * 2 + (c >> 5), rr = r & 15, cc = c & 31, ob = rr * 64 + cc * 2; return st * 1024 + (ob ^ (((ob >> 9) & 1) << 5)); }
__host__ __device__ __forceinline__ void stage_rc(int b, int& R, int& C) { const int st = b / 1024, sb = b % 1024, swz = sb ^ (((sb >> 9) & 1) << 5); R = (st >> 1) * 16 + swz / 64; C = (st & 1) * 32 + (swz % 64) / 2; }
__host__ __device__ __forceinline__ int perm32(int rho) { const int n = rho >> 4, i = rho & 15; return 8 * (i >> 2) + 4 * n + (i & 3); }

struct Unit { int pm, pn; };
struct Gemm { const bf16_t* A; const bf16_t* Bt; int M, N, K; };

struct StaticOrder {
    int nM, nN, nwg, G, c;
    __host__ __device__ void init(int M, int N, int G_, int c_) { nM = M / BM; nN = N / BM; nwg = nM * nN; G = G_; c = c_; }
    __host__ __device__ bool next(int i, Unit& u) const {
        const long L = (long)i * G + c; if (L >= nwg) return false;
        int wgid = (int)L; { const int q = nwg / NXCD, r = nwg % NXCD, xcd = wgid % NXCD, off = wgid / NXCD; wgid = (xcd < r ? xcd * (q + 1) : r * (q + 1) + (xcd - r) * q) + off; }
        const int nig = WGM * nN, gid = wgid / nig, fm = gid * WGM, gsz = (nM - fm) < WGM ? (nM - fm) : WGM;
        u.pm = fm + ((wgid % nig) % gsz); u.pn = (wgid % nig) / gsz; return true;
    }
    __device__ __forceinline__ void a_ready(const Unit&) const {}
    __device__ __forceinline__ void done(const Unit&) const {}
};

__device__ __forceinline__ unsigned cvt_pk_bf16(float lo, float hi) { unsigned r; asm volatile("v_cvt_pk_bf16_f32 %0, %1, %2" : "=v"(r) : "v"(lo), "v"(hi)); return r; }

template <class Epi, class Sched>
__device__ __forceinline__ void gemm_phase(PG8_LAS unsigned char* lds, const Gemm g, const Sched& S, const Epi& E, const int tid) {
    const int wid = __builtin_amdgcn_readfirstlane(tid >> 6), lane = tid & 63, wr = wid >> 2, wc = wid & 3, fr = lane & 15, fq = lane >> 4;
    const int K = g.K, nt = K / BK;
    unsigned voffA[2], voffB[2];
#pragma unroll
    for (int i = 0; i < 2; ++i) { int R, C; stage_rc(tid * 16 + i * 8192, R, C); const int Rb = Epi::PERM ? ((R & ~31) + perm32(R & 31)) : R;
        voffA[i] = (unsigned)(R * K + C) * 2u; voffB[i] = (unsigned)(Rb * K + C) * 2u; }
    const size_t kstep = (size_t)(BK * 2);
    const size_t hstep = (size_t)HALF * K * 2;
    const size_t tstep = 2 * hstep;
    const unsigned ldsw = (unsigned)wid * 1024u;
    const int aoff = lds_byte(wr * 64 + fr, fq * 8), boff = lds_byte(wc * 32 + fr, fq * 8);
#define PG8_SA(b, h) (((b) * 2 + (h)) * HTB)
#define PG8_SB(b, h) ((4 + (b) * 2 + (h)) * HTB)
#define PG8_STAGE(bufoff, gbase, voff) do { _Pragma("unroll") for (int _i = 0; _i < 2; ++_i) \
        __builtin_amdgcn_global_load_lds((const unsigned*)((const char*)(gbase) + (voff)[_i]), (PG8_LAS unsigned*)(lds + (bufoff) + ldsw + _i * 8192), 16, 0, 0); } while (0)
#define PG8_LDA(dst, b, h) do { _Pragma("unroll") for (int m = 0; m < 4; ++m) _Pragma("unroll") for (int k = 0; k < 2; ++k) dst[m][k] = *(const PG8_LAS bf16x8*)(lds + PG8_SA(b, h) + aoff + m * 2048 + k * 1024); } while (0)
#define PG8_LDB(dst, b, h) do { _Pragma("unroll") for (int n = 0; n < 2; ++n) _Pragma("unroll") for (int k = 0; k < 2; ++k) dst[n][k] = *(const PG8_LAS bf16x8*)(lds + PG8_SB(b, h) + boff + n * 2048 + k * 1024); } while (0)
#define PG8_MMA(ai, bj, At, Bt) do { __builtin_amdgcn_s_setprio(1); _Pragma("unroll") for (int m = 0; m < 4; ++m) _Pragma("unroll") for (int n = 0; n < 2; ++n) _Pragma("unroll") for (int k = 0; k < 2; ++k) \
        acc[ai][bj][m][n] = __builtin_amdgcn_mfma_f32_16x16x32_bf16(Bt[n][k], At[m][k], acc[ai][bj][m][n], 0, 0, 0); __builtin_amdgcn_s_setprio(0); } while (0)
#define PG8_WAIT_V(n) asm volatile("s_waitcnt vmcnt(" #n ")" ::: "memory")
#define PG8_WAIT_L(n) asm volatile("s_waitcnt lgkmcnt(" #n ")" ::: "memory")
#define PG8_BAR __builtin_amdgcn_s_barrier()
#define PG8_SCHED __builtin_amdgcn_sched_barrier(0)
    Unit cur, nxt; int ui = 0;
    if (!S.next(0, cur)) return;
    f32x4 acc[2][2][4][2];
#pragma unroll
    for (int a = 0; a < 2; ++a)
#pragma unroll
        for (int b = 0; b < 2; ++b)
#pragma unroll
            for (int m = 0; m < 4; ++m)
#pragma unroll
                for (int n = 0; n < 2; ++n) acc[a][b][m][n] = (f32x4){0.f, 0.f, 0.f, 0.f};
    bf16x8 At[4][2], B0[2][2], B1[2][2];
    const char* cA = (const char*)g.A + (size_t)cur.pm * tstep; const char* cB = (const char*)g.Bt + (size_t)cur.pn * tstep;
    S.a_ready(cur);
    PG8_STAGE(PG8_SB(0, 0), cB, voffB); PG8_STAGE(PG8_SA(0, 0), cA, voffA); PG8_STAGE(PG8_SB(0, 1), cB + hstep, voffB); PG8_STAGE(PG8_SA(0, 1), cA + hstep, voffA);
    if (wr == 1) PG8_BAR;
    PG8_WAIT_V(4); PG8_BAR;
    PG8_STAGE(PG8_SB(1, 0), cB + kstep, voffB); PG8_STAGE(PG8_SA(1, 0), cA + kstep, voffA); PG8_STAGE(PG8_SB(1, 1), cB + hstep + kstep, voffB);
    PG8_WAIT_V(6); PG8_BAR;
    for (;;) {
        const bool has_next = S.next(ui + 1, nxt);
        const char* nA = has_next ? (const char*)g.A + (size_t)nxt.pm * tstep : cA; const char* nB = has_next ? (const char*)g.Bt + (size_t)nxt.pn * tstep : cB;
        for (int t = 0; t < nt; t += 2) {
            const bool last = (t == nt - 2);
            const char* a1 = cA + (size_t)(t + 1) * kstep;
            const char* a2 = last ? nA : cA + (size_t)(t + 2) * kstep; const char* b2 = last ? nB : cB + (size_t)(t + 2) * kstep;
            const char* a3 = a2 + kstep; const char* b3 = b2 + kstep;
            if (last && has_next) S.a_ready(nxt);
            PG8_LDB(B0, 0, 0); PG8_SCHED; PG8_LDA(At, 0, 0); PG8_STAGE(PG8_SA(1, 1), a1 + hstep, voffA);
            PG8_WAIT_L(8); PG8_BAR; PG8_WAIT_L(0); PG8_MMA(0, 0, At, B0); PG8_BAR; PG8_SCHED;
            PG8_LDB(B1, 0, 1); PG8_STAGE(PG8_SB(0, 0), b2, voffB);
            PG8_BAR; PG8_WAIT_L(0); PG8_MMA(0, 1, At, B1); PG8_BAR;
            PG8_LDA(At, 0, 1); PG8_STAGE(PG8_SA(0, 0), a2, voffA);
            PG8_BAR; PG8_WAIT_L(0); PG8_MMA(1, 0, At, B0); PG8_BAR; PG8_SCHED;
            PG8_STAGE(PG8_SB(0, 1), b2 + hstep, voffB);
            PG8_WAIT_V(6); PG8_BAR; PG8_MMA(1, 1, At, B1); PG8_BAR;
            PG8_LDB(B0, 1, 0); PG8_SCHED; PG8_LDA(At, 1, 0); PG8_STAGE(PG8_SA(0, 1), a2 + hstep, voffA);
            PG8_WAIT_L(8); PG8_BAR; PG8_WAIT_L(0); PG8_MMA(0, 0, At, B0); PG8_BAR; PG8_SCHED;
            PG8_LDB(B1, 1, 1); PG8_STAGE(PG8_SB(1, 0), b3, voffB);
            PG8_BAR; PG8_WAIT_L(0); PG8_MMA(0, 1, At, B1); PG8_BAR;
            PG8_LDA(At, 1, 1); PG8_STAGE(PG8_SA(1, 0), a3, voffA);
            PG8_BAR; PG8_WAIT_L(0); PG8_MMA(1, 0, At, B0); PG8_BAR; PG8_SCHED;
            PG8_STAGE(PG8_SB(1, 1), b3 + hstep, voffB);
            PG8_WAIT_V(6); PG8_BAR; PG8_MMA(1, 1, At, B1); PG8_BAR;
        }
        E(acc, cur, wr, wc, fr, fq); S.done(cur);
        if (!has_next) break;
#pragma unroll
        for (int a = 0; a < 2; ++a)
#pragma unroll
            for (int b = 0; b < 2; ++b)
#pragma unroll
                for (int m = 0; m < 4; ++m)
#pragma unroll
                    for (int n = 0; n < 2; ++n) acc[a][b][m][n] = (f32x4){0.f, 0.f, 0.f, 0.f};
        cur = nxt; cA = nA; cB = nB; ++ui;
    }
    PG8_WAIT_V(0);
    if (wr == 0) PG8_BAR;
    PG8_BAR;
#undef PG8_SA
#undef PG8_SB
#undef PG8_STAGE
#undef PG8_LDA
#undef PG8_LDB
#undef PG8_MMA
#undef PG8_WAIT_V
#undef PG8_WAIT_L
#undef PG8_BAR
#undef PG8_SCHED
}
}

constexpr int NWAVES = 8, NTHREADS = 512;
constexpr int NB = 32, SEQ = 2048, DM = 1024, T = NB * SEQ;
constexpr int IN_COLS = 5320, NPROJ = 5888;
constexpr int N_PHASES = 13;
constexpr float ALPHA = 1.189207115002721f;
constexpr float LN_EPS = 1e-5f, RMS_EPS = 1e-6f;

constexpr size_t MiB = 1u << 20;
constexpr size_t WS_CTL = 0, CTL_ZERO_BYTES = 1 * MiB;
constexpr size_t WS_WIN = 1 * MiB, WS_WA = 13 * MiB, WS_WB = 15 * MiB, WS_WO = 16 * MiB, WS_WPQ = 18 * MiB;
constexpr size_t WS_UT8 = 24 * MiB, WS_VT8 = 40 * MiB, WS_UINV = 56 * MiB, WS_VINV = 56 * MiB + 65536;
constexpr size_t WS_XB = 88 * MiB;
constexpr size_t WS_QL = 216 * MiB;
constexpr size_t WS_MISC = 344 * MiB;
constexpr size_t WS_CKV = 376 * MiB;
constexpr size_t WS_QI = 392 * MiB, WS_QB = 456 * MiB, WS_FB = 520 * MiB, WS_IB = 584 * MiB, WS_GB = 648 * MiB;
constexpr size_t WS_GA = 712 * MiB, WS_GBT = 840 * MiB;
constexpr size_t WS_BM = 968 * MiB;
constexpr size_t WS_END = 984 * MiB;
constexpr size_t WS_MERGED = WS_XB, WS_X1B = WS_QL, WS_PQ = WS_QI, WS_IDS = WS_GB, WS_GATES = WS_GB + 32 * MiB, WS_HP = WS_GA, WS_FFN = WS_XB;
constexpr int CW_QU = 8192, CW_QV = 8192 + 512;
constexpr int CW_BAR = 4096;

constexpr int RING_BYTES = 131072;
constexpr int LDSCTL_OFF = RING_BYTES, MISC_OFF = LDSCTL_OFF + 320;
constexpr int LDS_BYTES = 147456;

#define GAS __attribute__((address_space(1)))
#define LAS __attribute__((address_space(3)))
typedef unsigned short bf16;
typedef unsigned v4u __attribute__((ext_vector_type(4)));
typedef unsigned v2u __attribute__((ext_vector_type(2)));
typedef float f32x4 __attribute__((ext_vector_type(4)));
typedef float f32x2 __attribute__((ext_vector_type(2)));
typedef GAS unsigned gu32;
#define RLX_AGENT __ATOMIC_RELAXED, __HIP_MEMORY_SCOPE_AGENT
#define LDS_WAIT() asm volatile("s_waitcnt lgkmcnt(0)" ::: "memory")
#define VM_WAIT() asm volatile("s_waitcnt vmcnt(0)" ::: "memory")
typedef __bf16 bf16x2_t __attribute__((ext_vector_type(2)));
__device__ __forceinline__ unsigned pk2(float lo, float hi) { const bf16x2_t v = {(__bf16)lo, (__bf16)hi}; return __builtin_bit_cast(unsigned, v); }
__device__ __forceinline__ float bflo(unsigned u) { return __uint_as_float(u << 16); }
__device__ __forceinline__ float bfhi(unsigned u) { return __uint_as_float(u & 0xffff0000u); }
__device__ __forceinline__ float bf2f(bf16 b) { return __uint_as_float(((unsigned)b) << 16); }
__device__ __forceinline__ float sigmoidf_(float x) { return 1.0f / (1.0f + __expf(-x)); }

#define XB_TMO      128
#define XB_XCNT(j)  (256  + 64 * (j))
#define XB_XSUB(j)  (1280 + 64 * (j))
#define XB_XGEN(j)  (2304 + 64 * (j))
#define XB_TOP      3328
#define XB_TOPGEN   3392
#define XCD_BAR_WORDS 3456
#define XB_SPIN_CAP (1u << 22)
__device__ __forceinline__ unsigned xb_ld(unsigned* p)              { return __hip_atomic_load(p, __ATOMIC_RELAXED, __HIP_MEMORY_SCOPE_AGENT); }
__device__ __forceinline__ unsigned xb_add(unsigned* p, unsigned v) { return __hip_atomic_fetch_add(p, v, __ATOMIC_RELAXED, __HIP_MEMORY_SCOPE_AGENT); }
__device__ __forceinline__ unsigned xb_xcc_id() { return (unsigned)__builtin_amdgcn_s_getreg((3 << 11) | 20) & 0xFu; }
#define XB_SPIN(cond, bar) do { unsigned _sp = 0; while (cond) { __builtin_amdgcn_s_sleep(1); \
    if ((++_sp & 255u) == 0u) { if (xb_ld(&(bar)[XB_TMO])) break; if (_sp > XB_SPIN_CAP) { atomicAdd(&(bar)[XB_TMO], 1u); break; } } } } while (0)
struct XcdBarrier { unsigned* bar; unsigned x; volatile LAS unsigned* st; };
__device__ __forceinline__ XcdBarrier xcd_barrier_post(unsigned* bar, volatile LAS unsigned* st) {
    XcdBarrier b; b.bar = bar; b.x = xb_xcc_id(); b.st = st;
    if (threadIdx.x == 0) (void)xb_add(&bar[XB_XCNT(b.x)], 1u);
    return b;
}
__device__ __forceinline__ void xcd_barrier_complete(unsigned* bar, unsigned x, unsigned& nloc, unsigned& nx) {
    const unsigned G = gridDim.x * gridDim.y * gridDim.z;
    unsigned sum, cnt, mine, sp = 0u;
    for (;;) {
        sum = 0u; cnt = 0u; mine = 0u;
#pragma unroll
        for (unsigned j = 0; j < 16; ++j) { const unsigned c = xb_ld(&bar[XB_XCNT(j)]); sum += c; cnt += (c > 0u) ? 1u : 0u; mine = (j == x) ? c : mine; }
        if (sum == G) break;
        __builtin_amdgcn_s_sleep(1);
        if ((++sp & 255u) == 0u) { if (xb_ld(&bar[XB_TMO])) break; if (sp > XB_SPIN_CAP) { atomicAdd(&bar[XB_TMO], 1u); break; } }
    }
    nloc = mine > 0u ? mine : 1u; nx = cnt > 0u ? cnt : 1u;
}
__device__ __forceinline__ void xcd_barrier(const XcdBarrier& b) {
    asm volatile("s_waitcnt vmcnt(0)" ::: "memory");
    __syncthreads();
    if (threadIdx.x == 0) {
        unsigned* bar = b.bar;
        __builtin_amdgcn_s_waitcnt(0);
        unsigned nloc = b.st[0], nx = b.st[1];
        if (nloc == 0u) { xcd_barrier_complete(bar, b.x, nloc, nx); b.st[0] = nloc; b.st[1] = nx; }
        const unsigned old = xb_add(&bar[XB_XSUB(b.x)], 1u);
        const unsigned gen = old / nloc;
        if (old + 1u == (gen + 1u) * nloc) {
            __builtin_amdgcn_fence(__ATOMIC_RELEASE, "agent");
            asm volatile("s_waitcnt vmcnt(0)" ::: "memory");
            const unsigned og = xb_add(&bar[XB_TOP], 1u);
            const unsigned tg = og / nx;
            if (og + 1u == (tg + 1u) * nx) xb_add(&bar[XB_TOPGEN], 1u);
            else XB_SPIN(xb_ld(&bar[XB_TOPGEN]) == tg, bar);
            __builtin_amdgcn_fence(__ATOMIC_ACQUIRE, "agent");
            xb_add(&bar[XB_XGEN(b.x)], 1u);
            asm volatile("s_waitcnt vmcnt(0)" ::: "memory");
        } else {
            XB_SPIN(xb_ld(&bar[XB_XGEN(b.x)]) == gen, bar);
            __builtin_amdgcn_fence(__ATOMIC_ACQUIRE, "agent");
            asm volatile("s_waitcnt vmcnt(0)" ::: "memory");
        }
    }
    __syncthreads();
}

struct Args { const float* in[20]; float* out; unsigned char* ws; int ph_lo, ph_hi, li, pad; };
enum { I_X = 0, I_WIN, I_KVG, I_WUK, I_WUV, I_RELB, I_LBP, I_BNG, I_WBRA, I_WBRB, I_WO, I_LN1G, I_LN1B, I_WPQ, I_SK1, I_SK2, I_UT, I_VT, I_LN2G, I_LN2B };

typedef const __attribute__((address_space(4))) Args* KArgs;
struct Frame {
    LAS unsigned char* lds;
    int tid, lane, wave, G;
    KArgs a;
    unsigned char* ws;
};

__device__ __forceinline__ float wave_sum(float v) {
#pragma unroll
    for (int o = 1; o < 64; o <<= 1) v += __shfl_xor(v, o);
    return v;
}
__device__ __forceinline__ float wave_max(float v) {
#pragma unroll
    for (int o = 1; o < 64; o <<= 1) v = fmaxf(v, __shfl_xor(v, o));
    return v;
}

__device__ __forceinline__ void cvt_bf16_stream(const float* src, bf16* dst, size_t n8, size_t gtid, size_t gthreads) {
    for (size_t i = gtid; i < n8; i += gthreads) {
        const f32x4 a = ((const f32x4*)src)[2 * i], b = ((const f32x4*)src)[2 * i + 1];
        v4u o; o.x = pk2(a.x, a.y); o.y = pk2(a.z, a.w); o.z = pk2(b.x, b.y); o.w = pk2(b.z, b.w);
        ((v4u*)dst)[i] = o;
    }
}
__device__ __forceinline__ void transpose_item(const float* W, int ldw, int K, int c0, int nvalid, bf16* WT, int r0, int k0, LAS float* scr, int lane) {
#pragma unroll 8
    for (int i = 0; i < 32; ++i) { const int kk = 2 * i + (lane >> 5), n = lane & 31; scr[kk * 33 + n] = (n < nvalid) ? W[(size_t)(k0 + kk) * ldw + c0 + n] : 0.f; }
    LDS_WAIT(); asm volatile("" ::: "memory");
    const int c = lane & 7;
#pragma unroll
    for (int j = 0; j < 4; ++j) { const int n = (lane >> 3) + 8 * j; const LAS float* s = scr + (8 * c) * 33 + n;
        v4u o; o.x = pk2(s[0 * 33], s[1 * 33]); o.y = pk2(s[2 * 33], s[3 * 33]); o.z = pk2(s[4 * 33], s[5 * 33]); o.w = pk2(s[6 * 33], s[7 * 33]);
        *(v4u*)(WT + (size_t)(r0 + n) * K + k0 + 8 * c) = o; }
    LDS_WAIT(); asm volatile("" ::: "memory");
}
__device__ __forceinline__ void win_block(int cb, int& c0, int& r0, int& nv) {
    nv = 32;
    if (cb < 4)        { c0 = 512 + 32 * cb;          r0 = 1024 + 32 * cb; }
    else if (cb < 6)   { c0 = 1152 + 32 * (cb - 4);   r0 = 1152 + 32 * (cb - 4); }
    else if (cb == 6)  { c0 = 1216;                   r0 = 1216; nv = 8; }
    else if (cb == 7)  { c0 = 0;                      r0 = 1248; nv = 0; }
    else if (cb < 24)  { c0 = 640 + 32 * (cb - 8);    r0 = 1280 + 32 * (cb - 8); }
    else if (cb < 40)  { c0 = 1224 + 32 * (cb - 24);  r0 = 1792 + 32 * (cb - 24); }
    else if (cb < 56)  { c0 = 1736 + 32 * (cb - 40);  r0 = 2304 + 32 * (cb - 40); }
    else if (cb < 72)  { c0 = 2248 + 32 * (cb - 56);  r0 = 2816 + 32 * (cb - 56); }
    else if (cb < 88)  { c0 = 2760 + 32 * (cb - 72);  r0 = 3328 + 32 * (cb - 72); }
    else if (cb < 120) { c0 = 3272 + 32 * (cb - 88);  r0 = 3840 + 32 * (cb - 88); }
    else               { c0 = 4296 + 32 * (cb - 120); r0 = 4864 + 32 * (cb - 120); }
}
__device__ __forceinline__ void p0_prologue(Frame& F) {
    KArgs const Ap = F.a;
    const size_t gtid = (size_t)blockIdx.x * NTHREADS + F.tid, gthreads = (size_t)F.G * NTHREADS;
    cvt_bf16_stream(Ap->in[I_X], (bf16*)(F.ws + WS_XB), (size_t)T * DM / 8, gtid, gthreads);
    {
        const int gw0 = blockIdx.x * NWAVES + F.wave, NGW0 = F.G * NWAVES;
        for (int r = gw0; r < 2 * 16384; r += NGW0) {
            const int tb = r >> 14, e = r & 16383;
            const float* src = (tb ? Ap->in[I_VT] : Ap->in[I_UT]) + (size_t)e * DM;
            unsigned char* dst = F.ws + (tb ? WS_VT8 : WS_UT8); float* inv = (float*)(F.ws + (tb ? WS_VINV : WS_UINV));
            f32x4 v[4]; float am = 0.f;
#pragma unroll
            for (int j = 0; j < 4; ++j) { v[j] = ((const f32x4*)src)[F.lane + 64 * j]; am = fmaxf(am, fmaxf(fmaxf(fabsf(v[j].x), fabsf(v[j].y)), fmaxf(fabsf(v[j].z), fabsf(v[j].w)))); }
            am = wave_max(am);
            const float sc = am > 0.f ? 256.0f / am : 1.0f;
            if (F.lane == 0) inv[e] = am > 0.f ? am * (1.0f / 256.0f) : 1.0f;
#pragma unroll
            for (int j = 0; j < 4; ++j) { const int d0 = 256 * j + 4 * F.lane, sl = d0 >> 7, off = d0 & 127;
                int wv = __builtin_amdgcn_cvt_pk_fp8_f32(v[j].x * sc, v[j].y * sc, 0, false); wv = __builtin_amdgcn_cvt_pk_fp8_f32(v[j].z * sc, v[j].w * sc, wv, true);
                *(unsigned*)(dst + ((size_t)sl * 16384 + e) * 128 + off) = (unsigned)wv; }
        }
    }
    LAS float* scr = (LAS float*)(F.lds + F.wave * 16384);
    const int gw = blockIdx.x * NWAVES + F.wave, NGW = F.G * NWAVES;
    constexpr int I_IN = 152 * 16, I_B = 32 * 8, I_O = 32 * 16, I_PQ = 64 * 16;
    for (int it = gw; it < I_IN + I_B + I_O + I_PQ; it += NGW) {
        int r = it;
        if (r < I_IN) { const int cb = r >> 4, kb = r & 15; int c0, r0, nv; win_block(cb, c0, r0, nv);
            transpose_item(Ap->in[I_WIN], IN_COLS, 1024, c0, nv, (bf16*)(F.ws + WS_WIN), r0, 64 * kb, scr, F.lane); continue; }
        r -= I_IN;
        if (r < I_B) { const int cb = r >> 3, kb = r & 7; transpose_item(Ap->in[I_WBRB], 1024, 512, 32 * cb, 32, (bf16*)(F.ws + WS_WB), 32 * cb, 64 * kb, scr, F.lane); continue; }
        r -= I_B;
        if (r < I_O) { const int cb = r >> 4, kb = r & 15; transpose_item(Ap->in[I_WO], 1024, 1024, 32 * cb, 32, (bf16*)(F.ws + WS_WO), 32 * cb, 64 * kb, scr, F.lane); continue; }
        r -= I_O;
        { const int cb = r >> 4, kb = r & 15; transpose_item(Ap->in[I_WPQ], 2048, 1024, 32 * cb, 32, (bf16*)(F.ws + WS_WPQ), 32 * cb, 64 * kb, scr, F.lane); }
    }
    __syncthreads();
    LAS float* Xa = (LAS float*)(F.lds);
    LAS float* Xb = (LAS float*)(F.lds + 128 * 65 * 4);
    const float* w_in = Ap->in[I_WIN]; const float* w_uk = Ap->in[I_WUK]; const float* w_uv = Ap->in[I_WUV]; const float* w_bra = Ap->in[I_WBRA];
    for (int it = blockIdx.x; it < 256; it += F.G) {
        if (it < 128) {
            const int h = it >> 4, k0 = (it & 15) * 64;
            for (int e = F.tid; e < 128 * 64; e += NTHREADS) { const int c = e >> 6, d = e & 63; Xa[c * 65 + d] = w_uk[c * 512 + h * 64 + d]; }
            for (int e = F.tid; e < 64 * 64; e += NTHREADS) { const int kk = e >> 6, d = e & 63; Xb[kk * 65 + d] = w_in[(size_t)(k0 + kk) * IN_COLS + h * 64 + d]; }
            __syncthreads();
            const int kk = F.tid & 63;
            for (int j = 0; j < 16; ++j) { const int c = (F.tid >> 6) + 8 * j; float s = 0.f;
#pragma unroll 16
                for (int d = 0; d < 64; ++d) s += Xb[kk * 65 + d] * Xa[c * 65 + d];
                ((bf16*)(F.ws + WS_WIN))[(size_t)(h * 128 + c) * 1024 + k0 + kk] = (bf16)(pk2(s * 0.125f, 0.f) & 0xffffu); }
            __syncthreads();
        } else {
            const int i2 = it - 128, h = i2 >> 4, n0 = (i2 & 15) * 64;
            for (int e = F.tid; e < 128 * 64; e += NTHREADS) { const int c = e >> 6, d = e & 63; Xa[c * 65 + d] = w_uv[c * 512 + h * 64 + d]; }
            for (int e = F.tid; e < 64 * 64; e += NTHREADS) { const int d = e >> 6, n = e & 63; Xb[d * 65 + n] = w_bra[(size_t)(h * 64 + d) * 1024 + n0 + n]; }
            __syncthreads();
            const int c = F.tid & 127;
            for (int j = 0; j < 16; ++j) { const int n = (F.tid >> 7) + 4 * j; float s = 0.f;
#pragma unroll 16
                for (int d = 0; d < 64; ++d) s += Xa[c * 65 + d] * Xb[d * 65 + n];
                ((bf16*)(F.ws + WS_WA))[(size_t)(n0 + n) * 1024 + h * 128 + c] = (bf16)(pk2(s, 0.f) & 0xffffu); }
            __syncthreads();
        }
    }
}

struct EpiProj {
    static constexpr bool PERM = true;
    unsigned char* ws;
    __device__ __forceinline__ void operator()(const f32x4 (&acc)[2][2][4][2], const pg8::Unit& u, int wr, int wc, int fr, int fq) const {
        const int pn = u.pn; size_t boff; int ldc, colt; bool sg = false;
        if (pn < 4)       { boff = WS_QL;   ldc = 1024; colt = pn * 256; }
        else if (pn == 4) { boff = WS_MISC; ldc = 256;  colt = 0; }
        else if (pn < 7)  { boff = WS_QI;   ldc = 512;  colt = (pn - 5) * 256; }
        else if (pn < 9)  { boff = WS_QB;   ldc = 512;  colt = (pn - 7) * 256; }
        else if (pn < 11) { boff = WS_FB;   ldc = 512;  colt = (pn - 9) * 256; }
        else if (pn < 13) { boff = WS_IB;   ldc = 512;  colt = (pn - 11) * 256; }
        else if (pn < 15) { boff = WS_GB;   ldc = 512;  colt = (pn - 13) * 256; }
        else if (pn < 19) { boff = WS_GA;   ldc = 1024; colt = (pn - 15) * 256; sg = true; }
        else              { boff = WS_GBT;  ldc = 1024; colt = (pn - 19) * 256; sg = true; }
        bf16* base = (bf16*)(ws + boff);
        const int row0 = u.pm * 256 + wr * 64 + fr, col0 = colt + wc * 32 + 8 * fq;
#pragma unroll
        for (int ai = 0; ai < 2; ++ai)
#pragma unroll
            for (int m = 0; m < 4; ++m) { bf16* rowp = base + (size_t)(row0 + ai * 128 + m * 16) * ldc + col0;
#pragma unroll
                for (int bj = 0; bj < 2; ++bj) { f32x4 v0 = acc[ai][bj][m][0], v1 = acc[ai][bj][m][1];
                    if (sg) {
#pragma unroll
                        for (int j = 0; j < 4; ++j) { v0[j] = sigmoidf_(v0[j]); v1[j] = sigmoidf_(v1[j]); } }
                    v4u w; w.x = pk2(v0[0], v0[1]); w.y = pk2(v0[2], v0[3]); w.z = pk2(v1[0], v1[1]); w.w = pk2(v1[2], v1[3]);
                    *(v4u*)(rowp + bj * 128) = w; } }
    }
};
template <int MODE> struct EpiBranch {
    static constexpr bool PERM = true;
    const bf16* gate; bf16* O;
    __device__ __forceinline__ void operator()(const f32x4 (&acc)[2][2][4][2], const pg8::Unit& u, int wr, int wc, int fr, int fq) const {
        const int row0 = u.pm * 256 + wr * 64 + fr, col0 = u.pn * 256 + wc * 32 + 8 * fq;
#pragma unroll
        for (int ai = 0; ai < 2; ++ai)
#pragma unroll
            for (int m = 0; m < 4; ++m) { const size_t off = (size_t)(row0 + ai * 128 + m * 16) * 1024 + col0;
#pragma unroll
                for (int bj = 0; bj < 2; ++bj) { const f32x4 v0 = acc[ai][bj][m][0], v1 = acc[ai][bj][m][1];
                    const v4u g = *(const v4u*)(gate + off + bj * 128);
                    float r0 = v0[0] * bflo(g.x), r1 = v0[1] * bfhi(g.x), r2 = v0[2] * bflo(g.y), r3 = v0[3] * bfhi(g.y), r4 = v1[0] * bflo(g.z), r5 = v1[1] * bfhi(g.z), r6 = v1[2] * bflo(g.w), r7 = v1[3] * bfhi(g.w);
                    if (MODE == 1) { const v4u p = *(const v4u*)(O + off + bj * 128);
                        r0 += bflo(p.x); r1 += bfhi(p.x); r2 += bflo(p.y); r3 += bfhi(p.y); r4 += bflo(p.z); r5 += bfhi(p.z); r6 += bflo(p.w); r7 += bfhi(p.w); }
                    v4u w; w.x = pk2(r0, r1); w.y = pk2(r2, r3); w.z = pk2(r4, r5); w.w = pk2(r6, r7);
                    *(v4u*)(O + off + bj * 128) = w; } }
    }
};
struct EpiResF32 {
    static constexpr bool PERM = false;
    const float* X; float* Y;
    __device__ __forceinline__ void operator()(const f32x4 (&acc)[2][2][4][2], const pg8::Unit& u, int wr, int wc, int fr, int fq) const {
        const int row0 = u.pm * 256 + wr * 64 + fr, col0 = u.pn * 256 + wc * 32 + 4 * fq;
#pragma unroll
        for (int ai = 0; ai < 2; ++ai)
#pragma unroll
            for (int m = 0; m < 4; ++m) { const size_t off = (size_t)(row0 + ai * 128 + m * 16) * 1024 + col0;
#pragma unroll
                for (int bj = 0; bj < 2; ++bj)
#pragma unroll
                    for (int n = 0; n < 2; ++n) { const f32x4 xv = *(const f32x4*)(X + off + bj * 128 + n * 16);
                        *(f32x4*)(Y + off + bj * 128 + n * 16) = xv * ALPHA + acc[ai][bj][m][n]; } }
    }
};
struct EpiPlainBf16 {
    static constexpr bool PERM = true;
    bf16* O; int ldc;
    __device__ __forceinline__ void operator()(const f32x4 (&acc)[2][2][4][2], const pg8::Unit& u, int wr, int wc, int fr, int fq) const {
        const int row0 = u.pm * 256 + wr * 64 + fr, col0 = u.pn * 256 + wc * 32 + 8 * fq;
#pragma unroll
        for (int ai = 0; ai < 2; ++ai)
#pragma unroll
            for (int m = 0; m < 4; ++m) { bf16* rowp = O + (size_t)(row0 + ai * 128 + m * 16) * ldc + col0;
#pragma unroll
                for (int bj = 0; bj < 2; ++bj) { const f32x4 v0 = acc[ai][bj][m][0], v1 = acc[ai][bj][m][1];
                    v4u w; w.x = pk2(v0[0], v0[1]); w.y = pk2(v0[2], v0[3]); w.z = pk2(v1[0], v1[1]); w.w = pk2(v1[2], v1[3]);
                    *(v4u*)(rowp + bj * 128) = w; } }
    }
};

__device__ __forceinline__ void p2_ckv_norm(Frame& F) {
    const bf16* misc = (const bf16*)(F.ws + WS_MISC); bf16* ckv = (bf16*)(F.ws + WS_CKV); const float* g = F.a->in[I_KVG];
    const int gw = blockIdx.x * NWAVES + F.wave, NGW = F.G * NWAVES, sub = F.lane >> 4, l16 = F.lane & 15;
    float gv[8];
#pragma unroll
    for (int j = 0; j < 8; ++j) gv[j] = g[l16 * 8 + j];
    for (int r4 = gw; r4 < T / 4; r4 += NGW) {
        const int t = r4 * 4 + sub;
        const v4u p = *(const v4u*)(misc + (size_t)t * 256 + l16 * 8);
        float v[8] = {bflo(p.x), bfhi(p.x), bflo(p.y), bfhi(p.y), bflo(p.z), bfhi(p.z), bflo(p.w), bfhi(p.w)};
        float ss = 0.f;
#pragma unroll
        for (int j = 0; j < 8; ++j) ss += v[j] * v[j];
        ss += __shfl_xor(ss, 1); ss += __shfl_xor(ss, 2); ss += __shfl_xor(ss, 4); ss += __shfl_xor(ss, 8);
        const float r = rsqrtf(ss * (1.0f / 128.0f) + RMS_EPS);
        v4u o; o.x = pk2(v[0] * r * gv[0], v[1] * r * gv[1]); o.y = pk2(v[2] * r * gv[2], v[3] * r * gv[3]); o.z = pk2(v[4] * r * gv[4], v[5] * r * gv[5]); o.w = pk2(v[6] * r * gv[6], v[7] * r * gv[7]);
        *(v4u*)(ckv + (size_t)t * 128 + l16 * 8) = o;
    }
}

__device__ __forceinline__ void p2_hgrn_simple(Frame& F) {
    const bf16* QB = (const bf16*)(F.ws + WS_QB); const bf16* FBp = (const bf16*)(F.ws + WS_FB); bf16* IB = (bf16*)(F.ws + WS_IB);
    const float* lbp = F.a->in[I_LBP];
    const int v = F.tid >> 2, dq = F.tid & 3;
    for (int item = blockIdx.x; item < NB * 4; item += F.G) {
        const int b = item >> 2, h = item & 3;
        float lb[32], S[32];
#pragma unroll
        for (int i = 0; i < 32; ++i) { const int d = h * 128 + dq * 32 + i; lb[i] = 1.0f / (1.0f + __expf(lbp[512 + d] - lbp[d])); S[i] = 0.f; }
        for (int t = 0; t < SEQ; ++t) {
            const size_t row = (size_t)b * SEQ + t;
            const v4u* qp = (const v4u*)(QB + row * 512 + h * 128 + dq * 32);
            const v4u* fp = (const v4u*)(FBp + row * 512 + h * 128 + dq * 32);
            const float vv = bf2f(IB[row * 512 + h * 128 + v]);
            float part = 0.f;
#pragma unroll
            for (int c = 0; c < 4; ++c) { const v4u q4 = qp[c], f4 = fp[c];
#pragma unroll
                for (int e = 0; e < 4; ++e) {
                    const unsigned qa = e == 0 ? q4.x : e == 1 ? q4.y : e == 2 ? q4.z : q4.w, fa = e == 0 ? f4.x : e == 1 ? f4.y : e == 2 ? f4.z : f4.w;
#pragma unroll
                    for (int hh = 0; hh < 2; ++hh) { const int i = c * 8 + e * 2 + hh;
                        const float q = hh ? bfhi(qa) : bflo(qa), z = hh ? bfhi(fa) : bflo(fa);
                        const float sg = sigmoidf_(z), f = lb[i] + (1.0f - lb[i]) * sg, k = (1.0f - lb[i]) * (1.0f - sg);
                        S[i] = f * S[i] + k * vv; part += q * S[i]; } } }
            part += __shfl_xor(part, 1); part += __shfl_xor(part, 2);
            if (dq == 0) IB[row * 512 + h * 128 + v] = (bf16)(pk2(part, 0.f) & 0xffffu);
        }
    }
}

__device__ __forceinline__ void p2_hgrn_chunked(Frame& F, bf16* OUTB, int nbatch) {
    typedef short bf16x8 __attribute__((ext_vector_type(8)));
    const bf16* QB = (const bf16*)(F.ws + WS_QB); const bf16* FBp = (const bf16*)(F.ws + WS_FB); bf16* IB = (bf16*)(F.ws + WS_IB);
    const float* lbp = F.a->in[I_LBP];
    constexpr int S136 = 136, S72 = 72;
    LAS bf16* QIN = (LAS bf16*)(F.lds);
    LAS bf16* KIN = (LAS bf16*)(F.lds + 17408);
    LAS bf16* QDEC = (LAS bf16*)(F.lds + 2 * 17408);
    LAS bf16* ST = (LAS bf16*)(F.lds + 3 * 17408);
    LAS bf16* KDT = (LAS bf16*)(F.lds + 4 * 17408);
    LAS bf16* VT = (LAS bf16*)(F.lds + 4 * 17408 + 18432);
    LAS bf16* ATT = (LAS bf16*)(F.lds + 4 * 17408 + 18432 + 9216);
    LAS float* SEG = (LAS float*)(F.lds + 4 * 17408 + 18432 + 2 * 9216);
    LAS float* DECAY = SEG + 512;
    const int tid = F.tid, lane = F.lane, w = F.wave, l15 = lane & 15, q4 = lane >> 4;
    const int d = tid & 127, tq = tid >> 7;
    const int vn = tid & 63, vg = tid >> 6;
    const int tr = w >> 1, tc2 = w & 1;
    for (int item = blockIdx.x; item < nbatch * 8; item += F.G) {
        const int b = item >> 3, h = (item >> 1) & 3, half = item & 1;
        const float lb = 1.0f / (1.0f + __expf(lbp[512 + h * 128 + d] - lbp[h * 128 + d])), oml = 1.0f - lb;
        f32x4 Sacc[4];
#pragma unroll
        for (int nt = 0; nt < 4; ++nt) Sacc[nt] = (f32x4){0.f, 0.f, 0.f, 0.f};
        for (int e = tid; e < 64 * S136 / 2; e += NTHREADS) ((LAS unsigned*)ST)[e] = 0u;
        const size_t rowb = (size_t)b * SEQ;
        const bf16* zp = FBp + (rowb + tq * 16) * 512 + h * 128 + d;
        const bf16* qp = QB + (rowb + tq * 16) * 512 + h * 128 + d;
        bf16* vp = IB + (rowb + vg * 8) * 512 + h * 128 + half * 64 + vn;
        unsigned short zr[16], qr[16], vr[8];
#pragma unroll
        for (int i = 0; i < 16; ++i) { zr[i] = zp[(size_t)i * 512]; qr[i] = qp[(size_t)i * 512]; }
#pragma unroll
        for (int i = 0; i < 8; ++i) vr[i] = vp[(size_t)i * 512];
        __syncthreads();
        for (int n = 0; n < SEQ / 64; ++n) {
            float c[16], kk[16], qf[16];
            { float run = 0.f;
#pragma unroll
              for (int i = 0; i < 16; ++i) { const float z = bf2f(zr[i]); const float e1 = __expf(-z), sg = 1.0f / (1.0f + e1);
                  run += __logf(lb + oml * sg); c[i] = run; kk[i] = oml * e1 * sg; qf[i] = bf2f(qr[i]); } }
            unsigned short vcur[8];
#pragma unroll
            for (int i = 0; i < 8; ++i) vcur[i] = vr[i];
            SEG[tq * 128 + d] = c[15];
            if (n + 1 < SEQ / 64) {
                const size_t o2 = (size_t)(n + 1) * 64 * 512;
#pragma unroll
                for (int i = 0; i < 16; ++i) { zr[i] = zp[o2 + (size_t)i * 512]; qr[i] = qp[o2 + (size_t)i * 512]; }
#pragma unroll
                for (int i = 0; i < 8; ++i) vr[i] = vp[o2 + (size_t)i * 512];
            }
            __syncthreads();
            { const float s0 = SEG[d], s1 = SEG[128 + d], s2 = SEG[256 + d], s3 = SEG[384 + d];
              const float off = tq == 0 ? 0.f : tq == 1 ? s0 : tq == 2 ? s0 + s1 : s0 + s1 + s2;
              const float bref = s0 + s1, blast = (s0 + s1) + (s2 + s3);
              const float enb = __expf(-bref), eb = __expf(bref), el = __expf(blast);
              if (tq == 0) DECAY[d] = el;
              unsigned kd[8];
#pragma unroll
              for (int i = 0; i < 16; i += 2) {
                  const float E0 = __expf(c[i] + off), E1 = __expf(c[i + 1] + off), r0 = 1.0f / E0, r1 = 1.0f / E1;
                  const int t0 = tq * 16 + i;
                  const unsigned qd = pk2(qf[i] * E0, qf[i + 1] * E1), qi = pk2(qf[i] * E0 * enb, qf[i + 1] * E1 * enb), ki = pk2(kk[i] * eb * r0, kk[i + 1] * eb * r1);
                  QDEC[t0 * S136 + d] = (bf16)(qd & 0xffffu); QDEC[(t0 + 1) * S136 + d] = (bf16)(qd >> 16);
                  QIN[t0 * S136 + d] = (bf16)(qi & 0xffffu); QIN[(t0 + 1) * S136 + d] = (bf16)(qi >> 16);
                  KIN[t0 * S136 + d] = (bf16)(ki & 0xffffu); KIN[(t0 + 1) * S136 + d] = (bf16)(ki >> 16);
                  kd[i >> 1] = pk2(kk[i] * el * r0, kk[i + 1] * el * r1);
              }
              *(LAS v4u*)(KDT + d * S72 + tq * 16) = (v4u){kd[0], kd[1], kd[2], kd[3]};
              *(LAS v4u*)(KDT + d * S72 + tq * 16 + 8) = (v4u){kd[4], kd[5], kd[6], kd[7]};
              v4u vv; vv.x = (unsigned)vcur[0] | ((unsigned)vcur[1] << 16); vv.y = (unsigned)vcur[2] | ((unsigned)vcur[3] << 16); vv.z = (unsigned)vcur[4] | ((unsigned)vcur[5] << 16); vv.w = (unsigned)vcur[6] | ((unsigned)vcur[7] << 16);
              *(LAS v4u*)(VT + vn * S72 + vg * 8) = vv;
            }
            __syncthreads();
#pragma unroll
            for (int j = 0; j < 2; ++j) {
                const int tc = 2 * tc2 + j;
                f32x4 acc = {0.f, 0.f, 0.f, 0.f};
                if (tc <= tr) {
#pragma unroll
                    for (int ks = 0; ks < 4; ++ks) {
                        const bf16x8 a = *(const LAS bf16x8*)(QIN + (tr * 16 + l15) * S136 + ks * 32 + 8 * q4);
                        const bf16x8 bb = *(const LAS bf16x8*)(KIN + (tc * 16 + l15) * S136 + ks * 32 + 8 * q4);
                        acc = __builtin_amdgcn_mfma_f32_16x16x32_bf16(a, bb, acc, 0, 0, 0);
                    }
                }
                const int s_ = tc * 16 + l15;
#pragma unroll
                for (int r = 0; r < 4; ++r) { const int t_ = tr * 16 + 4 * q4 + r; ATT[t_ * S72 + s_] = (bf16)(pk2(s_ <= t_ ? acc[r] : 0.f, 0.f) & 0xffffu); }
            }
            __syncthreads();
#pragma unroll
            for (int j = 0; j < 2; ++j) {
                const int nt = 2 * tc2 + j;
                f32x4 acc = {0.f, 0.f, 0.f, 0.f};
#pragma unroll
                for (int ks = 0; ks < 2; ++ks) {
                    const bf16x8 a = *(const LAS bf16x8*)(ATT + (tr * 16 + l15) * S72 + ks * 32 + 8 * q4);
                    const bf16x8 bb = *(const LAS bf16x8*)(VT + (nt * 16 + l15) * S72 + ks * 32 + 8 * q4);
                    acc = __builtin_amdgcn_mfma_f32_16x16x32_bf16(a, bb, acc, 0, 0, 0);
                }
#pragma unroll
                for (int ks = 0; ks < 4; ++ks) {
                    const bf16x8 a = *(const LAS bf16x8*)(QDEC + (tr * 16 + l15) * S136 + ks * 32 + 8 * q4);
                    const bf16x8 bb = *(const LAS bf16x8*)(ST + (nt * 16 + l15) * S136 + ks * 32 + 8 * q4);
                    acc = __builtin_amdgcn_mfma_f32_16x16x32_bf16(a, bb, acc, 0, 0, 0);
                }
                bf16* op = OUTB + (rowb + (size_t)n * 64 + tr * 16 + 4 * q4) * 512 + h * 128 + half * 64 + nt * 16 + l15;
#pragma unroll
                for (int r = 0; r < 4; ++r) op[(size_t)r * 512] = (bf16)(pk2(acc[r], 0.f) & 0xffffu);
            }
            __syncthreads();
            { const f32x4 dc = *(const LAS f32x4*)(DECAY + w * 16 + 4 * q4);
#pragma unroll
              for (int nt = 0; nt < 4; ++nt) {
                  f32x4 acc = Sacc[nt] * dc;
#pragma unroll
                  for (int ks = 0; ks < 2; ++ks) {
                      const bf16x8 a = *(const LAS bf16x8*)(KDT + (w * 16 + l15) * S72 + ks * 32 + 8 * q4);
                      const bf16x8 bb = *(const LAS bf16x8*)(VT + (nt * 16 + l15) * S72 + ks * 32 + 8 * q4);
                      acc = __builtin_amdgcn_mfma_f32_16x16x32_bf16(a, bb, acc, 0, 0, 0);
                  }
                  Sacc[nt] = acc;
                  *(LAS v2u*)(ST + (nt * 16 + l15) * S136 + w * 16 + 4 * q4) = (v2u){pk2(acc[0], acc[1]), pk2(acc[2], acc[3])};
              } }
        }
        __syncthreads();
    }
}

__device__ __forceinline__ unsigned mono_key(float f) { const unsigned u = __float_as_uint(f); return (u & 0x80000000u) ? ~u : (u | 0x80000000u); }
__device__ __forceinline__ void p2_indexer_simple(Frame& F) {
    typedef short bf16x8 __attribute__((ext_vector_type(8)));
    const bf16* misc = (const bf16*)(F.ws + WS_MISC); const bf16* QI = (const bf16*)(F.ws + WS_QI);
    unsigned long long* BMp = (unsigned long long*)(F.ws + WS_BM);
    LAS float* sc = (LAS float*)(F.lds + F.wave * 16384);
    const int gw = blockIdx.x * NWAVES + F.wave, NGW = F.G * NWAVES, lane = F.lane;
    const int l15 = lane & 15, q4 = lane >> 4;
    for (int tp = gw; tp < T / 2; tp += NGW) {
        const int t0 = tp * 2, b = t0 >> 11, pos = t0 & 2047, chunk = pos >> 6, nk = chunk + 1;
        if (nk <= 4) { if (lane < 32) { BMp[(size_t)t0 * 32 + lane] = (lane < nk) ? ~0ull : 0ull; BMp[(size_t)(t0 + 1) * 32 + lane] = (lane < nk) ? ~0ull : 0ull; } continue; }
        const bf16* ap = QI + (size_t)(t0 + (l15 >> 3)) * 512 + (l15 & 7) * 64 + 8 * q4;
        const bf16x8 a0 = *(const bf16x8*)ap, a1 = *(const bf16x8*)(ap + 32);
        float w[4];
        { const v2u p = *(const v2u*)(misc + (size_t)(t0 + (q4 >> 1)) * 256 + 192 + (q4 & 1) * 4); const float s_ = 0.04419417382415922f;
          w[0] = bflo(p.x) * s_; w[1] = bfhi(p.x) * s_; w[2] = bflo(p.y) * s_; w[3] = bfhi(p.y) * s_; }
        const bf16* kbase = misc + ((size_t)b * SEQ + l15) * 256 + 128 + 8 * q4;
#pragma unroll 2
        for (int kt = 0; kt < nk * 4; ++kt) {
            const bf16* kp = kbase + (size_t)kt * 16 * 256;
            const bf16x8 b0 = *(const bf16x8*)kp, b1 = *(const bf16x8*)(kp + 32);
            f32x4 acc = {0.f, 0.f, 0.f, 0.f};
            acc = __builtin_amdgcn_mfma_f32_16x16x32_bf16(a0, b0, acc, 0, 0, 0);
            acc = __builtin_amdgcn_mfma_f32_16x16x32_bf16(a1, b1, acc, 0, 0, 0);
            float part = w[0] * fmaxf(acc[0], 0.f) + w[1] * fmaxf(acc[1], 0.f) + w[2] * fmaxf(acc[2], 0.f) + w[3] * fmaxf(acc[3], 0.f);
            part += __shfl_xor(part, 16);
            if ((q4 & 1) == 0) sc[(q4 >> 1) * 2048 + kt * 16 + l15] = part;
        }
        for (int i = nk; i < 32; ++i) { sc[i * 64 + lane] = -INFINITY; sc[2048 + i * 64 + lane] = -INFINITY; }
        LDS_WAIT(); asm volatile("" ::: "memory");
#pragma unroll 1
        for (int tt = 0; tt < 2; ++tt) {
            unsigned long long* bmrow = BMp + (size_t)(t0 + tt) * 32;
            unsigned key[32];
#pragma unroll
            for (int i = 0; i < 32; ++i) key[i] = mono_key(sc[tt * 2048 + i * 64 + lane]);
            unsigned prefix = 0u;
#pragma unroll 1
            for (int bit = 31; bit >= 0; --bit) {
                const unsigned cand = prefix | (1u << bit); int cnt = 0;
#pragma unroll
                for (int i = 0; i < 32; ++i) { cnt += __builtin_popcountll(__ballot(key[i] >= cand)); if ((i & 3) == 3) __builtin_amdgcn_sched_barrier(0); }
                if (cnt >= 256) prefix = cand;
            }
            int ngt = 0;
#pragma unroll
            for (int i = 0; i < 32; ++i) { ngt += __builtin_popcountll(__ballot(key[i] > prefix)); if ((i & 3) == 3) __builtin_amdgcn_sched_barrier(0); }
            const int need = 256 - ngt; int running = 0;
            const unsigned long long lt_mask = (1ull << lane) - 1ull;
#pragma unroll
            for (int i = 0; i < 32; ++i) {
                const unsigned long long eq = __ballot(key[i] == prefix), gt = __ballot(key[i] > prefix);
                const int rank = running + __builtin_popcountll(eq & lt_mask);
                const unsigned long long se = __ballot(key[i] == prefix && rank < need);
                running += __builtin_popcountll(eq);
                const unsigned long long word = gt | se;
                if (lane == 0) bmrow[i] = word;
                __builtin_amdgcn_sched_barrier(0);
            }
        }
        LDS_WAIT(); asm volatile("" ::: "memory");
    }
}

__device__ __forceinline__ void p3_hg_finalize(Frame& F) {
    bf16* HG = (bf16*)(F.ws + WS_IB); const bf16* GBp = (const bf16*)(F.ws + WS_GB); const float* ng = F.a->in[I_BNG];
    const int gw = blockIdx.x * NWAVES + F.wave, NGW = F.G * NWAVES, sub = F.lane >> 4, l16 = F.lane & 15;
    float gv[8];
#pragma unroll
    for (int j = 0; j < 8; ++j) gv[j] = ng[l16 * 8 + j];
    for (int r4 = gw; r4 < T; r4 += NGW) {
        const size_t off = (size_t)r4 * 512 + sub * 128 + l16 * 8;
        const v4u p = *(const v4u*)(HG + off), q = *(const v4u*)(GBp + off);
        float v[8] = {bflo(p.x), bfhi(p.x), bflo(p.y), bfhi(p.y), bflo(p.z), bfhi(p.z), bflo(p.w), bfhi(p.w)};
        float gg[8] = {bflo(q.x), bfhi(q.x), bflo(q.y), bfhi(q.y), bflo(q.z), bfhi(q.z), bflo(q.w), bfhi(q.w)};
        float ss = 0.f;
#pragma unroll
        for (int j = 0; j < 8; ++j) ss += v[j] * v[j];
        ss += __shfl_xor(ss, 1); ss += __shfl_xor(ss, 2); ss += __shfl_xor(ss, 4); ss += __shfl_xor(ss, 8);
        const float r = rsqrtf(ss * (1.0f / 128.0f) + RMS_EPS);
        float o[8];
#pragma unroll
        for (int j = 0; j < 8; ++j) o[j] = v[j] * r * gv[j] * gg[j] * sigmoidf_(gg[j]);
        v4u w; w.x = pk2(o[0], o[1]); w.y = pk2(o[2], o[3]); w.z = pk2(o[4], o[5]); w.w = pk2(o[6], o[7]);
        *(v4u*)(HG + off) = w;
    }
}

__device__ __forceinline__ int t5_bucket(int rel) {
    const int n = rel < 0 ? -rel : rel; const int base = rel > 0 ? 16 : 0;
    int v;
    if (n < 8) v = n; else v = n >= 91 ? 15 : n >= 64 ? 14 : n >= 46 ? 13 : n >= 32 ? 12 : n >= 23 ? 11 : n >= 16 ? 10 : n >= 12 ? 9 : 8;
    return base + v;
}
__device__ __forceinline__ void p3_attn_simple(Frame& F) {
    const bf16* CKV = (const bf16*)(F.ws + WS_CKV); bf16* QL = (bf16*)(F.ws + WS_QL);
    const unsigned long long* BMp = (const unsigned long long*)(F.ws + WS_BM);
    LAS float* relb = (LAS float*)(F.lds + 8 * 12800);
    LAS float* qlf = (LAS float*)(F.lds + F.wave * 12800);
    LAS float* pl = (LAS float*)(F.lds + F.wave * 12800 + 4096);
    LAS unsigned short* idx = (LAS unsigned short*)(F.lds + F.wave * 12800 + 4096 + 8192);
    if (F.tid < 256) relb[F.tid] = F.a->in[I_RELB][F.tid];
    __syncthreads();
    const int gw = blockIdx.x * NWAVES + F.wave, NGW = F.G * NWAVES, lane = F.lane;
    const unsigned long long lt_mask = (1ull << lane) - 1ull;
    for (int t = gw; t < T; t += NGW) {
        const int b = t >> 11, pos = t & 2047, nk = (pos >> 6) + 1;
        {
#pragma unroll
            for (int j = 0; j < 2; ++j) { const v4u p = *(const v4u*)(QL + (size_t)t * 1024 + j * 512 + lane * 8);
                f32x4 a = {bflo(p.x), bfhi(p.x), bflo(p.y), bfhi(p.y)}, c = {bflo(p.z), bfhi(p.z), bflo(p.w), bfhi(p.w)};
                *(LAS f32x4*)(qlf + j * 512 + lane * 8) = a; *(LAS f32x4*)(qlf + j * 512 + lane * 8 + 4) = c; }
        }
        int n = 0;
        for (int i = 0; i < nk; ++i) {
            const unsigned long long word = BMp[(size_t)t * 32 + i];
            if ((word >> lane) & 1ull) idx[n + __builtin_popcountll(word & lt_mask)] = (unsigned short)(i * 64 + lane);
            n += __builtin_popcountll(word);
        }
        LDS_WAIT(); asm volatile("" ::: "memory");
#pragma unroll 1
        for (int j = 0; j < 4; ++j) {
            const int k = lane + 64 * j; const bool ok = k < n; const int s = ok ? (int)idx[k] : 0;
            const v4u* row = (const v4u*)(CKV + ((size_t)b * SEQ + s) * 128);
            float d[8];
#pragma unroll
            for (int h = 0; h < 8; ++h) d[h] = 0.f;
#pragma unroll 1
            for (int q4 = 0; q4 < 4; ++q4) {
                asm volatile("" ::: "memory");
                float ck[32];
#pragma unroll
                for (int c = 0; c < 4; ++c) { const v4u p = row[q4 * 4 + c]; ck[c * 8 + 0] = bflo(p.x); ck[c * 8 + 1] = bfhi(p.x); ck[c * 8 + 2] = bflo(p.y); ck[c * 8 + 3] = bfhi(p.y); ck[c * 8 + 4] = bflo(p.z); ck[c * 8 + 5] = bfhi(p.z); ck[c * 8 + 6] = bflo(p.w); ck[c * 8 + 7] = bfhi(p.w); }
#pragma unroll
                for (int h = 0; h < 8; ++h) {
#pragma unroll
                    for (int c = 0; c < 8; ++c) { const f32x4 q = *(const LAS f32x4*)(qlf + h * 128 + q4 * 32 + c * 4); d[h] += q.x * ck[c * 4] + q.y * ck[c * 4 + 1] + q.z * ck[c * 4 + 2] + q.w * ck[c * 4 + 3]; }
                    __builtin_amdgcn_sched_barrier(0);
                }
            }
            const int bk = t5_bucket(s - pos);
            f32x4 s0, s1;
            s0.x = ok ? d[0] + relb[bk * 8 + 0] : -INFINITY; s0.y = ok ? d[1] + relb[bk * 8 + 1] : -INFINITY; s0.z = ok ? d[2] + relb[bk * 8 + 2] : -INFINITY; s0.w = ok ? d[3] + relb[bk * 8 + 3] : -INFINITY;
            s1.x = ok ? d[4] + relb[bk * 8 + 4] : -INFINITY; s1.y = ok ? d[5] + relb[bk * 8 + 5] : -INFINITY; s1.z = ok ? d[6] + relb[bk * 8 + 6] : -INFINITY; s1.w = ok ? d[7] + relb[bk * 8 + 7] : -INFINITY;
            *(LAS f32x4*)(pl + k * 8) = s0; *(LAS f32x4*)(pl + k * 8 + 4) = s1;
        }
        LDS_WAIT(); asm volatile("" ::: "memory");
        {
            f32x4 a0[4], a1[4];
#pragma unroll
            for (int j = 0; j < 4; ++j) { a0[j] = *(const LAS f32x4*)(pl + (lane + 64 * j) * 8); a1[j] = *(const LAS f32x4*)(pl + (lane + 64 * j) * 8 + 4); }
#pragma unroll
            for (int h = 0; h < 8; ++h) {
                float v[4];
#pragma unroll
                for (int j = 0; j < 4; ++j) v[j] = h < 4 ? a0[j][h & 3] : a1[j][h & 3];
                float m = wave_max(fmaxf(fmaxf(v[0], v[1]), fmaxf(v[2], v[3])));
                float sum = 0.f;
#pragma unroll
                for (int j = 0; j < 4; ++j) { v[j] = __expf(v[j] - m); sum += v[j]; }
                const float inv = 1.0f / wave_sum(sum);
#pragma unroll
                for (int j = 0; j < 4; ++j) { if (h < 4) a0[j][h & 3] = v[j] * inv; else a1[j][h & 3] = v[j] * inv; }
            }
#pragma unroll
            for (int j = 0; j < 4; ++j) { *(LAS f32x4*)(pl + (lane + 64 * j) * 8) = a0[j]; *(LAS f32x4*)(pl + (lane + 64 * j) * 8 + 4) = a1[j]; }
        }
        LDS_WAIT(); asm volatile("" ::: "memory");
        float acc[8][2];
#pragma unroll
        for (int h = 0; h < 8; ++h) { acc[h][0] = 0.f; acc[h][1] = 0.f; }
        for (int k = 0; k < n; ++k) {
            const int s = (int)idx[k];
            const unsigned vv = *(const unsigned*)(CKV + ((size_t)b * SEQ + s) * 128 + 2 * lane);
            const float v0 = bflo(vv), v1 = bfhi(vv);
            const f32x4 p0 = *(const LAS f32x4*)(pl + k * 8), p1 = *(const LAS f32x4*)(pl + k * 8 + 4);
            acc[0][0] += p0.x * v0; acc[0][1] += p0.x * v1; acc[1][0] += p0.y * v0; acc[1][1] += p0.y * v1;
            acc[2][0] += p0.z * v0; acc[2][1] += p0.z * v1; acc[3][0] += p0.w * v0; acc[3][1] += p0.w * v1;
            acc[4][0] += p1.x * v0; acc[4][1] += p1.x * v1; acc[5][0] += p1.y * v0; acc[5][1] += p1.y * v1;
            acc[6][0] += p1.z * v0; acc[6][1] += p1.z * v1; acc[7][0] += p1.w * v0; acc[7][1] += p1.w * v1;
        }
#pragma unroll
        for (int h = 0; h < 8; ++h) *(unsigned*)(QL + (size_t)t * 1024 + h * 128 + 2 * lane) = pk2(acc[h][0], acc[h][1]);
        LDS_WAIT(); asm volatile("" ::: "memory");
    }
}

__device__ __forceinline__ unsigned offb(unsigned row, unsigned ch) { return 256u * row + 16u * (ch ^ (((row & 3u) << 2) | ((row >> 2) & 3u))); }
__device__ __forceinline__ void p3_attn_mfma(Frame& F) {
    typedef short bf16x8 __attribute__((ext_vector_type(8)));
    typedef short s16x4 __attribute__((ext_vector_type(4)));
    typedef float f32x16 __attribute__((ext_vector_type(16)));
    const bf16* CKV = (const bf16*)(F.ws + WS_CKV); bf16* QL = (bf16*)(F.ws + WS_QL);
    const unsigned long long* BMp = (const unsigned long long*)(F.ws + WS_BM);
    LAS unsigned char* KV = F.lds;
    LAS float* LUT = (LAS float*)(F.lds + 32768);
    const int tid = F.tid, lane = F.lane, head = F.wave, r = lane & 31, h = lane >> 5;
    for (int e = tid; e < 8 * 160; e += NTHREADS) { const int hh = e / 160, i = e % 160; const int rel = (i < 155 ? i : 154) - 91; LUT[e] = F.a->in[I_RELB][t5_bucket(rel) * 8 + hh]; }
    __syncthreads();
    const float bfar = LUT[head * 160];
    const unsigned blk = (lane >> 4) & 1, q4 = (lane & 15) >> 2, p4 = lane & 3;
    for (int uidx = blockIdx.x; uidx < NB * 64; uidx += F.G) {
        const int k = uidx >> 8, c0 = (uidx >> 5) & 7;
        const int b = uidx & 31, qt = 8 * k + ((k & 1) ? 7 - c0 : c0);
        const int t0 = qt * 32, nkt = (qt >> 1) + 1;
        const size_t trow = (size_t)b * SEQ + t0 + r;
        bf16x8 qf[8];
#pragma unroll
        for (int ks = 0; ks < 8; ++ks) qf[ks] = *(const bf16x8*)(QL + trow * 1024 + head * 128 + 16 * ks + 8 * h);
        f32x16 O[4];
#pragma unroll
        for (int cb = 0; cb < 4; ++cb)
#pragma unroll
            for (int i = 0; i < 16; ++i) O[cb][i] = 0.f;
        float m = -1e30f, l = 0.f;
        const int cid0 = tid * 2, lrow = cid0 >> 4, lch = cid0 & 15;
        const unsigned loff0 = (unsigned)(lrow >> 5) * 8192u + offb((unsigned)(lrow & 31), (unsigned)lch), loff1 = (unsigned)(lrow >> 5) * 8192u + offb((unsigned)(lrow & 31), (unsigned)lch + 1u);
        const bf16* gsrc = CKV + ((size_t)b * SEQ + lrow) * 128 + lch * 8;
        v4u g0 = *(const v4u*)gsrc, g1 = *(const v4u*)(gsrc + 8);
        __syncthreads();
        *(LAS v4u*)(KV + loff0) = g0; *(LAS v4u*)(KV + loff1) = g1;
        __syncthreads();
        for (int kt = 0; kt < nkt; ++kt) {
            LAS unsigned char* buf = KV + (kt & 1) * 16384;
            if (kt + 1 < nkt) { const bf16* gs = gsrc + (size_t)(kt + 1) * 64 * 128; g0 = *(const v4u*)gs; g1 = *(const v4u*)(gs + 8); }
            const unsigned long long bw = BMp[trow * 32 + kt];
            f32x16 ST[2];
#pragma unroll
            for (int s2 = 0; s2 < 2; ++s2) {
#pragma unroll
                for (int i = 0; i < 16; ++i) ST[s2][i] = 0.f;
#pragma unroll
                for (int ks = 0; ks < 8; ++ks) { const bf16x8 a = *(const LAS bf16x8*)(buf + s2 * 8192 + offb((unsigned)r, (unsigned)(2 * ks + h)));
                    ST[s2] = __builtin_amdgcn_mfma_f32_32x32x16_bf16(a, qf[ks], ST[s2], 0, 0, 0); }
            }
            const int relmax = kt * 64 + 63 - t0;
            const bool far = relmax <= -91;
            const unsigned wsel[2] = {(unsigned)bw >> (4 * h), (unsigned)(bw >> 32) >> (4 * h)};
            float mx = -1e30f;
#pragma unroll
            for (int s2 = 0; s2 < 2; ++s2)
#pragma unroll
                for (int i = 0; i < 16; ++i) {
                    const int cr = (i & 3) + 8 * (i >> 2);
                    float bias = bfar;
                    if (!far) { int rel = kt * 64 + 32 * s2 + cr + 4 * h - (t0 + r); rel = rel < -91 ? -91 : rel; bias = LUT[head * 160 + rel + 91]; }
                    const float sc = ST[s2][i] + bias; ST[s2][i] = sc;
                    if ((wsel[s2] >> cr) & 1u) mx = fmaxf(mx, sc);
                }
            mx = fmaxf(mx, __shfl_xor(mx, 32));
            const float mnew = fmaxf(m, mx), alpha = __expf(m - mnew);
            m = mnew;
            float ps = 0.f;
#pragma unroll
            for (int s2 = 0; s2 < 2; ++s2)
#pragma unroll
                for (int i = 0; i < 16; ++i) { const int cr = (i & 3) + 8 * (i >> 2);
                    const float pv = ((wsel[s2] >> cr) & 1u) ? __expf(ST[s2][i] - mnew) : 0.f; ST[s2][i] = pv; ps += pv; }
            l = l * alpha + ps;
#pragma unroll
            for (int cb = 0; cb < 4; ++cb)
#pragma unroll
                for (int i = 0; i < 16; ++i) O[cb][i] *= alpha;
#pragma unroll
            for (int s2 = 0; s2 < 2; ++s2)
#pragma unroll
                for (int u = 0; u < 2; ++u) {
                    v4u pk; pk.x = pk2(ST[s2][8 * u], ST[s2][8 * u + 1]); pk.y = pk2(ST[s2][8 * u + 2], ST[s2][8 * u + 3]); pk.z = pk2(ST[s2][8 * u + 4], ST[s2][8 * u + 5]); pk.w = pk2(ST[s2][8 * u + 6], ST[s2][8 * u + 7]);
                    const bf16x8 pf = __builtin_bit_cast(bf16x8, pk);
                    const unsigned row0 = 16u * u + 4u * h + q4;
#pragma unroll
                    for (int cb = 0; cb < 4; ++cb) {
                        const unsigned ch = 4u * cb + 2u * blk + (p4 >> 1);
                        const s16x4 lo = __builtin_amdgcn_ds_read_tr16_b64_v4i16((LAS s16x4*)(buf + s2 * 8192 + offb(row0, ch) + 8u * (p4 & 1u)));
                        const s16x4 hi = __builtin_amdgcn_ds_read_tr16_b64_v4i16((LAS s16x4*)(buf + s2 * 8192 + offb(row0 + 8u, ch) + 8u * (p4 & 1u)));
                        const bf16x8 va = __builtin_shufflevector(lo, hi, 0, 1, 2, 3, 4, 5, 6, 7);
                        O[cb] = __builtin_amdgcn_mfma_f32_32x32x16_bf16(va, pf, O[cb], 0, 0, 0);
                    }
                }
            if (kt + 1 < nkt) { LAS unsigned char* nb = KV + ((kt + 1) & 1) * 16384; *(LAS v4u*)(nb + loff0) = g0; *(LAS v4u*)(nb + loff1) = g1; }
            __syncthreads();
        }
        const float lt = l + __shfl_xor(l, 32), inv = 1.0f / lt;
#pragma unroll
        for (int cb = 0; cb < 4; ++cb)
#pragma unroll
            for (int g4 = 0; g4 < 4; ++g4) {
                v2u w; w.x = pk2(O[cb][4 * g4] * inv, O[cb][4 * g4 + 1] * inv); w.y = pk2(O[cb][4 * g4 + 2] * inv, O[cb][4 * g4 + 3] * inv);
                *(v2u*)(QL + trow * 1024 + head * 128 + 32 * cb + 8 * g4 + 4 * h) = w;
            }
    }
}

__device__ __forceinline__ void p6_ln1(Frame& F) {
    float* Y = F.a->out; bf16* X1B = (bf16*)(F.ws + WS_X1B); const float* g = F.a->in[I_LN1G]; const float* bb = F.a->in[I_LN1B];
    const int gw = blockIdx.x * NWAVES + F.wave, NGW = F.G * NWAVES, lane = F.lane;
    f32x4 gv[4], bv[4];
#pragma unroll
    for (int j = 0; j < 4; ++j) { gv[j] = ((const f32x4*)g)[lane + 64 * j]; bv[j] = ((const f32x4*)bb)[lane + 64 * j]; }
    for (int m = gw; m < T; m += NGW) {
        f32x4* yr = (f32x4*)(Y + (size_t)m * DM) + lane;
        f32x4 v[4]; float s = 0.f;
#pragma unroll
        for (int j = 0; j < 4; ++j) { v[j] = yr[64 * j]; s += (v[j].x + v[j].y) + (v[j].z + v[j].w); }
        const float mean = wave_sum(s) * (1.f / DM); float s2 = 0.f;
#pragma unroll
        for (int j = 0; j < 4; ++j) { v[j] = v[j] - mean; s2 += (v[j].x * v[j].x + v[j].y * v[j].y) + (v[j].z * v[j].z + v[j].w * v[j].w); }
        const float rstd = rsqrtf(wave_sum(s2) * (1.f / DM) + LN_EPS);
        v2u* o8 = (v2u*)(X1B + (size_t)m * DM) + lane;
#pragma unroll
        for (int j = 0; j < 4; ++j) { const f32x4 o = v[j] * rstd * gv[j] + bv[j]; yr[64 * j] = o; v2u w; w.x = pk2(o.x, o.y); w.y = pk2(o.z, o.w); o8[64 * j] = w; }
    }
}

#define TOP16_INSERT(tv, ti, val, id) do { \
    _Pragma("unroll") for (int _j = 15; _j >= 1; --_j) { const bool _up = (val) > tv[_j - 1]; const bool _here = (val) > tv[_j]; \
        tv[_j] = _up ? tv[_j - 1] : (_here ? (val) : tv[_j]); ti[_j] = _up ? ti[_j - 1] : (_here ? (id) : ti[_j]); } \
    { const bool _h0 = (val) > tv[0]; tv[0] = _h0 ? (val) : tv[0]; ti[0] = _h0 ? (id) : ti[0]; } } while (0)
__device__ __forceinline__ void p8_peer_route_simple(Frame& F) {
    const bf16* PQ = (const bf16*)(F.ws + WS_PQ); unsigned short* IDS = (unsigned short*)(F.ws + WS_IDS); float* GATES = (float*)(F.ws + WS_GATES);
    LAS float* K1 = (LAS float*)(F.lds); LAS float* K2 = (LAS float*)(F.lds + 65536);
    for (int e = F.tid; e < 16384; e += NTHREADS) { K1[e] = F.a->in[I_SK1][e]; K2[e] = F.a->in[I_SK2][e]; }
    __syncthreads();
    const size_t gtid = (size_t)blockIdx.x * NTHREADS + F.tid, gthreads = (size_t)F.G * NTHREADS;
    for (size_t item = gtid; item < (size_t)T * 8; item += gthreads) {
        const size_t t = item >> 3; const int h = (int)(item & 7);
        float v1[16], v2[16]; int i1[16], i2[16];
#pragma unroll
        for (int half = 0; half < 2; ++half) {
            const v4u* qp = (const v4u*)(PQ + t * 2048 + h * 256 + half * 128);
            v4u q[16];
#pragma unroll
            for (int c = 0; c < 16; ++c) q[c] = qp[c];
            float tv[16]; int ti[16];
#pragma unroll
            for (int j = 0; j < 16; ++j) { tv[j] = -INFINITY; ti[j] = 0; }
            const LAS float* KK = half ? K2 : K1;
#pragma unroll 1
            for (int n = 0; n < 128; ++n) {
                float d = 0.f;
#pragma unroll
                for (int c = 0; c < 16; ++c) { const f32x4 ka = *(const LAS f32x4*)(KK + n * 128 + c * 8), kb = *(const LAS f32x4*)(KK + n * 128 + c * 8 + 4);
                    d += ka.x * bflo(q[c].x) + ka.y * bfhi(q[c].x) + ka.z * bflo(q[c].y) + ka.w * bfhi(q[c].y) + kb.x * bflo(q[c].z) + kb.y * bfhi(q[c].z) + kb.z * bflo(q[c].w) + kb.w * bfhi(q[c].w);
                    if ((c & 3) == 3) __builtin_amdgcn_sched_barrier(0); }
                TOP16_INSERT(tv, ti, d, n);
            }
#pragma unroll
            for (int j = 0; j < 16; ++j) { if (half) { v2[j] = tv[j]; i2[j] = ti[j]; } else { v1[j] = tv[j]; i1[j] = ti[j]; } }
        }
        float tv[16]; int ti[16];
#pragma unroll
        for (int j = 0; j < 16; ++j) { tv[j] = -INFINITY; ti[j] = 0; }
#pragma unroll
        for (int a = 0; a < 16; ++a)
#pragma unroll
            for (int c = 0; c < 16; ++c)
                if ((a + 1) * (c + 1) <= 16) { const float val = v1[a] + v2[c]; const int id = i1[a] * 128 + i2[c]; TOP16_INSERT(tv, ti, val, id); }
        float ev[16], sum = 0.f;
#pragma unroll
        for (int j = 0; j < 16; ++j) { ev[j] = __expf(tv[j] - tv[0]); sum += ev[j]; }
        const float inv = 1.0f / sum;
#pragma unroll
        for (int j8 = 0; j8 < 2; ++j8) {
            v4u w; w.x = (unsigned)ti[j8 * 8] | ((unsigned)ti[j8 * 8 + 1] << 16); w.y = (unsigned)ti[j8 * 8 + 2] | ((unsigned)ti[j8 * 8 + 3] << 16);
            w.z = (unsigned)ti[j8 * 8 + 4] | ((unsigned)ti[j8 * 8 + 5] << 16); w.w = (unsigned)ti[j8 * 8 + 6] | ((unsigned)ti[j8 * 8 + 7] << 16);
            *(v4u*)(IDS + t * 128 + h * 16 + j8 * 8) = w;
        }
#pragma unroll
        for (int j4 = 0; j4 < 4; ++j4)
            *(f32x4*)(GATES + t * 128 + h * 16 + j4 * 4) = (f32x4){ev[j4 * 4] * inv, ev[j4 * 4 + 1] * inv, ev[j4 * 4 + 2] * inv, ev[j4 * 4 + 3] * inv};
    }
}

template <int CTRL> __device__ __forceinline__ float dppf(float x) { return __builtin_bit_cast(float, __builtin_amdgcn_mov_dpp(__builtin_bit_cast(int, x), CTRL, 0xf, 0xf, true)); }
constexpr int Q_CHUNK = 32;
__device__ __forceinline__ void p9_u_phase(Frame& F) {
    const unsigned char* UT8 = F.ws + WS_UT8; const bf16* X1B = (const bf16*)(F.ws + WS_X1B); const unsigned short* IDS = (const unsigned short*)(F.ws + WS_IDS);
    float* HP = (float*)(F.ws + WS_HP); unsigned* qh = (unsigned*)(F.ws + WS_CTL) + CW_QU;
    const int lane = F.lane, sub = lane & 7, g = lane >> 3;
    const unsigned xcc = xb_xcc_id() & 7u;
    for (int s = 0; s < 8; ++s) {
        const int j = (int)((xcc + (unsigned)s) & 7u);
        const unsigned char* tab = UT8 + (size_t)j * 16384 * 128 + sub * 16;
        for (;;) {
            unsigned base = 0u; if (lane == 0) base = xb_add(qh + 64 * j, (unsigned)Q_CHUNK);
            base = (unsigned)__builtin_amdgcn_readfirstlane((int)base);
            if (base >= (unsigned)T) break;
#pragma unroll 1
            for (int tt = 0; tt < Q_CHUNK; ++tt) {
                const size_t t = (size_t)base + tt;
                const v4u xa = *(const v4u*)(X1B + t * 1024 + j * 128 + sub * 16), xb = *(const v4u*)(X1B + t * 1024 + j * 128 + sub * 16 + 8);
                const float xf[16] = {bflo(xa.x), bfhi(xa.x), bflo(xa.y), bfhi(xa.y), bflo(xa.z), bfhi(xa.z), bflo(xa.w), bfhi(xa.w), bflo(xb.x), bfhi(xb.x), bflo(xb.y), bfhi(xb.y), bflo(xb.z), bfhi(xb.z), bflo(xb.w), bfhi(xb.w)};
                const v4u ia = *(const v4u*)(IDS + t * 128 + g * 16), ib = *(const v4u*)(IDS + t * 128 + g * 16 + 8);
                const unsigned idw[8] = {ia.x, ia.y, ia.z, ia.w, ib.x, ib.y, ib.z, ib.w};
                v4u q[16];
#pragma unroll
                for (int i = 0; i < 16; ++i) { const unsigned e = (idw[i >> 1] >> (16 * (i & 1))) & 0xffffu; q[i] = *(const v4u*)(tab + (size_t)e * 128); }
                float hs0 = 0.f, hs1 = 0.f;
#pragma unroll
                for (int i = 0; i < 16; ++i) {
                    const f32x2 a0 = __builtin_amdgcn_cvt_pk_f32_fp8((int)q[i].x, false), a1 = __builtin_amdgcn_cvt_pk_f32_fp8((int)q[i].x, true);
                    const f32x2 b0 = __builtin_amdgcn_cvt_pk_f32_fp8((int)q[i].y, false), b1 = __builtin_amdgcn_cvt_pk_f32_fp8((int)q[i].y, true);
                    const f32x2 c0 = __builtin_amdgcn_cvt_pk_f32_fp8((int)q[i].z, false), c1 = __builtin_amdgcn_cvt_pk_f32_fp8((int)q[i].z, true);
                    const f32x2 d0 = __builtin_amdgcn_cvt_pk_f32_fp8((int)q[i].w, false), d1 = __builtin_amdgcn_cvt_pk_f32_fp8((int)q[i].w, true);
                    float p = (a0.x * xf[0] + a0.y * xf[1]) + (a1.x * xf[2] + a1.y * xf[3]) + (b0.x * xf[4] + b0.y * xf[5]) + (b1.x * xf[6] + b1.y * xf[7])
                            + (c0.x * xf[8] + c0.y * xf[9]) + (c1.x * xf[10] + c1.y * xf[11]) + (d0.x * xf[12] + d0.y * xf[13]) + (d1.x * xf[14] + d1.y * xf[15]);
                    p += dppf<0xB1>(p); p += dppf<0x4E>(p); p += dppf<0x141>(p);
                    if (i < 8) hs0 = (sub == i) ? p : hs0; else hs1 = (sub == i - 8) ? p : hs1;
                }
                float* hp = HP + ((size_t)j * T + t) * 128 + g * 16 + sub;
                hp[0] = hs0; hp[8] = hs1;
            }
        }
    }
}
__device__ __forceinline__ void p10_finalize(Frame& F) {
    const unsigned short* IDS = (const unsigned short*)(F.ws + WS_IDS); float* W = (float*)(F.ws + WS_GATES); const float* HP = (const float*)(F.ws + WS_HP);
    const float* UINV = (const float*)(F.ws + WS_UINV); const float* VINV = (const float*)(F.ws + WS_VINV);
    const size_t gtid = (size_t)blockIdx.x * NTHREADS + F.tid, gthreads = (size_t)F.G * NTHREADS;
    for (size_t idx = gtid; idx < (size_t)T * 128; idx += gthreads) {
        const unsigned e = IDS[idx]; float h = 0.f;
#pragma unroll
        for (int j = 0; j < 8; ++j) h += HP[(size_t)j * T * 128 + idx];
        h *= UINV[e];
        const float gl = 0.5f * h * (1.0f + erff(h * 0.7071067811865476f));
        W[idx] = W[idx] * gl * VINV[e];
    }
}
__device__ __forceinline__ void p11_v_phase(Frame& F) {
    const unsigned char* VT8 = F.ws + WS_VT8; const unsigned short* IDS = (const unsigned short*)(F.ws + WS_IDS); const float* W = (const float*)(F.ws + WS_GATES);
    float* FFN = (float*)(F.ws + WS_FFN); unsigned* qh = (unsigned*)(F.ws + WS_CTL) + CW_QV;
    const int lane = F.lane, sub = lane & 7, g = lane >> 3;
    const unsigned xcc = xb_xcc_id() & 7u;
    for (int s = 0; s < 8; ++s) {
        const int j = (int)((xcc + (unsigned)s) & 7u);
        const unsigned char* tab = VT8 + (size_t)j * 16384 * 128 + sub * 16;
        for (;;) {
            unsigned base = 0u; if (lane == 0) base = xb_add(qh + 64 * j, (unsigned)Q_CHUNK);
            base = (unsigned)__builtin_amdgcn_readfirstlane((int)base);
            if (base >= (unsigned)T) break;
#pragma unroll 1
            for (int tt = 0; tt < Q_CHUNK; ++tt) {
                const size_t t = (size_t)base + tt;
                const v4u ia = *(const v4u*)(IDS + t * 128 + g * 16), ib = *(const v4u*)(IDS + t * 128 + g * 16 + 8);
                const unsigned idw[8] = {ia.x, ia.y, ia.z, ia.w, ib.x, ib.y, ib.z, ib.w};
                const f32x4 w0 = *(const f32x4*)(W + t * 128 + g * 16), w1 = *(const f32x4*)(W + t * 128 + g * 16 + 4), w2 = *(const f32x4*)(W + t * 128 + g * 16 + 8), w3 = *(const f32x4*)(W + t * 128 + g * 16 + 12);
                const float wv[16] = {w0.x, w0.y, w0.z, w0.w, w1.x, w1.y, w1.z, w1.w, w2.x, w2.y, w2.z, w2.w, w3.x, w3.y, w3.z, w3.w};
                v4u q[16];
#pragma unroll
                for (int i = 0; i < 16; ++i) { const unsigned e = (idw[i >> 1] >> (16 * (i & 1))) & 0xffffu; q[i] = *(const v4u*)(tab + (size_t)e * 128); }
                float acc[16];
#pragma unroll
                for (int c = 0; c < 16; ++c) acc[c] = 0.f;
#pragma unroll
                for (int i = 0; i < 16; ++i) {
                    const unsigned qq[4] = {q[i].x, q[i].y, q[i].z, q[i].w};
#pragma unroll
                    for (int c = 0; c < 4; ++c) { const f32x2 lo = __builtin_amdgcn_cvt_pk_f32_fp8((int)qq[c], false), hi = __builtin_amdgcn_cvt_pk_f32_fp8((int)qq[c], true);
                        acc[4 * c] += wv[i] * lo.x; acc[4 * c + 1] += wv[i] * lo.y; acc[4 * c + 2] += wv[i] * hi.x; acc[4 * c + 3] += wv[i] * hi.y; }
                }
#pragma unroll
                for (int c = 0; c < 16; ++c) { float a = acc[c]; a += dppf<0x128>(a); a += __shfl_xor(a, 16); a += __shfl_xor(a, 32); acc[c] = a; }
                if (g == 0) { float* fp = FFN + t * 1024 + j * 128 + sub * 16;
                    *(f32x4*)(fp) = (f32x4){acc[0], acc[1], acc[2], acc[3]}; *(f32x4*)(fp + 4) = (f32x4){acc[4], acc[5], acc[6], acc[7]};
                    *(f32x4*)(fp + 8) = (f32x4){acc[8], acc[9], acc[10], acc[11]}; *(f32x4*)(fp + 12) = (f32x4){acc[12], acc[13], acc[14], acc[15]}; }
            }
        }
    }
}
__device__ __forceinline__ void p12_ln2(Frame& F) {
    float* X1 = F.a->out; const float* FFN = (const float*)(F.ws + WS_FFN); const float* g = F.a->in[I_LN2G]; const float* bb = F.a->in[I_LN2B];
    const int gw = blockIdx.x * NWAVES + F.wave, NGW = F.G * NWAVES, lane = F.lane;
    f32x4 gv[4], bv[4];
#pragma unroll
    for (int j = 0; j < 4; ++j) { gv[j] = ((const f32x4*)g)[lane + 64 * j]; bv[j] = ((const f32x4*)bb)[lane + 64 * j]; }
    for (int m = gw; m < T; m += NGW) {
        f32x4* xr = (f32x4*)(X1 + (size_t)m * DM) + lane; const f32x4* fr = (const f32x4*)(FFN + (size_t)m * DM) + lane;
        f32x4 v[4]; float s = 0.f;
#pragma unroll
        for (int j = 0; j < 4; ++j) { v[j] = xr[64 * j] * ALPHA + fr[64 * j]; s += (v[j].x + v[j].y) + (v[j].z + v[j].w); }
        const float mean = wave_sum(s) * (1.f / DM); float s2 = 0.f;
#pragma unroll
        for (int j = 0; j < 4; ++j) { v[j] = v[j] - mean; s2 += (v[j].x * v[j].x + v[j].y * v[j].y) + (v[j].z * v[j].z + v[j].w * v[j].w); }
        const float rstd = rsqrtf(wave_sum(s2) * (1.f / DM) + LN_EPS);
#pragma unroll
        for (int j = 0; j < 4; ++j) xr[64 * j] = v[j] * rstd * gv[j] + bv[j];
    }
}

__global__ void __launch_bounds__(NTHREADS, 2) hybrid_fwd(Args args) {
    extern __shared__ __attribute__((aligned(16))) unsigned char lds[];
    Frame F;
    F.lds = (LAS unsigned char*)lds;
    F.tid = threadIdx.x; F.lane = F.tid & 63; F.wave = __builtin_amdgcn_readfirstlane(F.tid >> 6);
    F.G = gridDim.x; F.a = (KArgs)__builtin_amdgcn_kernarg_segment_ptr(); F.ws = args.ws;
#define FRESH() do { int _t = threadIdx.x; asm volatile("" : "+v"(_t)); F.tid = _t; F.lane = _t & 63; F.wave = __builtin_amdgcn_readfirstlane(_t >> 6); \
        KArgs _k = (KArgs)__builtin_amdgcn_kernarg_segment_ptr(); asm volatile("" : "+s"(_k)); F.a = _k; F.ws = _k->ws; } while (0)
    volatile LAS unsigned* MISC = (volatile LAS unsigned*)(F.lds + MISC_OFF);
    for (int u = F.tid; u < (LDS_BYTES - LDSCTL_OFF) / 4; u += NTHREADS) ((LAS unsigned*)(F.lds + LDSCTL_OFF))[u] = 0u;
    __syncthreads();
    const int lo = args.ph_lo, hi = args.ph_hi;
    const bool need_bar = (hi - lo) > 1;
    XcdBarrier bar; bar.bar = (unsigned*)(args.ws + WS_CTL) + CW_BAR + args.li * XCD_BAR_WORDS; bar.x = 0; bar.st = nullptr;
    if (need_bar) bar = xcd_barrier_post(bar.bar, MISC + 8);
#if defined(PHASE_MASK)
#define IN(k) (((PHASE_MASK >> (k)) & 1) && lo <= (k) && (k) < hi)
#elif defined(ONLY_PHASE)
#define IN(k) ((k) == ONLY_PHASE && lo <= (k) && (k) < hi)
#else
#define IN(k) (lo <= (k) && (k) < hi)
#endif
#define SEAM(k) do { if (IN(k) && IN((k) + 1)) xcd_barrier(bar); } while (0)
    LAS unsigned char* ring = F.lds;

    if (IN(0)) { FRESH(); p0_prologue(F); }
    SEAM(0);
    if (IN(1)) {
        FRESH();
        pg8::Gemm g{(const bf16*)(F.ws + WS_XB), (const bf16*)(F.ws + WS_WIN), T, NPROJ, 1024}; pg8::StaticOrder S; S.init(T, NPROJ, F.G, (int)blockIdx.x);
        EpiProj E{F.ws};
        pg8::gemm_phase<EpiProj, pg8::StaticOrder>(ring, g, S, E, F.tid);
    }
    SEAM(1);
    if (IN(2)) {
        FRESH();
#if !defined(P2SEL) || (P2SEL & 1)
        p2_ckv_norm(F);
#endif
#if !defined(P2SEL) || (P2SEL & 2)
#if defined(HGRN_DEBUG)
        p2_hgrn_chunked(F, (bf16*)(F.ws + WS_END), 16);
        __syncthreads();
        FRESH();
        p2_hgrn_simple(F);
        VM_WAIT(); __syncthreads();
        FRESH();
        {
            unsigned* ctl = (unsigned*)(F.ws + WS_CTL);
            const bf16* A_ = (const bf16*)(F.ws + WS_END); const bf16* B_ = (const bf16*)(F.ws + WS_IB);
            float mx = 0.f; unsigned nn = 0;
            for (int item = blockIdx.x; item < NB * 4; item += F.G) { const int b = item >> 2, h = item & 3; if (b >= 16) continue;
                for (int e = F.tid; e < SEQ * 128; e += NTHREADS) { const size_t o = ((size_t)b * SEQ + (e >> 7)) * 512 + h * 128 + (e & 127);
                    const float x = bf2f(A_[o]), y = bf2f(B_[o]); if (x != x) ++nn; const float df = fabsf(x - y); if (df == df) mx = fmaxf(mx, df); } }
            mx = wave_max(mx); nn = (unsigned)wave_sum((float)nn);
            if (F.lane == 0) { atomicMax(ctl + 2048, __float_as_uint(mx)); atomicAdd(ctl + 2112, nn); }
        }
#elif defined(HGRN_SIMPLE)
        p2_hgrn_simple(F);
#else
        p2_hgrn_chunked(F, (bf16*)(F.ws + WS_IB), NB);
#endif
#endif
        __syncthreads();
        FRESH();
#if !defined(P2SEL) || (P2SEL & 4)
        p2_indexer_simple(F);
#endif
    }
    SEAM(2);
    if (IN(3)) { FRESH(); p3_hg_finalize(F); __syncthreads(); FRESH();
#ifdef ATTN_SIMPLE
        p3_attn_simple(F);
#else
        p3_attn_mfma(F);
#endif
    }
    SEAM(3);
    if (IN(4)) {
        FRESH();
        { pg8::Gemm g{(const bf16*)(F.ws + WS_QL), (const bf16*)(F.ws + WS_WA), T, 1024, 1024}; pg8::StaticOrder S; S.init(T, 1024, F.G, (int)blockIdx.x);
          EpiBranch<0> E{(const bf16*)(F.ws + WS_GA), (bf16*)(F.ws + WS_MERGED)};
          pg8::gemm_phase<EpiBranch<0>, pg8::StaticOrder>(ring, g, S, E, F.tid); }
        FRESH();
        { pg8::Gemm g{(const bf16*)(F.ws + WS_IB), (const bf16*)(F.ws + WS_WB), T, 1024, 512}; pg8::StaticOrder S; S.init(T, 1024, F.G, (int)blockIdx.x);
          EpiBranch<1> E{(const bf16*)(F.ws + WS_GBT), (bf16*)(F.ws + WS_MERGED)};
          pg8::gemm_phase<EpiBranch<1>, pg8::StaticOrder>(ring, g, S, E, F.tid); }
    }
    SEAM(4);
    if (IN(5)) {
        FRESH();
        pg8::Gemm g{(const bf16*)(F.ws + WS_MERGED), (const bf16*)(F.ws + WS_WO), T, 1024, 1024}; pg8::StaticOrder S; S.init(T, 1024, F.G, (int)blockIdx.x);
        EpiResF32 E{F.a->in[I_X], F.a->out};
        pg8::gemm_phase<EpiResF32, pg8::StaticOrder>(ring, g, S, E, F.tid);
    }
    SEAM(5);
    if (IN(6)) { FRESH(); p6_ln1(F); }
    SEAM(6);
    if (IN(7)) {
        FRESH();
        pg8::Gemm g{(const bf16*)(F.ws + WS_X1B), (const bf16*)(F.ws + WS_WPQ), T, 2048, 1024}; pg8::StaticOrder S; S.init(T, 2048, F.G, (int)blockIdx.x);
        EpiPlainBf16 E{(bf16*)(F.ws + WS_PQ), 2048};
        pg8::gemm_phase<EpiPlainBf16, pg8::StaticOrder>(ring, g, S, E, F.tid);
    }
    SEAM(7);
    if (IN(8)) { FRESH(); p8_peer_route_simple(F); }
    SEAM(8);
    if (IN(9)) { FRESH(); p9_u_phase(F); }
    SEAM(9);
    if (IN(10)) { FRESH(); p10_finalize(F); }
    SEAM(10);
    if (IN(11)) { FRESH(); p11_v_phase(F); }
    SEAM(11);
    if (IN(12)) { FRESH(); p12_ln2(F); }
#undef IN
#undef SEAM
}

extern "C" void kernel_launch(void* const* d_in, const int* in_sizes, int n_in, void* d_out, int out_size, void* d_ws, size_t ws_size, hipStream_t stream) {
    static int grid = 0;
    if (grid == 0) {
        if (n_in != 20 || out_size != T * DM || ws_size < WS_END) { fprintf(stderr, "kernel_launch: unexpected problem (n_in %d out %d ws %zu)\n", n_in, out_size, ws_size); grid = -1; return; }
        int dev = 0, cus = 0;
        if (hipGetDevice(&dev) != hipSuccess || hipDeviceGetAttribute(&cus, hipDeviceAttributeMultiprocessorCount, dev) != hipSuccess) { grid = -1; return; }
        if (hipFuncSetAttribute((const void*)hybrid_fwd, hipFuncAttributeMaxDynamicSharedMemorySize, LDS_BYTES) != hipSuccess) { fprintf(stderr, "kernel_launch: hipFuncSetAttribute failed\n"); grid = -1; return; }
        int per_cu = 0;
        if (hipOccupancyMaxActiveBlocksPerMultiprocessor(&per_cu, (const void*)hybrid_fwd, NTHREADS, LDS_BYTES) != hipSuccess || per_cu < 1) fprintf(stderr, "kernel_launch: occupancy query reports %d\n", per_cu);
        (void)hipGetLastError();
        grid = cus;
    }
    if (grid < 0) return;
    (void)hipMemsetAsync((char*)d_ws + WS_CTL, 0, CTL_ZERO_BYTES, stream);
    Args a{};
    for (int i = 0; i < 20; ++i) a.in[i] = (const float*)d_in[i];
    a.out = (float*)d_out; a.ws = (unsigned char*)d_ws;
    constexpr int NL = MK_N_LAUNCHES;
    for (int li = 0; li < NL; ++li) {
        a.ph_lo = (NL == 1) ? 0 : li; a.ph_hi = (NL == 1) ? N_PHASES : li + 1; a.li = li;
        hipLaunchKernelGGL(hybrid_fwd, dim3(grid), dim3(NTHREADS), LDS_BYTES, stream, a);
    }
}
```

```cpp
#include <hip/hip_runtime.h>
#include <cstdio>
#include <cstdint>

#ifndef MK_N_LAUNCHES
#define MK_N_LAUNCHES 1
#endif

namespace pg8 {
#define PG8_LAS __attribute__((address_space(3)))
typedef unsigned short bf16_t;
typedef short bf16x8 __attribute__((ext_vector_type(8)));
typedef float f32x4 __attribute__((ext_vector_type(4)));
typedef unsigned u32x4 __attribute__((ext_vector_type(4)));
constexpr int BM = 256, BK = 64, HALF = 128, HTB = HALF * BK * 2, STAGE_BYTES = 8 * HTB, NXCD = 8, WGM = 8;

__host__ __device__ __forceinline__ int lds_byte(int r, int c) { const int st = (r >> 4) * 2 + (c >> 5), rr = r & 15, cc = c & 31, ob = rr * 64 + cc * 2; return st * 1024 + (ob ^ (((ob >> 9) & 1) << 5)); }
__host__ __device__ __forceinline__ void stage_rc(int b, int& R, int& C) { const int st = b / 1024, sb = b % 1024, swz = sb ^ (((sb >> 9) & 1) << 5); R = (st >> 1) * 16 + swz / 64; C = (st & 1) * 32 + (swz % 64) / 2; }
__host__ __device__ __forceinline__ int perm32(int rho) { const int n = rho >> 4, i = rho & 15; return 8 * (i >> 2) + 4 * n + (i & 3); }

struct Unit { int pm, pn; };
struct Gemm { const bf16_t* A; const bf16_t* Bt; int M, N, K; };

struct StaticOrder {
    int nM, nN, nwg, G, c;
    __host__ __device__ void init(int M, int N, int G_, int c_) { nM = M / BM; nN = N / BM; nwg = nM * nN; G = G_; c = c_; }
    __host__ __device__ bool next(int i, Unit& u) const {
        const long L = (long)i * G + c; if (L >= nwg) return false;
        int wgid = (int)L; { const int q = nwg / NXCD, r = nwg % NXCD, xcd = wgid % NXCD, off = wgid / NXCD; wgid = (xcd < r ? xcd * (q + 1) : r * (q + 1) + (xcd - r) * q) + off; }
        const int nig = WGM * nN, gid = wgid / nig, fm = gid * WGM, gsz = (nM - fm) < WGM ? (nM - fm) : WGM;
        u.pm = fm + ((wgid % nig) % gsz); u.pn = (wgid % nig) / gsz; return true;
    }
    __device__ __forceinline__ void a_ready(const Unit&) const {}
    __device__ __forceinline__ void done(const Unit&) const {}
};

__device__ __forceinline__ unsigned cvt_pk_bf16(float lo, float hi) { unsigned r; asm volatile("v_cvt_pk_bf16_f32 %0, %1, %2" : "=v"(r) : "v"(lo), "v"(hi)); return r; }

template <class Epi, class Sched>
__device__ __forceinline__ void gemm_phase(PG8_LAS unsigned char* lds, const Gemm g, const Sched& S, const Epi& E, const int tid) {
    const int wid = __builtin_amdgcn_readfirstlane(tid >> 6), lane = tid & 63, wr = wid >> 2, wc = wid & 3, fr = lane & 15, fq = lane >> 4;
    const int K = g.K, nt = K / BK;
    unsigned voffA[2], voffB[2];
#pragma unroll
    for (int i = 0; i < 2; ++i) { int R, C; stage_rc(tid * 16 + i * 8192, R, C); const int Rb = Epi::PERM ? ((R & ~31) + perm32(R & 31)) : R;
        voffA[i] = (unsigned)(R * K + C) * 2u; voffB[i] = (unsigned)(Rb * K + C) * 2u; }
    const size_t kstep = (size_t)(BK * 2);
    const size_t hstep = (size_t)HALF * K * 2;
    const size_t tstep = 2 * hstep;
    const unsigned ldsw = (unsigned)wid * 1024u;
    const int aoff = lds_byte(wr * 64 + fr, fq * 8), boff = lds_byte(wc * 32 + fr, fq * 8);
#define PG8_SA(b, h) (((b) * 2 + (h)) * HTB)
#define PG8_SB(b, h) ((4 + (b) * 2 + (h)) * HTB)
#define PG8_STAGE(bufoff, gbase, voff) do { _Pragma("unroll") for (int _i = 0; _i < 2; ++_i) \
        __builtin_amdgcn_global_load_lds((const unsigned*)((const char*)(gbase) + (voff)[_i]), (PG8_LAS unsigned*)(lds + (bufoff) + ldsw + _i * 8192), 16, 0, 0); } while (0)
#define PG8_LDA(dst, b, h) do { _Pragma("unroll") for (int m = 0; m < 4; ++m) _Pragma("unroll") for (int k = 0; k < 2; ++k) dst[m][k] = *(const PG8_LAS bf16x8*)(lds + PG8_SA(b, h) + aoff + m * 2048 + k * 1024); } while (0)
#define PG8_LDB(dst, b, h) do { _Pragma("unroll") for (int n = 0; n < 2; ++n) _Pragma("unroll") for (int k = 0; k < 2; ++k) dst[n][k] = *(const PG8_LAS bf16x8*)(lds + PG8_SB(b, h) + boff + n * 2048 + k * 1024); } while (0)
#define PG8_MMA(ai, bj, At, Bt) do { __builtin_amdgcn_s_setprio(1); _Pragma("unroll") for (int m = 0; m < 4; ++m) _Pragma("unroll") for (int n = 0; n < 2; ++n) _Pragma("unroll") for (int k = 0; k < 2; ++k) \
        acc[ai][bj][m][n] = __builtin_amdgcn_mfma_f32_16x16x32_bf16(Bt[n][k], At[m][k], acc[ai][bj][m][n], 0, 0, 0); __builtin_amdgcn_s_setprio(0); } while (0)
#define PG8_WAIT_V(n) asm volatile("s_waitcnt vmcnt(" #n ")" ::: "memory")
#define PG8_WAIT_L(n) asm volatile("s_waitcnt lgkmcnt(" #n ")" ::: "memory")
#define PG8_BAR __builtin_amdgcn_s_barrier()
#define PG8_SCHED __builtin_amdgcn_sched_barrier(0)
    Unit cur, nxt; int ui = 0;
    if (!S.next(0, cur)) return;
    f32x4 acc[2][2][4][2];
#pragma unroll
    for (int a = 0; a < 2; ++a)
#pragma unroll
        for (int b = 0; b < 2; ++b)
#pragma unroll
            for (int m = 0; m < 4; ++m)
#pragma unroll
                for (int n = 0; n < 2; ++n) acc[a][b][m][n] = (f32x4){0.f, 0.f, 0.f, 0.f};
    bf16x8 At[4][2], B0[2][2], B1[2][2];
    const char* cA = (const char*)g.A + (size_t)cur.pm * tstep; const char* cB = (const char*)g.Bt + (size_t)cur.pn * tstep;
    S.a_ready(cur);
    PG8_STAGE(PG8_SB(0, 0), cB, voffB); PG8_STAGE(PG8_SA(0, 0), cA, voffA); PG8_STAGE(PG8_SB(0, 1), cB + hstep, voffB); PG8_STAGE(PG8_SA(0, 1), cA + hstep, voffA);
    if (wr == 1) PG8_BAR;
    PG8_WAIT_V(4); PG8_BAR;
    PG8_STAGE(PG8_SB(1, 0), cB + kstep, voffB); PG8_STAGE(PG8_SA(1, 0), cA + kstep, voffA); PG8_STAGE(PG8_SB(1, 1), cB + hstep + kstep, voffB);
    PG8_WAIT_V(6); PG8_BAR;
    for (;;) {
        const bool has_next = S.next(ui + 1, nxt);
        const char* nA = has_next ? (const char*)g.A + (size_t)nxt.pm * tstep : cA; const char* nB = has_next ? (const char*)g.Bt + (size_t)nxt.pn * tstep : cB;
        for (int t = 0; t < nt; t += 2) {
            const bool last = (t == nt - 2);
            const char* a1 = cA + (size_t)(t + 1) * kstep;
            const char* a2 = last ? nA : cA + (size_t)(t + 2) * kstep; const char* b2 = last ? nB : cB + (size_t)(t + 2) * kstep;
            const char* a3 = a2 + kstep; const char* b3 = b2 + kstep;
            if (last && has_next) S.a_ready(nxt);
            PG8_LDB(B0, 0, 0); PG8_SCHED; PG8_LDA(At, 0, 0); PG8_STAGE(PG8_SA(1, 1), a1 + hstep, voffA);
            PG8_WAIT_L(8); PG8_BAR; PG8_WAIT_L(0); PG8_MMA(0, 0, At, B0); PG8_BAR; PG8_SCHED;
            PG8_LDB(B1, 0, 1); PG8_STAGE(PG8_SB(0, 0), b2, voffB);
            PG8_BAR; PG8_WAIT_L(0); PG8_MMA(0, 1, At, B1); PG8_BAR;
            PG8_LDA(At, 0, 1); PG8_STAGE(PG8_SA(0, 0), a2, voffA);
            PG8_BAR; PG8_WAIT_L(0); PG8_MMA(1, 0, At, B0); PG8_BAR; PG8_SCHED;
            PG8_STAGE(PG8_SB(0, 1), b2 + hstep, voffB);
            PG8_WAIT_V(6); PG8_BAR; PG8_MMA(1, 1, At, B1); PG8_BAR;
            PG8_LDB(B0, 1, 0); PG8_SCHED; PG8_LDA(At, 1, 0); PG8_STAGE(PG8_SA(0, 1), a2 + hstep, voffA);
            PG8_WAIT_L(8); PG8_BAR; PG8_WAIT_L(0); PG8_MMA(0, 0, At, B0); PG8_BAR; PG8_SCHED;
            PG8_LDB(B1, 1, 1); PG8_STAGE(PG8_SB(1, 0), b3, voffB);
            PG8_BAR; PG8_WAIT_L(0); PG8_MMA(0, 1, At, B1); PG8_BAR;
            PG8_LDA(At, 1, 1); PG8_STAGE(PG8_SA(1, 0), a3, voffA);
            PG8_BAR; PG8_WAIT_L(0); PG8_MMA(1, 0, At, B0); PG8_BAR; PG8_SCHED;
            PG8_STAGE(PG8_SB(1, 1), b3 + hstep, voffB);
            PG8_WAIT_V(6); PG8_BAR; PG8_MMA(1, 1, At, B1); PG8_BAR;
        }
        E(acc, cur, wr, wc, fr, fq); S.done(cur);
        if (!has_next) break;
#pragma unroll
        for (int a = 0; a < 2; ++a)
#pragma unroll
            for (int b = 0; b < 2; ++b)
#pragma unroll
                for (int m = 0; m < 4; ++m)
#pragma unroll
                    for (int n = 0; n < 2; ++n) acc[a][b][m][n] = (f32x4){0.f, 0.f, 0.f, 0.f};
        cur = nxt; cA = nA; cB = nB; ++ui;
    }
    PG8_WAIT_V(0);
    if (wr == 0) PG8_BAR;
    PG8_BAR;
#undef PG8_SA
#undef PG8_SB
#undef PG8_STAGE
#undef PG8_LDA
#undef PG8_LDB
#undef PG8_MMA
#undef PG8_WAIT_V
#undef PG8_WAIT_L
#undef PG8_BAR
#undef PG8_SCHED
}
}

constexpr int NWAVES = 8, NTHREADS = 512;
constexpr int NB = 32, SEQ = 2048, DM = 1024, T = NB * SEQ;
constexpr int IN_COLS = 5320, NPROJ = 5888;
constexpr int N_PHASES = 13;
constexpr float ALPHA = 1.189207115002721f;
constexpr float LN_EPS = 1e-5f, RMS_EPS = 1e-6f;

constexpr size_t MiB = 1u << 20;
constexpr size_t WS_CTL = 0, CTL_ZERO_BYTES = 1 * MiB;
constexpr size_t WS_WIN = 1 * MiB, WS_WA = 13 * MiB, WS_WB = 15 * MiB, WS_WO = 16 * MiB, WS_WPQ = 18 * MiB;
constexpr size_t WS_UT8 = 24 * MiB, WS_VT8 = 40 * MiB, WS_UINV = 56 * MiB, WS_VINV = 56 * MiB + 65536;
constexpr size_t WS_XB = 88 * MiB;
constexpr size_t WS_QL = 216 * MiB;
constexpr size_t WS_MISC = 344 * MiB;
constexpr size_t WS_CKV = 376 * MiB;
constexpr size_t WS_QI = 392 * MiB, WS_QB = 456 * MiB, WS_FB = 520 * MiB, WS_IB = 584 * MiB, WS_GB = 648 * MiB;
constexpr size_t WS_GA = 712 * MiB, WS_GBT = 840 * MiB;
constexpr size_t WS_BM = 968 * MiB;
constexpr size_t WS_END = 984 * MiB;
constexpr size_t WS_MERGED = WS_XB, WS_X1B = WS_QL, WS_PQ = WS_QI, WS_IDS = WS_GB, WS_GATES = WS_GB + 32 * MiB, WS_HP = WS_GA, WS_FFN = WS_XB;
constexpr int CW_QU = 8192, CW_QV = 8192 + 512;
constexpr int CW_BAR = 4096;

constexpr int RING_BYTES = 131072;
constexpr int LDSCTL_OFF = RING_BYTES, MISC_OFF = LDSCTL_OFF + 320;
constexpr int LDS_BYTES = 147456;

#define GAS __attribute__((address_space(1)))
#define LAS __attribute__((address_space(3)))
typedef unsigned short bf16;
typedef unsigned v4u __attribute__((ext_vector_type(4)));
typedef unsigned v2u __attribute__((ext_vector_type(2)));
typedef float f32x4 __attribute__((ext_vector_type(4)));
typedef float f32x2 __attribute__((ext_vector_type(2)));
typedef GAS unsigned gu32;
#define RLX_AGENT __ATOMIC_RELAXED, __HIP_MEMORY_SCOPE_AGENT
#define LDS_WAIT() asm volatile("s_waitcnt lgkmcnt(0)" ::: "memory")
#define VM_WAIT() asm volatile("s_waitcnt vmcnt(0)" ::: "memory")
typedef __bf16 bf16x2_t __attribute__((ext_vector_type(2)));
__device__ __forceinline__ unsigned pk2(float lo, float hi) { const bf16x2_t v = {(__bf16)lo, (__bf16)hi}; return __builtin_bit_cast(unsigned, v); }
__device__ __forceinline__ float bflo(unsigned u) { return __uint_as_float(u << 16); }
__device__ __forceinline__ float bfhi(unsigned u) { return __uint_as_float(u & 0xffff0000u); }
__device__ __forceinline__ float bf2f(bf16 b) { return __uint_as_float(((unsigned)b) << 16); }
__device__ __forceinline__ float sigmoidf_(float x) { return 1.0f / (1.0f + __expf(-x)); }

#define XB_TMO      128
#define XB_XCNT(j)  (256  + 64 * (j))
#define XB_XSUB(j)  (1280 + 64 * (j))
#define XB_XGEN(j)  (2304 + 64 * (j))
#define XB_TOP      3328
#define XB_TOPGEN   3392
#define XCD_BAR_WORDS 3456
#define XB_SPIN_CAP (1u << 22)
__device__ __forceinline__ unsigned xb_ld(unsigned* p)              { return __hip_atomic_load(p, __ATOMIC_RELAXED, __HIP_MEMORY_SCOPE_AGENT); }
__device__ __forceinline__ unsigned xb_add(unsigned* p, unsigned v) { return __hip_atomic_fetch_add(p, v, __ATOMIC_RELAXED, __HIP_MEMORY_SCOPE_AGENT); }
__device__ __forceinline__ unsigned xb_xcc_id() { return (unsigned)__builtin_amdgcn_s_getreg((3 << 11) | 20) & 0xFu; }
#define XB_SPIN(cond, bar) do { unsigned _sp = 0; while (cond) { __builtin_amdgcn_s_sleep(1); \
    if ((++_sp & 255u) == 0u) { if (xb_ld(&(bar)[XB_TMO])) break; if (_sp > XB_SPIN_CAP) { atomicAdd(&(bar)[XB_TMO], 1u); break; } } } } while (0)
struct XcdBarrier { unsigned* bar; unsigned x; volatile LAS unsigned* st; };
__device__ __forceinline__ XcdBarrier xcd_barrier_post(unsigned* bar, volatile LAS unsigned* st) {
    XcdBarrier b; b.bar = bar; b.x = xb_xcc_id(); b.st = st;
    if (threadIdx.x == 0) (void)xb_add(&bar[XB_XCNT(b.x)], 1u);
    return b;
}
__device__ __forceinline__ void xcd_barrier_complete(unsigned* bar, unsigned x, unsigned& nloc, unsigned& nx) {
    const unsigned G = gridDim.x * gridDim.y * gridDim.z;
    unsigned sum, cnt, mine, sp = 0u;
    for (;;) {
        sum = 0u; cnt = 0u; mine = 0u;
#pragma unroll
        for (unsigned j = 0; j < 16; ++j) { const unsigned c = xb_ld(&bar[XB_XCNT(j)]); sum += c; cnt += (c > 0u) ? 1u : 0u; mine = (j == x) ? c : mine; }
        if (sum == G) break;
        __builtin_amdgcn_s_sleep(1);
        if ((++sp & 255u) == 0u) { if (xb_ld(&bar[XB_TMO])) break; if (sp > XB_SPIN_CAP) { atomicAdd(&bar[XB_TMO], 1u); break; } }
    }
    nloc = mine > 0u ? mine : 1u; nx = cnt > 0u ? cnt : 1u;
}
__device__ __forceinline__ void xcd_barrier(const XcdBarrier& b) {
    asm volatile("s_waitcnt vmcnt(0)" ::: "memory");
    __syncthreads();
    if (threadIdx.x == 0) {
        unsigned* bar = b.bar;
        __builtin_amdgcn_s_waitcnt(0);
        unsigned nloc = b.st[0], nx = b.st[1];
        if (nloc == 0u) { xcd_barrier_complete(bar, b.x, nloc, nx); b.st[0] = nloc; b.st[1] = nx; }
        const unsigned old = xb_add(&bar[XB_XSUB(b.x)], 1u);
        const unsigned gen = old / nloc;
        if (old + 1u == (gen + 1u) * nloc) {
            __builtin_amdgcn_fence(__ATOMIC_RELEASE, "agent");
            asm volatile("s_waitcnt vmcnt(0)" ::: "memory");
            const unsigned og = xb_add(&bar[XB_TOP], 1u);
            const unsigned tg = og / nx;
            if (og + 1u == (tg + 1u) * nx) xb_add(&bar[XB_TOPGEN], 1u);
            else XB_SPIN(xb_ld(&bar[XB_TOPGEN]) == tg, bar);
            __builtin_amdgcn_fence(__ATOMIC_ACQUIRE, "agent");
            xb_add(&bar[XB_XGEN(b.x)], 1u);
            asm volatile("s_waitcnt vmcnt(0)" ::: "memory");
        } else {
            XB_SPIN(xb_ld(&bar[XB_XGEN(b.x)]) == gen, bar);
            __builtin_amdgcn_fence(__ATOMIC_ACQUIRE, "agent");
            asm volatile("s_waitcnt vmcnt(0)" ::: "memory");
        }
    }
    __syncthreads();
}

struct Args { const float* in[20]; float* out; unsigned char* ws; int ph_lo, ph_hi, li, pad; };
enum { I_X = 0, I_WIN, I_KVG, I_WUK, I_WUV, I_RELB, I_LBP, I_BNG, I_WBRA, I_WBRB, I_WO, I_LN1G, I_LN1B, I_WPQ, I_SK1, I_SK2, I_UT, I_VT, I_LN2G, I_LN2B };

typedef const __attribute__((address_space(4))) Args* KArgs;
struct Frame {
    LAS unsigned char* lds;
    int tid, lane, wave, G;
    KArgs a;
    unsigned char* ws;
};

__device__ __forceinline__ float wave_sum(float v) {
#pragma unroll
    for (int o = 1; o < 64; o <<= 1) v += __shfl_xor(v, o);
    return v;
}
__device__ __forceinline__ float wave_max(float v) {
#pragma unroll
    for (int o = 1; o < 64; o <<= 1) v = fmaxf(v, __shfl_xor(v, o));
    return v;
}

__device__ __forceinline__ void cvt_bf16_stream(const float* src, bf16* dst, size_t n8, size_t gtid, size_t gthreads) {
    for (size_t i = gtid; i < n8; i += gthreads) {
        const f32x4 a = ((const f32x4*)src)[2 * i], b = ((const f32x4*)src)[2 * i + 1];
        v4u o; o.x = pk2(a.x, a.y); o.y = pk2(a.z, a.w); o.z = pk2(b.x, b.y); o.w = pk2(b.z, b.w);
        ((v4u*)dst)[i] = o;
    }
}
__device__ __forceinline__ void transpose_item(const float* W, int ldw, int K, int c0, int nvalid, bf16* WT, int r0, int k0, LAS float* scr, int lane) {
#pragma unroll 8
    for (int i = 0; i < 32; ++i) { const int kk = 2 * i + (lane >> 5), n = lane & 31; scr[kk * 33 + n] = (n < nvalid) ? W[(size_t)(k0 + kk) * ldw + c0 + n] : 0.f; }
    LDS_WAIT(); asm volatile("" ::: "memory");
    const int c = lane & 7;
#pragma unroll
    for (int j = 0; j < 4; ++j) { const int n = (lane >> 3) + 8 * j; const LAS float* s = scr + (8 * c) * 33 + n;
        v4u o; o.x = pk2(s[0 * 33], s[1 * 33]); o.y = pk2(s[2 * 33], s[3 * 33]); o.z = pk2(s[4 * 33], s[5 * 33]); o.w = pk2(s[6 * 33], s[7 * 33]);
        *(v4u*)(WT + (size_t)(r0 + n) * K + k0 + 8 * c) = o; }
    LDS_WAIT(); asm volatile("" ::: "memory");
}
__device__ __forceinline__ void win_block(int cb, int& c0, int& r0, int& nv) {
    nv = 32;
    if (cb < 4)        { c0 = 512 + 32 * cb;          r0 = 1024 + 32 * cb; }
    else if (cb < 6)   { c0 = 1152 + 32 * (cb - 4);   r0 = 1152 + 32 * (cb - 4); }
    else if (cb == 6)  { c0 = 1216;                   r0 = 1216; nv = 8; }
    else if (cb == 7)  { c0 = 0;                      r0 = 1248; nv = 0; }
    else if (cb < 24)  { c0 = 640 + 32 * (cb - 8);    r0 = 1280 + 32 * (cb - 8); }
    else if (cb < 40)  { c0 = 1224 + 32 * (cb - 24);  r0 = 1792 + 32 * (cb - 24); }
    else if (cb < 56)  { c0 = 1736 + 32 * (cb - 40);  r0 = 2304 + 32 * (cb - 40); }
    else if (cb < 72)  { c0 = 2248 + 32 * (cb - 56);  r0 = 2816 + 32 * (cb - 56); }
    else if (cb < 88)  { c0 = 2760 + 32 * (cb - 72);  r0 = 3328 + 32 * (cb - 72); }
    else if (cb < 120) { c0 = 3272 + 32 * (cb - 88);  r0 = 3840 + 32 * (cb - 88); }
    else               { c0 = 4296 + 32 * (cb - 120); r0 = 4864 + 32 * (cb - 120); }
}
__device__ __forceinline__ void p0_prologue(Frame& F) {
    KArgs const Ap = F.a;
    const size_t gtid = (size_t)blockIdx.x * NTHREADS + F.tid, gthreads = (size_t)F.G * NTHREADS;
    cvt_bf16_stream(Ap->in[I_X], (bf16*)(F.ws + WS_XB), (size_t)T * DM / 8, gtid, gthreads);
    {
        const int gw0 = blockIdx.x * NWAVES + F.wave, NGW0 = F.G * NWAVES;
        for (int r = gw0; r < 2 * 16384; r += NGW0) {
            const int tb = r >> 14, e = r & 16383;
            const float* src = (tb ? Ap->in[I_VT] : Ap->in[I_UT]) + (size_t)e * DM;
            unsigned char* dst = F.ws + (tb ? WS_VT8 : WS_UT8); float* inv = (float*)(F.ws + (tb ? WS_VINV : WS_UINV));
            f32x4 v[4]; float am = 0.f;
#pragma unroll
            for (int j = 0; j < 4; ++j) { v[j] = ((const f32x4*)src)[F.lane + 64 * j]; am = fmaxf(am, fmaxf(fmaxf(fabsf(v[j].x), fabsf(v[j].y)), fmaxf(fabsf(v[j].z), fabsf(v[j].w)))); }
            am = wave_max(am);
            const float sc = am > 0.f ? 256.0f / am : 1.0f;
            if (F.lane == 0) inv[e] = am > 0.f ? am * (1.0f / 256.0f) : 1.0f;
#pragma unroll
            for (int j = 0; j < 4; ++j) { const int d0 = 256 * j + 4 * F.lane, sl = d0 >> 7, off = d0 & 127;
                int wv = __builtin_amdgcn_cvt_pk_fp8_f32(v[j].x * sc, v[j].y * sc, 0, false); wv = __builtin_amdgcn_cvt_pk_fp8_f32(v[j].z * sc, v[j].w * sc, wv, true);
                *(unsigned*)(dst + ((size_t)sl * 16384 + e) * 128 + off) = (unsigned)wv; }
        }
    }
    LAS float* scr = (LAS float*)(F.lds + F.wave * 16384);
    const int gw = blockIdx.x * NWAVES + F.wave, NGW = F.G * NWAVES;
    constexpr int I_IN = 152 * 16, I_B = 32 * 8, I_O = 32 * 16, I_PQ = 64 * 16;
    for (int it = gw; it < I_IN + I_B + I_O + I_PQ; it += NGW) {
        int r = it;
        if (r < I_IN) { const int cb = r >> 4, kb = r & 15; int c0, r0, nv; win_block(cb, c0, r0, nv);
            transpose_item(Ap->in[I_WIN], IN_COLS, 1024, c0, nv, (bf16*)(F.ws + WS_WIN), r0, 64 * kb, scr, F.lane); continue; }
        r -= I_IN;
        if (r < I_B) { const int cb = r >> 3, kb = r & 7; transpose_item(Ap->in[I_WBRB], 1024, 512, 32 * cb, 32, (bf16*)(F.ws + WS_WB), 32 * cb, 64 * kb, scr, F.lane); continue; }
        r -= I_B;
        if (r < I_O) { const int cb = r >> 4, kb = r & 15; transpose_item(Ap->in[I_WO], 1024, 1024, 32 * cb, 32, (bf16*)(F.ws + WS_WO), 32 * cb, 64 * kb, scr, F.lane); continue; }
        r -= I_O;
        { const int cb = r >> 4, kb = r & 15; transpose_item(Ap->in[I_WPQ], 2048, 1024, 32 * cb, 32, (bf16*)(F.ws + WS_WPQ), 32 * cb, 64 * kb, scr, F.lane); }
    }
    __syncthreads();
    LAS float* Xa = (LAS float*)(F.lds);
    LAS float* Xb = (LAS float*)(F.lds + 128 * 65 * 4);
    const float* w_in = Ap->in[I_WIN]; const float* w_uk = Ap->in[I_WUK]; const float* w_uv = Ap->in[I_WUV]; const float* w_bra = Ap->in[I_WBRA];
    for (int it = blockIdx.x; it < 256; it += F.G) {
        if (it < 128) {
            const int h = it >> 4, k0 = (it & 15) * 64;
            for (int e = F.tid; e < 128 * 64; e += NTHREADS) { const int c = e >> 6, d = e & 63; Xa[c * 65 + d] = w_uk[c * 512 + h * 64 + d]; }
            for (int e = F.tid; e < 64 * 64; e += NTHREADS) { const int kk = e >> 6, d = e & 63; Xb[kk * 65 + d] = w_in[(size_t)(k0 + kk) * IN_COLS + h * 64 + d]; }
            __syncthreads();
            const int kk = F.tid & 63;
            for (int j = 0; j < 16; ++j) { const int c = (F.tid >> 6) + 8 * j; float s = 0.f;
#pragma unroll 16
                for (int d = 0; d < 64; ++d) s += Xb[kk * 65 + d] * Xa[c * 65 + d];
                ((bf16*)(F.ws + WS_WIN))[(size_t)(h * 128 + c) * 1024 + k0 + kk] = (bf16)(pk2(s * 0.125f, 0.f) & 0xffffu); }
            __syncthreads();
        } else {
            const int i2 = it - 128, h = i2 >> 4, n0 = (i2 & 15) * 64;
            for (int e = F.tid; e < 128 * 64; e += NTHREADS) { const int c = e >> 6, d = e & 63; Xa[c * 65 + d] = w_uv[c * 512 + h * 64 + d]; }
            for (int e = F.tid; e < 64 * 64; e += NTHREADS) { const int d = e >> 6, n = e & 63; Xb[d * 65 + n] = w_bra[(size_t)(h * 64 + d) * 1024 + n0 + n]; }
            __syncthreads();
            const int c = F.tid & 127;
            for (int j = 0; j < 16; ++j) { const int n = (F.tid >> 7) + 4 * j; float s = 0.f;
#pragma unroll 16
                for (int d = 0; d < 64; ++d) s += Xa[c * 65 + d] * Xb[d * 65 + n];
                ((bf16*)(F.ws + WS_WA))[(size_t)(n0 + n) * 1024 + h * 128 + c] = (bf16)(pk2(s, 0.f) & 0xffffu); }
            __syncthreads();
        }
    }
}

struct EpiProj {
    static constexpr bool PERM = true;
    unsigned char* ws;
    __device__ __forceinline__ void operator()(const f32x4 (&acc)[2][2][4][2], const pg8::Unit& u, int wr, int wc, int fr, int fq) const {
        const int pn = u.pn; size_t boff; int ldc, colt; bool sg = false;
        if (pn < 4)       { boff = WS_QL;   ldc = 1024; colt = pn * 256; }
        else if (pn == 4) { boff = WS_MISC; ldc = 256;  colt = 0; }
        else if (pn < 7)  { boff = WS_QI;   ldc = 512;  colt = (pn - 5) * 256; }
        else if (pn < 9)  { boff = WS_QB;   ldc = 512;  colt = (pn - 7) * 256; }
        else if (pn < 11) { boff = WS_FB;   ldc = 512;  colt = (pn - 9) * 256; }
        else if (pn < 13) { boff = WS_IB;   ldc = 512;  colt = (pn - 11) * 256; }
        else if (pn < 15) { boff = WS_GB;   ldc = 512;  colt = (pn - 13) * 256; }
        else if (pn < 19) { boff = WS_GA;   ldc = 1024; colt = (pn - 15) * 256; sg = true; }
        else              { boff = WS_GBT;  ldc = 1024; colt = (pn - 19) * 256; sg = true; }
        bf16* base = (bf16*)(ws + boff);
        const int row0 = u.pm * 256 + wr * 64 + fr, col0 = colt + wc * 32 + 8 * fq;
#pragma unroll
        for (int ai = 0; ai < 2; ++ai)
#pragma unroll
            for (int m = 0; m < 4; ++m) { bf16* rowp = base + (size_t)(row0 + ai * 128 + m * 16) * ldc + col0;
#pragma unroll
                for (int bj = 0; bj < 2; ++bj) { f32x4 v0 = acc[ai][bj][m][0], v1 = acc[ai][bj][m][1];
                    if (sg) {
#pragma unroll
                        for (int j = 0; j < 4; ++j) { v0[j] = sigmoidf_(v0[j]); v1[j] = sigmoidf_(v1[j]); } }
                    v4u w; w.x = pk2(v0[0], v0[1]); w.y = pk2(v0[2], v0[3]); w.z = pk2(v1[0], v1[1]); w.w = pk2(v1[2], v1[3]);
                    *(v4u*)(rowp + bj * 128) = w; } }
    }
};
template <int MODE> struct EpiBranch {
    static constexpr bool PERM = true;
    const bf16* gate; bf16* O;
    __device__ __forceinline__ void operator()(const f32x4 (&acc)[2][2][4][2], const pg8::Unit& u, int wr, int wc, int fr, int fq) const {
        const int row0 = u.pm * 256 + wr * 64 + fr, col0 = u.pn * 256 + wc * 32 + 8 * fq;
#pragma unroll
        for (int ai = 0; ai < 2; ++ai)
#pragma unroll
            for (int m = 0; m < 4; ++m) { const size_t off = (size_t)(row0 + ai * 128 + m * 16) * 1024 + col0;
#pragma unroll
                for (int bj = 0; bj < 2; ++bj) { const f32x4 v0 = acc[ai][bj][m][0], v1 = acc[ai][bj][m][1];
                    const v4u g = *(const v4u*)(gate + off + bj * 128);
                    float r0 = v0[0] * bflo(g.x), r1 = v0[1] * bfhi(g.x), r2 = v0[2] * bflo(g.y), r3 = v0[3] * bfhi(g.y), r4 = v1[0] * bflo(g.z), r5 = v1[1] * bfhi(g.z), r6 = v1[2] * bflo(g.w), r7 = v1[3] * bfhi(g.w);
                    if (MODE == 1) { const v4u p = *(const v4u*)(O + off + bj * 128);
                        r0 += bflo(p.x); r1 += bfhi(p.x); r2 += bflo(p.y); r3 += bfhi(p.y); r4 += bflo(p.z); r5 += bfhi(p.z); r6 += bflo(p.w); r7 += bfhi(p.w); }
                    v4u w; w.x = pk2(r0, r1); w.y = pk2(r2, r3); w.z = pk2(r4, r5); w.w = pk2(r6, r7);
                    *(v4u*)(O + off + bj * 128) = w; } }
    }
};
struct EpiResF32 {
    static constexpr bool PERM = false;
    const float* X; float* Y;
    __device__ __forceinline__ void operator()(const f32x4 (&acc)[2][2][4][2], const pg8::Unit& u, int wr, int wc, int fr, int fq) const {
        const int row0 = u.pm * 256 + wr * 64 + fr, col0 = u.pn * 256 + wc * 32 + 4 * fq;
#pragma unroll
        for (int ai = 0; ai < 2; ++ai)
#pragma unroll
            for (int m = 0; m < 4; ++m) { const size_t off = (size_t)(row0 + ai * 128 + m * 16) * 1024 + col0;
#pragma unroll
                for (int bj = 0; bj < 2; ++bj)
#pragma unroll
                    for (int n = 0; n < 2; ++n) { const f32x4 xv = *(const f32x4*)(X + off + bj * 128 + n * 16);
                        *(f32x4*)(Y + off + bj * 128 + n * 16) = xv * ALPHA + acc[ai][bj][m][n]; } }
    }
};
struct EpiPlainBf16 {
    static constexpr bool PERM = true;
    bf16* O; int ldc;
    __device__ __forceinline__ void operator()(const f32x4 (&acc)[2][2][4][2], const pg8::Unit& u, int wr, int wc, int fr, int fq) const {
        const int row0 = u.pm * 256 + wr * 64 + fr, col0 = u.pn * 256 + wc * 32 + 8 * fq;
#pragma unroll
        for (int ai = 0; ai < 2; ++ai)
#pragma unroll
            for (int m = 0; m < 4; ++m) { bf16* rowp = O + (size_t)(row0 + ai * 128 + m * 16) * ldc + col0;
#pragma unroll
                for (int bj = 0; bj < 2; ++bj) { const f32x4 v0 = acc[ai][bj][m][0], v1 = acc[ai][bj][m][1];
                    v4u w; w.x = pk2(v0[0], v0[1]); w.y = pk2(v0[2], v0[3]); w.z = pk2(v1[0], v1[1]); w.w = pk2(v1[2], v1[3]);
                    *(v4u*)(rowp + bj * 128) = w; } }
    }
};

__device__ __forceinline__ void p2_ckv_norm(Frame& F) {
    const bf16* misc = (const bf16*)(F.ws + WS_MISC); bf16* ckv = (bf16*)(F.ws + WS_CKV); const float* g = F.a->in[I_KVG];
    const int gw = blockIdx.x * NWAVES + F.wave, NGW = F.G * NWAVES, sub = F.lane >> 4, l16 = F.lane & 15;
    float gv[8];
#pragma unroll
    for (int j = 0; j < 8; ++j) gv[j] = g[l16 * 8 + j];
    for (int r4 = gw; r4 < T / 4; r4 += NGW) {
        const int t = r4 * 4 + sub;
        const v4u p = *(const v4u*)(misc + (size_t)t * 256 + l16 * 8);
        float v[8] = {bflo(p.x), bfhi(p.x), bflo(p.y), bfhi(p.y), bflo(p.z), bfhi(p.z), bflo(p.w), bfhi(p.w)};
        float ss = 0.f;
#pragma unroll
        for (int j = 0; j < 8; ++j) ss += v[j] * v[j];
        ss += __shfl_xor(ss, 1); ss += __shfl_xor(ss, 2); ss += __shfl_xor(ss, 4); ss += __shfl_xor(ss, 8);
        const float r = rsqrtf(ss * (1.0f / 128.0f) + RMS_EPS);
        v4u o; o.x = pk2(v[0] * r * gv[0], v[1] * r * gv[1]); o.y = pk2(v[2] * r * gv[2], v[3] * r * gv[3]); o.z = pk2(v[4] * r * gv[4], v[5] * r * gv[5]); o.w = pk2(v[6] * r * gv[6], v[7] * r * gv[7]);
        *(v4u*)(ckv + (size_t)t * 128 + l16 * 8) = o;
    }
}

__device__ __forceinline__ void p2_hgrn_simple(Frame& F) {
    const bf16* QB = (const bf16*)(F.ws + WS_QB); const bf16* FBp = (const bf16*)(F.ws + WS_FB); bf16* IB = (bf16*)(F.ws + WS_IB);
    const float* lbp = F.a->in[I_LBP];
    const int v = F.tid >> 2, dq = F.tid & 3;
    for (int item = blockIdx.x; item < NB * 4; item += F.G) {
        const int b = item >> 2, h = item & 3;
        float lb[32], S[32];
#pragma unroll
        for (int i = 0; i < 32; ++i) { const int d = h * 128 + dq * 32 + i; lb[i] = 1.0f / (1.0f + __expf(lbp[512 + d] - lbp[d])); S[i] = 0.f; }
        for (int t = 0; t < SEQ; ++t) {
            const size_t row = (size_t)b * SEQ + t;
            const v4u* qp = (const v4u*)(QB + row * 512 + h * 128 + dq * 32);
            const v4u* fp = (const v4u*)(FBp + row * 512 + h * 128 + dq * 32);
            const float vv = bf2f(IB[row * 512 + h * 128 + v]);
            float part = 0.f;
#pragma unroll
            for (int c = 0; c < 4; ++c) { const v4u q4 = qp[c], f4 = fp[c];
#pragma unroll
                for (int e = 0; e < 4; ++e) {
                    const unsigned qa = e == 0 ? q4.x : e == 1 ? q4.y : e == 2 ? q4.z : q4.w, fa = e == 0 ? f4.x : e == 1 ? f4.y : e == 2 ? f4.z : f4.w;
#pragma unroll
                    for (int hh = 0; hh < 2; ++hh) { const int i = c * 8 + e * 2 + hh;
                        const float q = hh ? bfhi(qa) : bflo(qa), z = hh ? bfhi(fa) : bflo(fa);
                        const float sg = sigmoidf_(z), f = lb[i] + (1.0f - lb[i]) * sg, k = (1.0f - lb[i]) * (1.0f - sg);
                        S[i] = f * S[i] + k * vv; part += q * S[i]; } } }
            part += __shfl_xor(part, 1); part += __shfl_xor(part, 2);
            if (dq == 0) IB[row * 512 + h * 128 + v] = (bf16)(pk2(part, 0.f) & 0xffffu);
        }
    }
}

__device__ __forceinline__ void p2_hgrn_chunked(Frame& F, bf16* OUTB, int nbatch) {
    typedef short bf16x8 __attribute__((ext_vector_type(8)));
    const bf16* QB = (const bf16*)(F.ws + WS_QB); const bf16* FBp = (const bf16*)(F.ws + WS_FB); bf16* IB = (bf16*)(F.ws + WS_IB);
    const float* lbp = F.a->in[I_LBP];
    constexpr int S136 = 136, S72 = 72;
    LAS bf16* QIN = (LAS bf16*)(F.lds);
    LAS bf16* KIN = (LAS bf16*)(F.lds + 17408);
    LAS bf16* QDEC = (LAS bf16*)(F.lds + 2 * 17408);
    LAS bf16* ST = (LAS bf16*)(F.lds + 3 * 17408);
    LAS bf16* KDT = (LAS bf16*)(F.lds + 4 * 17408);
    LAS bf16* VT = (LAS bf16*)(F.lds + 4 * 17408 + 18432);
    LAS bf16* ATT = (LAS bf16*)(F.lds + 4 * 17408 + 18432 + 9216);
    LAS float* SEG = (LAS float*)(F.lds + 4 * 17408 + 18432 + 2 * 9216);
    LAS float* DECAY = SEG + 512;
    const int tid = F.tid, lane = F.lane, w = F.wave, l15 = lane & 15, q4 = lane >> 4;
    const int d = tid & 127, tq = tid >> 7;
    const int vn = tid & 63, vg = tid >> 6;
    const int tr = w >> 1, tc2 = w & 1;
    for (int item = blockIdx.x; item < nbatch * 8; item += F.G) {
        const int b = item >> 3, h = (item >> 1) & 3, half = item & 1;
        const float lb = 1.0f / (1.0f + __expf(lbp[512 + h * 128 + d] - lbp[h * 128 + d])), oml = 1.0f - lb;
        f32x4 Sacc[4];
#pragma unroll
        for (int nt = 0; nt < 4; ++nt) Sacc[nt] = (f32x4){0.f, 0.f, 0.f, 0.f};
        for (int e = tid; e < 64 * S136 / 2; e += NTHREADS) ((LAS unsigned*)ST)[e] = 0u;
        const size_t rowb = (size_t)b * SEQ;
        const bf16* zp = FBp + (rowb + tq * 16) * 512 + h * 128 + d;
        const bf16* qp = QB + (rowb + tq * 16) * 512 + h * 128 + d;
        bf16* vp = IB + (rowb + vg * 8) * 512 + h * 128 + half * 64 + vn;
        unsigned short zr[16], qr[16], vr[8];
#pragma unroll
        for (int i = 0; i < 16; ++i) { zr[i] = zp[(size_t)i * 512]; qr[i] = qp[(size_t)i * 512]; }
#pragma unroll
        for (int i = 0; i < 8; ++i) vr[i] = vp[(size_t)i * 512];
        __syncthreads();
        for (int n = 0; n < SEQ / 64; ++n) {
            float c[16], kk[16], qf[16];
            { float run = 0.f;
#pragma unroll
              for (int i = 0; i < 16; ++i) { const float z = bf2f(zr[i]); const float e1 = __expf(-z), sg = 1.0f / (1.0f + e1);
                  run += __logf(lb + oml * sg); c[i] = run; kk[i] = oml * e1 * sg; qf[i] = bf2f(qr[i]); } }
            unsigned short vcur[8];
#pragma unroll
            for (int i = 0; i < 8; ++i) vcur[i] = vr[i];
            SEG[tq * 128 + d] = c[15];
            if (n + 1 < SEQ / 64) {
                const size_t o2 = (size_t)(n + 1) * 64 * 512;
#pragma unroll
                for (int i = 0; i < 16; ++i) { zr[i] = zp[o2 + (size_t)i * 512]; qr[i] = qp[o2 + (size_t)i * 512]; }
#pragma unroll
                for (int i = 0; i < 8; ++i) vr[i] = vp[o2 + (size_t)i * 512];
            }
            __syncthreads();
            { const float s0 = SEG[d], s1 = SEG[128 + d], s2 = SEG[256 + d], s3 = SEG[384 + d];
              const float off = tq == 0 ? 0.f : tq == 1 ? s0 : tq == 2 ? s0 + s1 : s0 + s1 + s2;
              const float bref = s0 + s1, blast = (s0 + s1) + (s2 + s3);
              const float enb = __expf(-bref), eb = __expf(bref), el = __expf(blast);
              if (tq == 0) DECAY[d] = el;
              unsigned kd[8];
#pragma unroll
              for (int i = 0; i < 16; i += 2) {
                  const float E0 = __expf(c[i] + off), E1 = __expf(c[i + 1] + off), r0 = 1.0f / E0, r1 = 1.0f / E1;
                  const int t0 = tq * 16 + i;
                  const unsigned qd = pk2(qf[i] * E0, qf[i + 1] * E1), qi = pk2(qf[i] * E0 * enb, qf[i + 1] * E1 * enb), ki = pk2(kk[i] * eb * r0, kk[i + 1] * eb * r1);
                  QDEC[t0 * S136 + d] = (bf16)(qd & 0xffffu); QDEC[(t0 + 1) * S136 + d] = (bf16)(qd >> 16);
                  QIN[t0 * S136 + d] = (bf16)(qi & 0xffffu); QIN[(t0 + 1) * S136 + d] = (bf16)(qi >> 16);
                  KIN[t0 * S136 + d] = (bf16)(ki & 0xffffu); KIN[(t0 + 1) * S136 + d] = (bf16)(ki >> 16);
                  kd[i >> 1] = pk2(kk[i] * el * r0, kk[i + 1] * el * r1);
              }
              *(LAS v4u*)(KDT + d * S72 + tq * 16) = (v4u){kd[0], kd[1], kd[2], kd[3]};
              *(LAS v4u*)(KDT + d * S72 + tq * 16 + 8) = (v4u){kd[4], kd[5], kd[6], kd[7]};
              v4u vv; vv.x = (unsigned)vcur[0] | ((unsigned)vcur[1] << 16); vv.y = (unsigned)vcur[2] | ((unsigned)vcur[3] << 16); vv.z = (unsigned)vcur[4] | ((unsigned)vcur[5] << 16); vv.w = (unsigned)vcur[6] | ((unsigned)vcur[7] << 16);
              *(LAS v4u*)(VT + vn * S72 + vg * 8) = vv;
            }
            __syncthreads();
#pragma unroll
            for (int j = 0; j < 2; ++j) {
                const int tc = 2 * tc2 + j;
                f32x4 acc = {0.f, 0.f, 0.f, 0.f};
                if (tc <= tr) {
#pragma unroll
                    for (int ks = 0; ks < 4; ++ks) {
                        const bf16x8 a = *(const LAS bf16x8*)(QIN + (tr * 16 + l15) * S136 + ks * 32 + 8 * q4);
                        const bf16x8 bb = *(const LAS bf16x8*)(KIN + (tc * 16 + l15) * S136 + ks * 32 + 8 * q4);
                        acc = __builtin_amdgcn_mfma_f32_16x16x32_bf16(a, bb, acc, 0, 0, 0);
                    }
                }
                const int s_ = tc * 16 + l15;
#pragma unroll
                for (int r = 0; r < 4; ++r) { const int t_ = tr * 16 + 4 * q4 + r; ATT[t_ * S72 + s_] = (bf16)(pk2(s_ <= t_ ? acc[r] : 0.f, 0.f) & 0xffffu); }
            }
            __syncthreads();
#pragma unroll
            for (int j = 0; j < 2; ++j) {
                const int nt = 2 * tc2 + j;
                f32x4 acc = {0.f, 0.f, 0.f, 0.f};
#pragma unroll
                for (int ks = 0; ks < 2; ++ks) {
                    const bf16x8 a = *(const LAS bf16x8*)(ATT + (tr * 16 + l15) * S72 + ks * 32 + 8 * q4);
                    const bf16x8 bb = *(const LAS bf16x8*)(VT + (nt * 16 + l15) * S72 + ks * 32 + 8 * q4);
                    acc = __builtin_amdgcn_mfma_f32_16x16x32_bf16(a, bb, acc, 0, 0, 0);
                }
#pragma unroll
                for (int ks = 0; ks < 4; ++ks) {
                    const bf16x8 a = *(const LAS bf16x8*)(QDEC + (tr * 16 + l15) * S136 + ks * 32 + 8 * q4);
                    const bf16x8 bb = *(const LAS bf16x8*)(ST + (nt * 16 + l15) * S136 + ks * 32 + 8 * q4);
                    acc = __builtin_amdgcn_mfma_f32_16x16x32_bf16(a, bb, acc, 0, 0, 0);
                }
                bf16* op = OUTB + (rowb + (size_t)n * 64 + tr * 16 + 4 * q4) * 512 + h * 128 + half * 64 + nt * 16 + l15;
#pragma unroll
                for (int r = 0; r < 4; ++r) op[(size_t)r * 512] = (bf16)(pk2(acc[r], 0.f) & 0xffffu);
            }
            __syncthreads();
            { const f32x4 dc = *(const LAS f32x4*)(DECAY + w * 16 + 4 * q4);
#pragma unroll
              for (int nt = 0; nt < 4; ++nt) {
                  f32x4 acc = Sacc[nt] * dc;
#pragma unroll
                  for (int ks = 0; ks < 2; ++ks) {
                      const bf16x8 a = *(const LAS bf16x8*)(KDT + (w * 16 + l15) * S72 + ks * 32 + 8 * q4);
                      const bf16x8 bb = *(const LAS bf16x8*)(VT + (nt * 16 + l15) * S72 + ks * 32 + 8 * q4);
                      acc = __builtin_amdgcn_mfma_f32_16x16x32_bf16(a, bb, acc, 0, 0, 0);
                  }
                  Sacc[nt] = acc;
                  *(LAS v2u*)(ST + (nt * 16 + l15) * S136 + w * 16 + 4 * q4) = (v2u){pk2(acc[0], acc[1]), pk2(acc[2], acc[3])};
              } }
        }
        __syncthreads();
    }
}

__device__ __forceinline__ unsigned mono_key(float f) { const unsigned u = __float_as_uint(f); return (u & 0x80000000u) ? ~u : (u | 0x80000000u); }
__device__ __forceinline__ void p2_indexer_simple(Frame& F) {
    typedef short bf16x8 __attribute__((ext_vector_type(8)));
    const bf16* misc = (const bf16*)(F.ws + WS_MISC); const bf16* QI = (const bf16*)(F.ws + WS_QI);
    unsigned long long* BMp = (unsigned long long*)(F.ws + WS_BM);
    LAS float* sc = (LAS float*)(F.lds + F.wave * 16384);
    const int gw = blockIdx.x * NWAVES + F.wave, NGW = F.G * NWAVES, lane = F.lane;
    const int l15 = lane & 15, q4 = lane >> 4;
    for (int tp = gw; tp < T / 2; tp += NGW) {
        const int t0 = tp * 2, b = t0 >> 11, pos = t0 & 2047, chunk = pos >> 6, nk = chunk + 1;
        if (nk <= 4) { if (lane < 32) { BMp[(size_t)t0 * 32 + lane] = (lane < nk) ? ~0ull : 0ull; BMp[(size_t)(t0 + 1) * 32 + lane] = (lane < nk) ? ~0ull : 0ull; } continue; }
        const bf16* ap = QI + (size_t)(t0 + (l15 >> 3)) * 512 + (l15 & 7) * 64 + 8 * q4;
        const bf16x8 a0 = *(const bf16x8*)ap, a1 = *(const bf16x8*)(ap + 32);
        float w[4];
        { const v2u p = *(const v2u*)(misc + (size_t)(t0 + (q4 >> 1)) * 256 + 192 + (q4 & 1) * 4); const float s_ = 0.04419417382415922f;
          w[0] = bflo(p.x) * s_; w[1] = bfhi(p.x) * s_; w[2] = bflo(p.y) * s_; w[3] = bfhi(p.y) * s_; }
        const bf16* kbase = misc + ((size_t)b * SEQ + l15) * 256 + 128 + 8 * q4;
#pragma unroll 2
        for (int kt = 0; kt < nk * 4; ++kt) {
            const bf16* kp = kbase + (size_t)kt * 16 * 256;
            const bf16x8 b0 = *(const bf16x8*)kp, b1 = *(const bf16x8*)(kp + 32);
            f32x4 acc = {0.f, 0.f, 0.f, 0.f};
            acc = __builtin_amdgcn_mfma_f32_16x16x32_bf16(a0, b0, acc, 0, 0, 0);
            acc = __builtin_amdgcn_mfma_f32_16x16x32_bf16(a1, b1, acc, 0, 0, 0);
            float part = w[0] * fmaxf(acc[0], 0.f) + w[1] * fmaxf(acc[1], 0.f) + w[2] * fmaxf(acc[2], 0.f) + w[3] * fmaxf(acc[3], 0.f);
            part += __shfl_xor(part, 16);
            if ((q4 & 1) == 0) sc[(q4 >> 1) * 2048 + kt * 16 + l15] = part;
        }
        for (int i = nk; i < 32; ++i) { sc[i * 64 + lane] = -INFINITY; sc[2048 + i * 64 + lane] = -INFINITY; }
        LDS_WAIT(); asm volatile("" ::: "memory");
#pragma unroll 1
        for (int tt = 0; tt < 2; ++tt) {
            unsigned long long* bmrow = BMp + (size_t)(t0 + tt) * 32;
            unsigned key[32];
#pragma unroll
            for (int i = 0; i < 32; ++i) key[i] = mono_key(sc[tt * 2048 + i * 64 + lane]);
            unsigned prefix = 0u;
#pragma unroll 1
            for (int bit = 31; bit >= 0; --bit) {
                const unsigned cand = prefix | (1u << bit); int cnt = 0;
#pragma unroll
                for (int i = 0; i < 32; ++i) { cnt += __builtin_popcountll(__ballot(key[i] >= cand)); if ((i & 3) == 3) __builtin_amdgcn_sched_barrier(0); }
                if (cnt >= 256) prefix = cand;
            }
            int ngt = 0;
#pragma unroll
            for (int i = 0; i < 32; ++i) { ngt += __builtin_popcountll(__ballot(key[i] > prefix)); if ((i & 3) == 3) __builtin_amdgcn_sched_barrier(0); }
            const int need = 256 - ngt; int running = 0;
            const unsigned long long lt_mask = (1ull << lane) - 1ull;
#pragma unroll
            for (int i = 0; i < 32; ++i) {
                const unsigned long long eq = __ballot(key[i] == prefix), gt = __ballot(key[i] > prefix);
                const int rank = running + __builtin_popcountll(eq & lt_mask);
                const unsigned long long se = __ballot(key[i] == prefix && rank < need);
                running += __builtin_popcountll(eq);
                const unsigned long long word = gt | se;
                if (lane == 0) bmrow[i] = word;
                __builtin_amdgcn_sched_barrier(0);
            }
        }
        LDS_WAIT(); asm volatile("" ::: "memory");
    }
}

__device__ __forceinline__ void p3_hg_finalize(Frame& F) {
    bf16* HG = (bf16*)(F.ws + WS_IB); const bf16* GBp = (const bf16*)(F.ws + WS_GB); const float* ng = F.a->in[I_BNG];
    const int gw = blockIdx.x * NWAVES + F.wave, NGW = F.G * NWAVES, sub = F.lane >> 4, l16 = F.lane & 15;
    float gv[8];
#pragma unroll
    for (int j = 0; j < 8; ++j) gv[j] = ng[l16 * 8 + j];
    for (int r4 = gw; r4 < T; r4 += NGW) {
        const size_t off = (size_t)r4 * 512 + sub * 128 + l16 * 8;
        const v4u p = *(const v4u*)(HG + off), q = *(const v4u*)(GBp + off);
        float v[8] = {bflo(p.x), bfhi(p.x), bflo(p.y), bfhi(p.y), bflo(p.z), bfhi(p.z), bflo(p.w), bfhi(p.w)};
        float gg[8] = {bflo(q.x), bfhi(q.x), bflo(q.y), bfhi(q.y), bflo(q.z), bfhi(q.z), bflo(q.w), bfhi(q.w)};
        float ss = 0.f;
#pragma unroll
        for (int j = 0; j < 8; ++j) ss += v[j] * v[j];
        ss += __shfl_xor(ss, 1); ss += __shfl_xor(ss, 2); ss += __shfl_xor(ss, 4); ss += __shfl_xor(ss, 8);
        const float r = rsqrtf(ss * (1.0f / 128.0f) + RMS_EPS);
        float o[8];
#pragma unroll
        for (int j = 0; j < 8; ++j) o[j] = v[j] * r * gv[j] * gg[j] * sigmoidf_(gg[j]);
        v4u w; w.x = pk2(o[0], o[1]); w.y = pk2(o[2], o[3]); w.z = pk2(o[4], o[5]); w.w = pk2(o[6], o[7]);
        *(v4u*)(HG + off) = w;
    }
}

__device__ __forceinline__ int t5_bucket(int rel) {
    const int n = rel < 0 ? -rel : rel; const int base = rel > 0 ? 16 : 0;
    int v;
    if (n < 8) v = n; else v = n >= 91 ? 15 : n >= 64 ? 14 : n >= 46 ? 13 : n >= 32 ? 12 : n >= 23 ? 11 : n >= 16 ? 10 : n >= 12 ? 9 : 8;
    return base + v;
}
__device__ __forceinline__ void p3_attn_simple(Frame& F) {
    const bf16* CKV = (const bf16*)(F.ws + WS_CKV); bf16* QL = (bf16*)(F.ws + WS_QL);
    const unsigned long long* BMp = (const unsigned long long*)(F.ws + WS_BM);
    LAS float* relb = (LAS float*)(F.lds + 8 * 12800);
    LAS float* qlf = (LAS float*)(F.lds + F.wave * 12800);
    LAS float* pl = (LAS float*)(F.lds + F.wave * 12800 + 4096);
    LAS unsigned short* idx = (LAS unsigned short*)(F.lds + F.wave * 12800 + 4096 + 8192);
    if (F.tid < 256) relb[F.tid] = F.a->in[I_RELB][F.tid];
    __syncthreads();
    const int gw = blockIdx.x * NWAVES + F.wave, NGW = F.G * NWAVES, lane = F.lane;
    const unsigned long long lt_mask = (1ull << lane) - 1ull;
    for (int t = gw; t < T; t += NGW) {
        const int b = t >> 11, pos = t & 2047, nk = (pos >> 6) + 1;
        {
#pragma unroll
            for (int j = 0; j < 2; ++j) { const v4u p = *(const v4u*)(QL + (size_t)t * 1024 + j * 512 + lane * 8);
                f32x4 a = {bflo(p.x), bfhi(p.x), bflo(p.y), bfhi(p.y)}, c = {bflo(p.z), bfhi(p.z), bflo(p.w), bfhi(p.w)};
                *(LAS f32x4*)(qlf + j * 512 + lane * 8) = a; *(LAS f32x4*)(qlf + j * 512 + lane * 8 + 4) = c; }
        }
        int n = 0;
        for (int i = 0; i < nk; ++i) {
            const unsigned long long word = BMp[(size_t)t * 32 + i];
            if ((word >> lane) & 1ull) idx[n + __builtin_popcountll(word & lt_mask)] = (unsigned short)(i * 64 + lane);
            n += __builtin_popcountll(word);
        }
        LDS_WAIT(); asm volatile("" ::: "memory");
#pragma unroll 1
        for (int j = 0; j < 4; ++j) {
            const int k = lane + 64 * j; const bool ok = k < n; const int s = ok ? (int)idx[k] : 0;
            const v4u* row = (const v4u*)(CKV + ((size_t)b * SEQ + s) * 128);
            float d[8];
#pragma unroll
            for (int h = 0; h < 8; ++h) d[h] = 0.f;
#pragma unroll 1
            for (int q4 = 0; q4 < 4; ++q4) {
                asm volatile("" ::: "memory");
                float ck[32];
#pragma unroll
                for (int c = 0; c < 4; ++c) { const v4u p = row[q4 * 4 + c]; ck[c * 8 + 0] = bflo(p.x); ck[c * 8 + 1] = bfhi(p.x); ck[c * 8 + 2] = bflo(p.y); ck[c * 8 + 3] = bfhi(p.y); ck[c * 8 + 4] = bflo(p.z); ck[c * 8 + 5] = bfhi(p.z); ck[c * 8 + 6] = bflo(p.w); ck[c * 8 + 7] = bfhi(p.w); }
#pragma unroll
                for (int h = 0; h < 8; ++h) {
#pragma unroll
                    for (int c = 0; c < 8; ++c) { const f32x4 q = *(const LAS f32x4*)(qlf + h * 128 + q4 * 32 + c * 4); d[h] += q.x * ck[c * 4] + q.y * ck[c * 4 + 1] + q.z * ck[c * 4 + 2] + q.w * ck[c * 4 + 3]; }
                    __builtin_amdgcn_sched_barrier(0);
                }
            }
            const int bk = t5_bucket(s - pos);
            f32x4 s0, s1;
            s0.x = ok ? d[0] + relb[bk * 8 + 0] : -INFINITY; s0.y = ok ? d[1] + relb[bk * 8 + 1] : -INFINITY; s0.z = ok ? d[2] + relb[bk * 8 + 2] : -INFINITY; s0.w = ok ? d[3] + relb[bk * 8 + 3] : -INFINITY;
            s1.x = ok ? d[4] + relb[bk * 8 + 4] : -INFINITY; s1.y = ok ? d[5] + relb[bk * 8 + 5] : -INFINITY; s1.z = ok ? d[6] + relb[bk * 8 + 6] : -INFINITY; s1.w = ok ? d[7] + relb[bk * 8 + 7] : -INFINITY;
            *(LAS f32x4*)(pl + k * 8) = s0; *(LAS f32x4*)(pl + k * 8 + 4) = s1;
        }
        LDS_WAIT(); asm volatile("" ::: "memory");
        {
            f32x4 a0[4], a1[4];
#pragma unroll
            for (int j = 0; j < 4; ++j) { a0[j] = *(const LAS f32x4*)(pl + (lane + 64 * j) * 8); a1[j] = *(const LAS f32x4*)(pl + (lane + 64 * j) * 8 + 4); }
#pragma unroll
            for (int h = 0; h < 8; ++h) {
                float v[4];
#pragma unroll
                for (int j = 0; j < 4; ++j) v[j] = h < 4 ? a0[j][h & 3] : a1[j][h & 3];
                float m = wave_max(fmaxf(fmaxf(v[0], v[1]), fmaxf(v[2], v[3])));
                float sum = 0.f;
#pragma unroll
                for (int j = 0; j < 4; ++j) { v[j] = __expf(v[j] - m); sum += v[j]; }
                const float inv = 1.0f / wave_sum(sum);
#pragma unroll
                for (int j = 0; j < 4; ++j) { if (h < 4) a0[j][h & 3] = v[j] * inv; else a1[j][h & 3] = v[j] * inv; }
            }
#pragma unroll
            for (int j = 0; j < 4; ++j) { *(LAS f32x4*)(pl + (lane + 64 * j) * 8) = a0[j]; *(LAS f32x4*)(pl + (lane + 64 * j) * 8 + 4) = a1[j]; }
        }
        LDS_WAIT(); asm volatile("" ::: "memory");
        float acc[8][2];
#pragma unroll
        for (int h = 0; h < 8; ++h) { acc[h][0] = 0.f; acc[h][1] = 0.f; }
        for (int k = 0; k < n; ++k) {
            const int s = (int)idx[k];
            const unsigned vv = *(const unsigned*)(CKV + ((size_t)b * SEQ + s) * 128 + 2 * lane);
            const float v0 = bflo(vv), v1 = bfhi(vv);
            const f32x4 p0 = *(const LAS f32x4*)(pl + k * 8), p1 = *(const LAS f32x4*)(pl + k * 8 + 4);
            acc[0][0] += p0.x * v0; acc[0][1] += p0.x * v1; acc[1][0] += p0.y * v0; acc[1][1] += p0.y * v1;
            acc[2][0] += p0.z * v0; acc[2][1] += p0.z * v1; acc[3][0] += p0.w * v0; acc[3][1] += p0.w * v1;
            acc[4][0] += p1.x * v0; acc[4][1] += p1.x * v1; acc[5][0] += p1.y * v0; acc[5][1] += p1.y * v1;
            acc[6][0] += p1.z * v0; acc[6][1] += p1.z * v1; acc[7][0] += p1.w * v0; acc[7][1] += p1.w * v1;
        }
#pragma unroll
        for (int h = 0; h < 8; ++h) *(unsigned*)(QL + (size_t)t * 1024 + h * 128 + 2 * lane) = pk2(acc[h][0], acc[h][1]);
        LDS_WAIT(); asm volatile("" ::: "memory");
    }
}

__device__ __forceinline__ unsigned offb(unsigned row, unsigned ch) { return 256u * row + 16u * (ch ^ (((row & 3u) << 2) | ((row >> 2) & 3u))); }
__device__ __forceinline__ void p3_attn_mfma(Frame& F) {
    typedef short bf16x8 __attribute__((ext_vector_type(8)));
    typedef short s16x4 __attribute__((ext_vector_type(4)));
    typedef float f32x16 __attribute__((ext_vector_type(16)));
    const bf16* CKV = (const bf16*)(F.ws + WS_CKV); bf16* QL = (bf16*)(F.ws + WS_QL);
    const unsigned long long* BMp = (const unsigned long long*)(F.ws + WS_BM);
    LAS unsigned char* KV = F.lds;
    LAS float* LUT = (LAS float*)(F.lds + 32768);
    const int tid = F.tid, lane = F.lane, head = F.wave, r = lane & 31, h = lane >> 5;
    for (int e = tid; e < 8 * 160; e += NTHREADS) { const int hh = e / 160, i = e % 160; const int rel = (i < 155 ? i : 154) - 91; LUT[e] = F.a->in[I_RELB][t5_bucket(rel) * 8 + hh]; }
    __syncthreads();
    const float bfar = LUT[head * 160];
    const unsigned blk = (lane >> 4) & 1, q4 = (lane & 15) >> 2, p4 = lane & 3;
    for (int uidx = blockIdx.x; uidx < NB * 64; uidx += F.G) {
        const int k = uidx >> 8, c0 = (uidx >> 5) & 7;
        const int b = uidx & 31, qt = 8 * k + ((k & 1) ? 7 - c0 : c0);
        const int t0 = qt * 32, nkt = (qt >> 1) + 1;
        const size_t trow = (size_t)b * SEQ + t0 + r;
        bf16x8 qf[8];
#pragma unroll
        for (int ks = 0; ks < 8; ++ks) qf[ks] = *(const bf16x8*)(QL + trow * 1024 + head * 128 + 16 * ks + 8 * h);
        f32x16 O[4];
#pragma unroll
        for (int cb = 0; cb < 4; ++cb)
#pragma unroll
            for (int i = 0; i < 16; ++i) O[cb][i] = 0.f;
        float m = -1e30f, l = 0.f;
        const int cid0 = tid * 2, lrow = cid0 >> 4, lch = cid0 & 15;
        const unsigned loff0 = (unsigned)(lrow >> 5) * 8192u + offb((unsigned)(lrow & 31), (unsigned)lch), loff1 = (unsigned)(lrow >> 5) * 8192u + offb((unsigned)(lrow & 31), (unsigned)lch + 1u);
        const bf16* gsrc = CKV + ((size_t)b * SEQ + lrow) * 128 + lch * 8;
        v4u g0 = *(const v4u*)gsrc, g1 = *(const v4u*)(gsrc + 8);
        __syncthreads();
        *(LAS v4u*)(KV + loff0) = g0; *(LAS v4u*)(KV + loff1) = g1;
        __syncthreads();
        for (int kt = 0; kt < nkt; ++kt) {
            LAS unsigned char* buf = KV + (kt & 1) * 16384;
            if (kt + 1 < nkt) { const bf16* gs = gsrc + (size_t)(kt + 1) * 64 * 128; g0 = *(const v4u*)gs; g1 = *(const v4u*)(gs + 8); }
            const unsigned long long bw = BMp[trow * 32 + kt];
            f32x16 ST[2];
#pragma unroll
            for (int s2 = 0; s2 < 2; ++s2) {
#pragma unroll
                for (int i = 0; i < 16; ++i) ST[s2][i] = 0.f;
#pragma unroll
                for (int ks = 0; ks < 8; ++ks) { const bf16x8 a = *(const LAS bf16x8*)(buf + s2 * 8192 + offb((unsigned)r, (unsigned)(2 * ks + h)));
                    ST[s2] = __builtin_amdgcn_mfma_f32_32x32x16_bf16(a, qf[ks], ST[s2], 0, 0, 0); }
            }
            const int relmax = kt * 64 + 63 - t0;
            const bool far = relmax <= -91;
            const unsigned wsel[2] = {(unsigned)bw >> (4 * h), (unsigned)(bw >> 32) >> (4 * h)};
            float mx = -1e30f;
#pragma unroll
            for (int s2 = 0; s2 < 2; ++s2)
#pragma unroll
                for (int i = 0; i < 16; ++i) {
                    const int cr = (i & 3) + 8 * (i >> 2);
                    float bias = bfar;
                    if (!far) { int rel = kt * 64 + 32 * s2 + cr + 4 * h - (t0 + r); rel = rel < -91 ? -91 : rel; bias = LUT[head * 160 + rel + 91]; }
                    const float sc = ST[s2][i] + bias; ST[s2][i] = sc;
                    if ((wsel[s2] >> cr) & 1u) mx = fmaxf(mx, sc);
                }
            mx = fmaxf(mx, __shfl_xor(mx, 32));
            const float mnew = fmaxf(m, mx), alpha = __expf(m - mnew);
            m = mnew;
            float ps = 0.f;
#pragma unroll
            for (int s2 = 0; s2 < 2; ++s2)
#pragma unroll
                for (int i = 0; i < 16; ++i) { const int cr = (i & 3) + 8 * (i >> 2);
                    const float pv = ((wsel[s2] >> cr) & 1u) ? __expf(ST[s2][i] - mnew) : 0.f; ST[s2][i] = pv; ps += pv; }
            l = l * alpha + ps;
#pragma unroll
            for (int cb = 0; cb < 4; ++cb)
#pragma unroll
                for (int i = 0; i < 16; ++i) O[cb][i] *= alpha;
#pragma unroll
            for (int s2 = 0; s2 < 2; ++s2)
#pragma unroll
                for (int u = 0; u < 2; ++u) {
                    v4u pk; pk.x = pk2(ST[s2][8 * u], ST[s2][8 * u + 1]); pk.y = pk2(ST[s2][8 * u + 2], ST[s2][8 * u + 3]); pk.z = pk2(ST[s2][8 * u + 4], ST[s2][8 * u + 5]); pk.w = pk2(ST[s2][8 * u + 6], ST[s2][8 * u + 7]);
                    const bf16x8 pf = __builtin_bit_cast(bf16x8, pk);
                    const unsigned row0 = 16u * u + 4u * h + q4;
#pragma unroll
                    for (int cb = 0; cb < 4; ++cb) {
                        const unsigned ch = 4u * cb + 2u * blk + (p4 >> 1);
                        const s16x4 lo = __builtin_amdgcn_ds_read_tr16_b64_v4i16((LAS s16x4*)(buf + s2 * 8192 + offb(row0, ch) + 8u * (p4 & 1u)));
                        const s16x4 hi = __builtin_amdgcn_ds_read_tr16_b64_v4i16((LAS s16x4*)(buf + s2 * 8192 + offb(row0 + 8u, ch) + 8u * (p4 & 1u)));
                        const bf16x8 va = __builtin_shufflevector(lo, hi, 0, 1, 2, 3, 4, 5, 6, 7);
                        O[cb] = __builtin_amdgcn_mfma_f32_32x32x16_bf16(va, pf, O[cb], 0, 0, 0);
                    }
                }
            if (kt + 1 < nkt) { LAS unsigned char* nb = KV + ((kt + 1) & 1) * 16384; *(LAS v4u*)(nb + loff0) = g0; *(LAS v4u*)(nb + loff1) = g1; }
            __syncthreads();
        }
        const float lt = l + __shfl_xor(l, 32), inv = 1.0f / lt;
#pragma unroll
        for (int cb = 0; cb < 4; ++cb)
#pragma unroll
            for (int g4 = 0; g4 < 4; ++g4) {
                v2u w; w.x = pk2(O[cb][4 * g4] * inv, O[cb][4 * g4 + 1] * inv); w.y = pk2(O[cb][4 * g4 + 2] * inv, O[cb][4 * g4 + 3] * inv);
                *(v2u*)(QL + trow * 1024 + head * 128 + 32 * cb + 8 * g4 + 4 * h) = w;
            }
    }
}

__device__ __forceinline__ void p6_ln1(Frame& F) {
    float* Y = F.a->out; bf16* X1B = (bf16*)(F.ws + WS_X1B); const float* g = F.a->in[I_LN1G]; const float* bb = F.a->in[I_LN1B];
    const int gw = blockIdx.x * NWAVES + F.wave, NGW = F.G * NWAVES, lane = F.lane;
    f32x4 gv[4], bv[4];
#pragma unroll
    for (int j = 0; j < 4; ++j) { gv[j] = ((const f32x4*)g)[lane + 64 * j]; bv[j] = ((const f32x4*)bb)[lane + 64 * j]; }
    for (int m = gw; m < T; m += NGW) {
        f32x4* yr = (f32x4*)(Y + (size_t)m * DM) + lane;
        f32x4 v[4]; float s = 0.f;
#pragma unroll
        for (int j = 0; j < 4; ++j) { v[j] = yr[64 * j]; s += (v[j].x + v[j].y) + (v[j].z + v[j].w); }
        const float mean = wave_sum(s) * (1.f / DM); float s2 = 0.f;
#pragma unroll
        for (int j = 0; j < 4; ++j) { v[j] = v[j] - mean; s2 += (v[j].x * v[j].x + v[j].y * v[j].y) + (v[j].z * v[j].z + v[j].w * v[j].w); }
        const float rstd = rsqrtf(wave_sum(s2) * (1.f / DM) + LN_EPS);
        v2u* o8 = (v2u*)(X1B + (size_t)m * DM) + lane;
#pragma unroll
        for (int j = 0; j < 4; ++j) { const f32x4 o = v[j] * rstd * gv[j] + bv[j]; yr[64 * j] = o; v2u w; w.x = pk2(o.x, o.y); w.y = pk2(o.z, o.w); o8[64 * j] = w; }
    }
}

#define TOP16_INSERT(tv, ti, val, id) do { \
    _Pragma("unroll") for (int _j = 15; _j >= 1; --_j) { const bool _up = (val) > tv[_j - 1]; const bool _here = (val) > tv[_j]; \
        tv[_j] = _up ? tv[_j - 1] : (_here ? (val) : tv[_j]); ti[_j] = _up ? ti[_j - 1] : (_here ? (id) : ti[_j]); } \
    { const bool _h0 = (val) > tv[0]; tv[0] = _h0 ? (val) : tv[0]; ti[0] = _h0 ? (id) : ti[0]; } } while (0)
__device__ __forceinline__ void p8_peer_route_simple(Frame& F) {
    const bf16* PQ = (const bf16*)(F.ws + WS_PQ); unsigned short* IDS = (unsigned short*)(F.ws + WS_IDS); float* GATES = (float*)(F.ws + WS_GATES);
    LAS float* K1 = (LAS float*)(F.lds); LAS float* K2 = (LAS float*)(F.lds + 65536);
    for (int e = F.tid; e < 16384; e += NTHREADS) { K1[e] = F.a->in[I_SK1][e]; K2[e] = F.a->in[I_SK2][e]; }
    __syncthreads();
    const size_t gtid = (size_t)blockIdx.x * NTHREADS + F.tid, gthreads = (size_t)F.G * NTHREADS;
    for (size_t item = gtid; item < (size_t)T * 8; item += gthreads) {
        const size_t t = item >> 3; const int h = (int)(item & 7);
        float v1[16], v2[16]; int i1[16], i2[16];
#pragma unroll
        for (int half = 0; half < 2; ++half) {
            const v4u* qp = (const v4u*)(PQ + t * 2048 + h * 256 + half * 128);
            v4u q[16];
#pragma unroll
            for (int c = 0; c < 16; ++c) q[c] = qp[c];
            float tv[16]; int ti[16];
#pragma unroll
            for (int j = 0; j < 16; ++j) { tv[j] = -INFINITY; ti[j] = 0; }
            const LAS float* KK = half ? K2 : K1;
#pragma unroll 1
            for (int n = 0; n < 128; ++n) {
                float d = 0.f;
#pragma unroll
                for (int c = 0; c < 16; ++c) { const f32x4 ka = *(const LAS f32x4*)(KK + n * 128 + c * 8), kb = *(const LAS f32x4*)(KK + n * 128 + c * 8 + 4);
                    d += ka.x * bflo(q[c].x) + ka.y * bfhi(q[c].x) + ka.z * bflo(q[c].y) + ka.w * bfhi(q[c].y) + kb.x * bflo(q[c].z) + kb.y * bfhi(q[c].z) + kb.z * bflo(q[c].w) + kb.w * bfhi(q[c].w);
                    if ((c & 3) == 3) __builtin_amdgcn_sched_barrier(0); }
                TOP16_INSERT(tv, ti, d, n);
            }
#pragma unroll
            for (int j = 0; j < 16; ++j) { if (half) { v2[j] = tv[j]; i2[j] = ti[j]; } else { v1[j] = tv[j]; i1[j] = ti[j]; } }
        }
        float tv[16]; int ti[16];
#pragma unroll
        for (int j = 0; j < 16; ++j) { tv[j] = -INFINITY; ti[j] = 0; }
#pragma unroll
        for (int a = 0; a < 16; ++a)
#pragma unroll
            for (int c = 0; c < 16; ++c)
                if ((a + 1) * (c + 1) <= 16) { const float val = v1[a] + v2[c]; const int id = i1[a] * 128 + i2[c]; TOP16_INSERT(tv, ti, val, id); }
        float ev[16], sum = 0.f;
#pragma unroll
        for (int j = 0; j < 16; ++j) { ev[j] = __expf(tv[j] - tv[0]); sum += ev[j]; }
        const float inv = 1.0f / sum;
#pragma unroll
        for (int j8 = 0; j8 < 2; ++j8) {
            v4u w; w.x = (unsigned)ti[j8 * 8] | ((unsigned)ti[j8 * 8 + 1] << 16); w.y = (unsigned)ti[j8 * 8 + 2] | ((unsigned)ti[j8 * 8 + 3] << 16);
            w.z = (unsigned)ti[j8 * 8 + 4] | ((unsigned)ti[j8 * 8 + 5] << 16); w.w = (unsigned)ti[j8 * 8 + 6] | ((unsigned)ti[j8 * 8 + 7] << 16);
            *(v4u*)(IDS + t * 128 + h * 16 + j8 * 8) = w;
        }
#pragma unroll
        for (int j4 = 0; j4 < 4; ++j4)
            *(f32x4*)(GATES + t * 128 + h * 16 + j4 * 4) = (f32x4){ev[j4 * 4] * inv, ev[j4 * 4 + 1] * inv, ev[j4 * 4 + 2] * inv, ev[j4 * 4 + 3] * inv};
    }
}

#define MED16_INSERT(tv, key) do { _Pragma("unroll") for (int _j = 15; _j >= 1; --_j) tv[_j] = __builtin_amdgcn_fmed3f(tv[_j - 1], tv[_j], (key)); tv[0] = fmaxf(tv[0], (key)); } while (0)
__device__ __forceinline__ void p8_peer_route_mfma(Frame& F) {
    typedef short bf16x8 __attribute__((ext_vector_type(8)));
    typedef float f32x16 __attribute__((ext_vector_type(16)));
    const bf16* PQ = (const bf16*)(F.ws + WS_PQ); unsigned short* IDS = (unsigned short*)(F.ws + WS_IDS); float* GATES = (float*)(F.ws + WS_GATES);
    LAS bf16* KB = (LAS bf16*)(F.lds);
    for (int e = F.tid; e < 2 * 16384; e += NTHREADS) { const int hs = e >> 14, n = (e >> 7) & 127, d = e & 127;
        KB[hs * 128 * 136 + n * 136 + d] = (bf16)(pk2((hs ? F.a->in[I_SK2] : F.a->in[I_SK1])[n * 128 + d], 0.f) & 0xffffu); }
    __syncthreads();
    const int lane = F.lane, head = F.wave, r = lane & 31, h = lane >> 5;
    for (int tile = blockIdx.x; tile < T / 32; tile += F.G) {
        const size_t tok = (size_t)tile * 32 + r;
        float v1[16], v2[16];
#pragma unroll
        for (int half = 0; half < 2; ++half) {
            bf16x8 qf[8];
#pragma unroll
            for (int ks = 0; ks < 8; ++ks) qf[ks] = *(const bf16x8*)(PQ + tok * 2048 + head * 256 + half * 128 + 16 * ks + 8 * h);
            float tv[16];
#pragma unroll
            for (int j = 0; j < 16; ++j) tv[j] = -INFINITY;
#pragma unroll 1
            for (int kt = 0; kt < 4; ++kt) {
                f32x16 st;
#pragma unroll
                for (int i = 0; i < 16; ++i) st[i] = 0.f;
#pragma unroll
                for (int ks = 0; ks < 8; ++ks) { const bf16x8 a = *(const LAS bf16x8*)(KB + half * 128 * 136 + (32 * kt + r) * 136 + 16 * ks + 8 * h);
                    st = __builtin_amdgcn_mfma_f32_32x32x16_bf16(a, qf[ks], st, 0, 0, 0); }
#pragma unroll
                for (int i = 0; i < 16; ++i) { const unsigned id = (unsigned)(32 * kt + (i & 3) + 8 * (i >> 2) + 4 * h);
                    const float key = __uint_as_float((__float_as_uint(st[i]) & 0xffffff80u) | (127u - id)); MED16_INSERT(tv, key); }
            }
            float pv[16];
#pragma unroll
            for (int j = 0; j < 16; ++j) pv[j] = __shfl_xor(tv[j], 32);
#pragma unroll
            for (int j = 0; j < 16; ++j) { const float key = pv[j]; MED16_INSERT(tv, key); }
#pragma unroll
            for (int j = 0; j < 16; ++j) { if (half) v2[j] = tv[j]; else v1[j] = tv[j]; }
        }
        float tv[16];
#pragma unroll
        for (int j = 0; j < 16; ++j) tv[j] = -INFINITY;
#pragma unroll
        for (int a = 0; a < 16; ++a)
#pragma unroll
            for (int c = 0; c < 16; ++c)
                if ((a + 1) * (c + 1) <= 16) { const float key = __uint_as_float((__float_as_uint(v1[a] + v2[c]) & 0xffffff00u) | (unsigned)(255 - (16 * a + c))); MED16_INSERT(tv, key); }
        float ev[16], sum = 0.f;
#pragma unroll
        for (int j = 0; j < 16; ++j) { ev[j] = __expf(tv[j] - tv[0]); sum += ev[j]; }
        const float inv = 1.0f / sum;
        unsigned ids[16];
#pragma unroll
        for (int j = 0; j < 16; ++j) { const unsigned idx = 255u - (__float_as_uint(tv[j]) & 0xffu), a = idx >> 4, c = idx & 15u;
            unsigned ba = 0u, bc = 0u;
#pragma unroll
            for (int q = 0; q < 16; ++q) { ba = (a == (unsigned)q) ? __float_as_uint(v1[q]) : ba; bc = (c == (unsigned)q) ? __float_as_uint(v2[q]) : bc; }
            ids[j] = (127u - (ba & 0x7fu)) * 128u + (127u - (bc & 0x7fu)); }
        if (h == 0) {
#pragma unroll
            for (int j8 = 0; j8 < 2; ++j8) {
                v4u w; w.x = ids[j8 * 8] | (ids[j8 * 8 + 1] << 16); w.y = ids[j8 * 8 + 2] | (ids[j8 * 8 + 3] << 16);
                w.z = ids[j8 * 8 + 4] | (ids[j8 * 8 + 5] << 16); w.w = ids[j8 * 8 + 6] | (ids[j8 * 8 + 7] << 16);
                *(v4u*)(IDS + tok * 128 + head * 16 + j8 * 8) = w;
            }
#pragma unroll
            for (int j4 = 0; j4 < 4; ++j4)
                *(f32x4*)(GATES + tok * 128 + head * 16 + j4 * 4) = (f32x4){ev[j4 * 4] * inv, ev[j4 * 4 + 1] * inv, ev[j4 * 4 + 2] * inv, ev[j4 * 4 + 3] * inv};
        }
    }
}

template <int CTRL> __device__ __forceinline__ float dppf(float x) { return __builtin_bit_cast(float, __builtin_amdgcn_mov_dpp(__builtin_bit_cast(int, x), CTRL, 0xf, 0xf, true)); }
constexpr int Q_CHUNK = 32;
__device__ __forceinline__ void p9_u_phase(Frame& F) {
    const unsigned char* UT8 = F.ws + WS_UT8; const bf16* X1B = (const bf16*)(F.ws + WS_X1B); const unsigned short* IDS = (const unsigned short*)(F.ws + WS_IDS);
    float* HP = (float*)(F.ws + WS_HP); unsigned* qh = (unsigned*)(F.ws + WS_CTL) + CW_QU;
    const int lane = F.lane, sub = lane & 7, g = lane >> 3;
    const unsigned xcc = xb_xcc_id() & 7u;
    for (int s = 0; s < 8; ++s) {
        const int j = (int)((xcc + (unsigned)s) & 7u);
        const unsigned char* tab = UT8 + (size_t)j * 16384 * 128 + sub * 16;
        for (;;) {
            unsigned base = 0u; if (lane == 0) base = xb_add(qh + 64 * j, (unsigned)Q_CHUNK);
            base = (unsigned)__builtin_amdgcn_readfirstlane((int)base);
            if (base >= (unsigned)T) break;
#pragma unroll 1
            for (int tt = 0; tt < Q_CHUNK; ++tt) {
                const size_t t = (size_t)base + tt;
                const v4u xa = *(const v4u*)(X1B + t * 1024 + j * 128 + sub * 16), xb = *(const v4u*)(X1B + t * 1024 + j * 128 + sub * 16 + 8);
                const float xf[16] = {bflo(xa.x), bfhi(xa.x), bflo(xa.y), bfhi(xa.y), bflo(xa.z), bfhi(xa.z), bflo(xa.w), bfhi(xa.w), bflo(xb.x), bfhi(xb.x), bflo(xb.y), bfhi(xb.y), bflo(xb.z), bfhi(xb.z), bflo(xb.w), bfhi(xb.w)};
                const v4u ia = *(const v4u*)(IDS + t * 128 + g * 16), ib = *(const v4u*)(IDS + t * 128 + g * 16 + 8);
                const unsigned idw[8] = {ia.x, ia.y, ia.z, ia.w, ib.x, ib.y, ib.z, ib.w};
                v4u q[16];
#pragma unroll
                for (int i = 0; i < 16; ++i) { const unsigned e = (idw[i >> 1] >> (16 * (i & 1))) & 0xffffu; q[i] = *(const v4u*)(tab + (size_t)e * 128); }
                float hs0 = 0.f, hs1 = 0.f;
#pragma unroll
                for (int i = 0; i < 16; ++i) {
                    const f32x2 a0 = __builtin_amdgcn_cvt_pk_f32_fp8((int)q[i].x, false), a1 = __builtin_amdgcn_cvt_pk_f32_fp8((int)q[i].x, true);
                    const f32x2 b0 = __builtin_amdgcn_cvt_pk_f32_fp8((int)q[i].y, false), b1 = __builtin_amdgcn_cvt_pk_f32_fp8((int)q[i].y, true);
                    const f32x2 c0 = __builtin_amdgcn_cvt_pk_f32_fp8((int)q[i].z, false), c1 = __builtin_amdgcn_cvt_pk_f32_fp8((int)q[i].z, true);
                    const f32x2 d0 = __builtin_amdgcn_cvt_pk_f32_fp8((int)q[i].w, false), d1 = __builtin_amdgcn_cvt_pk_f32_fp8((int)q[i].w, true);
                    float p = (a0.x * xf[0] + a0.y * xf[1]) + (a1.x * xf[2] + a1.y * xf[3]) + (b0.x * xf[4] + b0.y * xf[5]) + (b1.x * xf[6] + b1.y * xf[7])
                            + (c0.x * xf[8] + c0.y * xf[9]) + (c1.x * xf[10] + c1.y * xf[11]) + (d0.x * xf[12] + d0.y * xf[13]) + (d1.x * xf[14] + d1.y * xf[15]);
                    p += dppf<0xB1>(p); p += dppf<0x4E>(p); p += dppf<0x141>(p);
                    if (i < 8) hs0 = (sub == i) ? p : hs0; else hs1 = (sub == i - 8) ? p : hs1;
                }
                float* hp = HP + ((size_t)j * T + t) * 128 + g * 16 + sub;
                hp[0] = hs0; hp[8] = hs1;
            }
        }
    }
}
__device__ __forceinline__ void p10_finalize(Frame& F) {
    const unsigned short* IDS = (const unsigned short*)(F.ws + WS_IDS); float* W = (float*)(F.ws + WS_GATES); const float* HP = (const float*)(F.ws + WS_HP);
    const float* UINV = (const float*)(F.ws + WS_UINV); const float* VINV = (const float*)(F.ws + WS_VINV);
    const size_t gtid = (size_t)blockIdx.x * NTHREADS + F.tid, gthreads = (size_t)F.G * NTHREADS;
    for (size_t idx = gtid; idx < (size_t)T * 128; idx += gthreads) {
        const unsigned e = IDS[idx]; float h = 0.f;
#pragma unroll
        for (int j = 0; j < 8; ++j) h += HP[(size_t)j * T * 128 + idx];
        h *= UINV[e];
        const float gl = 0.5f * h * (1.0f + erff(h * 0.7071067811865476f));
        W[idx] = W[idx] * gl * VINV[e];
    }
}
__device__ __forceinline__ void p11_v_phase(Frame& F) {
    const unsigned char* VT8 = F.ws + WS_VT8; const unsigned short* IDS = (const unsigned short*)(F.ws + WS_IDS); const float* W = (const float*)(F.ws + WS_GATES);
    float* FFN = (float*)(F.ws + WS_FFN); unsigned* qh = (unsigned*)(F.ws + WS_CTL) + CW_QV;
    const int lane = F.lane, sub = lane & 7, g = lane >> 3;
    const unsigned xcc = xb_xcc_id() & 7u;
    for (int s = 0; s < 8; ++s) {
        const int j = (int)((xcc + (unsigned)s) & 7u);
        const unsigned char* tab = VT8 + (size_t)j * 16384 * 128 + sub * 16;
        for (;;) {
            unsigned base = 0u; if (lane == 0) base = xb_add(qh + 64 * j, (unsigned)Q_CHUNK);
            base = (unsigned)__builtin_amdgcn_readfirstlane((int)base);
            if (base >= (unsigned)T) break;
#pragma unroll 1
            for (int tt = 0; tt < Q_CHUNK; ++tt) {
                const size_t t = (size_t)base + tt;
                const v4u ia = *(const v4u*)(IDS + t * 128 + g * 16), ib = *(const v4u*)(IDS + t * 128 + g * 16 + 8);
                const unsigned idw[8] = {ia.x, ia.y, ia.z, ia.w, ib.x, ib.y, ib.z, ib.w};
                const f32x4 w0 = *(const f32x4*)(W + t * 128 + g * 16), w1 = *(const f32x4*)(W + t * 128 + g * 16 + 4), w2 = *(const f32x4*)(W + t * 128 + g * 16 + 8), w3 = *(const f32x4*)(W + t * 128 + g * 16 + 12);
                const float wv[16] = {w0.x, w0.y, w0.z, w0.w, w1.x, w1.y, w1.z, w1.w, w2.x, w2.y, w2.z, w2.w, w3.x, w3.y, w3.z, w3.w};
                v4u q[16];
#pragma unroll
                for (int i = 0; i < 16; ++i) { const unsigned e = (idw[i >> 1] >> (16 * (i & 1))) & 0xffffu; q[i] = *(const v4u*)(tab + (size_t)e * 128); }
                float acc[16];
#pragma unroll
                for (int c = 0; c < 16; ++c) acc[c] = 0.f;
#pragma unroll
                for (int i = 0; i < 16; ++i) {
                    const unsigned qq[4] = {q[i].x, q[i].y, q[i].z, q[i].w};
#pragma unroll
                    for (int c = 0; c < 4; ++c) { const f32x2 lo = __builtin_amdgcn_cvt_pk_f32_fp8((int)qq[c], false), hi = __builtin_amdgcn_cvt_pk_f32_fp8((int)qq[c], true);
                        acc[4 * c] += wv[i] * lo.x; acc[4 * c + 1] += wv[i] * lo.y; acc[4 * c + 2] += wv[i] * hi.x; acc[4 * c + 3] += wv[i] * hi.y; }
                }
#pragma unroll
                for (int c = 0; c < 16; ++c) { float a = acc[c]; a += dppf<0x128>(a); a += __shfl_xor(a, 16); a += __shfl_xor(a, 32); acc[c] = a; }
                if (g == 0) { float* fp = FFN + t * 1024 + j * 128 + sub * 16;
                    *(f32x4*)(fp) = (f32x4){acc[0], acc[1], acc[2], acc[3]}; *(f32x4*)(fp + 4) = (f32x4){acc[4], acc[5], acc[6], acc[7]};
                    *(f32x4*)(fp + 8) = (f32x4){acc[8], acc[9], acc[10], acc[11]}; *(f32x4*)(fp + 12) = (f32x4){acc[12], acc[13], acc[14], acc[15]}; }
            }
        }
    }
}
__device__ __forceinline__ void p12_ln2(Frame& F) {
    float* X1 = F.a->out; const float* FFN = (const float*)(F.ws + WS_FFN); const float* g = F.a->in[I_LN2G]; const float* bb = F.a->in[I_LN2B];
    const int gw = blockIdx.x * NWAVES + F.wave, NGW = F.G * NWAVES, lane = F.lane;
    f32x4 gv[4], bv[4];
#pragma unroll
    for (int j = 0; j < 4; ++j) { gv[j] = ((const f32x4*)g)[lane + 64 * j]; bv[j] = ((const f32x4*)bb)[lane + 64 * j]; }
    for (int m = gw; m < T; m += NGW) {
        f32x4* xr = (f32x4*)(X1 + (size_t)m * DM) + lane; const f32x4* fr = (const f32x4*)(FFN + (size_t)m * DM) + lane;
        f32x4 v[4]; float s = 0.f;
#pragma unroll
        for (int j = 0; j < 4; ++j) { v[j] = xr[64 * j] * ALPHA + fr[64 * j]; s += (v[j].x + v[j].y) + (v[j].z + v[j].w); }
        const float mean = wave_sum(s) * (1.f / DM); float s2 = 0.f;
#pragma unroll
        for (int j = 0; j < 4; ++j) { v[j] = v[j] - mean; s2 += (v[j].x * v[j].x + v[j].y * v[j].y) + (v[j].z * v[j].z + v[j].w * v[j].w); }
        const float rstd = rsqrtf(wave_sum(s2) * (1.f / DM) + LN_EPS);
#pragma unroll
        for (int j = 0; j < 4; ++j) xr[64 * j] = v[j] * rstd * gv[j] + bv[j];
    }
}

__global__ void __launch_bounds__(NTHREADS, 2) hybrid_fwd(Args args) {
    extern __shared__ __attribute__((aligned(16))) unsigned char lds[];
    Frame F;
    F.lds = (LAS unsigned char*)lds;
    F.tid = threadIdx.x; F.lane = F.tid & 63; F.wave = __builtin_amdgcn_readfirstlane(F.tid >> 6);
    F.G = gridDim.x; F.a = (KArgs)__builtin_amdgcn_kernarg_segment_ptr(); F.ws = args.ws;
#define FRESH() do { int _t = threadIdx.x; asm volatile("" : "+v"(_t)); F.tid = _t; F.lane = _t & 63; F.wave = __builtin_amdgcn_readfirstlane(_t >> 6); \
        KArgs _k = (KArgs)__builtin_amdgcn_kernarg_segment_ptr(); asm volatile("" : "+s"(_k)); F.a = _k; F.ws = _k->ws; } while (0)
    volatile LAS unsigned* MISC = (volatile LAS unsigned*)(F.lds + MISC_OFF);
    for (int u = F.tid; u < (LDS_BYTES - LDSCTL_OFF) / 4; u += NTHREADS) ((LAS unsigned*)(F.lds + LDSCTL_OFF))[u] = 0u;
    __syncthreads();
    const int lo = args.ph_lo, hi = args.ph_hi;
    const bool need_bar = (hi - lo) > 1;
    XcdBarrier bar; bar.bar = (unsigned*)(args.ws + WS_CTL) + CW_BAR + args.li * XCD_BAR_WORDS; bar.x = 0; bar.st = nullptr;
    if (need_bar) bar = xcd_barrier_post(bar.bar, MISC + 8);
#if defined(PHASE_MASK)
#define IN(k) (((PHASE_MASK >> (k)) & 1) && lo <= (k) && (k) < hi)
#elif defined(ONLY_PHASE)
#define IN(k) ((k) == ONLY_PHASE && lo <= (k) && (k) < hi)
#else
#define IN(k) (lo <= (k) && (k) < hi)
#endif
#define SEAM(k) do { if (IN(k) && IN((k) + 1)) xcd_barrier(bar); } while (0)
    LAS unsigned char* ring = F.lds;

    if (IN(0)) { FRESH(); p0_prologue(F); }
    SEAM(0);
    if (IN(1)) {
        FRESH();
        pg8::Gemm g{(const bf16*)(F.ws + WS_XB), (const bf16*)(F.ws + WS_WIN), T, NPROJ, 1024}; pg8::StaticOrder S; S.init(T, NPROJ, F.G, (int)blockIdx.x);
        EpiProj E{F.ws};
        pg8::gemm_phase<EpiProj, pg8::StaticOrder>(ring, g, S, E, F.tid);
    }
    SEAM(1);
    if (IN(2)) {
        FRESH();
#if !defined(P2SEL) || (P2SEL & 1)
        p2_ckv_norm(F);
#endif
#if !defined(P2SEL) || (P2SEL & 2)
#if defined(HGRN_DEBUG)
        p2_hgrn_chunked(F, (bf16*)(F.ws + WS_END), 16);
        __syncthreads();
        FRESH();
        p2_hgrn_simple(F);
        VM_WAIT(); __syncthreads();
        FRESH();
        {
            unsigned* ctl = (unsigned*)(F.ws + WS_CTL);
            const bf16* A_ = (const bf16*)(F.ws + WS_END); const bf16* B_ = (const bf16*)(F.ws + WS_IB);
            float mx = 0.f; unsigned nn = 0;
            for (int item = blockIdx.x; item < NB * 4; item += F.G) { const int b = item >> 2, h = item & 3; if (b >= 16) continue;
                for (int e = F.tid; e < SEQ * 128; e += NTHREADS) { const size_t o = ((size_t)b * SEQ + (e >> 7)) * 512 + h * 128 + (e & 127);
                    const float x = bf2f(A_[o]), y = bf2f(B_[o]); if (x != x) ++nn; const float df = fabsf(x - y); if (df == df) mx = fmaxf(mx, df); } }
            mx = wave_max(mx); nn = (unsigned)wave_sum((float)nn);
            if (F.lane == 0) { atomicMax(ctl + 2048, __float_as_uint(mx)); atomicAdd(ctl + 2112, nn); }
        }
#elif defined(HGRN_SIMPLE)
        p2_hgrn_simple(F);
#else
        p2_hgrn_chunked(F, (bf16*)(F.ws + WS_IB), NB);
#endif
#endif
        __syncthreads();
        FRESH();
#if !defined(P2SEL) || (P2SEL & 4)
        p2_indexer_simple(F);
#endif
    }
    SEAM(2);
    if (IN(3)) { FRESH(); p3_hg_finalize(F); __syncthreads(); FRESH();
#ifdef ATTN_SIMPLE
        p3_attn_simple(F);
#else
        p3_attn_mfma(F);
#endif
    }
    SEAM(3);
    if (IN(4)) {
        FRESH();
        { pg8::Gemm g{(const bf16*)(F.ws + WS_QL), (const bf16*)(F.ws + WS_WA), T, 1024, 1024}; pg8::StaticOrder S; S.init(T, 1024, F.G, (int)blockIdx.x);
          EpiBranch<0> E{(const bf16*)(F.ws + WS_GA), (bf16*)(F.ws + WS_MERGED)};
          pg8::gemm_phase<EpiBranch<0>, pg8::StaticOrder>(ring, g, S, E, F.tid); }
        FRESH();
        { pg8::Gemm g{(const bf16*)(F.ws + WS_IB), (const bf16*)(F.ws + WS_WB), T, 1024, 512}; pg8::StaticOrder S; S.init(T, 1024, F.G, (int)blockIdx.x);
          EpiBranch<1> E{(const bf16*)(F.ws + WS_GBT), (bf16*)(F.ws + WS_MERGED)};
          pg8::gemm_phase<EpiBranch<1>, pg8::StaticOrder>(ring, g, S, E, F.tid); }
    }
    SEAM(4);
    if (IN(5)) {
        FRESH();
        pg8::Gemm g{(const bf16*)(F.ws + WS_MERGED), (const bf16*)(F.ws + WS_WO), T, 1024, 1024}; pg8::StaticOrder S; S.init(T, 1024, F.G, (int)blockIdx.x);
        EpiResF32 E{F.a->in[I_X], F.a->out};
        pg8::gemm_phase<EpiResF32, pg8::StaticOrder>(ring, g, S, E, F.tid);
    }
    SEAM(5);
    if (IN(6)) { FRESH(); p6_ln1(F); }
    SEAM(6);
    if (IN(7)) {
        FRESH();
        pg8::Gemm g{(const bf16*)(F.ws + WS_X1B), (const bf16*)(F.ws + WS_WPQ), T, 2048, 1024}; pg8::StaticOrder S; S.init(T, 2048, F.G, (int)blockIdx.x);
        EpiPlainBf16 E{(bf16*)(F.ws + WS_PQ), 2048};
        pg8::gemm_phase<EpiPlainBf16, pg8::StaticOrder>(ring, g, S, E, F.tid);
    }
    SEAM(7);
    if (IN(8)) { FRESH();
#ifdef ROUTE_SIMPLE
        p8_peer_route_simple(F);
#else
        p8_peer_route_mfma(F);
#endif
    }
    SEAM(8);
    if (IN(9)) { FRESH(); p9_u_phase(F); }
    SEAM(9);
    if (IN(10)) { FRESH(); p10_finalize(F); }
    SEAM(10);
    if (IN(11)) { FRESH(); p11_v_phase(F); }
    SEAM(11);
    if (IN(12)) { FRESH(); p12_ln2(F); }
#undef IN
#undef SEAM
}

extern "C" void kernel_launch(void* const* d_in, const int* in_sizes, int n_in, void* d_out, int out_size, void* d_ws, size_t ws_size, hipStream_t stream) {
    static int grid = 0;
    if (grid == 0) {
        if (n_in != 20 || out_size != T * DM || ws_size < WS_END) { fprintf(stderr, "kernel_launch: unexpected problem (n_in %d out %d ws %zu)\n", n_in, out_size, ws_size); grid = -1; return; }
        int dev = 0, cus = 0;
        if (hipGetDevice(&dev) != hipSuccess || hipDeviceGetAttribute(&cus, hipDeviceAttributeMultiprocessorCount, dev) != hipSuccess) { grid = -1; return; }
        if (hipFuncSetAttribute((const void*)hybrid_fwd, hipFuncAttributeMaxDynamicSharedMemorySize, LDS_BYTES) != hipSuccess) { fprintf(stderr, "kernel_launch: hipFuncSetAttribute failed\n"); grid = -1; return; }
        int per_cu = 0;
        if (hipOccupancyMaxActiveBlocksPerMultiprocessor(&per_cu, (const void*)hybrid_fwd, NTHREADS, LDS_BYTES) != hipSuccess || per_cu < 1) fprintf(stderr, "kernel_launch: occupancy query reports %d\n", per_cu);
        (void)hipGetLastError();
        grid = cus;
    }
    if (grid < 0) return;
    (void)hipMemsetAsync((char*)d_ws + WS_CTL, 0, CTL_ZERO_BYTES, stream);
    Args a{};
    for (int i = 0; i < 20; ++i) a.in[i] = (const float*)d_in[i];
    a.out = (float*)d_out; a.ws = (unsigned char*)d_ws;
    constexpr int NL = MK_N_LAUNCHES;
    for (int li = 0; li < NL; ++li) {
        a.ph_lo = (NL == 1) ? 0 : li; a.ph_hi = (NL == 1) ? N_PHASES : li + 1; a.li = li;
        hipLaunchKernelGGL(hybrid_fwd, dim3(grid), dim3(NTHREADS), LDS_BYTES, stream, a);
    }
}
```

```cpp
#include <hip/hip_runtime.h>
#include <cstdio>
#include <cstdint>

#ifndef MK_N_LAUNCHES
#define MK_N_LAUNCHES 1
#endif

namespace pg8 {
#define PG8_LAS __attribute__((address_space(3)))
typedef unsigned short bf16_t;
typedef short bf16x8 __attribute__((ext_vector_type(8)));
typedef float f32x4 __attribute__((ext_vector_type(4)));
typedef unsigned u32x4 __attribute__((ext_vector_type(4)));
constexpr int BM = 256, BK = 64, HALF = 128, HTB = HALF * BK * 2, STAGE_BYTES = 8 * HTB, NXCD = 8, WGM = 8;

__host__ __device__ __forceinline__ int lds_byte(int r, int c) { const int st = (r >> 4) * 2 + (c >> 5), rr = r & 15, cc = c & 31, ob = rr * 64 + cc * 2; return st * 1024 + (ob ^ (((ob >> 9) & 1) << 5)); }
__host__ __device__ __forceinline__ void stage_rc(int b, int& R, int& C) { const int st = b / 1024, sb = b % 1024, swz = sb ^ (((sb >> 9) & 1) << 5); R = (st >> 1) * 16 + swz / 64; C = (st & 1) * 32 + (swz % 64) / 2; }
__host__ __device__ __forceinline__ int perm32(int rho) { const int n = rho >> 4, i = rho & 15; return 8 * (i >> 2) + 4 * n + (i & 3); }

struct Unit { int pm, pn; };
struct Gemm { const bf16_t* A; const bf16_t* Bt; int M, N, K; };

struct StaticOrder {
    int nM, nN, nwg, G, c;
    __host__ __device__ void init(int M, int N, int G_, int c_) { nM = M / BM; nN = N / BM; nwg = nM * nN; G = G_; c = c_; }
    __host__ __device__ bool next(int i, Unit& u) const {
        const long L = (long)i * G + c; if (L >= nwg) return false;
        int wgid = (int)L; { const int q = nwg / NXCD, r = nwg % NXCD, xcd = wgid % NXCD, off = wgid / NXCD; wgid = (xcd < r ? xcd * (q + 1) : r * (q + 1) + (xcd - r) * q) + off; }
        const int nig = WGM * nN, gid = wgid / nig, fm = gid * WGM, gsz = (nM - fm) < WGM ? (nM - fm) : WGM;
        u.pm = fm + ((wgid % nig) % gsz); u.pn = (wgid % nig) / gsz; return true;
    }
    __device__ __forceinline__ void a_ready(const Unit&) const {}
    __device__ __forceinline__ void done(const Unit&) const {}
};

__device__ __forceinline__ unsigned cvt_pk_bf16(float lo, float hi) { unsigned r; asm volatile("v_cvt_pk_bf16_f32 %0, %1, %2" : "=v"(r) : "v"(lo), "v"(hi)); return r; }

template <class Epi, class Sched>
__device__ __forceinline__ void gemm_phase(PG8_LAS unsigned char* lds, const Gemm g, const Sched& S, const Epi& E, const int tid) {
    const int wid = __builtin_amdgcn_readfirstlane(tid >> 6), lane = tid & 63, wr = wid >> 2, wc = wid & 3, fr = lane & 15, fq = lane >> 4;
    const int K = g.K, nt = K / BK;
    unsigned voffA[2], voffB[2];
#pragma unroll
    for (int i = 0; i < 2; ++i) { int R, C; stage_rc(tid * 16 + i * 8192, R, C); const int Rb = Epi::PERM ? ((R & ~31) + perm32(R & 31)) : R;
        voffA[i] = (unsigned)(R * K + C) * 2u; voffB[i] = (unsigned)(Rb * K + C) * 2u; }
    const size_t kstep = (size_t)(BK * 2);
    const size_t hstep = (size_t)HALF * K * 2;
    const size_t tstep = 2 * hstep;
    const unsigned ldsw = (unsigned)wid * 1024u;
    const int aoff = lds_byte(wr * 64 + fr, fq * 8), boff = lds_byte(wc * 32 + fr, fq * 8);
#define PG8_SA(b, h) (((b) * 2 + (h)) * HTB)
#define PG8_SB(b, h) ((4 + (b) * 2 + (h)) * HTB)
#define PG8_STAGE(bufoff, gbase, voff) do { _Pragma("unroll") for (int _i = 0; _i < 2; ++_i) \
        __builtin_amdgcn_global_load_lds((const unsigned*)((const char*)(gbase) + (voff)[_i]), (PG8_LAS unsigned*)(lds + (bufoff) + ldsw + _i * 8192), 16, 0, 0); } while (0)
#define PG8_LDA(dst, b, h) do { _Pragma("unroll") for (int m = 0; m < 4; ++m) _Pragma("unroll") for (int k = 0; k < 2; ++k) dst[m][k] = *(const PG8_LAS bf16x8*)(lds + PG8_SA(b, h) + aoff + m * 2048 + k * 1024); } while (0)
#define PG8_LDB(dst, b, h) do { _Pragma("unroll") for (int n = 0; n < 2; ++n) _Pragma("unroll") for (int k = 0; k < 2; ++k) dst[n][k] = *(const PG8_LAS bf16x8*)(lds + PG8_SB(b, h) + boff + n * 2048 + k * 1024); } while (0)
#define PG8_MMA(ai, bj, At, Bt) do { __builtin_amdgcn_s_setprio(1); _Pragma("unroll") for (int m = 0; m < 4; ++m) _Pragma("unroll") for (int n = 0; n < 2; ++n) _Pragma("unroll") for (int k = 0; k < 2; ++k) \
        acc[ai][bj][m][n] = __builtin_amdgcn_mfma_f32_16x16x32_bf16(Bt[n][k], At[m][k], acc[ai][bj][m][n], 0, 0, 0); __builtin_amdgcn_s_setprio(0); } while (0)
#define PG8_WAIT_V(n) asm volatile("s_waitcnt vmcnt(" #n ")" ::: "memory")
#define PG8_WAIT_L(n) asm volatile("s_waitcnt lgkmcnt(" #n ")" ::: "memory")
#define PG8_BAR __builtin_amdgcn_s_barrier()
#define PG8_SCHED __builtin_amdgcn_sched_barrier(0)
    Unit cur, nxt; int ui = 0;
    if (!S.next(0, cur)) return;
    f32x4 acc[2][2][4][2];
#pragma unroll
    for (int a = 0; a < 2; ++a)
#pragma unroll
        for (int b = 0; b < 2; ++b)
#pragma unroll
            for (int m = 0; m < 4; ++m)
#pragma unroll
                for (int n = 0; n < 2; ++n) acc[a][b][m][n] = (f32x4){0.f, 0.f, 0.f, 0.f};
    bf16x8 At[4][2], B0[2][2], B1[2][2];
    const char* cA = (const char*)g.A + (size_t)cur.pm * tstep; const char* cB = (const char*)g.Bt + (size_t)cur.pn * tstep;
    S.a_ready(cur);
    PG8_STAGE(PG8_SB(0, 0), cB, voffB); PG8_STAGE(PG8_SA(0, 0), cA, voffA); PG8_STAGE(PG8_SB(0, 1), cB + hstep, voffB); PG8_STAGE(PG8_SA(0, 1), cA + hstep, voffA);
    if (wr == 1) PG8_BAR;
    PG8_WAIT_V(4); PG8_BAR;
    PG8_STAGE(PG8_SB(1, 0), cB + kstep, voffB); PG8_STAGE(PG8_SA(1, 0), cA + kstep, voffA); PG8_STAGE(PG8_SB(1, 1), cB + hstep + kstep, voffB);
    PG8_WAIT_V(6); PG8_BAR;
    for (;;) {
        const bool has_next = S.next(ui + 1, nxt);
        const char* nA = has_next ? (const char*)g.A + (size_t)nxt.pm * tstep : cA; const char* nB = has_next ? (const char*)g.Bt + (size_t)nxt.pn * tstep : cB;
        for (int t = 0; t < nt; t += 2) {
            const bool last = (t == nt - 2);
            const char* a1 = cA + (size_t)(t + 1) * kstep;
            const char* a2 = last ? nA : cA + (size_t)(t + 2) * kstep; const char* b2 = last ? nB : cB + (size_t)(t + 2) * kstep;
            const char* a3 = a2 + kstep; const char* b3 = b2 + kstep;
            if (last && has_next) S.a_ready(nxt);
            PG8_LDB(B0, 0, 0); PG8_SCHED; PG8_LDA(At, 0, 0); PG8_STAGE(PG8_SA(1, 1), a1 + hstep, voffA);
            PG8_WAIT_L(8); PG8_BAR; PG8_WAIT_L(0); PG8_MMA(0, 0, At, B0); PG8_BAR; PG8_SCHED;
            PG8_LDB(B1, 0, 1); PG8_STAGE(PG8_SB(0, 0), b2, voffB);
            PG8_BAR; PG8_WAIT_L(0); PG8_MMA(0, 1, At, B1); PG8_BAR;
            PG8_LDA(At, 0, 1); PG8_STAGE(PG8_SA(0, 0), a2, voffA);
            PG8_BAR; PG8_WAIT_L(0); PG8_MMA(1, 0, At, B0); PG8_BAR; PG8_SCHED;
            PG8_STAGE(PG8_SB(0, 1), b2 + hstep, voffB);
            PG8_WAIT_V(6); PG8_BAR; PG8_MMA(1, 1, At, B1); PG8_BAR;
            PG8_LDB(B0, 1, 0); PG8_SCHED; PG8_LDA(At, 1, 0); PG8_STAGE(PG8_SA(0, 1), a2 + hstep, voffA);
            PG8_WAIT_L(8); PG8_BAR; PG8_WAIT_L(0); PG8_MMA(0, 0, At, B0); PG8_BAR; PG8_SCHED;
            PG8_LDB(B1, 1, 1); PG8_STAGE(PG8_SB(1, 0), b3, voffB);
            PG8_BAR; PG8_WAIT_L(0); PG8_MMA(0, 1, At, B1); PG8_BAR;
            PG8_LDA(At, 1, 1); PG8_STAGE(PG8_SA(1, 0), a3, voffA);
            PG8_BAR; PG8_WAIT_L(0); PG8_MMA(1, 0, At, B0); PG8_BAR; PG8_SCHED;
            PG8_STAGE(PG8_SB(1, 1), b3 + hstep, voffB);
            PG8_WAIT_V(6); PG8_BAR; PG8_MMA(1, 1, At, B1); PG8_BAR;
        }
        E(acc, cur, wr, wc, fr, fq); S.done(cur);
        if (!has_next) break;
#pragma unroll
        for (int a = 0; a < 2; ++a)
#pragma unroll
            for (int b = 0; b < 2; ++b)
#pragma unroll
                for (int m = 0; m < 4; ++m)
#pragma unroll
                    for (int n = 0; n < 2; ++n) acc[a][b][m][n] = (f32x4){0.f, 0.f, 0.f, 0.f};
        cur = nxt; cA = nA; cB = nB; ++ui;
    }
    PG8_WAIT_V(0);
    if (wr == 0) PG8_BAR;
    PG8_BAR;
#undef PG8_SA
#undef PG8_SB
#undef PG8_STAGE
#undef PG8_LDA
#undef PG8_LDB
#undef PG8_MMA
#undef PG8_WAIT_V
#undef PG8_WAIT_L
#undef PG8_BAR
#undef PG8_SCHED
}
template <class Epi, class Sched>
__device__ __forceinline__ void gemm_phase2(PG8_LAS unsigned char* lds, const Gemm g, const Gemm g2, const Sched& S, const Epi& E, const int tid) {
    const int wid = __builtin_amdgcn_readfirstlane(tid >> 6), lane = tid & 63, wr = wid >> 2, wc = wid & 3, fr = lane & 15, fq = lane >> 4;
    const int K = g.K, nt1 = K / BK, nt = nt1 + g2.K / BK;
    unsigned voffA[2], voffB[2];
#pragma unroll
    for (int i = 0; i < 2; ++i) { int R, C; stage_rc(tid * 16 + i * 8192, R, C); const int Rb = Epi::PERM ? ((R & ~31) + perm32(R & 31)) : R;
        voffA[i] = (unsigned)(R * K + C) * 2u; voffB[i] = (unsigned)(Rb * K + C) * 2u; }
    const size_t kstep = (size_t)(BK * 2);
    const size_t hstep = (size_t)HALF * K * 2;
    const size_t tstep = 2 * hstep;
    const unsigned ldsw = (unsigned)wid * 1024u;
    const int aoff = lds_byte(wr * 64 + fr, fq * 8), boff = lds_byte(wc * 32 + fr, fq * 8);
#define PG8_SA(b, h) (((b) * 2 + (h)) * HTB)
#define PG8_SB(b, h) ((4 + (b) * 2 + (h)) * HTB)
#define PG8_STAGE(bufoff, gbase, voff) do { _Pragma("unroll") for (int _i = 0; _i < 2; ++_i) \
        __builtin_amdgcn_global_load_lds((const unsigned*)((const char*)(gbase) + (voff)[_i]), (PG8_LAS unsigned*)(lds + (bufoff) + ldsw + _i * 8192), 16, 0, 0); } while (0)
#define PG8_LDA(dst, b, h) do { _Pragma("unroll") for (int m = 0; m < 4; ++m) _Pragma("unroll") for (int k = 0; k < 2; ++k) dst[m][k] = *(const PG8_LAS bf16x8*)(lds + PG8_SA(b, h) + aoff + m * 2048 + k * 1024); } while (0)
#define PG8_LDB(dst, b, h) do { _Pragma("unroll") for (int n = 0; n < 2; ++n) _Pragma("unroll") for (int k = 0; k < 2; ++k) dst[n][k] = *(const PG8_LAS bf16x8*)(lds + PG8_SB(b, h) + boff + n * 2048 + k * 1024); } while (0)
#define PG8_MMA(ai, bj, At, Bt) do { __builtin_amdgcn_s_setprio(1); _Pragma("unroll") for (int m = 0; m < 4; ++m) _Pragma("unroll") for (int n = 0; n < 2; ++n) _Pragma("unroll") for (int k = 0; k < 2; ++k) \
        acc[ai][bj][m][n] = __builtin_amdgcn_mfma_f32_16x16x32_bf16(Bt[n][k], At[m][k], acc[ai][bj][m][n], 0, 0, 0); __builtin_amdgcn_s_setprio(0); } while (0)
#define PG8_WAIT_V(n) asm volatile("s_waitcnt vmcnt(" #n ")" ::: "memory")
#define PG8_WAIT_L(n) asm volatile("s_waitcnt lgkmcnt(" #n ")" ::: "memory")
#define PG8_BAR __builtin_amdgcn_s_barrier()
#define PG8_SCHED __builtin_amdgcn_sched_barrier(0)
    Unit cur, nxt; int ui = 0;
    if (!S.next(0, cur)) return;
    f32x4 acc[2][2][4][2];
#pragma unroll
    for (int a = 0; a < 2; ++a)
#pragma unroll
        for (int b = 0; b < 2; ++b)
#pragma unroll
            for (int m = 0; m < 4; ++m)
#pragma unroll
                for (int n = 0; n < 2; ++n) acc[a][b][m][n] = (f32x4){0.f, 0.f, 0.f, 0.f};
    bf16x8 At[4][2], B0[2][2], B1[2][2];
    const char* cA = (const char*)g.A + (size_t)cur.pm * tstep; const char* cB = (const char*)g.Bt + (size_t)cur.pn * tstep;
    S.a_ready(cur);
    PG8_STAGE(PG8_SB(0, 0), cB, voffB); PG8_STAGE(PG8_SA(0, 0), cA, voffA); PG8_STAGE(PG8_SB(0, 1), cB + hstep, voffB); PG8_STAGE(PG8_SA(0, 1), cA + hstep, voffA);
    if (wr == 1) PG8_BAR;
    PG8_WAIT_V(4); PG8_BAR;
    PG8_STAGE(PG8_SB(1, 0), cB + kstep, voffB); PG8_STAGE(PG8_SA(1, 0), cA + kstep, voffA); PG8_STAGE(PG8_SB(1, 1), cB + hstep + kstep, voffB);
    PG8_WAIT_V(6); PG8_BAR;
    for (;;) {
        const bool has_next = S.next(ui + 1, nxt);
        const char* nA = has_next ? (const char*)g.A + (size_t)nxt.pm * tstep : cA; const char* nB = has_next ? (const char*)g.Bt + (size_t)nxt.pn * tstep : cB;
        const char* cA2 = (const char*)g2.A + (size_t)cur.pm * tstep - (size_t)nt1 * kstep; const char* cB2 = (const char*)g2.Bt + (size_t)cur.pn * tstep - (size_t)nt1 * kstep;
        for (int t = 0; t < nt; t += 2) {
            const bool last = (t == nt - 2);
            if (t == nt1) E.mid(acc, cur, wr, wc, fr, fq);
            const char* a1 = (t >= nt1 ? cA2 : cA) + (size_t)(t + 1) * kstep;
            const char* a2 = last ? nA : (t + 2 >= nt1 ? cA2 : cA) + (size_t)(t + 2) * kstep; const char* b2 = last ? nB : (t + 2 >= nt1 ? cB2 : cB) + (size_t)(t + 2) * kstep;
            const char* a3 = a2 + kstep; const char* b3 = b2 + kstep;
            if (last && has_next) S.a_ready(nxt);
            PG8_LDB(B0, 0, 0); PG8_SCHED; PG8_LDA(At, 0, 0); PG8_STAGE(PG8_SA(1, 1), a1 + hstep, voffA);
            PG8_WAIT_L(8); PG8_BAR; PG8_WAIT_L(0); PG8_MMA(0, 0, At, B0); PG8_BAR; PG8_SCHED;
            PG8_LDB(B1, 0, 1); PG8_STAGE(PG8_SB(0, 0), b2, voffB);
            PG8_BAR; PG8_WAIT_L(0); PG8_MMA(0, 1, At, B1); PG8_BAR;
            PG8_LDA(At, 0, 1); PG8_STAGE(PG8_SA(0, 0), a2, voffA);
            PG8_BAR; PG8_WAIT_L(0); PG8_MMA(1, 0, At, B0); PG8_BAR; PG8_SCHED;
            PG8_STAGE(PG8_SB(0, 1), b2 + hstep, voffB);
            PG8_WAIT_V(6); PG8_BAR; PG8_MMA(1, 1, At, B1); PG8_BAR;
            PG8_LDB(B0, 1, 0); PG8_SCHED; PG8_LDA(At, 1, 0); PG8_STAGE(PG8_SA(0, 1), a2 + hstep, voffA);
            PG8_WAIT_L(8); PG8_BAR; PG8_WAIT_L(0); PG8_MMA(0, 0, At, B0); PG8_BAR; PG8_SCHED;
            PG8_LDB(B1, 1, 1); PG8_STAGE(PG8_SB(1, 0), b3, voffB);
            PG8_BAR; PG8_WAIT_L(0); PG8_MMA(0, 1, At, B1); PG8_BAR;
            PG8_LDA(At, 1, 1); PG8_STAGE(PG8_SA(1, 0), a3, voffA);
            PG8_BAR; PG8_WAIT_L(0); PG8_MMA(1, 0, At, B0); PG8_BAR; PG8_SCHED;
            PG8_STAGE(PG8_SB(1, 1), b3 + hstep, voffB);
            PG8_WAIT_V(6); PG8_BAR; PG8_MMA(1, 1, At, B1); PG8_BAR;
        }
        E(acc, cur, wr, wc, fr, fq); S.done(cur);
        if (!has_next) break;
#pragma unroll
        for (int a = 0; a < 2; ++a)
#pragma unroll
            for (int b = 0; b < 2; ++b)
#pragma unroll
                for (int m = 0; m < 4; ++m)
#pragma unroll
                    for (int n = 0; n < 2; ++n) acc[a][b][m][n] = (f32x4){0.f, 0.f, 0.f, 0.f};
        cur = nxt; cA = nA; cB = nB; ++ui;
    }
    PG8_WAIT_V(0);
    if (wr == 0) PG8_BAR;
    PG8_BAR;
#undef PG8_SA
#undef PG8_SB
#undef PG8_STAGE
#undef PG8_LDA
#undef PG8_LDB
#undef PG8_MMA
#undef PG8_WAIT_V
#undef PG8_WAIT_L
#undef PG8_BAR
#undef PG8_SCHED
}
}

constexpr int NWAVES = 8, NTHREADS = 512;
constexpr int NB = 32, SEQ = 2048, DM = 1024, T = NB * SEQ;
constexpr int IN_COLS = 5320, NPROJ = 5888;
constexpr int N_PHASES = 13;
constexpr float ALPHA = 1.189207115002721f;
constexpr float LN_EPS = 1e-5f, RMS_EPS = 1e-6f;
constexpr float LOG2E = 1.4426950408889634f, QSCALE = 0.125f * LOG2E;

constexpr size_t MiB = 1u << 20;
constexpr size_t WS_CTL = 0, CTL_ZERO_BYTES = 64 * 1024;
constexpr size_t WS_WIN = 1 * MiB, WS_WA = 13 * MiB, WS_WB = 60 * MiB, WS_WO = 16 * MiB, WS_WPQ = 18 * MiB;
constexpr size_t WS_UT8 = 24 * MiB, WS_VT8 = 40 * MiB, WS_UINV = 56 * MiB, WS_VINV = 56 * MiB + 65536;
constexpr size_t WS_XB = 88 * MiB;
constexpr size_t WS_QL = 216 * MiB;
constexpr size_t WS_MISC = 344 * MiB;
constexpr size_t WS_CKV = 376 * MiB;
constexpr size_t WS_QI = 392 * MiB, WS_QB = 456 * MiB, WS_FB = 520 * MiB, WS_IB = 584 * MiB, WS_GB = 648 * MiB;
constexpr size_t WS_GA = 712 * MiB, WS_GBT = 776 * MiB;
constexpr size_t WS_HO = 840 * MiB;
constexpr size_t WS_BM = 968 * MiB;
constexpr size_t WS_END = 984 * MiB;
constexpr size_t WS_MERGED = WS_QI, WS_X1B = WS_QL, WS_PQ = WS_QI, WS_IDS = WS_GB, WS_GATES = WS_GB + 32 * MiB, WS_HP = WS_GA, WS_FFN = WS_XB;
constexpr size_t WS_STATS = 22 * MiB;
constexpr size_t WS_X8 = WS_XB, WS_XINV = 22 * MiB + 512 * 1024;
constexpr int CW_QU = 8192, CW_QV = 8192 + 512;
constexpr int CW_QIDX = 8192 + 1024;
constexpr int CW_BAR = 4096;

constexpr int RING_BYTES = 131072;
constexpr int LDS_BYTES = 163840;
constexpr int LDSCTL_OFF = LDS_BYTES - 512, MISC_OFF = LDSCTL_OFF + 320;

#define GAS __attribute__((address_space(1)))
#define LAS __attribute__((address_space(3)))
typedef unsigned short bf16;
typedef unsigned v4u __attribute__((ext_vector_type(4)));
typedef unsigned v2u __attribute__((ext_vector_type(2)));
typedef float f32x4 __attribute__((ext_vector_type(4)));
typedef float f32x2 __attribute__((ext_vector_type(2)));
typedef GAS unsigned gu32;
#define RLX_AGENT __ATOMIC_RELAXED, __HIP_MEMORY_SCOPE_AGENT
#define LDS_WAIT() asm volatile("s_waitcnt lgkmcnt(0)" ::: "memory")
#define VM_WAIT() asm volatile("s_waitcnt vmcnt(0)" ::: "memory")
typedef __bf16 bf16x2_t __attribute__((ext_vector_type(2)));
__device__ __forceinline__ unsigned pk2(float lo, float hi) { const bf16x2_t v = {(__bf16)lo, (__bf16)hi}; return __builtin_bit_cast(unsigned, v); }
__device__ __forceinline__ float bflo(unsigned u) { return __uint_as_float(u << 16); }
__device__ __forceinline__ float bfhi(unsigned u) { return __uint_as_float(u & 0xffff0000u); }
__device__ __forceinline__ float bf2f(bf16 b) { return __uint_as_float(((unsigned)b) << 16); }
__device__ __forceinline__ float sigmoidf_(float x) { return __builtin_amdgcn_rcpf(1.0f + __expf(-x)); }

#define XB_TMO      128
#define XB_XCNT(j)  (256  + 64 * (j))
#define XB_XSUB(j)  (1280 + 64 * (j))
#define XB_XGEN(j)  (2304 + 64 * (j))
#define XB_TOP      3328
#define XB_TOPGEN   3392
#define XCD_BAR_WORDS 3456
#define XB_SPIN_CAP (1u << 22)
__device__ __forceinline__ unsigned xb_ld(unsigned* p)              { return __hip_atomic_load(p, __ATOMIC_RELAXED, __HIP_MEMORY_SCOPE_AGENT); }
__device__ __forceinline__ unsigned xb_add(unsigned* p, unsigned v) { return __hip_atomic_fetch_add(p, v, __ATOMIC_RELAXED, __HIP_MEMORY_SCOPE_AGENT); }
__device__ __forceinline__ unsigned xb_xcc_id() { return (unsigned)__builtin_amdgcn_s_getreg((3 << 11) | 20) & 0xFu; }
#define XB_SPIN(cond, bar) do { unsigned _sp = 0; while (cond) { __builtin_amdgcn_s_sleep(1); \
    if ((++_sp & 255u) == 0u) { if (xb_ld(&(bar)[XB_TMO])) break; if (_sp > XB_SPIN_CAP) { atomicAdd(&(bar)[XB_TMO], 1u); break; } } } } while (0)
struct XcdBarrier { unsigned* bar; unsigned x; volatile LAS unsigned* st; };
__device__ __forceinline__ XcdBarrier xcd_barrier_post(unsigned* bar, volatile LAS unsigned* st) {
    XcdBarrier b; b.bar = bar; b.x = xb_xcc_id(); b.st = st;
    if (threadIdx.x == 0) (void)xb_add(&bar[XB_XCNT(b.x)], 1u);
    return b;
}
__device__ __forceinline__ void xcd_barrier_complete(unsigned* bar, unsigned x, unsigned& nloc, unsigned& nx) {
    const unsigned G = gridDim.x * gridDim.y * gridDim.z;
    unsigned sum, cnt, mine, sp = 0u;
    for (;;) {
        sum = 0u; cnt = 0u; mine = 0u;
#pragma unroll
        for (unsigned j = 0; j < 16; ++j) { const unsigned c = xb_ld(&bar[XB_XCNT(j)]); sum += c; cnt += (c > 0u) ? 1u : 0u; mine = (j == x) ? c : mine; }
        if (sum == G) break;
        __builtin_amdgcn_s_sleep(1);
        if ((++sp & 255u) == 0u) { if (xb_ld(&bar[XB_TMO])) break; if (sp > XB_SPIN_CAP) { atomicAdd(&bar[XB_TMO], 1u); break; } }
    }
    nloc = mine > 0u ? mine : 1u; nx = cnt > 0u ? cnt : 1u;
}
__device__ __forceinline__ void xcd_barrier(const XcdBarrier& b) {
    asm volatile("s_waitcnt vmcnt(0)" ::: "memory");
    __syncthreads();
    if (threadIdx.x == 0) {
        unsigned* bar = b.bar;
        __builtin_amdgcn_s_waitcnt(0);
        unsigned nloc = b.st[0], nx = b.st[1];
        if (nloc == 0u) { xcd_barrier_complete(bar, b.x, nloc, nx); b.st[0] = nloc; b.st[1] = nx; }
        const unsigned old = xb_add(&bar[XB_XSUB(b.x)], 1u);
        const unsigned gen = old / nloc;
        if (old + 1u == (gen + 1u) * nloc) {
            __builtin_amdgcn_fence(__ATOMIC_RELEASE, "agent");
            asm volatile("s_waitcnt vmcnt(0)" ::: "memory");
            const unsigned og = xb_add(&bar[XB_TOP], 1u);
            const unsigned tg = og / nx;
            if (og + 1u == (tg + 1u) * nx) xb_add(&bar[XB_TOPGEN], 1u);
            else XB_SPIN(xb_ld(&bar[XB_TOPGEN]) == tg, bar);
            __builtin_amdgcn_fence(__ATOMIC_ACQUIRE, "agent");
            xb_add(&bar[XB_XGEN(b.x)], 1u);
            asm volatile("s_waitcnt vmcnt(0)" ::: "memory");
        } else {
            XB_SPIN(xb_ld(&bar[XB_XGEN(b.x)]) == gen, bar);
            __builtin_amdgcn_fence(__ATOMIC_ACQUIRE, "agent");
            asm volatile("s_waitcnt vmcnt(0)" ::: "memory");
        }
    }
    __syncthreads();
}

struct Args { const float* in[20]; float* out; unsigned char* ws; int ph_lo, ph_hi, li, pad; };
enum { I_X = 0, I_WIN, I_KVG, I_WUK, I_WUV, I_RELB, I_LBP, I_BNG, I_WBRA, I_WBRB, I_WO, I_LN1G, I_LN1B, I_WPQ, I_SK1, I_SK2, I_UT, I_VT, I_LN2G, I_LN2B };

typedef const __attribute__((address_space(4))) Args* KArgs;
struct Frame {
    LAS unsigned char* lds;
    int tid, lane, wave, G;
    KArgs a;
    unsigned char* ws;
};

__device__ __forceinline__ float wave_sum(float v) {
#pragma unroll
    for (int o = 1; o < 64; o <<= 1) v += __shfl_xor(v, o);
    return v;
}
__device__ __forceinline__ float wave_sum_dpp(float v) {
    v += __builtin_bit_cast(float, __builtin_amdgcn_mov_dpp(__builtin_bit_cast(int, v), 0xB1, 0xf, 0xf, true));
    v += __builtin_bit_cast(float, __builtin_amdgcn_mov_dpp(__builtin_bit_cast(int, v), 0x4E, 0xf, 0xf, true));
    v += __builtin_bit_cast(float, __builtin_amdgcn_mov_dpp(__builtin_bit_cast(int, v), 0x141, 0xf, 0xf, true));
    v += __builtin_bit_cast(float, __builtin_amdgcn_mov_dpp(__builtin_bit_cast(int, v), 0x140, 0xf, 0xf, true));
    const int vi = __builtin_bit_cast(int, v);
    return (__int_as_float(__builtin_amdgcn_readlane(vi, 0)) + __int_as_float(__builtin_amdgcn_readlane(vi, 16))) + (__int_as_float(__builtin_amdgcn_readlane(vi, 32)) + __int_as_float(__builtin_amdgcn_readlane(vi, 48)));
}
__device__ __forceinline__ float wave_max(float v) {
#pragma unroll
    for (int o = 1; o < 64; o <<= 1) v = fmaxf(v, __shfl_xor(v, o));
    return v;
}

__device__ __forceinline__ void cvt_bf16_stream(const float* src, bf16* dst, size_t n8, size_t gtid, size_t gthreads) {
    for (size_t i = gtid; i < n8; i += gthreads) {
        const f32x4 a = ((const f32x4*)src)[2 * i], b = ((const f32x4*)src)[2 * i + 1];
        v4u o; o.x = pk2(a.x, a.y); o.y = pk2(a.z, a.w); o.z = pk2(b.x, b.y); o.w = pk2(b.z, b.w);
        ((v4u*)dst)[i] = o;
    }
}
__device__ __forceinline__ void transpose_item(const float* W, int ldw, int K, int c0, int nvalid, bf16* WT, int r0, int k0, LAS float* scr, int lane) {
    float tv[32];
#pragma unroll
    for (int i = 0; i < 32; ++i) { const int kk = 2 * i + (lane >> 5), n = lane & 31; tv[i] = (n < nvalid) ? W[(size_t)(k0 + kk) * ldw + c0 + n] : 0.f; }
#pragma unroll
    for (int i = 0; i < 32; ++i) { const int kk = 2 * i + (lane >> 5), n = lane & 31; scr[kk * 33 + n] = tv[i]; }
    LDS_WAIT(); asm volatile("" ::: "memory");
    const int c = lane & 7;
#pragma unroll
    for (int j = 0; j < 4; ++j) { const int n = (lane >> 3) + 8 * j; const LAS float* s = scr + (8 * c) * 33 + n;
        v4u o; o.x = pk2(s[0 * 33], s[1 * 33]); o.y = pk2(s[2 * 33], s[3 * 33]); o.z = pk2(s[4 * 33], s[5 * 33]); o.w = pk2(s[6 * 33], s[7 * 33]);
        *(v4u*)(WT + (size_t)(r0 + n) * K + k0 + 8 * c) = o; }
    LDS_WAIT(); asm volatile("" ::: "memory");
}
__device__ __forceinline__ void win_block(int cb, int& c0, int& r0, int& nv) {
    nv = 32;
    if (cb < 4)        { c0 = 512 + 32 * cb;          r0 = 1024 + 32 * cb; }
    else if (cb < 6)   { c0 = 1152 + 32 * (cb - 4);   r0 = 1152 + 32 * (cb - 4); }
    else if (cb == 6)  { c0 = 1216;                   r0 = 1216; nv = 8; }
    else if (cb == 7)  { c0 = 0;                      r0 = 1248; nv = 0; }
    else if (cb < 24)  { c0 = 640 + 32 * (cb - 8);    r0 = 1280 + 32 * (cb - 8); }
    else if (cb < 40)  { c0 = 1224 + 32 * (cb - 24);  r0 = 1792 + 32 * (cb - 24); }
    else if (cb < 56)  { c0 = 1736 + 32 * (cb - 40);  r0 = 2304 + 32 * (cb - 40); }
    else if (cb < 72)  { c0 = 2248 + 32 * (cb - 56);  r0 = 2816 + 32 * (cb - 56); }
    else if (cb < 88)  { c0 = 2760 + 32 * (cb - 72);  r0 = 3328 + 32 * (cb - 72); }
    else if (cb < 120) { c0 = 3272 + 32 * (cb - 88);  r0 = 3840 + 32 * (cb - 88); }
    else               { c0 = 4296 + 32 * (cb - 120); r0 = 4864 + 32 * (cb - 120); }
}
__device__ __forceinline__ void p0_prologue(Frame& F) {
    KArgs const Ap = F.a;
    const size_t gtid = (size_t)blockIdx.x * NTHREADS + F.tid, gthreads = (size_t)F.G * NTHREADS;
    cvt_bf16_stream(Ap->in[I_X], (bf16*)(F.ws + WS_XB), (size_t)T * DM / 8, gtid, gthreads);
    {
        const int gw0 = blockIdx.x * NWAVES + F.wave, NGW0 = F.G * NWAVES;
        for (int r0 = gw0; r0 < 2 * 16384; r0 += 2 * NGW0) {
            f32x4 v[2][4];
#pragma unroll
            for (int u = 0; u < 2; ++u) { const int r = r0 + u * NGW0; const int tb = r >> 14, e = r & 16383;
                if (r < 2 * 16384) { const float* src = (tb ? Ap->in[I_VT] : Ap->in[I_UT]) + (size_t)e * DM;
#pragma unroll
                    for (int j = 0; j < 4; ++j) v[u][j] = ((const f32x4*)src)[F.lane + 64 * j]; } }
#pragma unroll
            for (int u = 0; u < 2; ++u) { const int r = r0 + u * NGW0; const int tb = r >> 14, e = r & 16383;
                if (r < 2 * 16384) {
                    unsigned char* dst = F.ws + (tb ? WS_VT8 : WS_UT8); float* inv = (float*)(F.ws + (tb ? WS_VINV : WS_UINV));
                    float am = 0.f;
#pragma unroll
                    for (int j = 0; j < 4; ++j) am = fmaxf(am, fmaxf(fmaxf(fabsf(v[u][j].x), fabsf(v[u][j].y)), fmaxf(fabsf(v[u][j].z), fabsf(v[u][j].w))));
                    am = wave_max(am);
                    const float qmax = tb ? 256.0f : 127.0f;
                    const float sc = am > 0.f ? qmax / am : 1.0f;
                    if (F.lane == 0) inv[e] = am > 0.f ? am / qmax : 1.0f;
#pragma unroll
                    for (int j = 0; j < 4; ++j) { const int d0 = 256 * j + 4 * F.lane, sl = d0 >> 7, off = d0 & 127;
                        int wv;
                        if (tb) { wv = __builtin_amdgcn_cvt_pk_fp8_f32(v[u][j].x * sc, v[u][j].y * sc, 0, false); wv = __builtin_amdgcn_cvt_pk_fp8_f32(v[u][j].z * sc, v[u][j].w * sc, wv, true); }
                        else { const int a0 = (int)rintf(v[u][j].x * sc), a1 = (int)rintf(v[u][j].y * sc), a2 = (int)rintf(v[u][j].z * sc), a3 = (int)rintf(v[u][j].w * sc);
                            wv = (a0 & 0xff) | ((a1 & 0xff) << 8) | ((a2 & 0xff) << 16) | ((a3 & 0xff) << 24); }
                        *(unsigned*)(dst + ((size_t)sl * 16384 + e) * 128 + off) = (unsigned)wv; } } }
        }
    }
    LAS float* scr = (LAS float*)(F.lds + F.wave * 16384);
    const int gw = blockIdx.x * NWAVES + F.wave, NGW = F.G * NWAVES;
    constexpr int I_IN = 152 * 16, I_B = 32 * 8, I_O = 32 * 16, I_PQ = 64 * 16;
    for (int it = gw; it < I_IN + I_B + I_O + I_PQ; it += NGW) {
        int r = it;
        if (r < I_IN) { const int cb = r >> 4, kb = r & 15; int c0, r0, nv; win_block(cb, c0, r0, nv);
            transpose_item(Ap->in[I_WIN], IN_COLS, 1024, c0, nv, (bf16*)(F.ws + WS_WIN), r0, 64 * kb, scr, F.lane); continue; }
        r -= I_IN;
        if (r < I_B) { const int cb = r >> 3, kb = r & 7; transpose_item(Ap->in[I_WBRB], 1024, 1024, 32 * cb, 32, (bf16*)(F.ws + WS_WB), 32 * cb, 64 * kb, scr, F.lane); continue; }
        r -= I_B;
        if (r < I_O) { const int cb = r >> 4, kb = r & 15; transpose_item(Ap->in[I_WO], 1024, 1024, 32 * cb, 32, (bf16*)(F.ws + WS_WO), 32 * cb, 64 * kb, scr, F.lane); continue; }
        r -= I_O;
        { const int cb = r >> 4, kb = r & 15; transpose_item(Ap->in[I_WPQ], 2048, 1024, 32 * cb, 32, (bf16*)(F.ws + WS_WPQ), 32 * cb, 64 * kb, scr, F.lane); }
    }
    __syncthreads();
    LAS float* Xa = (LAS float*)(F.lds);
    LAS float* Xb = (LAS float*)(F.lds + 128 * 65 * 4);
    const float* w_in = Ap->in[I_WIN]; const float* w_uk = Ap->in[I_WUK]; const float* w_uv = Ap->in[I_WUV]; const float* w_bra = Ap->in[I_WBRA];
    for (int it = blockIdx.x; it < 256; it += F.G) {
        if (it < 128) {
            const int h = it >> 4, k0 = (it & 15) * 64;
            for (int e = F.tid; e < 128 * 64; e += NTHREADS) { const int c = e >> 6, d = e & 63; Xa[c * 65 + d] = w_uk[c * 512 + h * 64 + d]; }
            for (int e = F.tid; e < 64 * 64; e += NTHREADS) { const int kk = e >> 6, d = e & 63; Xb[kk * 65 + d] = w_in[(size_t)(k0 + kk) * IN_COLS + h * 64 + d]; }
            __syncthreads();
            const int kk = F.tid & 63;
            for (int j = 0; j < 16; ++j) { const int c = (F.tid >> 6) + 8 * j; float s = 0.f;
#pragma unroll 16
                for (int d = 0; d < 64; ++d) s += Xb[kk * 65 + d] * Xa[c * 65 + d];
                ((bf16*)(F.ws + WS_WIN))[(size_t)(h * 128 + c) * 1024 + k0 + kk] = (bf16)(pk2(s * QSCALE, 0.f) & 0xffffu); }
            __syncthreads();
        } else {
            const int i2 = it - 128, h = i2 >> 4, n0 = (i2 & 15) * 64;
            for (int e = F.tid; e < 128 * 64; e += NTHREADS) { const int c = e >> 6, d = e & 63; Xa[c * 65 + d] = w_uv[c * 512 + h * 64 + d]; }
            for (int e = F.tid; e < 64 * 64; e += NTHREADS) { const int d = e >> 6, n = e & 63; Xb[d * 65 + n] = w_bra[(size_t)(h * 64 + d) * 1024 + n0 + n]; }
            __syncthreads();
            const int c = F.tid & 127;
            for (int j = 0; j < 16; ++j) { const int n = (F.tid >> 7) + 4 * j; float s = 0.f;
#pragma unroll 16
                for (int d = 0; d < 64; ++d) s += Xa[c * 65 + d] * Xb[d * 65 + n];
                ((bf16*)(F.ws + WS_WA))[(size_t)(n0 + n) * 1024 + h * 128 + c] = (bf16)(pk2(s, 0.f) & 0xffffu); }
            __syncthreads();
        }
    }
}

struct EpiProj {
    static constexpr bool PERM = true;
    unsigned char* ws;
    __device__ __forceinline__ void operator()(const f32x4 (&acc)[2][2][4][2], const pg8::Unit& u, int wr, int wc, int fr, int fq) const {
        const int pn = u.pn; size_t boff; int ldc, colt; bool sg = false;
        if (pn < 4)       { boff = WS_QL;   ldc = 1024; colt = pn * 256; }
        else if (pn == 4) { boff = WS_MISC; ldc = 256;  colt = 0; }
        else if (pn < 7)  { boff = WS_QI;   ldc = 512;  colt = (pn - 5) * 256; }
        else if (pn < 9)  { boff = WS_QB;   ldc = 512;  colt = (pn - 7) * 256; }
        else if (pn < 11) { boff = WS_FB;   ldc = 512;  colt = (pn - 9) * 256; }
        else if (pn < 13) { boff = WS_IB;   ldc = 512;  colt = (pn - 11) * 256; }
        else if (pn < 15) { boff = WS_GB;   ldc = 512;  colt = (pn - 13) * 256; }
        else if (pn < 19) { boff = WS_GA;   ldc = 1024; colt = (pn - 15) * 256; sg = true; }
        else              { boff = WS_GBT;  ldc = 1024; colt = (pn - 19) * 256; sg = true; }
        const int row0 = u.pm * 256 + wr * 64 + fr, col0 = colt + wc * 32 + 8 * fq;
        if (sg) {
            unsigned char* base = ws + boff;
            const int colg = colt + wc * 64 + 16 * fq;
#pragma unroll
            for (int ai = 0; ai < 2; ++ai)
#pragma unroll
                for (int m = 0; m < 4; ++m) { unsigned char* rowp = base + (size_t)(row0 + ai * 128 + m * 16) * ldc + colg;
                    unsigned ww[4];
#pragma unroll
                    for (int bj = 0; bj < 2; ++bj) { const f32x4 v0 = acc[ai][bj][m][0], v1 = acc[ai][bj][m][1];
                        unsigned q[8];
#pragma unroll
                        for (int j = 0; j < 4; ++j) { q[j] = (unsigned)(int)fmaxf(rintf(255.0f * sigmoidf_(v0[j])), 1.0f); q[4 + j] = (unsigned)(int)fmaxf(rintf(255.0f * sigmoidf_(v1[j])), 1.0f); }
                        ww[2 * bj] = q[0] | (q[1] << 8) | (q[2] << 16) | (q[3] << 24); ww[2 * bj + 1] = q[4] | (q[5] << 8) | (q[6] << 16) | (q[7] << 24); }
                    v4u w; w.x = ww[0]; w.y = ww[1]; w.z = ww[2]; w.w = ww[3];
                    *(v4u*)rowp = w; }
        } else {
            bf16* base = (bf16*)(ws + boff);
#pragma unroll
            for (int ai = 0; ai < 2; ++ai)
#pragma unroll
                for (int m = 0; m < 4; ++m) { bf16* rowp = base + (size_t)(row0 + ai * 128 + m * 16) * ldc + col0;
#pragma unroll
                    for (int bj = 0; bj < 2; ++bj) { const f32x4 v0 = acc[ai][bj][m][0], v1 = acc[ai][bj][m][1];
                        v4u w; w.x = pk2(v0[0], v0[1]); w.y = pk2(v0[2], v0[3]); w.z = pk2(v1[0], v1[1]); w.w = pk2(v1[2], v1[3]);
                        *(v4u*)(rowp + bj * 128) = w; } }
        }
    }
};
template <int MODE> struct EpiBranch {
    static constexpr bool PERM = true;
    const unsigned char* gate; bf16* O;
    __device__ __forceinline__ void operator()(const f32x4 (&acc)[2][2][4][2], const pg8::Unit& u, int wr, int wc, int fr, int fq) const {
        const int row0 = u.pm * 256 + wr * 64 + fr, col0 = u.pn * 256 + wc * 32 + 8 * fq, colg = u.pn * 256 + wc * 64 + 16 * fq;
        constexpr float S = 1.0f / 255.0f;
#pragma unroll
        for (int ai = 0; ai < 2; ++ai)
#pragma unroll
            for (int m = 0; m < 4; ++m) { const size_t rb = (size_t)(row0 + ai * 128 + m * 16) * 1024; const size_t off = rb + col0;
                const v4u gg = *(const v4u*)(gate + rb + colg);
#pragma unroll
                for (int bj = 0; bj < 2; ++bj) { const f32x4 v0 = acc[ai][bj][m][0], v1 = acc[ai][bj][m][1];
                    const unsigned gx = bj ? gg.z : gg.x, gy = bj ? gg.w : gg.y;
                    float r0 = v0[0] * (S * (float)(gx & 0xffu)), r1 = v0[1] * (S * (float)((gx >> 8) & 0xffu)), r2 = v0[2] * (S * (float)((gx >> 16) & 0xffu)), r3 = v0[3] * (S * (float)(gx >> 24));
                    float r4 = v1[0] * (S * (float)(gy & 0xffu)), r5 = v1[1] * (S * (float)((gy >> 8) & 0xffu)), r6 = v1[2] * (S * (float)((gy >> 16) & 0xffu)), r7 = v1[3] * (S * (float)(gy >> 24));
                    if (MODE == 1) { const v4u p = *(const v4u*)(O + off + bj * 128);
                        r0 += bflo(p.x); r1 += bfhi(p.x); r2 += bflo(p.y); r3 += bfhi(p.y); r4 += bflo(p.z); r5 += bfhi(p.z); r6 += bflo(p.w); r7 += bfhi(p.w); }
                    v4u w; w.x = pk2(r0, r1); w.y = pk2(r2, r3); w.z = pk2(r4, r5); w.w = pk2(r6, r7);
                    *(v4u*)(O + off + bj * 128) = w; } }
    }
};
struct EpiMerge {
    static constexpr bool PERM = true;
    const unsigned char* ga; const unsigned char* gb; bf16* O;
    __device__ __forceinline__ void mid(f32x4 (&acc)[2][2][4][2], const pg8::Unit& u, int wr, int wc, int fr, int fq) const {
        unsigned rb0 = (unsigned)(u.pm * 256 + wr * 64 + fr) * 1024u + (unsigned)(u.pn * 256 + wc * 64 + 16 * fq);
        asm volatile("" : "+v"(rb0));
#pragma unroll
        for (int ai = 0; ai < 2; ++ai)
#pragma unroll
            for (int m = 0; m < 4; ++m) { const unsigned rb = rb0 + (unsigned)(ai * 128 + m * 16) * 1024u;
                const v4u xa = *(const v4u*)(ga + rb), xb = *(const v4u*)(gb + rb);
#pragma unroll
                for (int bj = 0; bj < 2; ++bj) { const unsigned ax = bj ? xa.z : xa.x, ay = bj ? xa.w : xa.y, bx = bj ? xb.z : xb.x, by = bj ? xb.w : xb.y;
#pragma unroll
                    for (int j = 0; j < 4; ++j) {
                        acc[ai][bj][m][0][j] *= (float)((ax >> (8 * j)) & 0xffu) * __builtin_amdgcn_rcpf((float)((bx >> (8 * j)) & 0xffu));
                        acc[ai][bj][m][1][j] *= (float)((ay >> (8 * j)) & 0xffu) * __builtin_amdgcn_rcpf((float)((by >> (8 * j)) & 0xffu)); } } }
    }
    __device__ __forceinline__ void operator()(const f32x4 (&acc)[2][2][4][2], const pg8::Unit& u, int wr, int wc, int fr, int fq) const {
        unsigned rb0 = (unsigned)(u.pm * 256 + wr * 64 + fr) * 1024u;
        asm volatile("" : "+v"(rb0));
        const unsigned col0 = (unsigned)(u.pn * 256 + wc * 32 + 8 * fq), colg = (unsigned)(u.pn * 256 + wc * 64 + 16 * fq);
        constexpr float S = 1.0f / 255.0f;
#pragma unroll
        for (int ai = 0; ai < 2; ++ai)
#pragma unroll
            for (int m = 0; m < 4; ++m) { const unsigned rb = rb0 + (unsigned)(ai * 128 + m * 16) * 1024u; const unsigned off = rb + col0;
                const v4u gg = *(const v4u*)(gb + (rb + colg));
#pragma unroll
                for (int bj = 0; bj < 2; ++bj) { const f32x4 v0 = acc[ai][bj][m][0], v1 = acc[ai][bj][m][1];
                    const unsigned gx = bj ? gg.z : gg.x, gy = bj ? gg.w : gg.y;
                    v4u w; w.x = pk2(v0[0] * (S * (float)(gx & 0xffu)), v0[1] * (S * (float)((gx >> 8) & 0xffu))); w.y = pk2(v0[2] * (S * (float)((gx >> 16) & 0xffu)), v0[3] * (S * (float)(gx >> 24)));
                    w.z = pk2(v1[0] * (S * (float)(gy & 0xffu)), v1[1] * (S * (float)((gy >> 8) & 0xffu))); w.w = pk2(v1[2] * (S * (float)((gy >> 16) & 0xffu)), v1[3] * (S * (float)(gy >> 24)));
                    *(v4u*)(O + (off + bj * 128)) = w; } }
    }
};
struct EpiResBf16 {
    static constexpr bool PERM = true;
    const bf16* X; bf16* Y;
    __device__ __forceinline__ void operator()(const f32x4 (&acc)[2][2][4][2], const pg8::Unit& u, int wr, int wc, int fr, int fq) const {
        const int row0 = u.pm * 256 + wr * 64 + fr, col0 = u.pn * 256 + wc * 32 + 8 * fq;
#pragma unroll
        for (int ai = 0; ai < 2; ++ai)
#pragma unroll
            for (int m = 0; m < 4; ++m) { const size_t off = (size_t)(row0 + ai * 128 + m * 16) * 1024 + col0;
#pragma unroll
                for (int bj = 0; bj < 2; ++bj) { const f32x4 v0 = acc[ai][bj][m][0], v1 = acc[ai][bj][m][1];
                    const v4u g = *(const v4u*)(X + off + bj * 128);
                    v4u w; w.x = pk2(v0[0] + ALPHA * bflo(g.x), v0[1] + ALPHA * bfhi(g.x)); w.y = pk2(v0[2] + ALPHA * bflo(g.y), v0[3] + ALPHA * bfhi(g.y));
                    w.z = pk2(v1[0] + ALPHA * bflo(g.z), v1[1] + ALPHA * bfhi(g.z)); w.w = pk2(v1[2] + ALPHA * bflo(g.w), v1[3] + ALPHA * bfhi(g.w));
                    *(v4u*)(Y + off + bj * 128) = w; } }
    }
};
struct EpiPlainBf16 {
    static constexpr bool PERM = true;
    bf16* O; int ldc;
    __device__ __forceinline__ void operator()(const f32x4 (&acc)[2][2][4][2], const pg8::Unit& u, int wr, int wc, int fr, int fq) const {
        const int row0 = u.pm * 256 + wr * 64 + fr, col0 = u.pn * 256 + wc * 32 + 8 * fq;
#pragma unroll
        for (int ai = 0; ai < 2; ++ai)
#pragma unroll
            for (int m = 0; m < 4; ++m) { bf16* rowp = O + (size_t)(row0 + ai * 128 + m * 16) * ldc + col0;
#pragma unroll
                for (int bj = 0; bj < 2; ++bj) { const f32x4 v0 = acc[ai][bj][m][0], v1 = acc[ai][bj][m][1];
                    v4u w; w.x = pk2(v0[0], v0[1]); w.y = pk2(v0[2], v0[3]); w.z = pk2(v1[0], v1[1]); w.w = pk2(v1[2], v1[3]);
                    *(v4u*)(rowp + bj * 128) = w; } }
    }
};

template <int CTRL> __device__ __forceinline__ float dppf(float x) { return __builtin_bit_cast(float, __builtin_amdgcn_mov_dpp(__builtin_bit_cast(int, x), CTRL, 0xf, 0xf, true)); }
__device__ __forceinline__ void p2_ckv_norm(Frame& F) {
    const bf16* misc = (const bf16*)(F.ws + WS_MISC); bf16* ckv = (bf16*)(F.ws + WS_CKV); const float* g = F.a->in[I_KVG];
    const int gw = blockIdx.x * NWAVES + F.wave, NGW = F.G * NWAVES, sub = F.lane >> 4, l16 = F.lane & 15;
    float gv[8];
#pragma unroll
    for (int j = 0; j < 8; ++j) gv[j] = g[l16 * 8 + j];
    for (int r4 = gw; r4 < T / 4; r4 += NGW) {
        const int t = r4 * 4 + sub;
        const v4u p = *(const v4u*)(misc + (size_t)t * 256 + l16 * 8);
        float v[8] = {bflo(p.x), bfhi(p.x), bflo(p.y), bfhi(p.y), bflo(p.z), bfhi(p.z), bflo(p.w), bfhi(p.w)};
        float ss = 0.f;
#pragma unroll
        for (int j = 0; j < 8; ++j) ss += v[j] * v[j];
        ss += __shfl_xor(ss, 1); ss += __shfl_xor(ss, 2); ss += __shfl_xor(ss, 4); ss += __shfl_xor(ss, 8);
        const float r = rsqrtf(ss * (1.0f / 128.0f) + RMS_EPS);
        v4u o; o.x = pk2(v[0] * r * gv[0], v[1] * r * gv[1]); o.y = pk2(v[2] * r * gv[2], v[3] * r * gv[3]); o.z = pk2(v[4] * r * gv[4], v[5] * r * gv[5]); o.w = pk2(v[6] * r * gv[6], v[7] * r * gv[7]);
        *(v4u*)(ckv + (size_t)t * 128 + l16 * 8) = o;
    }
}

__device__ __forceinline__ void p2_hgrn_simple(Frame& F) {
    const bf16* QB = (const bf16*)(F.ws + WS_QB); const bf16* FBp = (const bf16*)(F.ws + WS_FB); bf16* IB = (bf16*)(F.ws + WS_IB);
    const float* lbp = F.a->in[I_LBP];
    const int v = F.tid >> 2, dq = F.tid & 3;
    for (int item = blockIdx.x; item < NB * 4; item += F.G) {
        const int b = item >> 2, h = item & 3;
        float lb[32], S[32];
#pragma unroll
        for (int i = 0; i < 32; ++i) { const int d = h * 128 + dq * 32 + i; lb[i] = 1.0f / (1.0f + __expf(lbp[512 + d] - lbp[d])); S[i] = 0.f; }
        for (int t = 0; t < SEQ; ++t) {
            const size_t row = (size_t)b * SEQ + t;
            const v4u* qp = (const v4u*)(QB + row * 512 + h * 128 + dq * 32);
            const v4u* fp = (const v4u*)(FBp + row * 512 + h * 128 + dq * 32);
            const float vv = bf2f(IB[row * 512 + h * 128 + v]);
            float part = 0.f;
#pragma unroll
            for (int c = 0; c < 4; ++c) { const v4u q4 = qp[c], f4 = fp[c];
#pragma unroll
                for (int e = 0; e < 4; ++e) {
                    const unsigned qa = e == 0 ? q4.x : e == 1 ? q4.y : e == 2 ? q4.z : q4.w, fa = e == 0 ? f4.x : e == 1 ? f4.y : e == 2 ? f4.z : f4.w;
#pragma unroll
                    for (int hh = 0; hh < 2; ++hh) { const int i = c * 8 + e * 2 + hh;
                        const float q = hh ? bfhi(qa) : bflo(qa), z = hh ? bfhi(fa) : bflo(fa);
                        const float sg = sigmoidf_(z), f = lb[i] + (1.0f - lb[i]) * sg, k = (1.0f - lb[i]) * (1.0f - sg);
                        S[i] = f * S[i] + k * vv; part += q * S[i]; } } }
            part += __shfl_xor(part, 1); part += __shfl_xor(part, 2);
            if (dq == 0) IB[row * 512 + h * 128 + v] = (bf16)(pk2(part, 0.f) & 0xffffu);
        }
    }
}

__device__ __forceinline__ void p2_hgrn_chunked(Frame& F, bf16* OUTB, int nbatch, const int ostr) {
    typedef short bf16x8 __attribute__((ext_vector_type(8)));
    const bf16* QB = (const bf16*)(F.ws + WS_QB); const bf16* FBp = (const bf16*)(F.ws + WS_FB); const bf16* IB = (const bf16*)(F.ws + WS_IB);
    const float* lbp = F.a->in[I_LBP];
    constexpr int S136 = 136, S72 = 72;
    LAS bf16* QIN = (LAS bf16*)(F.lds);
    LAS bf16* KIN = (LAS bf16*)(F.lds + 17408);
    LAS bf16* QDEC = (LAS bf16*)(F.lds + 2 * 17408);
    LAS bf16* ST = (LAS bf16*)(F.lds + 3 * 17408);
    LAS bf16* KDT = (LAS bf16*)(F.lds + 3 * 17408 + 34816);
    LAS bf16* VT = (LAS bf16*)(F.lds + 3 * 17408 + 34816 + 18432);
    LAS bf16* ATT = (LAS bf16*)(F.lds + 3 * 17408 + 34816 + 2 * 18432);
    LAS float* SEG = (LAS float*)(F.lds + 3 * 17408 + 34816 + 2 * 18432 + 9216);
    LAS float* DECAY = SEG + 512;
    const int tid = F.tid, lane = F.lane, w = F.wave, l15 = lane & 15, q4 = lane >> 4;
    const int d = tid & 127, tq = tid >> 7;
    const int tr = w >> 1, tc2 = w & 1;
    for (int item = blockIdx.x; item < nbatch * 4; item += F.G) {
        const int b = item >> 2, h = item & 3;
        const float lb = 1.0f / (1.0f + __expf(lbp[512 + h * 128 + d] - lbp[h * 128 + d])), oml = 1.0f - lb;
        f32x4 Sacc[8];
#pragma unroll
        for (int nt = 0; nt < 8; ++nt) Sacc[nt] = (f32x4){0.f, 0.f, 0.f, 0.f};
        for (int e = tid; e < 128 * S136 / 2; e += NTHREADS) ((LAS unsigned*)ST)[e] = 0u;
        const size_t rowb = (size_t)b * SEQ;
        const bf16* zp = FBp + (rowb + tq * 16) * 512 + h * 128 + d;
        const bf16* qp = QB + (rowb + tq * 16) * 512 + h * 128 + d;
        const bf16* vp = IB + (rowb + tq * 16) * 512 + h * 128 + d;
        unsigned short zr[16], qr[16], vr[16];
#pragma unroll
        for (int i = 0; i < 16; ++i) { zr[i] = zp[(size_t)i * 512]; qr[i] = qp[(size_t)i * 512]; vr[i] = vp[(size_t)i * 512]; }
        __syncthreads();
        for (int n = 0; n < SEQ / 64; ++n) {
            float c[16], kk[16], qf[16];
            { float run = 0.f;
#pragma unroll
              for (int i = 0; i < 16; ++i) { const float z = bf2f(zr[i]); const float e1 = __expf(-z), sg = __builtin_amdgcn_rcpf(1.0f + e1);
                  run += __logf(lb + oml * sg); c[i] = run; kk[i] = oml * e1 * sg; qf[i] = bf2f(qr[i]); } }
            v4u vv0, vv1;
            vv0.x = (unsigned)vr[0] | ((unsigned)vr[1] << 16); vv0.y = (unsigned)vr[2] | ((unsigned)vr[3] << 16); vv0.z = (unsigned)vr[4] | ((unsigned)vr[5] << 16); vv0.w = (unsigned)vr[6] | ((unsigned)vr[7] << 16);
            vv1.x = (unsigned)vr[8] | ((unsigned)vr[9] << 16); vv1.y = (unsigned)vr[10] | ((unsigned)vr[11] << 16); vv1.z = (unsigned)vr[12] | ((unsigned)vr[13] << 16); vv1.w = (unsigned)vr[14] | ((unsigned)vr[15] << 16);
            SEG[tq * 128 + d] = c[15];
            if (n + 1 < SEQ / 64) {
                const size_t o2 = (size_t)(n + 1) * 64 * 512;
#pragma unroll
                for (int i = 0; i < 16; ++i) { zr[i] = zp[o2 + (size_t)i * 512]; qr[i] = qp[o2 + (size_t)i * 512]; vr[i] = vp[o2 + (size_t)i * 512]; }
            }
            __syncthreads();
            { const float s0 = SEG[d], s1 = SEG[128 + d], s2 = SEG[256 + d], s3 = SEG[384 + d];
              const float off = tq == 0 ? 0.f : tq == 1 ? s0 : tq == 2 ? s0 + s1 : s0 + s1 + s2;
              const float bref = s0 + s1, blast = (s0 + s1) + (s2 + s3);
              const float enb = __expf(-bref), eb = __expf(bref), el = __expf(blast);
              if (tq == 0) DECAY[d] = el;
              unsigned kd[8];
#pragma unroll
              for (int i = 0; i < 16; i += 2) {
                  const float E0 = __expf(c[i] + off), E1 = __expf(c[i + 1] + off), r0 = __builtin_amdgcn_rcpf(E0), r1 = __builtin_amdgcn_rcpf(E1);
                  const int t0 = tq * 16 + i;
                  const unsigned qd = pk2(qf[i] * E0, qf[i + 1] * E1), qi = pk2(qf[i] * E0 * enb, qf[i + 1] * E1 * enb), ki = pk2(kk[i] * eb * r0, kk[i + 1] * eb * r1);
                  QDEC[t0 * S136 + d] = (bf16)(qd & 0xffffu); QDEC[(t0 + 1) * S136 + d] = (bf16)(qd >> 16);
                  QIN[t0 * S136 + d] = (bf16)(qi & 0xffffu); QIN[(t0 + 1) * S136 + d] = (bf16)(qi >> 16);
                  KIN[t0 * S136 + d] = (bf16)(ki & 0xffffu); KIN[(t0 + 1) * S136 + d] = (bf16)(ki >> 16);
                  kd[i >> 1] = pk2(kk[i] * el * r0, kk[i + 1] * el * r1);
              }
              *(LAS v4u*)(KDT + d * S72 + tq * 16) = (v4u){kd[0], kd[1], kd[2], kd[3]};
              *(LAS v4u*)(KDT + d * S72 + tq * 16 + 8) = (v4u){kd[4], kd[5], kd[6], kd[7]};
              *(LAS v4u*)(VT + d * S72 + tq * 16) = vv0;
              *(LAS v4u*)(VT + d * S72 + tq * 16 + 8) = vv1;
            }
            __syncthreads();
#pragma unroll
            for (int j = 0; j < 2; ++j) {
                const int tc = 2 * tc2 + j;
                f32x4 acc = {0.f, 0.f, 0.f, 0.f};
                if (tc <= tr) {
#pragma unroll
                    for (int ks = 0; ks < 4; ++ks) {
                        const bf16x8 a = *(const LAS bf16x8*)(QIN + (tr * 16 + l15) * S136 + ks * 32 + 8 * q4);
                        const bf16x8 bb = *(const LAS bf16x8*)(KIN + (tc * 16 + l15) * S136 + ks * 32 + 8 * q4);
                        acc = __builtin_amdgcn_mfma_f32_16x16x32_bf16(a, bb, acc, 0, 0, 0);
                    }
                }
                const int s_ = tc * 16 + l15;
#pragma unroll
                for (int r = 0; r < 4; ++r) { const int t_ = tr * 16 + 4 * q4 + r; ATT[t_ * S72 + s_] = (bf16)(pk2(s_ <= t_ ? acc[r] : 0.f, 0.f) & 0xffffu); }
            }
            __syncthreads();
#pragma unroll
            for (int j = 0; j < 4; ++j) {
                const int nt = 4 * tc2 + j;
                f32x4 acc = {0.f, 0.f, 0.f, 0.f};
#pragma unroll
                for (int ks = 0; ks < 2; ++ks) {
                    const bf16x8 a = *(const LAS bf16x8*)(ATT + (tr * 16 + l15) * S72 + ks * 32 + 8 * q4);
                    const bf16x8 bb = *(const LAS bf16x8*)(VT + (nt * 16 + l15) * S72 + ks * 32 + 8 * q4);
                    acc = __builtin_amdgcn_mfma_f32_16x16x32_bf16(a, bb, acc, 0, 0, 0);
                }
#pragma unroll
                for (int ks = 0; ks < 4; ++ks) {
                    const bf16x8 a = *(const LAS bf16x8*)(QDEC + (tr * 16 + l15) * S136 + ks * 32 + 8 * q4);
                    const bf16x8 bb = *(const LAS bf16x8*)(ST + (nt * 16 + l15) * S136 + ks * 32 + 8 * q4);
                    acc = __builtin_amdgcn_mfma_f32_16x16x32_bf16(a, bb, acc, 0, 0, 0);
                }
                bf16* op = OUTB + (rowb + (size_t)n * 64 + tr * 16 + 4 * q4) * ostr + h * 128 + nt * 16 + l15;
#pragma unroll
                for (int r = 0; r < 4; ++r) op[(size_t)r * ostr] = (bf16)(pk2(acc[r], 0.f) & 0xffffu);
            }
            __syncthreads();
            { const f32x4 dc = *(const LAS f32x4*)(DECAY + w * 16 + 4 * q4);
#pragma unroll
              for (int nt = 0; nt < 8; ++nt) {
                  f32x4 acc = Sacc[nt] * dc;
#pragma unroll
                  for (int ks = 0; ks < 2; ++ks) {
                      const bf16x8 a = *(const LAS bf16x8*)(KDT + (w * 16 + l15) * S72 + ks * 32 + 8 * q4);
                      const bf16x8 bb = *(const LAS bf16x8*)(VT + (nt * 16 + l15) * S72 + ks * 32 + 8 * q4);
                      acc = __builtin_amdgcn_mfma_f32_16x16x32_bf16(a, bb, acc, 0, 0, 0);
                  }
                  Sacc[nt] = acc;
                  *(LAS v2u*)(ST + (nt * 16 + l15) * S136 + w * 16 + 4 * q4) = (v2u){pk2(acc[0], acc[1]), pk2(acc[2], acc[3])};
              } }
        }
        __syncthreads();
    }
}

__device__ __forceinline__ unsigned mono_key(float f) { const unsigned u = __float_as_uint(f); return (u & 0x80000000u) ? ~u : (u | 0x80000000u); }
__device__ __forceinline__ void p2_indexer_simple(Frame& F) {
    typedef short bf16x8 __attribute__((ext_vector_type(8)));
    const bf16* misc = (const bf16*)(F.ws + WS_MISC); const bf16* QI = (const bf16*)(F.ws + WS_QI);
    unsigned long long* BMp = (unsigned long long*)(F.ws + WS_BM);
    LAS float* sc = (LAS float*)(F.lds + F.wave * 16384);
    const int gw = blockIdx.x * NWAVES + F.wave, NGW = F.G * NWAVES, lane = F.lane;
    const int l15 = lane & 15, q4 = lane >> 4;
    for (int tp = gw; tp < T / 2; tp += NGW) {
        const int t0 = tp * 2, b = t0 >> 11, pos = t0 & 2047, chunk = pos >> 6, nk = chunk + 1;
        if (nk <= 4) { if (lane < 32) { BMp[(size_t)t0 * 32 + lane] = (lane < nk) ? ~0ull : 0ull; BMp[(size_t)(t0 + 1) * 32 + lane] = (lane < nk) ? ~0ull : 0ull; } continue; }
        const bf16* ap = QI + (size_t)(t0 + (l15 >> 3)) * 512 + (l15 & 7) * 64 + 8 * q4;
        const bf16x8 a0 = *(const bf16x8*)ap, a1 = *(const bf16x8*)(ap + 32);
        float w[4];
        { const v2u p = *(const v2u*)(misc + (size_t)(t0 + (q4 >> 1)) * 256 + 192 + (q4 & 1) * 4); const float s_ = 0.04419417382415922f;
          w[0] = bflo(p.x) * s_; w[1] = bfhi(p.x) * s_; w[2] = bflo(p.y) * s_; w[3] = bfhi(p.y) * s_; }
        const bf16* kbase = misc + ((size_t)b * SEQ + l15) * 256 + 128 + 8 * q4;
#pragma unroll 2
        for (int kt = 0; kt < nk * 4; ++kt) {
            const bf16* kp = kbase + (size_t)kt * 16 * 256;
            const bf16x8 b0 = *(const bf16x8*)kp, b1 = *(const bf16x8*)(kp + 32);
            f32x4 acc = {0.f, 0.f, 0.f, 0.f};
            acc = __builtin_amdgcn_mfma_f32_16x16x32_bf16(a0, b0, acc, 0, 0, 0);
            acc = __builtin_amdgcn_mfma_f32_16x16x32_bf16(a1, b1, acc, 0, 0, 0);
            float part = w[0] * fmaxf(acc[0], 0.f) + w[1] * fmaxf(acc[1], 0.f) + w[2] * fmaxf(acc[2], 0.f) + w[3] * fmaxf(acc[3], 0.f);
            part += __shfl_xor(part, 16);
            if ((q4 & 1) == 0) sc[(q4 >> 1) * 2048 + kt * 16 + l15] = part;
        }
        for (int i = nk; i < 32; ++i) { sc[i * 64 + lane] = -INFINITY; sc[2048 + i * 64 + lane] = -INFINITY; }
        LDS_WAIT(); asm volatile("" ::: "memory");
#pragma unroll 1
        for (int tt = 0; tt < 2; ++tt) {
            unsigned long long* bmrow = BMp + (size_t)(t0 + tt) * 32;
            unsigned key[32];
#pragma unroll
            for (int i = 0; i < 32; ++i) key[i] = mono_key(sc[tt * 2048 + i * 64 + lane]);
            unsigned prefix = 0u;
#pragma unroll 1
            for (int bit = 31; bit >= 0; --bit) {
                const unsigned cand = prefix | (1u << bit); int cnt = 0;
#pragma unroll
                for (int i = 0; i < 32; ++i) { cnt += __builtin_popcountll(__ballot(key[i] >= cand)); if ((i & 3) == 3) __builtin_amdgcn_sched_barrier(0); }
                if (cnt >= 256) prefix = cand;
            }
            int ngt = 0;
#pragma unroll
            for (int i = 0; i < 32; ++i) { ngt += __builtin_popcountll(__ballot(key[i] > prefix)); if ((i & 3) == 3) __builtin_amdgcn_sched_barrier(0); }
            const int need = 256 - ngt; int running = 0;
            const unsigned long long lt_mask = (1ull << lane) - 1ull;
#pragma unroll
            for (int i = 0; i < 32; ++i) {
                const unsigned long long eq = __ballot(key[i] == prefix), gt = __ballot(key[i] > prefix);
                const int rank = running + __builtin_popcountll(eq & lt_mask);
                const unsigned long long se = __ballot(key[i] == prefix && rank < need);
                running += __builtin_popcountll(eq);
                const unsigned long long word = gt | se;
                if (lane == 0) bmrow[i] = word;
                __builtin_amdgcn_sched_barrier(0);
            }
        }
        LDS_WAIT(); asm volatile("" ::: "memory");
    }
}

__device__ __forceinline__ void p2_indexer_blk(Frame& F, unsigned long long& pr_extra) {
    typedef short bf16x8 __attribute__((ext_vector_type(8)));
    const bf16* misc = (const bf16*)(F.ws + WS_MISC); const bf16* QI = (const bf16*)(F.ws + WS_QI);
    unsigned long long* BMp = (unsigned long long*)(F.ws + WS_BM);
    LAS float* sc = (LAS float*)(F.lds + F.wave * 16384);
    LAS unsigned char* KT = F.lds + 131072;
    LAS unsigned* HS = (LAS unsigned*)(F.lds + 149504 + F.wave * 1024);
    LAS unsigned* CL = (LAS unsigned*)(F.lds + 157696 + F.wave * 512);
    const int tid = F.tid, lane = F.lane, wv = F.wave, l15 = lane & 15, q4 = lane >> 4;
    const int srow = tid >> 3, sch = tid & 7;
    unsigned* qidx = (unsigned*)(F.ws + WS_CTL) + CW_QIDX;
    volatile LAS unsigned* slot = (volatile LAS unsigned*)(F.lds + MISC_OFF) + 16;
    const unsigned xcc_ = xb_xcc_id() & 7u;
    int qs = 0;
    for (;;) {
        __syncthreads();
        if (tid == 0) { unsigned g_ = 0xffffffffu; int q_ = qs;
            for (; q_ < 8; ++q_) { const unsigned x_ = (xcc_ + (unsigned)q_) & 7u; const unsigned v_ = xb_add(qidx + 64 * x_, 1u); if (v_ < 512u) { g_ = (x_ << 16) | v_; break; } }
            slot[0] = g_; slot[1] = (unsigned)q_; }
        __syncthreads();
        const unsigned gq = slot[0]; qs = (int)slot[1];
        if (gq == 0xffffffffu) break;
        const int g = (int)(gq & 0xffffu), b = (int)(gq >> 16) + 8 * (g & 3), p = 127 - (g >> 2);
        const int pos0 = p * 16, nk = (pos0 >> 6) + 1;
        const int t0 = b * SEQ + pos0 + 2 * wv;
        if (nk <= 4) { if (lane < 32) { BMp[(size_t)t0 * 32 + lane] = (lane < nk) ? ~0ull : 0ull; BMp[(size_t)(t0 + 1) * 32 + lane] = (lane < nk) ? ~0ull : 0ull; } continue; }
        const bf16* ap = QI + (size_t)(t0 + (l15 >> 3)) * 512 + (l15 & 7) * 64 + 8 * q4;
        const bf16x8 a0 = *(const bf16x8*)ap, a1 = *(const bf16x8*)(ap + 32);
        float w[4];
        { const v2u pw = *(const v2u*)(misc + (size_t)(t0 + (q4 >> 1)) * 256 + 192 + (q4 & 1) * 4); const float s_ = 0.04419417382415922f;
          w[0] = bflo(pw.x) * s_; w[1] = bfhi(pw.x) * s_; w[2] = bflo(pw.y) * s_; w[3] = bfhi(pw.y) * s_; }
        const bf16* ksrc = misc + ((size_t)b * SEQ + srow) * 256 + 128 + sch * 8;
        const unsigned kdst = (unsigned)srow * 144u + (unsigned)sch * 16u;
        v4u kreg = *(const v4u*)ksrc;
        *(LAS v4u*)(KT + kdst) = kreg;
        __syncthreads();
        for (int kt = 0; kt < nk; ++kt) {
            LAS unsigned char* buf = KT + (kt & 1) * 9216;
            if (kt + 1 < nk) kreg = *(const v4u*)(ksrc + (size_t)(kt + 1) * 64 * 256);
            float part[4];
#pragma unroll
            for (int st = 0; st < 4; ++st) {
                const bf16x8 b0 = *(const LAS bf16x8*)(buf + (16 * st + l15) * 144 + 16 * q4), b1 = *(const LAS bf16x8*)(buf + (16 * st + l15) * 144 + 16 * q4 + 64);
                f32x4 acc = {0.f, 0.f, 0.f, 0.f};
                acc = __builtin_amdgcn_mfma_f32_16x16x32_bf16(a0, b0, acc, 0, 0, 0);
                acc = __builtin_amdgcn_mfma_f32_16x16x32_bf16(a1, b1, acc, 0, 0, 0);
                part[st] = w[0] * fmaxf(acc[0], 0.f) + w[1] * fmaxf(acc[1], 0.f) + w[2] * fmaxf(acc[2], 0.f) + w[3] * fmaxf(acc[3], 0.f);
            }
#pragma unroll
            for (int pr = 0; pr < 2; ++pr) {
                const auto sw = __builtin_amdgcn_permlane16_swap(__float_as_uint(part[2 * pr]), __float_as_uint(part[2 * pr + 1]), false, false);
                sc[(lane >> 5) * 2048 + kt * 64 + 32 * pr + (lane & 31)] = __uint_as_float(sw[0]) + __uint_as_float(sw[1]);
            }
            if (kt + 1 < nk) *(LAS v4u*)(KT + ((kt + 1) & 1) * 9216 + kdst) = kreg;
            __syncthreads();
        }
#ifdef PROBE_SEL
        const unsigned long long ps0 = __builtin_amdgcn_s_memrealtime();
#endif
#pragma unroll 1
        for (int tt = 0; tt < 2; ++tt) {
            unsigned long long* bmrow = BMp + (size_t)(t0 + tt) * 32;
            int ln = lane; asm volatile("" : "+v"(ln));
            unsigned key[32];
            unsigned prefix = 0u; bool have = false, simple = false;
            {
                float sv[32]; int binv[32];
                float smin = INFINITY, smax = -INFINITY;
#pragma unroll
                for (int i = 0; i < 32; ++i) { sv[i] = -INFINITY; if (i < nk) { sv[i] = sc[tt * 2048 + i * 64 + lane]; smin = fminf(smin, sv[i]); smax = fmaxf(smax, sv[i]); } }
#pragma unroll
                for (int i = 0; i < 32; ++i) key[i] = mono_key(sv[i]);
                smin = fminf(smin, dppf<0xB1>(smin)); smin = fminf(smin, dppf<0x4E>(smin)); smin = fminf(smin, dppf<0x141>(smin)); smin = fminf(smin, dppf<0x140>(smin));
                smax = fmaxf(smax, dppf<0xB1>(smax)); smax = fmaxf(smax, dppf<0x4E>(smax)); smax = fmaxf(smax, dppf<0x141>(smax)); smax = fmaxf(smax, dppf<0x140>(smax));
#define RLF(v, l) __int_as_float(__builtin_amdgcn_readlane(__float_as_int(v), (l)))
                smin = fminf(fminf(RLF(smin, 0), RLF(smin, 16)), fminf(RLF(smin, 32), RLF(smin, 48)));
                smax = fmaxf(fmaxf(RLF(smax, 0), RLF(smax, 16)), fmaxf(RLF(smax, 32), RLF(smax, 48)));
#undef RLF
                const float range = smax - smin;
                if (range > 0.f && range < 3.0e38f) {
                    const float scale = 255.99f / range;
                    *(LAS v4u*)(HS + 4 * lane) = (v4u){0u, 0u, 0u, 0u};
                    LDS_WAIT(); asm volatile("" ::: "memory");
#pragma unroll
                    for (int i = 0; i < 32; ++i) { binv[i] = -1;
                        if (i < nk) { int bq = (int)((sv[i] - smin) * scale); bq = bq < 0 ? 0 : (bq > 255 ? 255 : bq); binv[i] = bq; __hip_atomic_fetch_add(HS + bq, 1u, __ATOMIC_RELAXED, __HIP_MEMORY_SCOPE_WORKGROUP); } }
                    LDS_WAIT(); asm volatile("" ::: "memory");
                    const v4u hq = *(const LAS v4u*)(HS + 252 - 4 * lane);
                    const int h0 = (int)hq.w, h1 = (int)hq.z, h2 = (int)hq.y, h3 = (int)hq.x, sl = (h0 + h1) + (h2 + h3);
                    int P = sl;
                    P += __builtin_amdgcn_mov_dpp(P, 0x111, 0xf, 0xf, true); P += __builtin_amdgcn_mov_dpp(P, 0x112, 0xf, 0xf, true);
                    P += __builtin_amdgcn_mov_dpp(P, 0x114, 0xf, 0xf, true); P += __builtin_amdgcn_mov_dpp(P, 0x118, 0xf, 0xf, true);
                    { const int r0 = __builtin_amdgcn_readlane(P, 15), r1 = __builtin_amdgcn_readlane(P, 31), r2 = __builtin_amdgcn_readlane(P, 47); const int row = lane >> 4;
                      P += (row > 0 ? r0 : 0) + (row > 1 ? r1 : 0) + (row > 2 ? r2 : 0); }
                    const unsigned long long ball = __ballot(P >= 256);
                    if (ball != 0ull) {
                        const int L = __builtin_ctzll(ball);
                        int cab = __builtin_amdgcn_readlane(P - sl, L);
                        const int g0_ = __builtin_amdgcn_readlane(h0, L), g1_ = __builtin_amdgcn_readlane(h1, L), g2_ = __builtin_amdgcn_readlane(h2, L), g3_ = __builtin_amdgcn_readlane(h3, L);
                        int B, mB;
                        if (cab + g0_ >= 256) { B = 255 - 4 * L; mB = g0_; }
                        else if (cab + g0_ + g1_ >= 256) { cab += g0_; B = 254 - 4 * L; mB = g1_; }
                        else if (cab + g0_ + g1_ + g2_ >= 256) { cab += g0_ + g1_; B = 253 - 4 * L; mB = g2_; }
                        else { cab += g0_ + g1_ + g2_; B = 252 - 4 * L; mB = g3_; }
                        const int need = 256 - cab;
                        if (mB <= 64) {
                            int cntl = 0;
#pragma unroll
                            for (int i = 0; i < 32; ++i) cntl += (binv[i] == B) ? 1 : 0;
                            int Q = cntl;
                            Q += __builtin_amdgcn_mov_dpp(Q, 0x111, 0xf, 0xf, true); Q += __builtin_amdgcn_mov_dpp(Q, 0x112, 0xf, 0xf, true);
                            Q += __builtin_amdgcn_mov_dpp(Q, 0x114, 0xf, 0xf, true); Q += __builtin_amdgcn_mov_dpp(Q, 0x118, 0xf, 0xf, true);
                            { const int r0 = __builtin_amdgcn_readlane(Q, 15), r1 = __builtin_amdgcn_readlane(Q, 31), r2 = __builtin_amdgcn_readlane(Q, 47); const int row = lane >> 4;
                              Q += (row > 0 ? r0 : 0) + (row > 1 ? r1 : 0) + (row > 2 ? r2 : 0); }
                            int pos = Q - cntl;
#pragma unroll
                            for (int i = 0; i < 32; ++i) { if (i < nk) { const bool inb = binv[i] == B; CL[inb ? pos : 64 + lane] = key[i]; pos += inb ? 1 : 0; } }
                            LDS_WAIT(); asm volatile("" ::: "memory");
                            const unsigned cv = lane < mB ? CL[lane] : 0u;
                            int gt = 0, ge = 0;
                            for (int jj = 0; jj < mB; ++jj) { const unsigned cj = (unsigned)__builtin_amdgcn_readlane((int)cv, jj); gt += cj > cv ? 1 : 0; ge += cj >= cv ? 1 : 0; }
                            const unsigned long long hit = __ballot(lane < mB && gt < need && need <= ge);
                            if (hit != 0ull) { const int hl = __builtin_ctzll(hit); prefix = (unsigned)__builtin_amdgcn_readlane((int)cv, hl); have = true;
                                const int gth = __builtin_amdgcn_readlane(gt, hl), geh = __builtin_amdgcn_readlane(ge, hl); simple = (geh - gth) == (need - gth); }
                        }
                    }
                }
            }
            if (!have) {
            prefix = 0u;
#pragma unroll 1
            for (int bit = 31; bit >= 0; --bit) {
                const unsigned cand = prefix | (1u << bit); int cl = 0;
#pragma unroll
                for (int gq = 0; gq < 8; ++gq) {
                    if (gq * 4 < nk) {
#pragma unroll
                        for (int i = gq * 4; i < gq * 4 + 4; ++i) cl += (key[i] >= cand) ? 1 : 0;
                    }
                }
                cl += __builtin_amdgcn_mov_dpp(cl, 0xB1, 0xf, 0xf, true); cl += __builtin_amdgcn_mov_dpp(cl, 0x4E, 0xf, 0xf, true);
                cl += __builtin_amdgcn_mov_dpp(cl, 0x141, 0xf, 0xf, true); cl += __builtin_amdgcn_mov_dpp(cl, 0x140, 0xf, 0xf, true);
                const int cnt = __builtin_amdgcn_readlane(cl, 0) + __builtin_amdgcn_readlane(cl, 16) + __builtin_amdgcn_readlane(cl, 32) + __builtin_amdgcn_readlane(cl, 48);
                if (cnt >= 256) prefix = cand;
                if (cnt == 256) break;
            }
            }
            if (simple) {
                unsigned wl = 0u, wh = 0u;
#pragma unroll
                for (int i = 0; i < 32; ++i) { if (i < nk) { const unsigned long long word = __ballot(key[i] >= prefix); if (ln == i) { wl = (unsigned)word; wh = (unsigned)(word >> 32); } } }
                if (lane < nk) bmrow[lane] = ((unsigned long long)wh << 32) | (unsigned long long)wl;
            } else {
                int ngt = 0;
    #pragma unroll
                for (int i = 0; i < 32; ++i) { ngt += __builtin_popcountll(__ballot(key[i] > prefix)); if ((i & 3) == 3) __builtin_amdgcn_sched_barrier(0); }
                const int need = 256 - ngt; int running = 0;
                const unsigned long long lt_mask = (1ull << lane) - 1ull;
    #pragma unroll
                for (int i = 0; i < 32; ++i) {
                    const unsigned long long eq = __ballot(key[i] == prefix), gt = __ballot(key[i] > prefix);
                    const int rank = running + __builtin_popcountll(eq & lt_mask);
                    const unsigned long long se = __ballot(key[i] == prefix && rank < need);
                    running += __builtin_popcountll(eq);
                    const unsigned long long word = gt | se;
                    if (lane == 0) bmrow[i] = word;
                    __builtin_amdgcn_sched_barrier(0);
                }
            }
        }
#ifdef PROBE_SEL
        pr_extra += __builtin_amdgcn_s_memrealtime() - ps0;
#endif
        LDS_WAIT(); asm volatile("" ::: "memory");
    }
}

__device__ __forceinline__ void p3_hg_finalize(Frame& F) {
    bf16* HG = (bf16*)(F.ws + WS_HO); const bf16* GBp = (const bf16*)(F.ws + WS_GB); const float* ng = F.a->in[I_BNG];
    const int gw = blockIdx.x * NWAVES + F.wave, NGW = F.G * NWAVES, sub = F.lane >> 4, l16 = F.lane & 15;
    float gv[8];
#pragma unroll
    for (int j = 0; j < 8; ++j) gv[j] = ng[l16 * 8 + j];
    for (int r4 = gw; r4 < T; r4 += NGW) {
        const size_t off = (size_t)r4 * 512 + sub * 128 + l16 * 8, offh = off + (size_t)r4 * 512;
        const v4u p = *(const v4u*)(HG + offh), q = *(const v4u*)(GBp + off);
        float v[8] = {bflo(p.x), bfhi(p.x), bflo(p.y), bfhi(p.y), bflo(p.z), bfhi(p.z), bflo(p.w), bfhi(p.w)};
        float gg[8] = {bflo(q.x), bfhi(q.x), bflo(q.y), bfhi(q.y), bflo(q.z), bfhi(q.z), bflo(q.w), bfhi(q.w)};
        float ss = 0.f;
#pragma unroll
        for (int j = 0; j < 8; ++j) ss += v[j] * v[j];
        ss += __shfl_xor(ss, 1); ss += __shfl_xor(ss, 2); ss += __shfl_xor(ss, 4); ss += __shfl_xor(ss, 8);
        const float r = rsqrtf(ss * (1.0f / 128.0f) + RMS_EPS);
        float o[8];
#pragma unroll
        for (int j = 0; j < 8; ++j) o[j] = v[j] * r * gv[j] * gg[j] * sigmoidf_(gg[j]);
        v4u w; w.x = pk2(o[0], o[1]); w.y = pk2(o[2], o[3]); w.z = pk2(o[4], o[5]); w.w = pk2(o[6], o[7]);
        *(v4u*)(HG + offh) = w;
    }
}

__device__ __forceinline__ int t5_bucket(int rel) {
    const int n = rel < 0 ? -rel : rel; const int base = rel > 0 ? 16 : 0;
    int v;
    if (n < 8) v = n; else v = n >= 91 ? 15 : n >= 64 ? 14 : n >= 46 ? 13 : n >= 32 ? 12 : n >= 23 ? 11 : n >= 16 ? 10 : n >= 12 ? 9 : 8;
    return base + v;
}
__device__ __forceinline__ void p3_attn_simple(Frame& F) {
    const bf16* CKV = (const bf16*)(F.ws + WS_CKV); bf16* QL = (bf16*)(F.ws + WS_QL);
    const unsigned long long* BMp = (const unsigned long long*)(F.ws + WS_BM);
    LAS float* relb = (LAS float*)(F.lds + 8 * 12800);
    LAS float* qlf = (LAS float*)(F.lds + F.wave * 12800);
    LAS float* pl = (LAS float*)(F.lds + F.wave * 12800 + 4096);
    LAS unsigned short* idx = (LAS unsigned short*)(F.lds + F.wave * 12800 + 4096 + 8192);
    if (F.tid < 256) relb[F.tid] = F.a->in[I_RELB][F.tid];
    __syncthreads();
    const int gw = blockIdx.x * NWAVES + F.wave, NGW = F.G * NWAVES, lane = F.lane;
    const unsigned long long lt_mask = (1ull << lane) - 1ull;
    for (int t = gw; t < T; t += NGW) {
        const int b = t >> 11, pos = t & 2047, nk = (pos >> 6) + 1;
        {
#pragma unroll
            for (int j = 0; j < 2; ++j) { const v4u p = *(const v4u*)(QL + (size_t)t * 1024 + j * 512 + lane * 8);
                f32x4 a = {bflo(p.x), bfhi(p.x), bflo(p.y), bfhi(p.y)}, c = {bflo(p.z), bfhi(p.z), bflo(p.w), bfhi(p.w)};
                *(LAS f32x4*)(qlf + j * 512 + lane * 8) = a; *(LAS f32x4*)(qlf + j * 512 + lane * 8 + 4) = c; }
        }
        int n = 0;
        for (int i = 0; i < nk; ++i) {
            const unsigned long long word = BMp[(size_t)t * 32 + i];
            if ((word >> lane) & 1ull) idx[n + __builtin_popcountll(word & lt_mask)] = (unsigned short)(i * 64 + lane);
            n += __builtin_popcountll(word);
        }
        LDS_WAIT(); asm volatile("" ::: "memory");
#pragma unroll 1
        for (int j = 0; j < 4; ++j) {
            const int k = lane + 64 * j; const bool ok = k < n; const int s = ok ? (int)idx[k] : 0;
            const v4u* row = (const v4u*)(CKV + ((size_t)b * SEQ + s) * 128);
            float d[8];
#pragma unroll
            for (int h = 0; h < 8; ++h) d[h] = 0.f;
#pragma unroll 1
            for (int q4 = 0; q4 < 4; ++q4) {
                asm volatile("" ::: "memory");
                float ck[32];
#pragma unroll
                for (int c = 0; c < 4; ++c) { const v4u p = row[q4 * 4 + c]; ck[c * 8 + 0] = bflo(p.x); ck[c * 8 + 1] = bfhi(p.x); ck[c * 8 + 2] = bflo(p.y); ck[c * 8 + 3] = bfhi(p.y); ck[c * 8 + 4] = bflo(p.z); ck[c * 8 + 5] = bfhi(p.z); ck[c * 8 + 6] = bflo(p.w); ck[c * 8 + 7] = bfhi(p.w); }
#pragma unroll
                for (int h = 0; h < 8; ++h) {
#pragma unroll
                    for (int c = 0; c < 8; ++c) { const f32x4 q = *(const LAS f32x4*)(qlf + h * 128 + q4 * 32 + c * 4); d[h] += q.x * ck[c * 4] + q.y * ck[c * 4 + 1] + q.z * ck[c * 4 + 2] + q.w * ck[c * 4 + 3]; }
                    __builtin_amdgcn_sched_barrier(0);
                }
            }
            const int bk = t5_bucket(s - pos);
            f32x4 s0, s1;
            s0.x = ok ? d[0] + relb[bk * 8 + 0] : -INFINITY; s0.y = ok ? d[1] + relb[bk * 8 + 1] : -INFINITY; s0.z = ok ? d[2] + relb[bk * 8 + 2] : -INFINITY; s0.w = ok ? d[3] + relb[bk * 8 + 3] : -INFINITY;
            s1.x = ok ? d[4] + relb[bk * 8 + 4] : -INFINITY; s1.y = ok ? d[5] + relb[bk * 8 + 5] : -INFINITY; s1.z = ok ? d[6] + relb[bk * 8 + 6] : -INFINITY; s1.w = ok ? d[7] + relb[bk * 8 + 7] : -INFINITY;
            *(LAS f32x4*)(pl + k * 8) = s0; *(LAS f32x4*)(pl + k * 8 + 4) = s1;
        }
        LDS_WAIT(); asm volatile("" ::: "memory");
        {
            f32x4 a0[4], a1[4];
#pragma unroll
            for (int j = 0; j < 4; ++j) { a0[j] = *(const LAS f32x4*)(pl + (lane + 64 * j) * 8); a1[j] = *(const LAS f32x4*)(pl + (lane + 64 * j) * 8 + 4); }
#pragma unroll
            for (int h = 0; h < 8; ++h) {
                float v[4];
#pragma unroll
                for (int j = 0; j < 4; ++j) v[j] = h < 4 ? a0[j][h & 3] : a1[j][h & 3];
                float m = wave_max(fmaxf(fmaxf(v[0], v[1]), fmaxf(v[2], v[3])));
                float sum = 0.f;
#pragma unroll
                for (int j = 0; j < 4; ++j) { v[j] = __expf(v[j] - m); sum += v[j]; }
                const float inv = 1.0f / wave_sum(sum);
#pragma unroll
                for (int j = 0; j < 4; ++j) { if (h < 4) a0[j][h & 3] = v[j] * inv; else a1[j][h & 3] = v[j] * inv; }
            }
#pragma unroll
            for (int j = 0; j < 4; ++j) { *(LAS f32x4*)(pl + (lane + 64 * j) * 8) = a0[j]; *(LAS f32x4*)(pl + (lane + 64 * j) * 8 + 4) = a1[j]; }
        }
        LDS_WAIT(); asm volatile("" ::: "memory");
        float acc[8][2];
#pragma unroll
        for (int h = 0; h < 8; ++h) { acc[h][0] = 0.f; acc[h][1] = 0.f; }
        for (int k = 0; k < n; ++k) {
            const int s = (int)idx[k];
            const unsigned vv = *(const unsigned*)(CKV + ((size_t)b * SEQ + s) * 128 + 2 * lane);
            const float v0 = bflo(vv), v1 = bfhi(vv);
            const f32x4 p0 = *(const LAS f32x4*)(pl + k * 8), p1 = *(const LAS f32x4*)(pl + k * 8 + 4);
            acc[0][0] += p0.x * v0; acc[0][1] += p0.x * v1; acc[1][0] += p0.y * v0; acc[1][1] += p0.y * v1;
            acc[2][0] += p0.z * v0; acc[2][1] += p0.z * v1; acc[3][0] += p0.w * v0; acc[3][1] += p0.w * v1;
            acc[4][0] += p1.x * v0; acc[4][1] += p1.x * v1; acc[5][0] += p1.y * v0; acc[5][1] += p1.y * v1;
            acc[6][0] += p1.z * v0; acc[6][1] += p1.z * v1; acc[7][0] += p1.w * v0; acc[7][1] += p1.w * v1;
        }
#pragma unroll
        for (int h = 0; h < 8; ++h) *(unsigned*)(QL + (size_t)t * 1024 + h * 128 + 2 * lane) = pk2(acc[h][0], acc[h][1]);
        LDS_WAIT(); asm volatile("" ::: "memory");
    }
}

__device__ __forceinline__ unsigned offb(unsigned row, unsigned ch) { return 256u * row + 16u * (ch ^ (((row & 3u) << 2) | ((row >> 2) & 3u))); }
__device__ __forceinline__ void p3_attn_mfma(Frame& F) {
    typedef short bf16x8 __attribute__((ext_vector_type(8)));
    typedef short s16x4 __attribute__((ext_vector_type(4)));
    typedef float f32x16 __attribute__((ext_vector_type(16)));
    const bf16* CKV = (const bf16*)(F.ws + WS_CKV); bf16* QL = (bf16*)(F.ws + WS_QL);
    const unsigned long long* BMp = (const unsigned long long*)(F.ws + WS_BM);
    LAS unsigned char* KV = F.lds;
    LAS float* LUT = (LAS float*)(F.lds + 49152);
    LAS unsigned char* QS = F.lds + 57344 + F.wave * 8192;
    const int tid = F.tid, lane = F.lane, head = F.wave, r = lane & 31, h = lane >> 5;
    for (int e = tid; e < 8 * 160; e += NTHREADS) { const int hh = e / 160, i = e % 160; const int rel = (i < 155 ? i : 154) - 91; LUT[e] = F.a->in[I_RELB][t5_bucket(rel) * 8 + hh] * LOG2E; }
    __syncthreads();
    const float bfar = LUT[head * 160];
    const unsigned blk = (lane >> 4) & 1, q4 = (lane & 15) >> 2, p4 = lane & 3;
    unsigned kofs[8], tofs[2][4];
#pragma unroll
    for (int ks = 0; ks < 8; ++ks) kofs[ks] = offb((unsigned)r, (unsigned)(2 * ks + h));
#pragma unroll
    for (int tp = 0; tp < 2; ++tp)
#pragma unroll
        for (int cb = 0; cb < 4; ++cb) tofs[tp][cb] = offb(8u * tp + 4u * h + q4, 4u * cb + 2u * blk + (p4 >> 1)) + 8u * (p4 & 1u);
    const unsigned qsb = 256u * (lane >> 4) + 16u * ((lane & 15) ^ ((lane >> 4) << 2)), owb = 256u * r + 16u * (((r & 3u) << 2) | ((r >> 2) & 3u)) + 8u * h;
#define ATT_QK(bb, ST) do { _Pragma("unroll") for (int s2 = 0; s2 < 2; ++s2) { \
        const f32x16 zero16 = {0.f, 0.f, 0.f, 0.f, 0.f, 0.f, 0.f, 0.f, 0.f, 0.f, 0.f, 0.f, 0.f, 0.f, 0.f, 0.f}; \
        { const bf16x8 a_ = *(const LAS bf16x8*)(KV + ((bb) + kofs[0]) + s2 * 8192); ST[s2] = __builtin_amdgcn_mfma_f32_32x32x16_bf16(a_, qreg[0], zero16, 0, 0, 0); } \
        _Pragma("unroll") for (int ks = 1; ks < 8; ++ks) { const bf16x8 a_ = *(const LAS bf16x8*)(KV + ((bb) + kofs[ks]) + s2 * 8192); \
            ST[s2] = __builtin_amdgcn_mfma_f32_32x32x16_bf16(a_, qreg[ks], ST[s2], 0, 0, 0); } } } while (0)
#define ATT_SM(kt, bw, FAR) do { \
        const int wsel_[2] = {(int)((unsigned)(bw) >> (4 * h)), (int)((unsigned)((bw) >> 32) >> (4 * h))}; \
        float mx_ = -1e30f; \
        _Pragma("unroll") for (int s2 = 0; s2 < 2; ++s2) _Pragma("unroll") for (int i = 0; i < 16; ++i) { \
            const int cr_ = (i & 3) + 8 * (i >> 2); float bias_ = bfar; \
            if (!(FAR)) { int rel_ = (kt) * 64 + 32 * s2 + cr_ + 4 * h - (t0 + r); rel_ = rel_ < -91 ? -91 : rel_; bias_ = LUT[head * 160 + rel_ + 91]; } \
            const unsigned mk_ = (unsigned)__builtin_amdgcn_sbfe(wsel_[s2], cr_, 1); \
            const float sc_ = __uint_as_float((__float_as_uint(ST[s2][i] + bias_) & mk_) | (0xff800000u & ~mk_)); \
            ST[s2][i] = sc_; mx_ = fmaxf(mx_, sc_); } \
        mx_ = fmaxf(mx_, __shfl_xor(mx_, 32)); \
        const float mnew_ = fmaxf(m, mx_), alpha_ = __builtin_amdgcn_exp2f(m - mnew_); \
        const bool changed_ = __builtin_amdgcn_ballot_w64(mnew_ != m) != 0ull; \
        m = mnew_; float ps_ = 0.f; \
        _Pragma("unroll") for (int s2 = 0; s2 < 2; ++s2) _Pragma("unroll") for (int i = 0; i < 16; ++i) { const float pv_ = __builtin_amdgcn_exp2f(ST[s2][i] - mnew_); ST[s2][i] = pv_; ps_ += pv_; } \
        l = l * alpha_ + ps_; \
        if (changed_) { _Pragma("unroll") for (int cb = 0; cb < 4; ++cb) _Pragma("unroll") for (int i = 0; i < 16; ++i) O[cb][i] *= alpha_; } } while (0)
#define ATT_PV(bb) do { _Pragma("unroll") for (int s2 = 0; s2 < 2; ++s2) _Pragma("unroll") for (int u = 0; u < 2; ++u) { \
        v4u pk_; pk_.x = pk2(ST[s2][8 * u], ST[s2][8 * u + 1]); pk_.y = pk2(ST[s2][8 * u + 2], ST[s2][8 * u + 3]); pk_.z = pk2(ST[s2][8 * u + 4], ST[s2][8 * u + 5]); pk_.w = pk2(ST[s2][8 * u + 6], ST[s2][8 * u + 7]); \
        const bf16x8 pf_ = __builtin_bit_cast(bf16x8, pk_); \
        _Pragma("unroll") for (int cb = 0; cb < 4; ++cb) { \
            const s16x4 lo_ = __builtin_amdgcn_ds_read_tr16_b64_v4i16((LAS s16x4*)(KV + ((bb) + tofs[0][cb]) + s2 * 8192 + u * 4096)); \
            const s16x4 hi_ = __builtin_amdgcn_ds_read_tr16_b64_v4i16((LAS s16x4*)(KV + ((bb) + tofs[1][cb]) + s2 * 8192 + u * 4096)); \
            const bf16x8 va_ = __builtin_shufflevector(lo_, hi_, 0, 1, 2, 3, 4, 5, 6, 7); \
            O[cb] = __builtin_amdgcn_mfma_f32_32x32x16_bf16(va_, pf_, O[cb], 0, 0, 0); } __builtin_amdgcn_sched_barrier(0); } } while (0)
    for (int uidx = blockIdx.x; uidx < NB * 64; uidx += F.G) {
        const int k = uidx >> 8, c0 = (uidx >> 5) & 7;
        const int b = uidx & 31, qt = 8 * k + ((k & 1) ? 7 - c0 : c0);
        const int t0 = qt * 32, nkt = (qt >> 1) + 1;
        const size_t trow = (size_t)b * SEQ + t0 + r;
        {
            const size_t qb = ((size_t)b * SEQ + t0 + (lane >> 4)) * 1024 + head * 128 + (lane & 15) * 8;
            unsigned ql = qsb; asm volatile("" : "+v"(ql));
#pragma unroll
            for (int i = 0; i < 8; ++i) *(LAS v4u*)(QS + (ql ^ (16u * (i & 3))) + 1024 * i) = *(const v4u*)(QL + qb + (size_t)(4 * i) * 1024);
        }
        bf16x8 qreg[8];
#pragma unroll
        for (int ks = 0; ks < 8; ++ks) qreg[ks] = *(const LAS bf16x8*)(QS + kofs[ks]);
        f32x16 O[4], ST[2];
#pragma unroll
        for (int cb = 0; cb < 4; ++cb)
#pragma unroll
            for (int i = 0; i < 16; ++i) O[cb][i] = 0.f;
        float m = -1e30f, l = 0.f;
        const int drow = 4 * head + (lane >> 4), dch = (lane & 15) ^ (((drow & 3) << 2) | ((drow >> 2) & 3));
        const bf16* gsrc = CKV + ((size_t)b * SEQ + drow) * 128 + dch * 8;
#define ATT_LOAD(bufoff, ktile) do { _Pragma("unroll") for (int j_ = 0; j_ < 2; ++j_) \
            __builtin_amdgcn_global_load_lds((const unsigned*)(gsrc + ((size_t)(ktile) * 64 + 32 * j_) * 128), (LAS unsigned*)(KV + (bufoff) + j_ * 8192 + head * 1024), 16, 0, 0); } while (0)
        ATT_LOAD(0u, 0);
        if (nkt > 1) ATT_LOAD(16384u, 1);
        unsigned long long bw = BMp[trow * 32];
        asm volatile("s_waitcnt vmcnt(0)" ::: "memory");
        __syncthreads();
        ATT_QK(0u, ST);
        unsigned bi = 0u;
        const int kfar = t0 >= 154 ? ((t0 - 154) >> 6) + 1 : 0;
#define ATT_ITER(FAR) do { \
            const unsigned buf = bi; \
            const unsigned bi1 = bi == 32768u ? 0u : bi + 16384u, bi2 = bi1 == 32768u ? 0u : bi1 + 16384u; \
            if (kt + 2 < nkt) ATT_LOAD(bi2, kt + 2); \
            unsigned long long bwn = 0ull; if (kt + 1 < nkt) bwn = BMp[trow * 32 + kt + 1]; \
            const unsigned nb = (kt + 1 < nkt) ? bi1 : bi; \
            f32x16 SN[2]; \
            ATT_QK(nb, SN); \
            ATT_SM(kt, bw, FAR); \
            _Pragma("unroll") for (int sg = 0; sg < 16; ++sg) { __builtin_amdgcn_sched_group_barrier(0x008, 1, 0); __builtin_amdgcn_sched_group_barrier(0x100, 2, 0); __builtin_amdgcn_sched_group_barrier(0x002, 18, 0); } \
            ATT_PV(buf); \
            ST[0] = SN[0]; ST[1] = SN[1]; \
            bw = bwn; bi = bi1; \
            asm volatile("s_waitcnt vmcnt(0)" ::: "memory"); \
            __syncthreads(); } while (0)
        int kt = 0;
        for (; kt < kfar; ++kt) ATT_ITER(true);
        for (; kt < nkt; ++kt) ATT_ITER(false);
#undef ATT_ITER
#undef ATT_LOAD
        const float lt = l + __shfl_xor(l, 32), inv = 1.0f / lt;
        unsigned ow = owb; asm volatile("" : "+v"(ow));
#pragma unroll
        for (int cb = 0; cb < 4; ++cb)
#pragma unroll
            for (int g4 = 0; g4 < 4; ++g4) {
                v2u w; w.x = pk2(O[cb][4 * g4] * inv, O[cb][4 * g4 + 1] * inv); w.y = pk2(O[cb][4 * g4 + 2] * inv, O[cb][4 * g4 + 3] * inv);
                *(LAS v2u*)(QS + (ow ^ (16u * (4 * cb + g4)))) = w;
            }
        {
            const size_t qb = ((size_t)b * SEQ + t0 + (lane >> 4)) * 1024 + head * 128 + (lane & 15) * 8;
            unsigned ql = qsb; asm volatile("" : "+v"(ql));
#pragma unroll
            for (int i = 0; i < 8; ++i) *(v4u*)(QL + qb + (size_t)(4 * i) * 1024) = *(const LAS v4u*)(QS + (ql ^ (16u * (i & 3))) + 1024 * i);
        }
    }
#undef ATT_QK
#undef ATT_SM
#undef ATT_PV
}

__device__ __forceinline__ void p6_ln1(Frame& F) {
    bf16* X1B = (bf16*)(F.ws + WS_X1B); const float* g = F.a->in[I_LN1G]; const float* bb = F.a->in[I_LN1B];
    const int gw = blockIdx.x * NWAVES + F.wave, NGW = F.G * NWAVES, lane = F.lane;
    f32x4 gv[4], bv[4];
#pragma unroll
    for (int j = 0; j < 4; ++j) { gv[j] = ((const f32x4*)g)[lane + 64 * j]; bv[j] = ((const f32x4*)bb)[lane + 64 * j]; }
    for (int m = gw; m < T; m += NGW) {
        v2u* o8 = (v2u*)(X1B + (size_t)m * DM) + lane;
        f32x4 v[4]; float s = 0.f;
#pragma unroll
        for (int j = 0; j < 4; ++j) { const v2u p = o8[64 * j]; v[j] = (f32x4){bflo(p.x), bfhi(p.x), bflo(p.y), bfhi(p.y)}; s += (v[j].x + v[j].y) + (v[j].z + v[j].w); }
        const float mean = wave_sum_dpp(s) * (1.f / DM); float s2 = 0.f;
#pragma unroll
        for (int j = 0; j < 4; ++j) { v[j] = v[j] - mean; s2 += (v[j].x * v[j].x + v[j].y * v[j].y) + (v[j].z * v[j].z + v[j].w * v[j].w); }
        const float rstd = rsqrtf(wave_sum_dpp(s2) * (1.f / DM) + LN_EPS);
        float am = 0.f;
#pragma unroll
        for (int j = 0; j < 4; ++j) { const f32x4 o = v[j] * rstd * gv[j] + bv[j]; v[j] = o; v2u w; w.x = pk2(o.x, o.y); w.y = pk2(o.z, o.w); o8[64 * j] = w;
            am = fmaxf(am, fmaxf(fmaxf(fabsf(o.x), fabsf(o.y)), fmaxf(fabsf(o.z), fabsf(o.w)))); }
        {
            am = wave_max(am);
            const float sc = am > 0.f ? 127.0f / am : 1.0f;
            if (lane == 0) ((float*)(F.ws + WS_XINV))[m] = am > 0.f ? am * (1.0f / 127.0f) : 1.0f;
#pragma unroll
            for (int j = 0; j < 4; ++j) { const int a0 = (int)rintf(v[j].x * sc), a1 = (int)rintf(v[j].y * sc), a2 = (int)rintf(v[j].z * sc), a3 = (int)rintf(v[j].w * sc);
                *(unsigned*)(F.ws + WS_X8 + (size_t)m * DM + 4 * lane + 256 * j) = (unsigned)((a0 & 0xff) | ((a1 & 0xff) << 8) | ((a2 & 0xff) << 16) | ((a3 & 0xff) << 24)); }
        }
    }
}

#define TOP16_INSERT(tv, ti, val, id) do { \
    _Pragma("unroll") for (int _j = 15; _j >= 1; --_j) { const bool _up = (val) > tv[_j - 1]; const bool _here = (val) > tv[_j]; \
        tv[_j] = _up ? tv[_j - 1] : (_here ? (val) : tv[_j]); ti[_j] = _up ? ti[_j - 1] : (_here ? (id) : ti[_j]); } \
    { const bool _h0 = (val) > tv[0]; tv[0] = _h0 ? (val) : tv[0]; ti[0] = _h0 ? (id) : ti[0]; } } while (0)
__device__ __forceinline__ void p8_peer_route_simple(Frame& F) {
    const bf16* PQ = (const bf16*)(F.ws + WS_PQ); unsigned short* IDS = (unsigned short*)(F.ws + WS_IDS); float* GATES = (float*)(F.ws + WS_GATES);
    LAS float* K1 = (LAS float*)(F.lds); LAS float* K2 = (LAS float*)(F.lds + 65536);
    for (int e = F.tid; e < 16384; e += NTHREADS) { K1[e] = F.a->in[I_SK1][e]; K2[e] = F.a->in[I_SK2][e]; }
    __syncthreads();
    const size_t gtid = (size_t)blockIdx.x * NTHREADS + F.tid, gthreads = (size_t)F.G * NTHREADS;
    for (size_t item = gtid; item < (size_t)T * 8; item += gthreads) {
        const size_t t = item >> 3; const int h = (int)(item & 7);
        float v1[16], v2[16]; int i1[16], i2[16];
#pragma unroll
        for (int half = 0; half < 2; ++half) {
            const v4u* qp = (const v4u*)(PQ + t * 2048 + h * 256 + half * 128);
            v4u q[16];
#pragma unroll
            for (int c = 0; c < 16; ++c) q[c] = qp[c];
            float tv[16]; int ti[16];
#pragma unroll
            for (int j = 0; j < 16; ++j) { tv[j] = -INFINITY; ti[j] = 0; }
            const LAS float* KK = half ? K2 : K1;
#pragma unroll 1
            for (int n = 0; n < 128; ++n) {
                float d = 0.f;
#pragma unroll
                for (int c = 0; c < 16; ++c) { const f32x4 ka = *(const LAS f32x4*)(KK + n * 128 + c * 8), kb = *(const LAS f32x4*)(KK + n * 128 + c * 8 + 4);
                    d += ka.x * bflo(q[c].x) + ka.y * bfhi(q[c].x) + ka.z * bflo(q[c].y) + ka.w * bfhi(q[c].y) + kb.x * bflo(q[c].z) + kb.y * bfhi(q[c].z) + kb.z * bflo(q[c].w) + kb.w * bfhi(q[c].w);
                    if ((c & 3) == 3) __builtin_amdgcn_sched_barrier(0); }
                TOP16_INSERT(tv, ti, d, n);
            }
#pragma unroll
            for (int j = 0; j < 16; ++j) { if (half) { v2[j] = tv[j]; i2[j] = ti[j]; } else { v1[j] = tv[j]; i1[j] = ti[j]; } }
        }
        float tv[16]; int ti[16];
#pragma unroll
        for (int j = 0; j < 16; ++j) { tv[j] = -INFINITY; ti[j] = 0; }
#pragma unroll
        for (int a = 0; a < 16; ++a)
#pragma unroll
            for (int c = 0; c < 16; ++c)
                if ((a + 1) * (c + 1) <= 16) { const float val = v1[a] + v2[c]; const int id = i1[a] * 128 + i2[c]; TOP16_INSERT(tv, ti, val, id); }
        float ev[16], sum = 0.f;
#pragma unroll
        for (int j = 0; j < 16; ++j) { ev[j] = __expf(tv[j] - tv[0]); sum += ev[j]; }
        const float inv = 1.0f / sum;
#pragma unroll
        for (int j8 = 0; j8 < 2; ++j8) {
            v4u w; w.x = (unsigned)ti[j8 * 8] | ((unsigned)ti[j8 * 8 + 1] << 16); w.y = (unsigned)ti[j8 * 8 + 2] | ((unsigned)ti[j8 * 8 + 3] << 16);
            w.z = (unsigned)ti[j8 * 8 + 4] | ((unsigned)ti[j8 * 8 + 5] << 16); w.w = (unsigned)ti[j8 * 8 + 6] | ((unsigned)ti[j8 * 8 + 7] << 16);
            *(v4u*)(IDS + t * 128 + h * 16 + j8 * 8) = w;
        }
#pragma unroll
        for (int j4 = 0; j4 < 4; ++j4)
            *(f32x4*)(GATES + t * 128 + h * 16 + j4 * 4) = (f32x4){ev[j4 * 4] * inv, ev[j4 * 4 + 1] * inv, ev[j4 * 4 + 2] * inv, ev[j4 * 4 + 3] * inv};
    }
}

#define RT_CE(a, b) do { const float hi_ = __builtin_amdgcn_fmed3f((a), (b), rt_pinf), lo_ = __builtin_amdgcn_fmed3f((a), (b), rt_ninf); (a) = hi_; (b) = lo_; } while (0)
#define RT_SORT16(x) do { RT_CE(x[0], x[13]); RT_CE(x[1], x[12]); RT_CE(x[2], x[15]); RT_CE(x[3], x[14]); RT_CE(x[4], x[8]); RT_CE(x[5], x[6]); RT_CE(x[7], x[11]); RT_CE(x[9], x[10]); RT_CE(x[0], x[5]); RT_CE(x[1], x[7]); RT_CE(x[2], x[9]); RT_CE(x[3], x[4]); RT_CE(x[6], x[13]); RT_CE(x[8], x[14]); RT_CE(x[10], x[15]); RT_CE(x[11], x[12]); RT_CE(x[0], x[1]); RT_CE(x[2], x[3]); RT_CE(x[4], x[5]); RT_CE(x[6], x[8]); RT_CE(x[7], x[9]); RT_CE(x[10], x[11]); RT_CE(x[12], x[13]); RT_CE(x[14], x[15]); RT_CE(x[0], x[2]); RT_CE(x[1], x[3]); RT_CE(x[4], x[10]); RT_CE(x[5], x[11]); RT_CE(x[6], x[7]); RT_CE(x[8], x[9]); RT_CE(x[12], x[14]); RT_CE(x[13], x[15]); RT_CE(x[1], x[2]); RT_CE(x[3], x[12]); RT_CE(x[4], x[6]); RT_CE(x[5], x[7]); RT_CE(x[8], x[10]); RT_CE(x[9], x[11]); RT_CE(x[13], x[14]); RT_CE(x[1], x[4]); RT_CE(x[2], x[6]); RT_CE(x[5], x[8]); RT_CE(x[7], x[10]); RT_CE(x[9], x[13]); RT_CE(x[11], x[14]); RT_CE(x[2], x[4]); RT_CE(x[3], x[6]); RT_CE(x[9], x[12]); RT_CE(x[11], x[13]); RT_CE(x[3], x[5]); RT_CE(x[6], x[8]); RT_CE(x[7], x[9]); RT_CE(x[10], x[12]); RT_CE(x[3], x[4]); RT_CE(x[5], x[6]); RT_CE(x[7], x[8]); RT_CE(x[9], x[10]); RT_CE(x[11], x[12]); RT_CE(x[6], x[7]); RT_CE(x[8], x[9]); } while (0)
#define RT_MERGE16(r, q) do { r[0] = __builtin_amdgcn_fmed3f(r[0], q[15], rt_pinf); r[1] = __builtin_amdgcn_fmed3f(r[1], q[14], rt_pinf); r[2] = __builtin_amdgcn_fmed3f(r[2], q[13], rt_pinf); r[3] = __builtin_amdgcn_fmed3f(r[3], q[12], rt_pinf); r[4] = __builtin_amdgcn_fmed3f(r[4], q[11], rt_pinf); r[5] = __builtin_amdgcn_fmed3f(r[5], q[10], rt_pinf); r[6] = __builtin_amdgcn_fmed3f(r[6], q[9], rt_pinf); r[7] = __builtin_amdgcn_fmed3f(r[7], q[8], rt_pinf); r[8] = __builtin_amdgcn_fmed3f(r[8], q[7], rt_pinf); r[9] = __builtin_amdgcn_fmed3f(r[9], q[6], rt_pinf); r[10] = __builtin_amdgcn_fmed3f(r[10], q[5], rt_pinf); r[11] = __builtin_amdgcn_fmed3f(r[11], q[4], rt_pinf); r[12] = __builtin_amdgcn_fmed3f(r[12], q[3], rt_pinf); r[13] = __builtin_amdgcn_fmed3f(r[13], q[2], rt_pinf); r[14] = __builtin_amdgcn_fmed3f(r[14], q[1], rt_pinf); r[15] = __builtin_amdgcn_fmed3f(r[15], q[0], rt_pinf); RT_CE(r[0], r[8]); RT_CE(r[1], r[9]); RT_CE(r[2], r[10]); RT_CE(r[3], r[11]); RT_CE(r[4], r[12]); RT_CE(r[5], r[13]); RT_CE(r[6], r[14]); RT_CE(r[7], r[15]); RT_CE(r[0], r[4]); RT_CE(r[1], r[5]); RT_CE(r[2], r[6]); RT_CE(r[3], r[7]); RT_CE(r[8], r[12]); RT_CE(r[9], r[13]); RT_CE(r[10], r[14]); RT_CE(r[11], r[15]); RT_CE(r[0], r[2]); RT_CE(r[1], r[3]); RT_CE(r[4], r[6]); RT_CE(r[5], r[7]); RT_CE(r[8], r[10]); RT_CE(r[9], r[11]); RT_CE(r[12], r[14]); RT_CE(r[13], r[15]); RT_CE(r[0], r[1]); RT_CE(r[2], r[3]); RT_CE(r[4], r[5]); RT_CE(r[6], r[7]); RT_CE(r[8], r[9]); RT_CE(r[10], r[11]); RT_CE(r[12], r[13]); RT_CE(r[14], r[15]); } while (0)
#define RT_MERGE8(r, q) do { r[8] = __builtin_amdgcn_fmed3f(r[8], q[7], rt_pinf); r[9] = __builtin_amdgcn_fmed3f(r[9], q[6], rt_pinf); r[10] = __builtin_amdgcn_fmed3f(r[10], q[5], rt_pinf); r[11] = __builtin_amdgcn_fmed3f(r[11], q[4], rt_pinf); r[12] = __builtin_amdgcn_fmed3f(r[12], q[3], rt_pinf); r[13] = __builtin_amdgcn_fmed3f(r[13], q[2], rt_pinf); r[14] = __builtin_amdgcn_fmed3f(r[14], q[1], rt_pinf); r[15] = __builtin_amdgcn_fmed3f(r[15], q[0], rt_pinf); RT_CE(r[0], r[8]); RT_CE(r[1], r[9]); RT_CE(r[2], r[10]); RT_CE(r[3], r[11]); RT_CE(r[4], r[12]); RT_CE(r[5], r[13]); RT_CE(r[6], r[14]); RT_CE(r[7], r[15]); RT_CE(r[0], r[4]); RT_CE(r[1], r[5]); RT_CE(r[2], r[6]); RT_CE(r[3], r[7]); RT_CE(r[8], r[12]); RT_CE(r[9], r[13]); RT_CE(r[10], r[14]); RT_CE(r[11], r[15]); RT_CE(r[0], r[2]); RT_CE(r[1], r[3]); RT_CE(r[4], r[6]); RT_CE(r[5], r[7]); RT_CE(r[8], r[10]); RT_CE(r[9], r[11]); RT_CE(r[12], r[14]); RT_CE(r[13], r[15]); RT_CE(r[0], r[1]); RT_CE(r[2], r[3]); RT_CE(r[4], r[5]); RT_CE(r[6], r[7]); RT_CE(r[8], r[9]); RT_CE(r[10], r[11]); RT_CE(r[12], r[13]); RT_CE(r[14], r[15]); } while (0)
#define MED16_INSERT(tv, key) do { _Pragma("unroll") for (int _j = 15; _j >= 1; --_j) tv[_j] = __builtin_amdgcn_fmed3f(tv[_j - 1], tv[_j], (key)); tv[0] = fmaxf(tv[0], (key)); } while (0)
__device__ __forceinline__ void p8_peer_route_mfma(Frame& F) {
    typedef short bf16x8 __attribute__((ext_vector_type(8)));
    typedef float f32x16 __attribute__((ext_vector_type(16)));
    const bf16* PQ = (const bf16*)(F.ws + WS_PQ); unsigned short* IDS = (unsigned short*)(F.ws + WS_IDS); float* GATES = (float*)(F.ws + WS_GATES);
    LAS bf16* KB = (LAS bf16*)(F.lds);
    for (int e = F.tid; e < 2 * 16384; e += NTHREADS) { const int hs = e >> 14, n = (e >> 7) & 127, d = e & 127;
        KB[hs * 128 * 136 + n * 136 + d] = (bf16)(pk2((hs ? F.a->in[I_SK2] : F.a->in[I_SK1])[n * 128 + d], 0.f) & 0xffffu); }
    __syncthreads();
    const int lane = F.lane, head = F.wave, r = lane & 31, h = lane >> 5;
    const float rt_pinf = INFINITY, rt_ninf = -INFINITY;
    for (int tile = blockIdx.x; tile < T / 32; tile += F.G) {
        const size_t tok = (size_t)tile * 32 + r;
        float v1[16], v2[16];
#pragma unroll
        for (int half = 0; half < 2; ++half) {
            bf16x8 qf[8];
#pragma unroll
            for (int ks = 0; ks < 8; ++ks) qf[ks] = *(const bf16x8*)(PQ + tok * 2048 + head * 256 + half * 128 + 16 * ks + 8 * h);
            float tv[16];
#pragma unroll
            for (int j = 0; j < 16; ++j) tv[j] = -INFINITY;
#pragma unroll 1
            for (int kt = 0; kt < 4; ++kt) {
                f32x16 st;
#pragma unroll
                for (int i = 0; i < 16; ++i) st[i] = 0.f;
#pragma unroll
                for (int ks = 0; ks < 8; ++ks) { const bf16x8 a = *(const LAS bf16x8*)(KB + half * 128 * 136 + (32 * kt + r) * 136 + 16 * ks + 8 * h);
                    st = __builtin_amdgcn_mfma_f32_32x32x16_bf16(a, qf[ks], st, 0, 0, 0); }
                float sk[16];
#pragma unroll
                for (int i = 0; i < 16; ++i) { const unsigned id = (unsigned)(32 * kt + (i & 3) + 8 * (i >> 2) + 4 * h);
                    sk[i] = __uint_as_float((__float_as_uint(st[i]) & 0xffffff80u) | (127u - id)); }
                RT_SORT16(sk);
                RT_MERGE16(tv, sk);
            }
            float pv[16];
#pragma unroll
            for (int j = 0; j < 16; ++j) pv[j] = __shfl_xor(tv[j], 32);
            RT_MERGE16(tv, pv);
#pragma unroll
            for (int j = 0; j < 16; ++j) { if (half) v2[j] = tv[j]; else v1[j] = tv[j]; }
        }
#define RT_CAND(a, c) __uint_as_float((__float_as_uint(v1[a] + v2[c]) & 0xffffff00u) | (unsigned)(255 - (16 * (a) + (c))))
        float tv[16];
#pragma unroll
        for (int c = 0; c < 16; ++c) tv[c] = RT_CAND(0, c);
        { float q8[8];
#pragma unroll
          for (int c = 0; c < 8; ++c) q8[c] = RT_CAND(1, c);
          RT_MERGE8(tv, q8);
#pragma unroll
          for (int a = 8; a < 16; ++a) q8[a - 8] = RT_CAND(a, 0);
          RT_MERGE8(tv, q8); }
#pragma unroll
        for (int a = 2; a < 8; ++a)
#pragma unroll
            for (int c = 0; c < 5; ++c)
                if ((a + 1) * (c + 1) <= 16) { const float key = RT_CAND(a, c); MED16_INSERT(tv, key); }
#undef RT_CAND
        float ev[16], sum = 0.f;
#pragma unroll
        for (int j = 0; j < 16; ++j) { ev[j] = __expf(tv[j] - tv[0]); sum += ev[j]; }
        const float inv = 1.0f / sum;
        unsigned t1[4], t2[4];
#pragma unroll
        for (int q = 0; q < 4; ++q) {
            t1[q] = (127u - (__float_as_uint(v1[4 * q]) & 0x7fu)) | ((127u - (__float_as_uint(v1[4 * q + 1]) & 0x7fu)) << 8) | ((127u - (__float_as_uint(v1[4 * q + 2]) & 0x7fu)) << 16) | ((127u - (__float_as_uint(v1[4 * q + 3]) & 0x7fu)) << 24);
            t2[q] = (127u - (__float_as_uint(v2[4 * q]) & 0x7fu)) | ((127u - (__float_as_uint(v2[4 * q + 1]) & 0x7fu)) << 8) | ((127u - (__float_as_uint(v2[4 * q + 2]) & 0x7fu)) << 16) | ((127u - (__float_as_uint(v2[4 * q + 3]) & 0x7fu)) << 24);
        }
        unsigned ids[16];
#pragma unroll
        for (int j = 0; j < 16; ++j) { const unsigned idx = 255u - (__float_as_uint(tv[j]) & 0xffu), a = idx >> 4, c = idx & 15u;
            const unsigned alo = (a & 8u) ? t1[2] : t1[0], ahi = (a & 8u) ? t1[3] : t1[1], clo = (c & 8u) ? t2[2] : t2[0], chi = (c & 8u) ? t2[3] : t2[1];
            const unsigned ia = __builtin_amdgcn_perm(ahi, alo, 0x0c0c0c00u | (a & 7u)), ic = __builtin_amdgcn_perm(chi, clo, 0x0c0c0c00u | (c & 7u));
            ids[j] = ia * 128u + ic; }
        if (h == 0) {
#pragma unroll
            for (int j8 = 0; j8 < 2; ++j8) {
                v4u w; w.x = ids[j8 * 8] | (ids[j8 * 8 + 1] << 16); w.y = ids[j8 * 8 + 2] | (ids[j8 * 8 + 3] << 16);
                w.z = ids[j8 * 8 + 4] | (ids[j8 * 8 + 5] << 16); w.w = ids[j8 * 8 + 6] | (ids[j8 * 8 + 7] << 16);
                *(v4u*)(IDS + tok * 128 + head * 16 + j8 * 8) = w;
            }
#pragma unroll
            for (int j4 = 0; j4 < 4; ++j4)
                *(f32x4*)(GATES + tok * 128 + head * 16 + j4 * 4) = (f32x4){ev[j4 * 4] * inv, ev[j4 * 4 + 1] * inv, ev[j4 * 4 + 2] * inv, ev[j4 * 4 + 3] * inv};
        }
    }
}

constexpr int Q_CHUNK = 32;
__device__ __forceinline__ void u_step(const v4u (&qc)[16], v4u (&qn)[16], const v4u xq, const v4u na, const v4u nb, const bool donext, const unsigned char* tab, bf16* hp, int sub) {
    const unsigned nw[8] = {na.x, na.y, na.z, na.w, nb.x, nb.y, nb.z, nb.w};
    int hs0 = 0, hs1 = 0;
#pragma unroll
    for (int i = 0; i < 16; ++i) {
        if (donext) { const unsigned e = (nw[i >> 1] >> (16 * (i & 1))) & 0xffffu; qn[i] = *(const v4u*)(tab + (size_t)e * 128); }
        int p = __builtin_amdgcn_sdot4((int)qc[i].x, (int)xq.x, 0, false);
        p = __builtin_amdgcn_sdot4((int)qc[i].y, (int)xq.y, p, false);
        p = __builtin_amdgcn_sdot4((int)qc[i].z, (int)xq.z, p, false);
        p = __builtin_amdgcn_sdot4((int)qc[i].w, (int)xq.w, p, false);
        p += __builtin_amdgcn_mov_dpp(p, 0xB1, 0xf, 0xf, true); p += __builtin_amdgcn_mov_dpp(p, 0x4E, 0xf, 0xf, true); p += __builtin_amdgcn_mov_dpp(p, 0x141, 0xf, 0xf, true);
        if (i & 1) hs1 = (sub == (i >> 1)) ? p : hs1; else hs0 = (sub == (i >> 1)) ? p : hs0;
        __builtin_amdgcn_sched_barrier(0);
    }
    *(unsigned*)hp = pk2((float)hs0, (float)hs1);
}
__device__ __forceinline__ void p9_u_phase(Frame& F) {
    const unsigned char* UT8 = F.ws + WS_UT8; const unsigned char* X8 = F.ws + WS_X8; const unsigned short* IDS = (const unsigned short*)(F.ws + WS_IDS);
    bf16* HP = (bf16*)(F.ws + WS_HP); unsigned* qh = (unsigned*)(F.ws + WS_CTL) + CW_QU;
    const int lane = F.lane, sub = lane & 7, g = lane >> 3;
    const unsigned xcc = xb_xcc_id() & 7u;
    for (int s = 0; s < 8; ++s) {
        const int j = (int)((xcc + (unsigned)s) & 7u);
        const unsigned char* tab = UT8 + (size_t)j * 16384 * 128 + sub * 16;
        for (;;) {
            unsigned base = 0u; if (lane == 0) base = xb_add(qh + 64 * j, (unsigned)Q_CHUNK);
            base = (unsigned)__builtin_amdgcn_readfirstlane((int)base);
            if (base >= (unsigned)T) break;
            const unsigned char* xp = X8 + (size_t)base * 1024 + j * 128 + sub * 16;
            const unsigned short* ip = IDS + (size_t)base * 128 + g * 16;
            bf16* hpb = HP + ((size_t)j * T + base) * 128 + g * 16 + 2 * sub;
            v4u q0[16], q1[16];
            v4u ia = *(const v4u*)ip, ib = *(const v4u*)(ip + 8);
            { const unsigned w0[8] = {ia.x, ia.y, ia.z, ia.w, ib.x, ib.y, ib.z, ib.w};
#pragma unroll
              for (int i = 0; i < 16; ++i) { const unsigned e = (w0[i >> 1] >> (16 * (i & 1))) & 0xffffu; q0[i] = *(const v4u*)(tab + (size_t)e * 128); } }
            v4u na = *(const v4u*)(ip + 128), nb = *(const v4u*)(ip + 128 + 8);
            v4u fa = *(const v4u*)(ip + 256), fb = *(const v4u*)(ip + 256 + 8);
            v4u xa = *(const v4u*)xp;
#pragma unroll 1
            for (int tt = 0; tt < Q_CHUNK; tt += 2) {
                const bool more = tt + 2 < Q_CHUNK;
                const int t3 = tt + 3 < Q_CHUNK ? tt + 3 : Q_CHUNK - 1, t4 = tt + 4 < Q_CHUNK ? tt + 4 : Q_CHUNK - 1;
                const v4u xa1 = *(const v4u*)(xp + (size_t)(tt + 1) * 1024);
                u_step(q0, q1, xa, na, nb, true, tab, hpb + (size_t)tt * 128, sub);
                na = fa; nb = fb; fa = *(const v4u*)(ip + (size_t)t3 * 128); fb = *(const v4u*)(ip + (size_t)t3 * 128 + 8);
                if (more) xa = *(const v4u*)(xp + (size_t)(tt + 2) * 1024);
                u_step(q1, q0, xa1, na, nb, more, tab, hpb + (size_t)(tt + 1) * 128, sub);
                na = fa; nb = fb; fa = *(const v4u*)(ip + (size_t)t4 * 128); fb = *(const v4u*)(ip + (size_t)t4 * 128 + 8);
            }
        }
    }
}
__device__ __forceinline__ void p10_finalize(Frame& F) {
    const unsigned short* IDS = (const unsigned short*)(F.ws + WS_IDS); float* W = (float*)(F.ws + WS_GATES); const bf16* HP = (const bf16*)(F.ws + WS_HP);
    const float* UINV = (const float*)(F.ws + WS_UINV); const float* VINV = (const float*)(F.ws + WS_VINV); const float* XINV = (const float*)(F.ws + WS_XINV);
    const size_t gtid = (size_t)blockIdx.x * NTHREADS + F.tid, gthreads = (size_t)F.G * NTHREADS;
    constexpr size_t NTOT = (size_t)T * 128;
    for (size_t i0 = gtid; i0 < NTOT; i0 += 4 * gthreads) {
        unsigned e[4]; float h[4], gt[4];
#pragma unroll
        for (int k = 0; k < 4; ++k) { size_t idx = i0 + (size_t)k * gthreads; idx = idx < NTOT ? idx : NTOT - 1; e[k] = IDS[idx]; gt[k] = W[idx]; h[k] = 0.f; }
#pragma unroll
        for (int j = 0; j < 8; ++j)
#pragma unroll
            for (int k = 0; k < 4; ++k) { size_t idx = i0 + (size_t)k * gthreads; idx = idx < NTOT ? idx : NTOT - 1; h[k] += bf2f(HP[(size_t)j * T * 128 + idx]); }
#pragma unroll
        for (int k = 0; k < 4; ++k) { const size_t idx = i0 + (size_t)k * gthreads; if (idx >= NTOT) continue;
            const float hh = h[k] * UINV[e[k]] * XINV[idx >> 7];
            const float gl = 0.5f * hh * (1.0f + erff(hh * 0.7071067811865476f));
            W[idx] = gt[k] * gl * VINV[e[k]]; }
    }
}
__device__ __forceinline__ void v_step(const v4u (&qc)[16], v4u (&qn)[16], const f32x4 w0, const f32x4 w1, const f32x4 w2, const f32x4 w3, const v4u na, const v4u nb, const bool donext, const unsigned char* tab, bf16* fp, int g) {
    const float wv[16] = {w0.x, w0.y, w0.z, w0.w, w1.x, w1.y, w1.z, w1.w, w2.x, w2.y, w2.z, w2.w, w3.x, w3.y, w3.z, w3.w};
    const unsigned nw[8] = {na.x, na.y, na.z, na.w, nb.x, nb.y, nb.z, nb.w};
    f32x2 acc[8];
#pragma unroll
    for (int c = 0; c < 8; ++c) acc[c] = (f32x2){0.f, 0.f};
#pragma unroll
    for (int i = 0; i < 16; ++i) {
        if (donext) { const unsigned e = (nw[i >> 1] >> (16 * (i & 1))) & 0xffffu; qn[i] = *(const v4u*)(tab + (size_t)e * 128); }
        const unsigned qq[4] = {qc[i].x, qc[i].y, qc[i].z, qc[i].w};
        const f32x2 ww = {wv[i], wv[i]};
#pragma unroll
        for (int c = 0; c < 4; ++c) { acc[2 * c] = __builtin_amdgcn_cvt_pk_f32_fp8((int)qq[c], false) * ww + acc[2 * c]; acc[2 * c + 1] = __builtin_amdgcn_cvt_pk_f32_fp8((int)qq[c], true) * ww + acc[2 * c + 1]; }
        __builtin_amdgcn_sched_barrier(0);
    }
    float a16[16];
#pragma unroll
    for (int c = 0; c < 8; ++c) { a16[2 * c] = acc[c].x; a16[2 * c + 1] = acc[c].y; }
    float s8[8], s4[4];
#pragma unroll
    for (int c = 0; c < 8; ++c) { const auto sw = __builtin_amdgcn_permlane32_swap(__float_as_uint(a16[c]), __float_as_uint(a16[c + 8]), false, false); s8[c] = __uint_as_float(sw[0]) + __uint_as_float(sw[1]); }
#pragma unroll
    for (int c = 0; c < 4; ++c) { const auto sw = __builtin_amdgcn_permlane16_swap(__float_as_uint(s8[c]), __float_as_uint(s8[c + 4]), false, false); s4[c] = __uint_as_float(sw[0]) + __uint_as_float(sw[1]); }
#pragma unroll
    for (int c = 0; c < 4; ++c) s4[c] += dppf<0x128>(s4[c]);
    if ((g & 1) == 0) { v2u o; o.x = pk2(s4[0], s4[1]); o.y = pk2(s4[2], s4[3]); *(v2u*)(fp + 4 * (g >> 1)) = o; }
}
__device__ __forceinline__ void p11_v_phase(Frame& F) {
    const unsigned char* VT8 = F.ws + WS_VT8; const unsigned short* IDS = (const unsigned short*)(F.ws + WS_IDS); const float* W = (const float*)(F.ws + WS_GATES);
    bf16* FFN = (bf16*)(F.ws + WS_FFN); unsigned* qh = (unsigned*)(F.ws + WS_CTL) + CW_QV;
    const int lane = F.lane, sub = lane & 7, g = lane >> 3;
    const unsigned xcc = xb_xcc_id() & 7u;
    for (int s = 0; s < 8; ++s) {
        const int j = (int)((xcc + (unsigned)s) & 7u);
        const unsigned char* tab = VT8 + (size_t)j * 16384 * 128 + sub * 16;
        for (;;) {
            unsigned base = 0u; if (lane == 0) base = xb_add(qh + 64 * j, (unsigned)Q_CHUNK);
            base = (unsigned)__builtin_amdgcn_readfirstlane((int)base);
            if (base >= (unsigned)T) break;
            const float* wp = W + (size_t)base * 128 + g * 16;
            const unsigned short* ip = IDS + (size_t)base * 128 + g * 16;
            bf16* fpb = FFN + (size_t)base * 1024 + j * 128 + sub * 16;
            v4u q0[16], q1[16];
            { const v4u ia = *(const v4u*)ip, ib = *(const v4u*)(ip + 8); const unsigned w0[8] = {ia.x, ia.y, ia.z, ia.w, ib.x, ib.y, ib.z, ib.w};
#pragma unroll
              for (int i = 0; i < 16; ++i) { const unsigned e = (w0[i >> 1] >> (16 * (i & 1))) & 0xffffu; q0[i] = *(const v4u*)(tab + (size_t)e * 128); } }
            v4u na = *(const v4u*)(ip + 128), nb = *(const v4u*)(ip + 128 + 8);
            v4u fa = *(const v4u*)(ip + 256), fb = *(const v4u*)(ip + 256 + 8);
            f32x4 wa = *(const f32x4*)wp, wb = *(const f32x4*)(wp + 4), wc = *(const f32x4*)(wp + 8), wd = *(const f32x4*)(wp + 12);
#pragma unroll 1
            for (int tt = 0; tt < Q_CHUNK; tt += 2) {
                const bool more = tt + 2 < Q_CHUNK;
                const int t3 = tt + 3 < Q_CHUNK ? tt + 3 : Q_CHUNK - 1, t4 = tt + 4 < Q_CHUNK ? tt + 4 : Q_CHUNK - 1;
                const float* w1p = wp + (size_t)(tt + 1) * 128;
                const f32x4 wa1 = *(const f32x4*)w1p, wb1 = *(const f32x4*)(w1p + 4), wc1 = *(const f32x4*)(w1p + 8), wd1 = *(const f32x4*)(w1p + 12);
                v_step(q0, q1, wa, wb, wc, wd, na, nb, true, tab, fpb + (size_t)tt * 1024, g);
                na = fa; nb = fb; fa = *(const v4u*)(ip + (size_t)t3 * 128); fb = *(const v4u*)(ip + (size_t)t3 * 128 + 8);
                if (more) { const float* w2p = wp + (size_t)(tt + 2) * 128; wa = *(const f32x4*)w2p; wb = *(const f32x4*)(w2p + 4); wc = *(const f32x4*)(w2p + 8); wd = *(const f32x4*)(w2p + 12); }
                v_step(q1, q0, wa1, wb1, wc1, wd1, na, nb, more, tab, fpb + (size_t)(tt + 1) * 1024, g);
                na = fa; nb = fb; fa = *(const v4u*)(ip + (size_t)t4 * 128); fb = *(const v4u*)(ip + (size_t)t4 * 128 + 8);
            }
        }
    }
}
__device__ __forceinline__ void p12_ln2(Frame& F) {
    float* OUT = F.a->out; const bf16* FFN = (const bf16*)(F.ws + WS_FFN); const bf16* X1B = (const bf16*)(F.ws + WS_X1B);
    const float* g = F.a->in[I_LN2G]; const float* bb = F.a->in[I_LN2B];
    const int gw = blockIdx.x * NWAVES + F.wave, NGW = F.G * NWAVES, lane = F.lane;
    f32x4 gv[4], bv[4];
#pragma unroll
    for (int j = 0; j < 4; ++j) { gv[j] = ((const f32x4*)g)[lane + 64 * j]; bv[j] = ((const f32x4*)bb)[lane + 64 * j]; }
    for (int m = gw; m < T; m += NGW) {
        f32x4* yr = (f32x4*)(OUT + (size_t)m * DM) + lane; const v2u* fr = (const v2u*)(FFN + (size_t)m * DM) + lane; const v2u* xr = (const v2u*)(X1B + (size_t)m * DM) + lane;
        f32x4 v[4]; float s = 0.f;
#pragma unroll
        for (int j = 0; j < 4; ++j) { const v2u f = fr[64 * j], x = xr[64 * j];
            v[j] = (f32x4){bflo(x.x), bfhi(x.x), bflo(x.y), bfhi(x.y)} * ALPHA + (f32x4){bflo(f.x), bfhi(f.x), bflo(f.y), bfhi(f.y)}; s += (v[j].x + v[j].y) + (v[j].z + v[j].w); }
        const float mean = wave_sum_dpp(s) * (1.f / DM); float s2 = 0.f;
#pragma unroll
        for (int j = 0; j < 4; ++j) { v[j] = v[j] - mean; s2 += (v[j].x * v[j].x + v[j].y * v[j].y) + (v[j].z * v[j].z + v[j].w * v[j].w); }
        const float rstd = rsqrtf(wave_sum_dpp(s2) * (1.f / DM) + LN_EPS);
#pragma unroll
        for (int j = 0; j < 4; ++j) yr[64 * j] = v[j] * rstd * gv[j] + bv[j];
    }
}

__global__ void __launch_bounds__(NTHREADS, 2) hybrid_fwd(Args args) {
    extern __shared__ __attribute__((aligned(16))) unsigned char lds[];
    Frame F;
    F.lds = (LAS unsigned char*)lds;
    F.tid = threadIdx.x; F.lane = F.tid & 63; F.wave = __builtin_amdgcn_readfirstlane(F.tid >> 6);
    F.G = gridDim.x; F.a = (KArgs)__builtin_amdgcn_kernarg_segment_ptr(); F.ws = args.ws;
#define FRESH() do { int _t = threadIdx.x; asm volatile("" : "+v"(_t)); F.tid = _t; F.lane = _t & 63; F.wave = __builtin_amdgcn_readfirstlane(_t >> 6); \
        KArgs _k = (KArgs)__builtin_amdgcn_kernarg_segment_ptr(); asm volatile("" : "+s"(_k)); F.a = _k; F.ws = _k->ws; } while (0)
    volatile LAS unsigned* MISC = (volatile LAS unsigned*)(F.lds + MISC_OFF);
    for (int u = F.tid; u < (LDS_BYTES - LDSCTL_OFF) / 4; u += NTHREADS) ((LAS unsigned*)(F.lds + LDSCTL_OFF))[u] = 0u;
    __syncthreads();
    const int lo = args.ph_lo, hi = args.ph_hi;
    const bool need_bar = (hi - lo) > 1;
    XcdBarrier bar; bar.bar = (unsigned*)(args.ws + WS_CTL) + CW_BAR + args.li * XCD_BAR_WORDS; bar.x = 0; bar.st = nullptr;
    if (need_bar) bar = xcd_barrier_post(bar.bar, MISC + 8);
#if defined(PHASE_MASK)
#define IN(k) (((PHASE_MASK >> (k)) & 1) && lo <= (k) && (k) < hi)
#elif defined(ONLY_PHASE)
#define IN(k) ((k) == ONLY_PHASE && lo <= (k) && (k) < hi)
#else
#define IN(k) (lo <= (k) && (k) < hi)
#endif
    unsigned long long pr_extra = 0ull;
#ifdef PROBE_LO
    unsigned long long pr_t0 = 0ull, pr_t1 = 0ull;
#define PSTAMP(k) do { if ((k) == PROBE_LO) pr_t0 = __builtin_amdgcn_s_memrealtime(); if ((k) == PROBE_HI + 1) pr_t1 = __builtin_amdgcn_s_memrealtime(); } while (0)
#else
#define PSTAMP(k) do {} while (0)
#endif
#ifdef PROBE_BARMASK
#define SEAM(k) do { if (IN(k) && IN((k) + 1)) { const unsigned long long _b0 = __builtin_amdgcn_s_memrealtime(); xcd_barrier(bar); if ((PROBE_BARMASK >> (k)) & 1) pr_extra += __builtin_amdgcn_s_memrealtime() - _b0; } } while (0)
#else
#define SEAM(k) do { if (IN(k) && IN((k) + 1)) xcd_barrier(bar); } while (0)
#endif
    LAS unsigned char* ring = F.lds;

    PSTAMP(0);
    if (IN(0)) { FRESH(); p0_prologue(F); }
    SEAM(0);
    PSTAMP(1);
    if (IN(1)) {
        FRESH();
        pg8::Gemm g{(const bf16*)(F.ws + WS_XB), (const bf16*)(F.ws + WS_WIN), T, NPROJ, 1024}; pg8::StaticOrder S; S.init(T, NPROJ, F.G, (int)blockIdx.x);
        EpiProj E{F.ws};
        pg8::gemm_phase<EpiProj, pg8::StaticOrder>(ring, g, S, E, F.tid);
    }
    SEAM(1);
    PSTAMP(2);
    if (IN(2)) {
        FRESH();
#if !defined(P2SEL) || (P2SEL & 1)
        p2_ckv_norm(F);
#endif
        PSTAMP(21);
#if !defined(P2SEL) || (P2SEL & 2)
#if defined(HGRN_DEBUG)
        p2_hgrn_chunked(F, (bf16*)(F.ws + WS_END), 16, 512);
        __syncthreads();
        FRESH();
        p2_hgrn_simple(F);
        VM_WAIT(); __syncthreads();
        FRESH();
        {
            unsigned* ctl = (unsigned*)(F.ws + WS_CTL);
            const bf16* A_ = (const bf16*)(F.ws + WS_END); const bf16* B_ = (const bf16*)(F.ws + WS_IB);
            float mx = 0.f; unsigned nn = 0;
            for (int item = blockIdx.x; item < NB * 4; item += F.G) { const int b = item >> 2, h = item & 3; if (b >= 16) continue;
                for (int e = F.tid; e < SEQ * 128; e += NTHREADS) { const size_t o = ((size_t)b * SEQ + (e >> 7)) * 512 + h * 128 + (e & 127);
                    const float x = bf2f(A_[o]), y = bf2f(B_[o]); if (x != x) ++nn; const float df = fabsf(x - y); if (df == df) mx = fmaxf(mx, df); } }
            mx = wave_max(mx); nn = (unsigned)wave_sum((float)nn);
            if (F.lane == 0) { atomicMax(ctl + 2048, __float_as_uint(mx)); atomicAdd(ctl + 2112, nn); }
        }
#elif defined(HGRN_SIMPLE)
        p2_hgrn_simple(F);
#else
        p2_hgrn_chunked(F, (bf16*)(F.ws + WS_HO), NB, 1024);
#endif
#endif
        __syncthreads();
        PSTAMP(22);
        FRESH();
#if !defined(P2SEL) || (P2SEL & 4)
#ifdef INDEXER_OLD
        p2_indexer_simple(F);
#else
        p2_indexer_blk(F, pr_extra);
#endif
#endif
    }
    SEAM(2);
    PSTAMP(3);
    if (IN(3)) { FRESH(); p3_hg_finalize(F); __syncthreads(); FRESH();
#ifdef ATTN_SIMPLE
        p3_attn_simple(F);
#else
        p3_attn_mfma(F);
#endif
    }
    SEAM(3);
    PSTAMP(4);
    if (IN(4)) {
        FRESH();
        { pg8::Gemm g{(const bf16*)(F.ws + WS_QL), (const bf16*)(F.ws + WS_WA), T, 1024, 1024}, g2{(const bf16*)(F.ws + WS_HO), (const bf16*)(F.ws + WS_WB), T, 1024, 512};
          pg8::StaticOrder S; S.init(T, 1024, F.G, (int)blockIdx.x);
          EpiMerge E{(const unsigned char*)(F.ws + WS_GA), (const unsigned char*)(F.ws + WS_GBT), (bf16*)(F.ws + WS_MERGED)};
          pg8::gemm_phase2<EpiMerge, pg8::StaticOrder>(ring, g, g2, S, E, F.tid); }
    }
    SEAM(4);
    PSTAMP(5);
    if (IN(5)) {
        FRESH();
        pg8::Gemm g{(const bf16*)(F.ws + WS_MERGED), (const bf16*)(F.ws + WS_WO), T, 1024, 1024}; pg8::StaticOrder S; S.init(T, 1024, F.G, (int)blockIdx.x);
        EpiResBf16 E{(const bf16*)(F.ws + WS_XB), (bf16*)(F.ws + WS_X1B)};
        pg8::gemm_phase<EpiResBf16, pg8::StaticOrder>(ring, g, S, E, F.tid);
    }
    SEAM(5);
    PSTAMP(6);
    if (IN(6)) { FRESH(); p6_ln1(F); }
    SEAM(6);
    PSTAMP(7);
    if (IN(7)) {
        FRESH();
        pg8::Gemm g{(const bf16*)(F.ws + WS_X1B), (const bf16*)(F.ws + WS_WPQ), T, 2048, 1024}; pg8::StaticOrder S; S.init(T, 2048, F.G, (int)blockIdx.x);
        EpiPlainBf16 E{(bf16*)(F.ws + WS_PQ), 2048};
        pg8::gemm_phase<EpiPlainBf16, pg8::StaticOrder>(ring, g, S, E, F.tid);
    }
    SEAM(7);
    PSTAMP(8);
    if (IN(8)) { FRESH();
#ifdef ROUTE_SIMPLE
        p8_peer_route_simple(F);
#else
        p8_peer_route_mfma(F);
#endif
    }
    SEAM(8);
    PSTAMP(9);
    if (IN(9)) { FRESH(); p9_u_phase(F); }
    SEAM(9);
    PSTAMP(10);
    if (IN(10)) { FRESH(); p10_finalize(F); }
    SEAM(10);
    PSTAMP(11);
    if (IN(11)) { FRESH(); p11_v_phase(F); }
    SEAM(11);
    PSTAMP(12);
    if (IN(12)) { FRESH(); p12_ln2(F); }
    PSTAMP(13);
#if defined(PROBE_SEL) || defined(PROBE_BARMASK)
    if (blockIdx.x == 0 && F.tid == 0) { const unsigned long long t2 = __builtin_amdgcn_s_memrealtime(); while (__builtin_amdgcn_s_memrealtime() - t2 < pr_extra) __builtin_amdgcn_s_sleep(8); }
#endif
#ifdef PROBE_LO
    if (blockIdx.x == 0 && F.tid == 0) { const unsigned long long dt = pr_t1 - pr_t0, t2 = __builtin_amdgcn_s_memrealtime(); while (__builtin_amdgcn_s_memrealtime() - t2 < dt) __builtin_amdgcn_s_sleep(8); }
#endif
#undef IN
#undef SEAM
}

extern "C" void kernel_launch(void* const* d_in, const int* in_sizes, int n_in, void* d_out, int out_size, void* d_ws, size_t ws_size, hipStream_t stream) {
    static int grid = 0;
    if (grid == 0) {
        if (n_in != 20 || out_size != T * DM || ws_size < WS_END) { fprintf(stderr, "kernel_launch: unexpected problem (n_in %d out %d ws %zu)\n", n_in, out_size, ws_size); grid = -1; return; }
        int dev = 0, cus = 0;
        if (hipGetDevice(&dev) != hipSuccess || hipDeviceGetAttribute(&cus, hipDeviceAttributeMultiprocessorCount, dev) != hipSuccess) { grid = -1; return; }
        if (hipFuncSetAttribute((const void*)hybrid_fwd, hipFuncAttributeMaxDynamicSharedMemorySize, LDS_BYTES) != hipSuccess) { fprintf(stderr, "kernel_launch: hipFuncSetAttribute failed\n"); grid = -1; return; }
        int per_cu = 0;
        if (hipOccupancyMaxActiveBlocksPerMultiprocessor(&per_cu, (const void*)hybrid_fwd, NTHREADS, LDS_BYTES) != hipSuccess || per_cu < 1) fprintf(stderr, "kernel_launch: occupancy query reports %d\n", per_cu);
        (void)hipGetLastError();
        grid = cus;
    }
    if (grid < 0) return;
    (void)hipMemsetAsync((char*)d_ws + WS_CTL, 0, CTL_ZERO_BYTES, stream);
    Args a{};
    for (int i = 0; i < 20; ++i) a.in[i] = (const float*)d_in[i];
    a.out = (float*)d_out; a.ws = (unsigned char*)d_ws;
    constexpr int NL = MK_N_LAUNCHES;
    for (int li = 0; li < NL; ++li) {
        a.ph_lo = (NL == 1) ? 0 : li; a.ph_hi = (NL == 1) ? N_PHASES : li + 1; a.li = li;
        hipLaunchKernelGGL(hybrid_fwd, dim3(grid), dim3(NTHREADS), LDS_BYTES, stream, a);
    }
}
```

```cpp
#include <hip/hip_runtime.h>
#include <cstdio>
#include <cstdint>

#ifndef MK_N_LAUNCHES
#define MK_N_LAUNCHES 1
#endif

namespace pg8 {
#define PG8_LAS __attribute__((address_space(3)))
typedef unsigned short bf16_t;
typedef short bf16x8 __attribute__((ext_vector_type(8)));
typedef float f32x4 __attribute__((ext_vector_type(4)));
typedef unsigned u32x4 __attribute__((ext_vector_type(4)));
constexpr int BM = 256, BK = 64, HALF = 128, HTB = HALF * BK * 2, STAGE_BYTES = 8 * HTB, NXCD = 8, WGM = 8;

__host__ __device__ __forceinline__ int lds_byte(int r, int c) { const int st = (r >> 4) * 2 + (c >> 5), rr = r & 15, cc = c & 31, ob = rr * 64 + cc * 2; return st * 1024 + (ob ^ (((ob >> 9) & 1) << 5)); }
__host__ __device__ __forceinline__ void stage_rc(int b, int& R, int& C) { const int st = b / 1024, sb = b % 1024, swz = sb ^ (((sb >> 9) & 1) << 5); R = (st >> 1) * 16 + swz / 64; C = (st & 1) * 32 + (swz % 64) / 2; }
__host__ __device__ __forceinline__ int perm32(int rho) { const int n = rho >> 4, i = rho & 15; return 8 * (i >> 2) + 4 * n + (i & 3); }

struct Unit { int pm, pn; };
struct Gemm { const bf16_t* A; const bf16_t* Bt; int M, N, K; };

struct StaticOrder {
    int nM, nN, nwg, G, c;
    __host__ __device__ void init(int M, int N, int G_, int c_) { nM = M / BM; nN = N / BM; nwg = nM * nN; G = G_; c = c_; }
    __host__ __device__ bool next(int i, Unit& u) const {
        const long L = (long)i * G + c; if (L >= nwg) return false;
        int wgid = (int)L; { const int q = nwg / NXCD, r = nwg % NXCD, xcd = wgid % NXCD, off = wgid / NXCD; wgid = (xcd < r ? xcd * (q + 1) : r * (q + 1) + (xcd - r) * q) + off; }
        const int nig = WGM * nN, gid = wgid / nig, fm = gid * WGM, gsz = (nM - fm) < WGM ? (nM - fm) : WGM;
        u.pm = fm + ((wgid % nig) % gsz); u.pn = (wgid % nig) / gsz; return true;
    }
    __device__ __forceinline__ void a_ready(const Unit&) const {}
    __device__ __forceinline__ void done(const Unit&) const {}
};

__device__ __forceinline__ unsigned cvt_pk_bf16(float lo, float hi) { unsigned r; asm volatile("v_cvt_pk_bf16_f32 %0, %1, %2" : "=v"(r) : "v"(lo), "v"(hi)); return r; }

template <class Epi, class Sched>
__device__ __forceinline__ void gemm_phase(PG8_LAS unsigned char* lds, const Gemm g, const Sched& S, const Epi& E, const int tid) {
    const int wid = __builtin_amdgcn_readfirstlane(tid >> 6), lane = tid & 63, wr = wid >> 2, wc = wid & 3, fr = lane & 15, fq = lane >> 4;
    const int K = g.K, nt = K / BK;
    unsigned voffA[2], voffB[2];
#pragma unroll
    for (int i = 0; i < 2; ++i) { int R, C; stage_rc(tid * 16 + i * 8192, R, C); const int Rb = Epi::PERM ? ((R & ~31) + perm32(R & 31)) : R;
        voffA[i] = (unsigned)(R * K + C) * 2u; voffB[i] = (unsigned)(Rb * K + C) * 2u; }
    const size_t kstep = (size_t)(BK * 2);
    const size_t hstep = (size_t)HALF * K * 2;
    const size_t tstep = 2 * hstep;
    const unsigned ldsw = (unsigned)wid * 1024u;
    const int aoff = lds_byte(wr * 64 + fr, fq * 8), boff = lds_byte(wc * 32 + fr, fq * 8);
#define PG8_SA(b, h) (((b) * 2 + (h)) * HTB)
#define PG8_SB(b, h) ((4 + (b) * 2 + (h)) * HTB)
#define PG8_STAGE(bufoff, gbase, voff) do { _Pragma("unroll") for (int _i = 0; _i < 2; ++_i) \
        __builtin_amdgcn_global_load_lds((const unsigned*)((const char*)(gbase) + (voff)[_i]), (PG8_LAS unsigned*)(lds + (bufoff) + ldsw + _i * 8192), 16, 0, 0); } while (0)
#define PG8_LDA(dst, b, h) do { _Pragma("unroll") for (int m = 0; m < 4; ++m) _Pragma("unroll") for (int k = 0; k < 2; ++k) dst[m][k] = *(const PG8_LAS bf16x8*)(lds + PG8_SA(b, h) + aoff + m * 2048 + k * 1024); } while (0)
#define PG8_LDB(dst, b, h) do { _Pragma("unroll") for (int n = 0; n < 2; ++n) _Pragma("unroll") for (int k = 0; k < 2; ++k) dst[n][k] = *(const PG8_LAS bf16x8*)(lds + PG8_SB(b, h) + boff + n * 2048 + k * 1024); } while (0)
#define PG8_MMA(ai, bj, At, Bt) do { __builtin_amdgcn_s_setprio(1); _Pragma("unroll") for (int m = 0; m < 4; ++m) _Pragma("unroll") for (int n = 0; n < 2; ++n) _Pragma("unroll") for (int k = 0; k < 2; ++k) \
        acc[ai][bj][m][n] = __builtin_amdgcn_mfma_f32_16x16x32_bf16(Bt[n][k], At[m][k], acc[ai][bj][m][n], 0, 0, 0); __builtin_amdgcn_s_setprio(0); } while (0)
#define PG8_WAIT_V(n) asm volatile("s_waitcnt vmcnt(" #n ")" ::: "memory")
#define PG8_WAIT_L(n) asm volatile("s_waitcnt lgkmcnt(" #n ")" ::: "memory")
#define PG8_BAR __builtin_amdgcn_s_barrier()
#define PG8_SCHED __builtin_amdgcn_sched_barrier(0)
    Unit cur, nxt; int ui = 0;
    if (!S.next(0, cur)) return;
    f32x4 acc[2][2][4][2];
#pragma unroll
    for (int a = 0; a < 2; ++a)
#pragma unroll
        for (int b = 0; b < 2; ++b)
#pragma unroll
            for (int m = 0; m < 4; ++m)
#pragma unroll
                for (int n = 0; n < 2; ++n) acc[a][b][m][n] = (f32x4){0.f, 0.f, 0.f, 0.f};
    bf16x8 At[4][2], B0[2][2], B1[2][2];
    const char* cA = (const char*)g.A + (size_t)cur.pm * tstep; const char* cB = (const char*)g.Bt + (size_t)cur.pn * tstep;
    S.a_ready(cur);
    PG8_STAGE(PG8_SB(0, 0), cB, voffB); PG8_STAGE(PG8_SA(0, 0), cA, voffA); PG8_STAGE(PG8_SB(0, 1), cB + hstep, voffB); PG8_STAGE(PG8_SA(0, 1), cA + hstep, voffA);
    if (wr == 1) PG8_BAR;
    PG8_WAIT_V(4); PG8_BAR;
    PG8_STAGE(PG8_SB(1, 0), cB + kstep, voffB); PG8_STAGE(PG8_SA(1, 0), cA + kstep, voffA); PG8_STAGE(PG8_SB(1, 1), cB + hstep + kstep, voffB);
    PG8_WAIT_V(6); PG8_BAR;
    for (;;) {
        const bool has_next = S.next(ui + 1, nxt);
        const char* nA = has_next ? (const char*)g.A + (size_t)nxt.pm * tstep : cA; const char* nB = has_next ? (const char*)g.Bt + (size_t)nxt.pn * tstep : cB;
        for (int t = 0; t < nt; t += 2) {
            const bool last = (t == nt - 2);
            const char* a1 = cA + (size_t)(t + 1) * kstep;
            const char* a2 = last ? nA : cA + (size_t)(t + 2) * kstep; const char* b2 = last ? nB : cB + (size_t)(t + 2) * kstep;
            const char* a3 = a2 + kstep; const char* b3 = b2 + kstep;
            if (last && has_next) S.a_ready(nxt);
            PG8_LDB(B0, 0, 0); PG8_SCHED; PG8_LDA(At, 0, 0); PG8_STAGE(PG8_SA(1, 1), a1 + hstep, voffA);
            PG8_WAIT_L(8); PG8_BAR; PG8_WAIT_L(0); PG8_MMA(0, 0, At, B0); PG8_BAR; PG8_SCHED;
            PG8_LDB(B1, 0, 1); PG8_STAGE(PG8_SB(0, 0), b2, voffB);
            PG8_BAR; PG8_WAIT_L(0); PG8_MMA(0, 1, At, B1); PG8_BAR;
            PG8_LDA(At, 0, 1); PG8_STAGE(PG8_SA(0, 0), a2, voffA);
            PG8_BAR; PG8_WAIT_L(0); PG8_MMA(1, 0, At, B0); PG8_BAR; PG8_SCHED;
            PG8_STAGE(PG8_SB(0, 1), b2 + hstep, voffB);
            PG8_WAIT_V(6); PG8_BAR; PG8_MMA(1, 1, At, B1); PG8_BAR;
            PG8_LDB(B0, 1, 0); PG8_SCHED; PG8_LDA(At, 1, 0); PG8_STAGE(PG8_SA(0, 1), a2 + hstep, voffA);
            PG8_WAIT_L(8); PG8_BAR; PG8_WAIT_L(0); PG8_MMA(0, 0, At, B0); PG8_BAR; PG8_SCHED;
            PG8_LDB(B1, 1, 1); PG8_STAGE(PG8_SB(1, 0), b3, voffB);
            PG8_BAR; PG8_WAIT_L(0); PG8_MMA(0, 1, At, B1); PG8_BAR;
            PG8_LDA(At, 1, 1); PG8_STAGE(PG8_SA(1, 0), a3, voffA);
            PG8_BAR; PG8_WAIT_L(0); PG8_MMA(1, 0, At, B0); PG8_BAR; PG8_SCHED;
            PG8_STAGE(PG8_SB(1, 1), b3 + hstep, voffB);
            PG8_WAIT_V(6); PG8_BAR; PG8_MMA(1, 1, At, B1); PG8_BAR;
        }
        E(acc, cur, wr, wc, fr, fq); S.done(cur);
        if (!has_next) break;
#pragma unroll
        for (int a = 0; a < 2; ++a)
#pragma unroll
            for (int b = 0; b < 2; ++b)
#pragma unroll
                for (int m = 0; m < 4; ++m)
#pragma unroll
                    for (int n = 0; n < 2; ++n) acc[a][b][m][n] = (f32x4){0.f, 0.f, 0.f, 0.f};
        cur = nxt; cA = nA; cB = nB; ++ui;
    }
    PG8_WAIT_V(0);
    if (wr == 0) PG8_BAR;
    PG8_BAR;
#undef PG8_SA
#undef PG8_SB
#undef PG8_STAGE
#undef PG8_LDA
#undef PG8_LDB
#undef PG8_MMA
#undef PG8_WAIT_V
#undef PG8_WAIT_L
#undef PG8_BAR
#undef PG8_SCHED
}
template <class Epi, class Sched>
__device__ __forceinline__ void gemm_phase2(PG8_LAS unsigned char* lds, const Gemm g, const Gemm g2, const Sched& S, const Epi& E, const int tid) {
    const int wid = __builtin_amdgcn_readfirstlane(tid >> 6), lane = tid & 63, wr = wid >> 2, wc = wid & 3, fr = lane & 15, fq = lane >> 4;
    const int K = g.K, nt1 = K / BK, nt = nt1 + g2.K / BK;
    unsigned voffA[2], voffB[2];
#pragma unroll
    for (int i = 0; i < 2; ++i) { int R, C; stage_rc(tid * 16 + i * 8192, R, C); const int Rb = Epi::PERM ? ((R & ~31) + perm32(R & 31)) : R;
        voffA[i] = (unsigned)(R * K + C) * 2u; voffB[i] = (unsigned)(Rb * K + C) * 2u; }
    const size_t kstep = (size_t)(BK * 2);
    const size_t hstep = (size_t)HALF * K * 2;
    const size_t tstep = 2 * hstep;
    const unsigned ldsw = (unsigned)wid * 1024u;
    const int aoff = lds_byte(wr * 64 + fr, fq * 8), boff = lds_byte(wc * 32 + fr, fq * 8);
#define PG8_SA(b, h) (((b) * 2 + (h)) * HTB)
#define PG8_SB(b, h) ((4 + (b) * 2 + (h)) * HTB)
#define PG8_STAGE(bufoff, gbase, voff) do { _Pragma("unroll") for (int _i = 0; _i < 2; ++_i) \
        __builtin_amdgcn_global_load_lds((const unsigned*)((const char*)(gbase) + (voff)[_i]), (PG8_LAS unsigned*)(lds + (bufoff) + ldsw + _i * 8192), 16, 0, 0); } while (0)
#define PG8_LDA(dst, b, h) do { _Pragma("unroll") for (int m = 0; m < 4; ++m) _Pragma("unroll") for (int k = 0; k < 2; ++k) dst[m][k] = *(const PG8_LAS bf16x8*)(lds + PG8_SA(b, h) + aoff + m * 2048 + k * 1024); } while (0)
#define PG8_LDB(dst, b, h) do { _Pragma("unroll") for (int n = 0; n < 2; ++n) _Pragma("unroll") for (int k = 0; k < 2; ++k) dst[n][k] = *(const PG8_LAS bf16x8*)(lds + PG8_SB(b, h) + boff + n * 2048 + k * 1024); } while (0)
#define PG8_MMA(ai, bj, At, Bt) do { __builtin_amdgcn_s_setprio(1); _Pragma("unroll") for (int m = 0; m < 4; ++m) _Pragma("unroll") for (int n = 0; n < 2; ++n) _Pragma("unroll") for (int k = 0; k < 2; ++k) \
        acc[ai][bj][m][n] = __builtin_amdgcn_mfma_f32_16x16x32_bf16(Bt[n][k], At[m][k], acc[ai][bj][m][n], 0, 0, 0); __builtin_amdgcn_s_setprio(0); } while (0)
#define PG8_WAIT_V(n) asm volatile("s_waitcnt vmcnt(" #n ")" ::: "memory")
#define PG8_WAIT_L(n) asm volatile("s_waitcnt lgkmcnt(" #n ")" ::: "memory")
#define PG8_BAR __builtin_amdgcn_s_barrier()
#define PG8_SCHED __builtin_amdgcn_sched_barrier(0)
    Unit cur, nxt; int ui = 0;
    if (!S.next(0, cur)) return;
    f32x4 acc[2][2][4][2];
#pragma unroll
    for (int a = 0; a < 2; ++a)
#pragma unroll
        for (int b = 0; b < 2; ++b)
#pragma unroll
            for (int m = 0; m < 4; ++m)
#pragma unroll
                for (int n = 0; n < 2; ++n) acc[a][b][m][n] = (f32x4){0.f, 0.f, 0.f, 0.f};
    bf16x8 At[4][2], B0[2][2], B1[2][2];
    const char* cA = (const char*)g.A + (size_t)cur.pm * tstep; const char* cB = (const char*)g.Bt + (size_t)cur.pn * tstep;
    S.a_ready(cur);
    PG8_STAGE(PG8_SB(0, 0), cB, voffB); PG8_STAGE(PG8_SA(0, 0), cA, voffA); PG8_STAGE(PG8_SB(0, 1), cB + hstep, voffB); PG8_STAGE(PG8_SA(0, 1), cA + hstep, voffA);
    if (wr == 1) PG8_BAR;
    PG8_WAIT_V(4); PG8_BAR;
    PG8_STAGE(PG8_SB(1, 0), cB + kstep, voffB); PG8_STAGE(PG8_SA(1, 0), cA + kstep, voffA); PG8_STAGE(PG8_SB(1, 1), cB + hstep + kstep, voffB);
    PG8_WAIT_V(6); PG8_BAR;
    for (;;) {
        const bool has_next = S.next(ui + 1, nxt);
        const char* nA = has_next ? (const char*)g.A + (size_t)nxt.pm * tstep : cA; const char* nB = has_next ? (const char*)g.Bt + (size_t)nxt.pn * tstep : cB;
        const char* cA2 = (const char*)g2.A + (size_t)cur.pm * tstep - (size_t)nt1 * kstep; const char* cB2 = (const char*)g2.Bt + (size_t)cur.pn * tstep - (size_t)nt1 * kstep;
        for (int t = 0; t < nt; t += 2) {
            const bool last = (t == nt - 2);
            if (t == nt1) E.mid(acc, cur, wr, wc, fr, fq);
            const char* a1 = (t >= nt1 ? cA2 : cA) + (size_t)(t + 1) * kstep;
            const char* a2 = last ? nA : (t + 2 >= nt1 ? cA2 : cA) + (size_t)(t + 2) * kstep; const char* b2 = last ? nB : (t + 2 >= nt1 ? cB2 : cB) + (size_t)(t + 2) * kstep;
            const char* a3 = a2 + kstep; const char* b3 = b2 + kstep;
            if (last && has_next) S.a_ready(nxt);
            PG8_LDB(B0, 0, 0); PG8_SCHED; PG8_LDA(At, 0, 0); PG8_STAGE(PG8_SA(1, 1), a1 + hstep, voffA);
            PG8_WAIT_L(8); PG8_BAR; PG8_WAIT_L(0); PG8_MMA(0, 0, At, B0); PG8_BAR; PG8_SCHED;
            PG8_LDB(B1, 0, 1); PG8_STAGE(PG8_SB(0, 0), b2, voffB);
            PG8_BAR; PG8_WAIT_L(0); PG8_MMA(0, 1, At, B1); PG8_BAR;
            PG8_LDA(At, 0, 1); PG8_STAGE(PG8_SA(0, 0), a2, voffA);
            PG8_BAR; PG8_WAIT_L(0); PG8_MMA(1, 0, At, B0); PG8_BAR; PG8_SCHED;
            PG8_STAGE(PG8_SB(0, 1), b2 + hstep, voffB);
            PG8_WAIT_V(6); PG8_BAR; PG8_MMA(1, 1, At, B1); PG8_BAR;
            PG8_LDB(B0, 1, 0); PG8_SCHED; PG8_LDA(At, 1, 0); PG8_STAGE(PG8_SA(0, 1), a2 + hstep, voffA);
            PG8_WAIT_L(8); PG8_BAR; PG8_WAIT_L(0); PG8_MMA(0, 0, At, B0); PG8_BAR; PG8_SCHED;
            PG8_LDB(B1, 1, 1); PG8_STAGE(PG8_SB(1, 0), b3, voffB);
            PG8_BAR; PG8_WAIT_L(0); PG8_MMA(0, 1, At, B1); PG8_BAR;
            PG8_LDA(At, 1, 1); PG8_STAGE(PG8_SA(1, 0), a3, voffA);
            PG8_BAR; PG8_WAIT_L(0); PG8_MMA(1, 0, At, B0); PG8_BAR; PG8_SCHED;
            PG8_STAGE(PG8_SB(1, 1), b3 + hstep, voffB);
            PG8_WAIT_V(6); PG8_BAR; PG8_MMA(1, 1, At, B1); PG8_BAR;
        }
        E(acc, cur, wr, wc, fr, fq); S.done(cur);
        if (!has_next) break;
#pragma unroll
        for (int a = 0; a < 2; ++a)
#pragma unroll
            for (int b = 0; b < 2; ++b)
#pragma unroll
                for (int m = 0; m < 4; ++m)
#pragma unroll
                    for (int n = 0; n < 2; ++n) acc[a][b][m][n] = (f32x4){0.f, 0.f, 0.f, 0.f};
        cur = nxt; cA = nA; cB = nB; ++ui;
    }
    PG8_WAIT_V(0);
    if (wr == 0) PG8_BAR;
    PG8_BAR;
#undef PG8_SA
#undef PG8_SB
#undef PG8_STAGE
#undef PG8_LDA
#undef PG8_LDB
#undef PG8_MMA
#undef PG8_WAIT_V
#undef PG8_WAIT_L
#undef PG8_BAR
#undef PG8_SCHED
}
}

constexpr int NWAVES = 8, NTHREADS = 512;
constexpr int NB = 32, SEQ = 2048, DM = 1024, T = NB * SEQ;
constexpr int IN_COLS = 5320, NPROJ = 5888;
constexpr int N_PHASES = 13;
constexpr float ALPHA = 1.189207115002721f;
constexpr float LN_EPS = 1e-5f, RMS_EPS = 1e-6f;
constexpr float LOG2E = 1.4426950408889634f, QSCALE = 0.125f * LOG2E;

constexpr size_t MiB = 1u << 20;
constexpr size_t WS_CTL = 0, CTL_ZERO_BYTES = 64 * 1024;
constexpr size_t WS_WIN = 1 * MiB, WS_WA = 13 * MiB, WS_WB = 60 * MiB, WS_WO = 16 * MiB, WS_WPQ = 18 * MiB;
constexpr size_t WS_UT8 = 24 * MiB, WS_VT8 = 40 * MiB, WS_UINV = 56 * MiB, WS_VINV = 56 * MiB + 65536;
constexpr size_t WS_XB = 88 * MiB;
constexpr size_t WS_QL = 216 * MiB;
constexpr size_t WS_MISC = 344 * MiB;
constexpr size_t WS_CKV = 376 * MiB;
constexpr size_t WS_QI = 392 * MiB, WS_QB = 456 * MiB, WS_FB = 520 * MiB, WS_IB = 584 * MiB, WS_GB = 648 * MiB;
constexpr size_t WS_GA = 712 * MiB, WS_GBT = 776 * MiB;
constexpr size_t WS_HO = 840 * MiB;
constexpr size_t WS_BM = 968 * MiB;
constexpr size_t WS_END = 984 * MiB;
constexpr size_t WS_MERGED = WS_QI, WS_X1B = WS_QL, WS_PQ = WS_QI, WS_IDS = WS_GB, WS_GATES = WS_GB + 32 * MiB, WS_W8 = WS_GB + 16 * MiB, WS_WSC = WS_GB + 24 * MiB, WS_HP = WS_GA, WS_FFN = WS_XB;
constexpr size_t WS_STATS = 22 * MiB;
constexpr size_t WS_X8 = WS_XB, WS_XINV = 22 * MiB + 512 * 1024;
constexpr int CW_QU = 8192, CW_QV = 8192 + 512;
constexpr int CW_QIDX = 8192 + 1024;
constexpr int CW_BAR = 4096;

constexpr int RING_BYTES = 131072;
constexpr int LDS_BYTES = 163840;
constexpr int LDSCTL_OFF = LDS_BYTES - 512, MISC_OFF = LDSCTL_OFF + 320;

#define GAS __attribute__((address_space(1)))
#define LAS __attribute__((address_space(3)))
typedef unsigned short bf16;
typedef unsigned v4u __attribute__((ext_vector_type(4)));
typedef unsigned v2u __attribute__((ext_vector_type(2)));
typedef float f32x4 __attribute__((ext_vector_type(4)));
typedef float f32x2 __attribute__((ext_vector_type(2)));
typedef GAS unsigned gu32;
#define RLX_AGENT __ATOMIC_RELAXED, __HIP_MEMORY_SCOPE_AGENT
#define LDS_WAIT() asm volatile("s_waitcnt lgkmcnt(0)" ::: "memory")
#define VM_WAIT() asm volatile("s_waitcnt vmcnt(0)" ::: "memory")
typedef __bf16 bf16x2_t __attribute__((ext_vector_type(2)));
__device__ __forceinline__ unsigned pk2(float lo, float hi) { const bf16x2_t v = {(__bf16)lo, (__bf16)hi}; return __builtin_bit_cast(unsigned, v); }
__device__ __forceinline__ float bflo(unsigned u) { return __uint_as_float(u << 16); }
__device__ __forceinline__ float bfhi(unsigned u) { return __uint_as_float(u & 0xffff0000u); }
__device__ __forceinline__ float bf2f(bf16 b) { return __uint_as_float(((unsigned)b) << 16); }
__device__ __forceinline__ float sigmoidf_(float x) { return __builtin_amdgcn_rcpf(1.0f + __expf(-x)); }

#define XB_TMO      128
#define XB_XCNT(j)  (256  + 64 * (j))
#define XB_XSUB(j)  (1280 + 64 * (j))
#define XB_XGEN(j)  (2304 + 64 * (j))
#define XB_TOP      3328
#define XB_TOPGEN   3392
#define XCD_BAR_WORDS 3456
#define XB_SPIN_CAP (1u << 22)
__device__ __forceinline__ unsigned xb_ld(unsigned* p)              { return __hip_atomic_load(p, __ATOMIC_RELAXED, __HIP_MEMORY_SCOPE_AGENT); }
__device__ __forceinline__ unsigned xb_add(unsigned* p, unsigned v) { return __hip_atomic_fetch_add(p, v, __ATOMIC_RELAXED, __HIP_MEMORY_SCOPE_AGENT); }
__device__ __forceinline__ unsigned xb_xcc_id() { return (unsigned)__builtin_amdgcn_s_getreg((3 << 11) | 20) & 0xFu; }
#define XB_SPIN(cond, bar) do { unsigned _sp = 0; while (cond) { __builtin_amdgcn_s_sleep(1); \
    if ((++_sp & 255u) == 0u) { if (xb_ld(&(bar)[XB_TMO])) break; if (_sp > XB_SPIN_CAP) { atomicAdd(&(bar)[XB_TMO], 1u); break; } } } } while (0)
struct XcdBarrier { unsigned* bar; unsigned x; volatile LAS unsigned* st; };
__device__ __forceinline__ XcdBarrier xcd_barrier_post(unsigned* bar, volatile LAS unsigned* st) {
    XcdBarrier b; b.bar = bar; b.x = xb_xcc_id(); b.st = st;
    if (threadIdx.x == 0) (void)xb_add(&bar[XB_XCNT(b.x)], 1u);
    return b;
}
__device__ __forceinline__ void xcd_barrier_complete(unsigned* bar, unsigned x, unsigned& nloc, unsigned& nx) {
    const unsigned G = gridDim.x * gridDim.y * gridDim.z;
    unsigned sum, cnt, mine, sp = 0u;
    for (;;) {
        sum = 0u; cnt = 0u; mine = 0u;
#pragma unroll
        for (unsigned j = 0; j < 16; ++j) { const unsigned c = xb_ld(&bar[XB_XCNT(j)]); sum += c; cnt += (c > 0u) ? 1u : 0u; mine = (j == x) ? c : mine; }
        if (sum == G) break;
        __builtin_amdgcn_s_sleep(1);
        if ((++sp & 255u) == 0u) { if (xb_ld(&bar[XB_TMO])) break; if (sp > XB_SPIN_CAP) { atomicAdd(&bar[XB_TMO], 1u); break; } }
    }
    nloc = mine > 0u ? mine : 1u; nx = cnt > 0u ? cnt : 1u;
}
__device__ __forceinline__ void xcd_barrier(const XcdBarrier& b) {
    asm volatile("s_waitcnt vmcnt(0)" ::: "memory");
    __syncthreads();
    if (threadIdx.x == 0) {
        unsigned* bar = b.bar;
        __builtin_amdgcn_s_waitcnt(0);
        unsigned nloc = b.st[0], nx = b.st[1];
        if (nloc == 0u) { xcd_barrier_complete(bar, b.x, nloc, nx); b.st[0] = nloc; b.st[1] = nx; }
        const unsigned old = xb_add(&bar[XB_XSUB(b.x)], 1u);
        const unsigned gen = old / nloc;
        if (old + 1u == (gen + 1u) * nloc) {
            __builtin_amdgcn_fence(__ATOMIC_RELEASE, "agent");
            asm volatile("s_waitcnt vmcnt(0)" ::: "memory");
            (void)xb_add(&bar[XB_TOP], 1u);
            XB_SPIN(xb_ld(&bar[XB_TOP]) < (gen + 1u) * nx, bar);
            __builtin_amdgcn_fence(__ATOMIC_ACQUIRE, "agent");
            asm volatile("s_waitcnt vmcnt(0)" ::: "memory");
        } else {
            XB_SPIN(xb_ld(&bar[XB_TOP]) < (gen + 1u) * nx, bar);
            __builtin_amdgcn_fence(__ATOMIC_ACQUIRE, "agent");
            asm volatile("s_waitcnt vmcnt(0)" ::: "memory");
        }
    }
    __syncthreads();
}

struct Args { const float* in[20]; float* out; unsigned char* ws; int ph_lo, ph_hi, li, pad; };
enum { I_X = 0, I_WIN, I_KVG, I_WUK, I_WUV, I_RELB, I_LBP, I_BNG, I_WBRA, I_WBRB, I_WO, I_LN1G, I_LN1B, I_WPQ, I_SK1, I_SK2, I_UT, I_VT, I_LN2G, I_LN2B };

typedef const __attribute__((address_space(4))) Args* KArgs;
struct Frame {
    LAS unsigned char* lds;
    int tid, lane, wave, G;
    KArgs a;
    unsigned char* ws;
};

__device__ __forceinline__ float wave_sum(float v) {
#pragma unroll
    for (int o = 1; o < 64; o <<= 1) v += __shfl_xor(v, o);
    return v;
}
__device__ __forceinline__ float wave_sum_dpp(float v) {
    v += __builtin_bit_cast(float, __builtin_amdgcn_mov_dpp(__builtin_bit_cast(int, v), 0xB1, 0xf, 0xf, true));
    v += __builtin_bit_cast(float, __builtin_amdgcn_mov_dpp(__builtin_bit_cast(int, v), 0x4E, 0xf, 0xf, true));
    v += __builtin_bit_cast(float, __builtin_amdgcn_mov_dpp(__builtin_bit_cast(int, v), 0x141, 0xf, 0xf, true));
    v += __builtin_bit_cast(float, __builtin_amdgcn_mov_dpp(__builtin_bit_cast(int, v), 0x140, 0xf, 0xf, true));
    const int vi = __builtin_bit_cast(int, v);
    return (__int_as_float(__builtin_amdgcn_readlane(vi, 0)) + __int_as_float(__builtin_amdgcn_readlane(vi, 16))) + (__int_as_float(__builtin_amdgcn_readlane(vi, 32)) + __int_as_float(__builtin_amdgcn_readlane(vi, 48)));
}
__device__ __forceinline__ float wave_max(float v) {
#pragma unroll
    for (int o = 1; o < 64; o <<= 1) v = fmaxf(v, __shfl_xor(v, o));
    return v;
}

__device__ __forceinline__ void cvt_bf16_stream(const float* src, bf16* dst, size_t n8, size_t gtid, size_t gthreads) {
    for (size_t i0 = gtid; i0 < n8; i0 += 8 * gthreads) {
        f32x4 a[8], b[8];
#pragma unroll
        for (int u = 0; u < 8; ++u) { size_t i = i0 + (size_t)u * gthreads; i = i < n8 ? i : n8 - 1; a[u] = ((const f32x4*)src)[2 * i]; b[u] = ((const f32x4*)src)[2 * i + 1]; }
#pragma unroll
        for (int u = 0; u < 8; ++u) { const size_t i = i0 + (size_t)u * gthreads; if (i >= n8) continue;
            v4u o; o.x = pk2(a[u].x, a[u].y); o.y = pk2(a[u].z, a[u].w); o.z = pk2(b[u].x, b[u].y); o.w = pk2(b[u].z, b[u].w);
            ((v4u*)dst)[i] = o; }
    }
}
__device__ __forceinline__ void transpose_item(const float* W, int ldw, int K, int c0, int nvalid, bf16* WT, int r0, int k0, LAS float* scr, int lane) {
    float tv[32];
#pragma unroll
    for (int i = 0; i < 32; ++i) { const int kk = 2 * i + (lane >> 5), n = lane & 31; tv[i] = (n < nvalid) ? W[(size_t)(k0 + kk) * ldw + c0 + n] : 0.f; }
#pragma unroll
    for (int i = 0; i < 32; ++i) { const int kk = 2 * i + (lane >> 5), n = lane & 31; scr[kk * 33 + n] = tv[i]; }
    LDS_WAIT(); asm volatile("" ::: "memory");
    const int c = lane & 7;
#pragma unroll
    for (int j = 0; j < 4; ++j) { const int n = (lane >> 3) + 8 * j; const LAS float* s = scr + (8 * c) * 33 + n;
        v4u o; o.x = pk2(s[0 * 33], s[1 * 33]); o.y = pk2(s[2 * 33], s[3 * 33]); o.z = pk2(s[4 * 33], s[5 * 33]); o.w = pk2(s[6 * 33], s[7 * 33]);
        *(v4u*)(WT + (size_t)(r0 + n) * K + k0 + 8 * c) = o; }
    LDS_WAIT(); asm volatile("" ::: "memory");
}
__device__ __forceinline__ void win_block(int cb, int& c0, int& r0, int& nv) {
    nv = 32;
    if (cb < 4)        { c0 = 512 + 32 * cb;          r0 = 1024 + 32 * cb; }
    else if (cb < 6)   { c0 = 1152 + 32 * (cb - 4);   r0 = 1152 + 32 * (cb - 4); }
    else if (cb == 6)  { c0 = 1216;                   r0 = 1216; nv = 8; }
    else if (cb == 7)  { c0 = 0;                      r0 = 1248; nv = 0; }
    else if (cb < 24)  { c0 = 640 + 32 * (cb - 8);    r0 = 1280 + 32 * (cb - 8); }
    else if (cb < 40)  { c0 = 1224 + 32 * (cb - 24);  r0 = 1792 + 32 * (cb - 24); }
    else if (cb < 56)  { c0 = 1736 + 32 * (cb - 40);  r0 = 2304 + 32 * (cb - 40); }
    else if (cb < 72)  { c0 = 2248 + 32 * (cb - 56);  r0 = 2816 + 32 * (cb - 56); }
    else if (cb < 88)  { c0 = 2760 + 32 * (cb - 72);  r0 = 3328 + 32 * (cb - 72); }
    else if (cb < 120) { c0 = 3272 + 32 * (cb - 88);  r0 = 3840 + 32 * (cb - 88); }
    else               { c0 = 4296 + 32 * (cb - 120); r0 = 4864 + 32 * (cb - 120); }
}
__device__ __forceinline__ void p0_prologue(Frame& F) {
    KArgs const Ap = F.a;
    const size_t gtid = (size_t)blockIdx.x * NTHREADS + F.tid, gthreads = (size_t)F.G * NTHREADS;
    cvt_bf16_stream(Ap->in[I_X], (bf16*)(F.ws + WS_XB), (size_t)T * DM / 8, gtid, gthreads);
    {
        const int gw0 = blockIdx.x * NWAVES + F.wave, NGW0 = F.G * NWAVES;
        for (int r0 = gw0; r0 < 2 * 16384; r0 += 4 * NGW0) {
            f32x4 v[4][4];
#pragma unroll
            for (int u = 0; u < 4; ++u) { const int r = r0 + u * NGW0; const int tb = r >> 14, e = r & 16383;
                if (r < 2 * 16384) { const float* src = (tb ? Ap->in[I_VT] : Ap->in[I_UT]) + (size_t)e * DM;
#pragma unroll
                    for (int j = 0; j < 4; ++j) v[u][j] = ((const f32x4*)src)[F.lane + 64 * j]; } }
#pragma unroll
            for (int u = 0; u < 4; ++u) { const int r = r0 + u * NGW0; const int tb = r >> 14, e = r & 16383;
                if (r < 2 * 16384) {
                    unsigned char* dst = F.ws + (tb ? WS_VT8 : WS_UT8); float* inv = (float*)(F.ws + WS_UINV) + tb;
                    float am = 0.f;
#pragma unroll
                    for (int j = 0; j < 4; ++j) am = fmaxf(am, fmaxf(fmaxf(fabsf(v[u][j].x), fabsf(v[u][j].y)), fmaxf(fabsf(v[u][j].z), fabsf(v[u][j].w))));
                    am = wave_max(am);
                    const float qmax = 127.0f;
                    const float sc = am > 0.f ? qmax / am : 1.0f;
                    if (F.lane == 0) inv[2 * e] = am > 0.f ? am / qmax : 1.0f;
#pragma unroll
                    for (int j = 0; j < 4; ++j) { const int d0 = 256 * j + 4 * F.lane, sl = d0 >> 7, off = d0 & 127;
                        int wv;
                        { const int a0 = (int)rintf(v[u][j].x * sc), a1 = (int)rintf(v[u][j].y * sc), a2 = (int)rintf(v[u][j].z * sc), a3 = (int)rintf(v[u][j].w * sc);
                            wv = (a0 & 0xff) | ((a1 & 0xff) << 8) | ((a2 & 0xff) << 16) | ((a3 & 0xff) << 24); }
                        *(unsigned*)(dst + ((size_t)sl * 16384 + e) * 128 + off) = (unsigned)wv; } } }
        }
    }
    LAS float* scr = (LAS float*)(F.lds + F.wave * 16384);
    const int gw = blockIdx.x * NWAVES + F.wave, NGW = F.G * NWAVES;
    constexpr int I_IN = 152 * 16, I_B = 32 * 8, I_O = 32 * 16, I_PQ = 64 * 16;
    for (int it = gw; it < I_IN + I_B + I_O + I_PQ; it += NGW) {
        int r = it;
        if (r < I_IN) { const int cb = r >> 4, kb = r & 15; int c0, r0, nv; win_block(cb, c0, r0, nv);
            transpose_item(Ap->in[I_WIN], IN_COLS, 1024, c0, nv, (bf16*)(F.ws + WS_WIN), r0, 64 * kb, scr, F.lane); continue; }
        r -= I_IN;
        if (r < I_B) { const int cb = r >> 3, kb = r & 7; transpose_item(Ap->in[I_WBRB], 1024, 1024, 32 * cb, 32, (bf16*)(F.ws + WS_WB), 32 * cb, 64 * kb, scr, F.lane); continue; }
        r -= I_B;
        if (r < I_O) { const int cb = r >> 4, kb = r & 15; transpose_item(Ap->in[I_WO], 1024, 1024, 32 * cb, 32, (bf16*)(F.ws + WS_WO), 32 * cb, 64 * kb, scr, F.lane); continue; }
        r -= I_O;
        { const int cb = r >> 4, kb = r & 15; transpose_item(Ap->in[I_WPQ], 2048, 1024, 32 * cb, 32, (bf16*)(F.ws + WS_WPQ), 32 * cb, 64 * kb, scr, F.lane); }
    }
    __syncthreads();
    LAS float* Xa = (LAS float*)(F.lds);
    LAS float* Xb = (LAS float*)(F.lds + 128 * 65 * 4);
    const float* w_in = Ap->in[I_WIN]; const float* w_uk = Ap->in[I_WUK]; const float* w_uv = Ap->in[I_WUV]; const float* w_bra = Ap->in[I_WBRA];
    for (int it = blockIdx.x; it < 256; it += F.G) {
        if (it < 128) {
            const int h = it >> 4, k0 = (it & 15) * 64;
            for (int e = F.tid; e < 128 * 64; e += NTHREADS) { const int c = e >> 6, d = e & 63; Xa[c * 65 + d] = w_uk[c * 512 + h * 64 + d]; }
            for (int e = F.tid; e < 64 * 64; e += NTHREADS) { const int kk = e >> 6, d = e & 63; Xb[kk * 65 + d] = w_in[(size_t)(k0 + kk) * IN_COLS + h * 64 + d]; }
            __syncthreads();
            const int kk = F.tid & 63;
            for (int j = 0; j < 16; ++j) { const int c = (F.tid >> 6) + 8 * j; float s = 0.f;
#pragma unroll 16
                for (int d = 0; d < 64; ++d) s += Xb[kk * 65 + d] * Xa[c * 65 + d];
                ((bf16*)(F.ws + WS_WIN))[(size_t)(h * 128 + c) * 1024 + k0 + kk] = (bf16)(pk2(s * QSCALE, 0.f) & 0xffffu); }
            __syncthreads();
        } else {
            const int i2 = it - 128, h = i2 >> 4, n0 = (i2 & 15) * 64;
            for (int e = F.tid; e < 128 * 64; e += NTHREADS) { const int c = e >> 6, d = e & 63; Xa[c * 65 + d] = w_uv[c * 512 + h * 64 + d]; }
            for (int e = F.tid; e < 64 * 64; e += NTHREADS) { const int d = e >> 6, n = e & 63; Xb[d * 65 + n] = w_bra[(size_t)(h * 64 + d) * 1024 + n0 + n]; }
            __syncthreads();
            const int c = F.tid & 127;
            for (int j = 0; j < 16; ++j) { const int n = (F.tid >> 7) + 4 * j; float s = 0.f;
#pragma unroll 16
                for (int d = 0; d < 64; ++d) s += Xa[c * 65 + d] * Xb[d * 65 + n];
                ((bf16*)(F.ws + WS_WA))[(size_t)(n0 + n) * 1024 + h * 128 + c] = (bf16)(pk2(s, 0.f) & 0xffffu); }
            __syncthreads();
        }
    }
}

struct EpiProj {
    static constexpr bool PERM = true;
    unsigned char* ws;
    __device__ __forceinline__ void operator()(const f32x4 (&acc)[2][2][4][2], const pg8::Unit& u, int wr, int wc, int fr, int fq) const {
        const int pn = u.pn; size_t boff; int ldc, colt; bool sg = false;
        if (pn < 4)       { boff = WS_QL;   ldc = 1024; colt = pn * 256; }
        else if (pn == 4) { boff = WS_MISC; ldc = 256;  colt = 0; }
        else if (pn < 7)  { boff = WS_QI;   ldc = 512;  colt = (pn - 5) * 256; }
        else if (pn < 9)  { boff = WS_QB;   ldc = 512;  colt = (pn - 7) * 256; }
        else if (pn < 11) { boff = WS_FB;   ldc = 512;  colt = (pn - 9) * 256; }
        else if (pn < 13) { boff = WS_IB;   ldc = 512;  colt = (pn - 11) * 256; }
        else if (pn < 15) { boff = WS_GB;   ldc = 512;  colt = (pn - 13) * 256; }
        else if (pn < 19) { boff = WS_GA;   ldc = 1024; colt = (pn - 15) * 256; sg = true; }
        else              { boff = WS_GBT;  ldc = 1024; colt = (pn - 19) * 256; sg = true; }
        const int row0 = u.pm * 256 + wr * 64 + fr, col0 = colt + wc * 32 + 8 * fq;
        if (sg) {
            unsigned char* base = ws + boff;
            const int colg = colt + wc * 64 + 16 * fq;
#pragma unroll
            for (int ai = 0; ai < 2; ++ai)
#pragma unroll
                for (int m = 0; m < 4; ++m) { unsigned char* rowp = base + (size_t)(row0 + ai * 128 + m * 16) * ldc + colg;
                    unsigned ww[4];
#pragma unroll
                    for (int bj = 0; bj < 2; ++bj) { const f32x4 v0 = acc[ai][bj][m][0], v1 = acc[ai][bj][m][1];
                        unsigned q[8];
#pragma unroll
                        for (int j = 0; j < 4; ++j) { q[j] = (unsigned)(int)fmaxf(rintf(255.0f * sigmoidf_(v0[j])), 1.0f); q[4 + j] = (unsigned)(int)fmaxf(rintf(255.0f * sigmoidf_(v1[j])), 1.0f); }
                        ww[2 * bj] = q[0] | (q[1] << 8) | (q[2] << 16) | (q[3] << 24); ww[2 * bj + 1] = q[4] | (q[5] << 8) | (q[6] << 16) | (q[7] << 24); }
                    v4u w; w.x = ww[0]; w.y = ww[1]; w.z = ww[2]; w.w = ww[3];
                    *(v4u*)rowp = w; }
        } else {
            bf16* base = (bf16*)(ws + boff);
#pragma unroll
            for (int ai = 0; ai < 2; ++ai)
#pragma unroll
                for (int m = 0; m < 4; ++m) { bf16* rowp = base + (size_t)(row0 + ai * 128 + m * 16) * ldc + col0;
#pragma unroll
                    for (int bj = 0; bj < 2; ++bj) { const f32x4 v0 = acc[ai][bj][m][0], v1 = acc[ai][bj][m][1];
                        v4u w; w.x = pk2(v0[0], v0[1]); w.y = pk2(v0[2], v0[3]); w.z = pk2(v1[0], v1[1]); w.w = pk2(v1[2], v1[3]);
                        *(v4u*)(rowp + bj * 128) = w; } }
        }
    }
};
template <int MODE> struct EpiBranch {
    static constexpr bool PERM = true;
    const unsigned char* gate; bf16* O;
    __device__ __forceinline__ void operator()(const f32x4 (&acc)[2][2][4][2], const pg8::Unit& u, int wr, int wc, int fr, int fq) const {
        const int row0 = u.pm * 256 + wr * 64 + fr, col0 = u.pn * 256 + wc * 32 + 8 * fq, colg = u.pn * 256 + wc * 64 + 16 * fq;
        constexpr float S = 1.0f / 255.0f;
#pragma unroll
        for (int ai = 0; ai < 2; ++ai)
#pragma unroll
            for (int m = 0; m < 4; ++m) { const size_t rb = (size_t)(row0 + ai * 128 + m * 16) * 1024; const size_t off = rb + col0;
                const v4u gg = *(const v4u*)(gate + rb + colg);
#pragma unroll
                for (int bj = 0; bj < 2; ++bj) { const f32x4 v0 = acc[ai][bj][m][0], v1 = acc[ai][bj][m][1];
                    const unsigned gx = bj ? gg.z : gg.x, gy = bj ? gg.w : gg.y;
                    float r0 = v0[0] * (S * (float)(gx & 0xffu)), r1 = v0[1] * (S * (float)((gx >> 8) & 0xffu)), r2 = v0[2] * (S * (float)((gx >> 16) & 0xffu)), r3 = v0[3] * (S * (float)(gx >> 24));
                    float r4 = v1[0] * (S * (float)(gy & 0xffu)), r5 = v1[1] * (S * (float)((gy >> 8) & 0xffu)), r6 = v1[2] * (S * (float)((gy >> 16) & 0xffu)), r7 = v1[3] * (S * (float)(gy >> 24));
                    if (MODE == 1) { const v4u p = *(const v4u*)(O + off + bj * 128);
                        r0 += bflo(p.x); r1 += bfhi(p.x); r2 += bflo(p.y); r3 += bfhi(p.y); r4 += bflo(p.z); r5 += bfhi(p.z); r6 += bflo(p.w); r7 += bfhi(p.w); }
                    v4u w; w.x = pk2(r0, r1); w.y = pk2(r2, r3); w.z = pk2(r4, r5); w.w = pk2(r6, r7);
                    *(v4u*)(O + off + bj * 128) = w; } }
    }
};
struct EpiMerge {
    static constexpr bool PERM = true;
    const unsigned char* ga; const unsigned char* gb; bf16* O;
    __device__ __forceinline__ void mid(f32x4 (&acc)[2][2][4][2], const pg8::Unit& u, int wr, int wc, int fr, int fq) const {
        unsigned rb0 = (unsigned)(u.pm * 256 + wr * 64 + fr) * 1024u + (unsigned)(u.pn * 256 + wc * 64 + 16 * fq);
        asm volatile("" : "+v"(rb0));
#pragma unroll
        for (int ai = 0; ai < 2; ++ai)
#pragma unroll
            for (int m = 0; m < 4; ++m) { const unsigned rb = rb0 + (unsigned)(ai * 128 + m * 16) * 1024u;
                const v4u xa = *(const v4u*)(ga + rb), xb = *(const v4u*)(gb + rb);
#pragma unroll
                for (int bj = 0; bj < 2; ++bj) { const unsigned ax = bj ? xa.z : xa.x, ay = bj ? xa.w : xa.y, bx = bj ? xb.z : xb.x, by = bj ? xb.w : xb.y;
#pragma unroll
                    for (int j = 0; j < 4; ++j) {
                        acc[ai][bj][m][0][j] *= (float)((ax >> (8 * j)) & 0xffu) * __builtin_amdgcn_rcpf((float)((bx >> (8 * j)) & 0xffu));
                        acc[ai][bj][m][1][j] *= (float)((ay >> (8 * j)) & 0xffu) * __builtin_amdgcn_rcpf((float)((by >> (8 * j)) & 0xffu)); } } }
    }
    __device__ __forceinline__ void operator()(const f32x4 (&acc)[2][2][4][2], const pg8::Unit& u, int wr, int wc, int fr, int fq) const {
        unsigned rb0 = (unsigned)(u.pm * 256 + wr * 64 + fr) * 1024u;
        asm volatile("" : "+v"(rb0));
        const unsigned col0 = (unsigned)(u.pn * 256 + wc * 32 + 8 * fq), colg = (unsigned)(u.pn * 256 + wc * 64 + 16 * fq);
        constexpr float S = 1.0f / 255.0f;
#pragma unroll
        for (int ai = 0; ai < 2; ++ai)
#pragma unroll
            for (int m = 0; m < 4; ++m) { const unsigned rb = rb0 + (unsigned)(ai * 128 + m * 16) * 1024u; const unsigned off = rb + col0;
                const v4u gg = *(const v4u*)(gb + (rb + colg));
#pragma unroll
                for (int bj = 0; bj < 2; ++bj) { const f32x4 v0 = acc[ai][bj][m][0], v1 = acc[ai][bj][m][1];
                    const unsigned gx = bj ? gg.z : gg.x, gy = bj ? gg.w : gg.y;
                    v4u w; w.x = pk2(v0[0] * (S * (float)(gx & 0xffu)), v0[1] * (S * (float)((gx >> 8) & 0xffu))); w.y = pk2(v0[2] * (S * (float)((gx >> 16) & 0xffu)), v0[3] * (S * (float)(gx >> 24)));
                    w.z = pk2(v1[0] * (S * (float)(gy & 0xffu)), v1[1] * (S * (float)((gy >> 8) & 0xffu))); w.w = pk2(v1[2] * (S * (float)((gy >> 16) & 0xffu)), v1[3] * (S * (float)(gy >> 24)));
                    *(v4u*)(O + (off + bj * 128)) = w; } }
    }
};
struct EpiResBf16 {
    static constexpr bool PERM = true;
    const bf16* X; bf16* Y;
    __device__ __forceinline__ void operator()(const f32x4 (&acc)[2][2][4][2], const pg8::Unit& u, int wr, int wc, int fr, int fq) const {
        const int row0 = u.pm * 256 + wr * 64 + fr, col0 = u.pn * 256 + wc * 32 + 8 * fq;
#pragma unroll
        for (int ai = 0; ai < 2; ++ai)
#pragma unroll
            for (int m = 0; m < 4; ++m) { const size_t off = (size_t)(row0 + ai * 128 + m * 16) * 1024 + col0;
#pragma unroll
                for (int bj = 0; bj < 2; ++bj) { const f32x4 v0 = acc[ai][bj][m][0], v1 = acc[ai][bj][m][1];
                    const v4u g = *(const v4u*)(X + off + bj * 128);
                    v4u w; w.x = pk2(v0[0] + ALPHA * bflo(g.x), v0[1] + ALPHA * bfhi(g.x)); w.y = pk2(v0[2] + ALPHA * bflo(g.y), v0[3] + ALPHA * bfhi(g.y));
                    w.z = pk2(v1[0] + ALPHA * bflo(g.z), v1[1] + ALPHA * bfhi(g.z)); w.w = pk2(v1[2] + ALPHA * bflo(g.w), v1[3] + ALPHA * bfhi(g.w));
                    *(v4u*)(Y + off + bj * 128) = w; } }
    }
};
struct EpiPlainBf16 {
    static constexpr bool PERM = true;
    bf16* O; int ldc;
    __device__ __forceinline__ void operator()(const f32x4 (&acc)[2][2][4][2], const pg8::Unit& u, int wr, int wc, int fr, int fq) const {
        const int row0 = u.pm * 256 + wr * 64 + fr, col0 = u.pn * 256 + wc * 32 + 8 * fq;
#pragma unroll
        for (int ai = 0; ai < 2; ++ai)
#pragma unroll
            for (int m = 0; m < 4; ++m) { bf16* rowp = O + (size_t)(row0 + ai * 128 + m * 16) * ldc + col0;
#pragma unroll
                for (int bj = 0; bj < 2; ++bj) { const f32x4 v0 = acc[ai][bj][m][0], v1 = acc[ai][bj][m][1];
                    v4u w; w.x = pk2(v0[0], v0[1]); w.y = pk2(v0[2], v0[3]); w.z = pk2(v1[0], v1[1]); w.w = pk2(v1[2], v1[3]);
                    *(v4u*)(rowp + bj * 128) = w; } }
    }
};

template <int CTRL> __device__ __forceinline__ float dppf(float x) { return __builtin_bit_cast(float, __builtin_amdgcn_mov_dpp(__builtin_bit_cast(int, x), CTRL, 0xf, 0xf, true)); }
__device__ __forceinline__ void p2_ckv_norm(Frame& F) {
    const bf16* misc = (const bf16*)(F.ws + WS_MISC); bf16* ckv = (bf16*)(F.ws + WS_CKV); const float* g = F.a->in[I_KVG];
    const int gw = blockIdx.x * NWAVES + F.wave, NGW = F.G * NWAVES, sub = F.lane >> 4, l16 = F.lane & 15;
    float gv[8];
#pragma unroll
    for (int j = 0; j < 8; ++j) gv[j] = g[l16 * 8 + j];
    for (int r0 = gw; r0 < T / 4; r0 += 4 * NGW) {
        v4u p[4];
#pragma unroll
        for (int u = 0; u < 4; ++u) { const int r4 = r0 + u * NGW; const int t = (r4 < T / 4 ? r4 : gw) * 4 + sub; p[u] = *(const v4u*)(misc + (size_t)t * 256 + l16 * 8); }
#pragma unroll
        for (int u = 0; u < 4; ++u) { const int r4 = r0 + u * NGW; if (r4 >= T / 4) continue; const int t = r4 * 4 + sub;
            float v[8] = {bflo(p[u].x), bfhi(p[u].x), bflo(p[u].y), bfhi(p[u].y), bflo(p[u].z), bfhi(p[u].z), bflo(p[u].w), bfhi(p[u].w)};
            float ss = 0.f;
#pragma unroll
            for (int j = 0; j < 8; ++j) ss += v[j] * v[j];
            ss += dppf<0xB1>(ss); ss += dppf<0x4E>(ss); ss += dppf<0x141>(ss); ss += dppf<0x140>(ss);
            const float r = rsqrtf(ss * (1.0f / 128.0f) + RMS_EPS);
            v4u o; o.x = pk2(v[0] * r * gv[0], v[1] * r * gv[1]); o.y = pk2(v[2] * r * gv[2], v[3] * r * gv[3]); o.z = pk2(v[4] * r * gv[4], v[5] * r * gv[5]); o.w = pk2(v[6] * r * gv[6], v[7] * r * gv[7]);
            *(v4u*)(ckv + (size_t)t * 128 + l16 * 8) = o; }
    }
}

__device__ __forceinline__ void p2_hgrn_simple(Frame& F) {
    const bf16* QB = (const bf16*)(F.ws + WS_QB); const bf16* FBp = (const bf16*)(F.ws + WS_FB); bf16* IB = (bf16*)(F.ws + WS_IB);
    const float* lbp = F.a->in[I_LBP];
    const int v = F.tid >> 2, dq = F.tid & 3;
    for (int item = blockIdx.x; item < NB * 4; item += F.G) {
        const int b = item >> 2, h = item & 3;
        float lb[32], S[32];
#pragma unroll
        for (int i = 0; i < 32; ++i) { const int d = h * 128 + dq * 32 + i; lb[i] = 1.0f / (1.0f + __expf(lbp[512 + d] - lbp[d])); S[i] = 0.f; }
        for (int t = 0; t < SEQ; ++t) {
            const size_t row = (size_t)b * SEQ + t;
            const v4u* qp = (const v4u*)(QB + row * 512 + h * 128 + dq * 32);
            const v4u* fp = (const v4u*)(FBp + row * 512 + h * 128 + dq * 32);
            const float vv = bf2f(IB[row * 512 + h * 128 + v]);
            float part = 0.f;
#pragma unroll
            for (int c = 0; c < 4; ++c) { const v4u q4 = qp[c], f4 = fp[c];
#pragma unroll
                for (int e = 0; e < 4; ++e) {
                    const unsigned qa = e == 0 ? q4.x : e == 1 ? q4.y : e == 2 ? q4.z : q4.w, fa = e == 0 ? f4.x : e == 1 ? f4.y : e == 2 ? f4.z : f4.w;
#pragma unroll
                    for (int hh = 0; hh < 2; ++hh) { const int i = c * 8 + e * 2 + hh;
                        const float q = hh ? bfhi(qa) : bflo(qa), z = hh ? bfhi(fa) : bflo(fa);
                        const float sg = sigmoidf_(z), f = lb[i] + (1.0f - lb[i]) * sg, k = (1.0f - lb[i]) * (1.0f - sg);
                        S[i] = f * S[i] + k * vv; part += q * S[i]; } } }
            part += __shfl_xor(part, 1); part += __shfl_xor(part, 2);
            if (dq == 0) IB[row * 512 + h * 128 + v] = (bf16)(pk2(part, 0.f) & 0xffffu);
        }
    }
}

__device__ __forceinline__ void p2_hgrn_chunked(Frame& F, bf16* OUTB, int nbatch, const int ostr) {
    typedef short bf16x8 __attribute__((ext_vector_type(8)));
    const bf16* QB = (const bf16*)(F.ws + WS_QB); const bf16* FBp = (const bf16*)(F.ws + WS_FB); const bf16* IB = (const bf16*)(F.ws + WS_IB);
    const float* lbp = F.a->in[I_LBP];
    constexpr int S136 = 136, S72 = 72;
    LAS bf16* QIN = (LAS bf16*)(F.lds);
    LAS bf16* KIN = (LAS bf16*)(F.lds + 17408);
    LAS bf16* QDEC = (LAS bf16*)(F.lds + 2 * 17408);
    LAS bf16* ST = (LAS bf16*)(F.lds + 3 * 17408);
    LAS bf16* KDT = (LAS bf16*)(F.lds + 3 * 17408 + 34816);
    LAS bf16* VT = (LAS bf16*)(F.lds + 3 * 17408 + 34816 + 18432);
    LAS bf16* ATT = (LAS bf16*)(F.lds + 3 * 17408 + 34816 + 2 * 18432);
    LAS float* SEG = (LAS float*)(F.lds + 3 * 17408 + 34816 + 2 * 18432 + 9216);
    LAS float* DECAY = SEG + 512;
    const int tid = F.tid, lane = F.lane, w = F.wave, l15 = lane & 15, q4 = lane >> 4;
    const int d = tid & 127, tq = tid >> 7;
    const int tr = w >> 1, tc2 = w & 1;
    for (int item = blockIdx.x; item < nbatch * 4; item += F.G) {
        const int b = item >> 2, h = item & 3;
        const float lb = 1.0f / (1.0f + __expf(lbp[512 + h * 128 + d] - lbp[h * 128 + d])), oml = 1.0f - lb;
        f32x4 Sacc[8];
#pragma unroll
        for (int nt = 0; nt < 8; ++nt) Sacc[nt] = (f32x4){0.f, 0.f, 0.f, 0.f};
        for (int e = tid; e < 128 * S136 / 2; e += NTHREADS) ((LAS unsigned*)ST)[e] = 0u;
        const size_t rowb = (size_t)b * SEQ;
        const bf16* zp = FBp + (rowb + tq * 16) * 512 + h * 128 + d;
        const bf16* qp = QB + (rowb + tq * 16) * 512 + h * 128 + d;
        const bf16* vp = IB + (rowb + tq * 16) * 512 + h * 128 + d;
        unsigned short zr[16], qr[16], vr[16];
#pragma unroll
        for (int i = 0; i < 16; ++i) { zr[i] = zp[(size_t)i * 512]; qr[i] = qp[(size_t)i * 512]; vr[i] = vp[(size_t)i * 512]; }
        __syncthreads();
        for (int n = 0; n < SEQ / 64; ++n) {
            float c[16], kk[16], qf[16];
            { float run = 0.f;
#pragma unroll
              for (int i = 0; i < 16; ++i) { const float z = bf2f(zr[i]); const float e1 = __expf(-z), sg = __builtin_amdgcn_rcpf(1.0f + e1);
                  run += __logf(lb + oml * sg); c[i] = run; kk[i] = oml * e1 * sg; qf[i] = bf2f(qr[i]); } }
            v4u vv0, vv1;
            vv0.x = (unsigned)vr[0] | ((unsigned)vr[1] << 16); vv0.y = (unsigned)vr[2] | ((unsigned)vr[3] << 16); vv0.z = (unsigned)vr[4] | ((unsigned)vr[5] << 16); vv0.w = (unsigned)vr[6] | ((unsigned)vr[7] << 16);
            vv1.x = (unsigned)vr[8] | ((unsigned)vr[9] << 16); vv1.y = (unsigned)vr[10] | ((unsigned)vr[11] << 16); vv1.z = (unsigned)vr[12] | ((unsigned)vr[13] << 16); vv1.w = (unsigned)vr[14] | ((unsigned)vr[15] << 16);
            SEG[tq * 128 + d] = c[15];
            if (n + 1 < SEQ / 64) {
                const size_t o2 = (size_t)(n + 1) * 64 * 512;
#pragma unroll
                for (int i = 0; i < 16; ++i) { zr[i] = zp[o2 + (size_t)i * 512]; qr[i] = qp[o2 + (size_t)i * 512]; vr[i] = vp[o2 + (size_t)i * 512]; }
            }
            __syncthreads();
            { const float s0 = SEG[d], s1 = SEG[128 + d], s2 = SEG[256 + d], s3 = SEG[384 + d];
              const float off = tq == 0 ? 0.f : tq == 1 ? s0 : tq == 2 ? s0 + s1 : s0 + s1 + s2;
              const float bref = s0 + s1, blast = (s0 + s1) + (s2 + s3);
              const float enb = __expf(-bref), eb = __expf(bref), el = __expf(blast);
              if (tq == 0) DECAY[d] = el;
              unsigned kd[8];
#pragma unroll
              for (int i = 0; i < 16; i += 2) {
                  const float E0 = __expf(c[i] + off), E1 = __expf(c[i + 1] + off), r0 = __builtin_amdgcn_rcpf(E0), r1 = __builtin_amdgcn_rcpf(E1);
                  const int t0 = tq * 16 + i;
                  const unsigned qd = pk2(qf[i] * E0, qf[i + 1] * E1), qi = pk2(qf[i] * E0 * enb, qf[i + 1] * E1 * enb), ki = pk2(kk[i] * eb * r0, kk[i + 1] * eb * r1);
                  QDEC[t0 * S136 + d] = (bf16)(qd & 0xffffu); QDEC[(t0 + 1) * S136 + d] = (bf16)(qd >> 16);
                  QIN[t0 * S136 + d] = (bf16)(qi & 0xffffu); QIN[(t0 + 1) * S136 + d] = (bf16)(qi >> 16);
                  KIN[t0 * S136 + d] = (bf16)(ki & 0xffffu); KIN[(t0 + 1) * S136 + d] = (bf16)(ki >> 16);
                  kd[i >> 1] = pk2(kk[i] * el * r0, kk[i + 1] * el * r1);
              }
              *(LAS v4u*)(KDT + d * S72 + tq * 16) = (v4u){kd[0], kd[1], kd[2], kd[3]};
              *(LAS v4u*)(KDT + d * S72 + tq * 16 + 8) = (v4u){kd[4], kd[5], kd[6], kd[7]};
              *(LAS v4u*)(VT + d * S72 + tq * 16) = vv0;
              *(LAS v4u*)(VT + d * S72 + tq * 16 + 8) = vv1;
            }
            __syncthreads();
#pragma unroll
            for (int j = 0; j < 2; ++j) {
                const int tc = 2 * tc2 + j;
                f32x4 acc = {0.f, 0.f, 0.f, 0.f};
                if (tc <= tr) {
#pragma unroll
                    for (int ks = 0; ks < 4; ++ks) {
                        const bf16x8 a = *(const LAS bf16x8*)(QIN + (tr * 16 + l15) * S136 + ks * 32 + 8 * q4);
                        const bf16x8 bb = *(const LAS bf16x8*)(KIN + (tc * 16 + l15) * S136 + ks * 32 + 8 * q4);
                        acc = __builtin_amdgcn_mfma_f32_16x16x32_bf16(a, bb, acc, 0, 0, 0);
                    }
                }
                const int s_ = tc * 16 + l15;
#pragma unroll
                for (int r = 0; r < 4; ++r) { const int t_ = tr * 16 + 4 * q4 + r; ATT[t_ * S72 + s_] = (bf16)(pk2(s_ <= t_ ? acc[r] : 0.f, 0.f) & 0xffffu); }
            }
            __syncthreads();
#pragma unroll
            for (int j = 0; j < 4; ++j) {
                const int nt = 4 * tc2 + j;
                f32x4 acc = {0.f, 0.f, 0.f, 0.f};
#pragma unroll
                for (int ks = 0; ks < 2; ++ks) {
                    const bf16x8 a = *(const LAS bf16x8*)(ATT + (tr * 16 + l15) * S72 + ks * 32 + 8 * q4);
                    const bf16x8 bb = *(const LAS bf16x8*)(VT + (nt * 16 + l15) * S72 + ks * 32 + 8 * q4);
                    acc = __builtin_amdgcn_mfma_f32_16x16x32_bf16(a, bb, acc, 0, 0, 0);
                }
#pragma unroll
                for (int ks = 0; ks < 4; ++ks) {
                    const bf16x8 a = *(const LAS bf16x8*)(QDEC + (tr * 16 + l15) * S136 + ks * 32 + 8 * q4);
                    const bf16x8 bb = *(const LAS bf16x8*)(ST + (nt * 16 + l15) * S136 + ks * 32 + 8 * q4);
                    acc = __builtin_amdgcn_mfma_f32_16x16x32_bf16(a, bb, acc, 0, 0, 0);
                }
                bf16* op = OUTB + (rowb + (size_t)n * 64 + tr * 16 + 4 * q4) * ostr + h * 128 + nt * 16 + l15;
#pragma unroll
                for (int r = 0; r < 4; ++r) op[(size_t)r * ostr] = (bf16)(pk2(acc[r], 0.f) & 0xffffu);
            }
            __syncthreads();
            { const f32x4 dc = *(const LAS f32x4*)(DECAY + w * 16 + 4 * q4);
#pragma unroll
              for (int nt = 0; nt < 8; ++nt) {
                  f32x4 acc = Sacc[nt] * dc;
#pragma unroll
                  for (int ks = 0; ks < 2; ++ks) {
                      const bf16x8 a = *(const LAS bf16x8*)(KDT + (w * 16 + l15) * S72 + ks * 32 + 8 * q4);
                      const bf16x8 bb = *(const LAS bf16x8*)(VT + (nt * 16 + l15) * S72 + ks * 32 + 8 * q4);
                      acc = __builtin_amdgcn_mfma_f32_16x16x32_bf16(a, bb, acc, 0, 0, 0);
                  }
                  Sacc[nt] = acc;
                  *(LAS v2u*)(ST + (nt * 16 + l15) * S136 + w * 16 + 4 * q4) = (v2u){pk2(acc[0], acc[1]), pk2(acc[2], acc[3])};
              } }
        }
        __syncthreads();
    }
}

__device__ __forceinline__ unsigned mono_key(float f) { const unsigned u = __float_as_uint(f); return (u & 0x80000000u) ? ~u : (u | 0x80000000u); }
__device__ __forceinline__ void p2_indexer_simple(Frame& F) {
    typedef short bf16x8 __attribute__((ext_vector_type(8)));
    const bf16* misc = (const bf16*)(F.ws + WS_MISC); const bf16* QI = (const bf16*)(F.ws + WS_QI);
    unsigned long long* BMp = (unsigned long long*)(F.ws + WS_BM);
    LAS float* sc = (LAS float*)(F.lds + F.wave * 16384);
    const int gw = blockIdx.x * NWAVES + F.wave, NGW = F.G * NWAVES, lane = F.lane;
    const int l15 = lane & 15, q4 = lane >> 4;
    for (int tp = gw; tp < T / 2; tp += NGW) {
        const int t0 = tp * 2, b = t0 >> 11, pos = t0 & 2047, chunk = pos >> 6, nk = chunk + 1;
        if (nk <= 4) { if (lane < 32) { BMp[(size_t)t0 * 32 + lane] = (lane < nk) ? ~0ull : 0ull; BMp[(size_t)(t0 + 1) * 32 + lane] = (lane < nk) ? ~0ull : 0ull; } continue; }
        const bf16* ap = QI + (size_t)(t0 + (l15 >> 3)) * 512 + (l15 & 7) * 64 + 8 * q4;
        const bf16x8 a0 = *(const bf16x8*)ap, a1 = *(const bf16x8*)(ap + 32);
        float w[4];
        { const v2u p = *(const v2u*)(misc + (size_t)(t0 + (q4 >> 1)) * 256 + 192 + (q4 & 1) * 4); const float s_ = 0.04419417382415922f;
          w[0] = bflo(p.x) * s_; w[1] = bfhi(p.x) * s_; w[2] = bflo(p.y) * s_; w[3] = bfhi(p.y) * s_; }
        const bf16* kbase = misc + ((size_t)b * SEQ + l15) * 256 + 128 + 8 * q4;
#pragma unroll 2
        for (int kt = 0; kt < nk * 4; ++kt) {
            const bf16* kp = kbase + (size_t)kt * 16 * 256;
            const bf16x8 b0 = *(const bf16x8*)kp, b1 = *(const bf16x8*)(kp + 32);
            f32x4 acc = {0.f, 0.f, 0.f, 0.f};
            acc = __builtin_amdgcn_mfma_f32_16x16x32_bf16(a0, b0, acc, 0, 0, 0);
            acc = __builtin_amdgcn_mfma_f32_16x16x32_bf16(a1, b1, acc, 0, 0, 0);
            float part = w[0] * fmaxf(acc[0], 0.f) + w[1] * fmaxf(acc[1], 0.f) + w[2] * fmaxf(acc[2], 0.f) + w[3] * fmaxf(acc[3], 0.f);
            part += __shfl_xor(part, 16);
            if ((q4 & 1) == 0) sc[(q4 >> 1) * 2048 + kt * 16 + l15] = part;
        }
        for (int i = nk; i < 32; ++i) { sc[i * 64 + lane] = -INFINITY; sc[2048 + i * 64 + lane] = -INFINITY; }
        LDS_WAIT(); asm volatile("" ::: "memory");
#pragma unroll 1
        for (int tt = 0; tt < 2; ++tt) {
            unsigned long long* bmrow = BMp + (size_t)(t0 + tt) * 32;
            unsigned key[32];
#pragma unroll
            for (int i = 0; i < 32; ++i) key[i] = mono_key(sc[tt * 2048 + i * 64 + lane]);
            unsigned prefix = 0u;
#pragma unroll 1
            for (int bit = 31; bit >= 0; --bit) {
                const unsigned cand = prefix | (1u << bit); int cnt = 0;
#pragma unroll
                for (int i = 0; i < 32; ++i) { cnt += __builtin_popcountll(__ballot(key[i] >= cand)); if ((i & 3) == 3) __builtin_amdgcn_sched_barrier(0); }
                if (cnt >= 256) prefix = cand;
            }
            int ngt = 0;
#pragma unroll
            for (int i = 0; i < 32; ++i) { ngt += __builtin_popcountll(__ballot(key[i] > prefix)); if ((i & 3) == 3) __builtin_amdgcn_sched_barrier(0); }
            const int need = 256 - ngt; int running = 0;
            const unsigned long long lt_mask = (1ull << lane) - 1ull;
#pragma unroll
            for (int i = 0; i < 32; ++i) {
                const unsigned long long eq = __ballot(key[i] == prefix), gt = __ballot(key[i] > prefix);
                const int rank = running + __builtin_popcountll(eq & lt_mask);
                const unsigned long long se = __ballot(key[i] == prefix && rank < need);
                running += __builtin_popcountll(eq);
                const unsigned long long word = gt | se;
                if (lane == 0) bmrow[i] = word;
                __builtin_amdgcn_sched_barrier(0);
            }
        }
        LDS_WAIT(); asm volatile("" ::: "memory");
    }
}

__device__ __forceinline__ void p2_indexer_blk(Frame& F, unsigned long long& pr_extra) {
    typedef short bf16x8 __attribute__((ext_vector_type(8)));
    const bf16* misc = (const bf16*)(F.ws + WS_MISC); const bf16* QI = (const bf16*)(F.ws + WS_QI);
    unsigned long long* BMp = (unsigned long long*)(F.ws + WS_BM);
    LAS float* sc = (LAS float*)(F.lds + F.wave * 16384);
    LAS unsigned char* KT = F.lds + 131072;
    LAS unsigned* HS = (LAS unsigned*)(F.lds + 149504 + F.wave * 1024);
    LAS unsigned* CL = (LAS unsigned*)(F.lds + 157696 + F.wave * 512);
    const int tid = F.tid, lane = F.lane, wv = F.wave, l15 = lane & 15, q4 = lane >> 4;
    const int srow = tid >> 3, sch = tid & 7;
    unsigned* qidx = (unsigned*)(F.ws + WS_CTL) + CW_QIDX;
    volatile LAS unsigned* slot = (volatile LAS unsigned*)(F.lds + MISC_OFF) + 16;
    const unsigned xcc_ = xb_xcc_id() & 7u;
    int qs = 0;
    for (;;) {
        __syncthreads();
        if (tid == 0) { unsigned g_ = 0xffffffffu; int q_ = qs;
            for (; q_ < 8; ++q_) { const unsigned x_ = (xcc_ + (unsigned)q_) & 7u; const unsigned v_ = xb_add(qidx + 64 * x_, 1u); if (v_ < 512u) { g_ = (x_ << 16) | v_; break; } }
            slot[0] = g_; slot[1] = (unsigned)q_; }
        __syncthreads();
        const unsigned gq = slot[0]; qs = (int)slot[1];
        if (gq == 0xffffffffu) break;
        const int g = (int)(gq & 0xffffu), b = (int)(gq >> 16) + 8 * (g & 3), p = 127 - (g >> 2);
        const int pos0 = p * 16, nk = (pos0 >> 6) + 1;
        const int t0 = b * SEQ + pos0 + 2 * wv;
        if (nk <= 4) { if (lane < 32) { BMp[(size_t)t0 * 32 + lane] = (lane < nk) ? ~0ull : 0ull; BMp[(size_t)(t0 + 1) * 32 + lane] = (lane < nk) ? ~0ull : 0ull; } continue; }
        const bf16* ap = QI + (size_t)(t0 + (l15 >> 3)) * 512 + (l15 & 7) * 64 + 8 * q4;
        const bf16x8 a0 = *(const bf16x8*)ap, a1 = *(const bf16x8*)(ap + 32);
        float w[4];
        { const v2u pw = *(const v2u*)(misc + (size_t)(t0 + (q4 >> 1)) * 256 + 192 + (q4 & 1) * 4); const float s_ = 0.04419417382415922f;
          w[0] = bflo(pw.x) * s_; w[1] = bfhi(pw.x) * s_; w[2] = bflo(pw.y) * s_; w[3] = bfhi(pw.y) * s_; }
        const bf16* ksrc = misc + ((size_t)b * SEQ + srow) * 256 + 128 + sch * 8;
        const unsigned kdst = (unsigned)srow * 144u + (unsigned)sch * 16u;
        v4u kA = *(const v4u*)ksrc, kB = kA;
        *(LAS v4u*)(KT + kdst) = kA;
        if (nk > 1) kA = *(const v4u*)(ksrc + (size_t)64 * 256);
        __syncthreads();
#define IDX_TILE(kt_, KW, KL) do { \
            LAS unsigned char* buf = KT + ((kt_) & 1) * 9216; \
            if ((kt_) + 2 < nk) KL = *(const v4u*)(ksrc + (size_t)((kt_) + 2) * 64 * 256); \
            float part[4]; \
            _Pragma("unroll") for (int st = 0; st < 4; ++st) { \
                const bf16x8 b0 = *(const LAS bf16x8*)(buf + (16 * st + l15) * 144 + 16 * q4), b1 = *(const LAS bf16x8*)(buf + (16 * st + l15) * 144 + 16 * q4 + 64); \
                f32x4 acc = {0.f, 0.f, 0.f, 0.f}; \
                acc = __builtin_amdgcn_mfma_f32_16x16x32_bf16(a0, b0, acc, 0, 0, 0); \
                acc = __builtin_amdgcn_mfma_f32_16x16x32_bf16(a1, b1, acc, 0, 0, 0); \
                part[st] = w[0] * fmaxf(acc[0], 0.f) + w[1] * fmaxf(acc[1], 0.f) + w[2] * fmaxf(acc[2], 0.f) + w[3] * fmaxf(acc[3], 0.f); } \
            _Pragma("unroll") for (int pr = 0; pr < 2; ++pr) {     \
                const auto sw = __builtin_amdgcn_permlane16_swap(__float_as_uint(part[2 * pr]), __float_as_uint(part[2 * pr + 1]), false, false); \
                sc[(lane >> 5) * 2048 + (kt_) * 64 + 32 * pr + (lane & 31)] = __uint_as_float(sw[0]) + __uint_as_float(sw[1]); } \
            if ((kt_) + 1 < nk) *(LAS v4u*)(KT + (((kt_) + 1) & 1) * 9216 + kdst) = KW; \
            __syncthreads(); } while (0)
        for (int kt = 0; kt < nk; kt += 2) {
            IDX_TILE(kt, kA, kB);
            if (kt + 1 < nk) IDX_TILE(kt + 1, kB, kA);
        }
#undef IDX_TILE
#ifdef PROBE_SEL
        const unsigned long long ps0 = __builtin_amdgcn_s_memrealtime();
#endif
#pragma unroll 1
        for (int tt = 0; tt < 2; ++tt) {
            unsigned long long* bmrow = BMp + (size_t)(t0 + tt) * 32;
            int ln = lane; asm volatile("" : "+v"(ln));
            unsigned key[32];
            unsigned prefix = 0u; bool have = false, simple = false;
            {
                float sv[32]; int binv[32];
                float smin = INFINITY, smax = -INFINITY;
#pragma unroll
                for (int i = 0; i < 32; ++i) { sv[i] = -INFINITY; if (i < nk) { sv[i] = sc[tt * 2048 + i * 64 + lane]; smin = fminf(smin, sv[i]); smax = fmaxf(smax, sv[i]); } }
#pragma unroll
                for (int i = 0; i < 32; ++i) key[i] = mono_key(sv[i]);
                smin = fminf(smin, dppf<0xB1>(smin)); smin = fminf(smin, dppf<0x4E>(smin)); smin = fminf(smin, dppf<0x141>(smin)); smin = fminf(smin, dppf<0x140>(smin));
                smax = fmaxf(smax, dppf<0xB1>(smax)); smax = fmaxf(smax, dppf<0x4E>(smax)); smax = fmaxf(smax, dppf<0x141>(smax)); smax = fmaxf(smax, dppf<0x140>(smax));
#define RLF(v, l) __int_as_float(__builtin_amdgcn_readlane(__float_as_int(v), (l)))
                smin = fminf(fminf(RLF(smin, 0), RLF(smin, 16)), fminf(RLF(smin, 32), RLF(smin, 48)));
                smax = fmaxf(fmaxf(RLF(smax, 0), RLF(smax, 16)), fmaxf(RLF(smax, 32), RLF(smax, 48)));
#undef RLF
                const float range = smax - smin;
                if (range > 0.f && range < 3.0e38f) {
                    const float scale = 255.99f / range;
                    *(LAS v4u*)(HS + 4 * lane) = (v4u){0u, 0u, 0u, 0u};
                    LDS_WAIT(); asm volatile("" ::: "memory");
#pragma unroll
                    for (int i = 0; i < 32; ++i) { binv[i] = -1;
                        if (i < nk) { int bq = (int)((sv[i] - smin) * scale); bq = bq < 0 ? 0 : (bq > 255 ? 255 : bq); binv[i] = bq; __hip_atomic_fetch_add(HS + bq, 1u, __ATOMIC_RELAXED, __HIP_MEMORY_SCOPE_WORKGROUP); } }
                    LDS_WAIT(); asm volatile("" ::: "memory");
                    const v4u hq = *(const LAS v4u*)(HS + 252 - 4 * lane);
                    const int h0 = (int)hq.w, h1 = (int)hq.z, h2 = (int)hq.y, h3 = (int)hq.x, sl = (h0 + h1) + (h2 + h3);
                    int P = sl;
                    P += __builtin_amdgcn_mov_dpp(P, 0x111, 0xf, 0xf, true); P += __builtin_amdgcn_mov_dpp(P, 0x112, 0xf, 0xf, true);
                    P += __builtin_amdgcn_mov_dpp(P, 0x114, 0xf, 0xf, true); P += __builtin_amdgcn_mov_dpp(P, 0x118, 0xf, 0xf, true);
                    { const int r0 = __builtin_amdgcn_readlane(P, 15), r1 = __builtin_amdgcn_readlane(P, 31), r2 = __builtin_amdgcn_readlane(P, 47); const int row = lane >> 4;
                      P += (row > 0 ? r0 : 0) + (row > 1 ? r1 : 0) + (row > 2 ? r2 : 0); }
                    const unsigned long long ball = __ballot(P >= 256);
                    if (ball != 0ull) {
                        const int L = __builtin_ctzll(ball);
                        int cab = __builtin_amdgcn_readlane(P - sl, L);
                        const int g0_ = __builtin_amdgcn_readlane(h0, L), g1_ = __builtin_amdgcn_readlane(h1, L), g2_ = __builtin_amdgcn_readlane(h2, L), g3_ = __builtin_amdgcn_readlane(h3, L);
                        int B, mB;
                        if (cab + g0_ >= 256) { B = 255 - 4 * L; mB = g0_; }
                        else if (cab + g0_ + g1_ >= 256) { cab += g0_; B = 254 - 4 * L; mB = g1_; }
                        else if (cab + g0_ + g1_ + g2_ >= 256) { cab += g0_ + g1_; B = 253 - 4 * L; mB = g2_; }
                        else { cab += g0_ + g1_ + g2_; B = 252 - 4 * L; mB = g3_; }
                        const int need = 256 - cab;
                        if (mB <= 64) {
                            int cntl = 0;
#pragma unroll
                            for (int i = 0; i < 32; ++i) cntl += (binv[i] == B) ? 1 : 0;
                            int Q = cntl;
                            Q += __builtin_amdgcn_mov_dpp(Q, 0x111, 0xf, 0xf, true); Q += __builtin_amdgcn_mov_dpp(Q, 0x112, 0xf, 0xf, true);
                            Q += __builtin_amdgcn_mov_dpp(Q, 0x114, 0xf, 0xf, true); Q += __builtin_amdgcn_mov_dpp(Q, 0x118, 0xf, 0xf, true);
                            { const int r0 = __builtin_amdgcn_readlane(Q, 15), r1 = __builtin_amdgcn_readlane(Q, 31), r2 = __builtin_amdgcn_readlane(Q, 47); const int row = lane >> 4;
                              Q += (row > 0 ? r0 : 0) + (row > 1 ? r1 : 0) + (row > 2 ? r2 : 0); }
                            int pos = Q - cntl;
#pragma unroll
                            for (int i = 0; i < 32; ++i) { if (i < nk) { const bool inb = binv[i] == B; CL[inb ? pos : 64 + lane] = key[i]; pos += inb ? 1 : 0; } }
                            LDS_WAIT(); asm volatile("" ::: "memory");
                            const unsigned cv = lane < mB ? CL[lane] : 0u;
                            int gt = 0, ge = 0;
                            for (int jj = 0; jj < mB; ++jj) { const unsigned cj = (unsigned)__builtin_amdgcn_readlane((int)cv, jj); gt += cj > cv ? 1 : 0; ge += cj >= cv ? 1 : 0; }
                            const unsigned long long hit = __ballot(lane < mB && gt < need && need <= ge);
                            if (hit != 0ull) { const int hl = __builtin_ctzll(hit); prefix = (unsigned)__builtin_amdgcn_readlane((int)cv, hl); have = true;
                                const int gth = __builtin_amdgcn_readlane(gt, hl), geh = __builtin_amdgcn_readlane(ge, hl); simple = (geh - gth) == (need - gth); }
                        }
                    }
                }
            }
            if (!have) {
            prefix = 0u;
#pragma unroll 1
            for (int bit = 31; bit >= 0; --bit) {
                const unsigned cand = prefix | (1u << bit); int cl = 0;
#pragma unroll
                for (int gq = 0; gq < 8; ++gq) {
                    if (gq * 4 < nk) {
#pragma unroll
                        for (int i = gq * 4; i < gq * 4 + 4; ++i) cl += (key[i] >= cand) ? 1 : 0;
                    }
                }
                cl += __builtin_amdgcn_mov_dpp(cl, 0xB1, 0xf, 0xf, true); cl += __builtin_amdgcn_mov_dpp(cl, 0x4E, 0xf, 0xf, true);
                cl += __builtin_amdgcn_mov_dpp(cl, 0x141, 0xf, 0xf, true); cl += __builtin_amdgcn_mov_dpp(cl, 0x140, 0xf, 0xf, true);
                const int cnt = __builtin_amdgcn_readlane(cl, 0) + __builtin_amdgcn_readlane(cl, 16) + __builtin_amdgcn_readlane(cl, 32) + __builtin_amdgcn_readlane(cl, 48);
                if (cnt >= 256) prefix = cand;
                if (cnt == 256) break;
            }
            }
            if (simple) {
                unsigned wl = 0u, wh = 0u;
#pragma unroll
                for (int i = 0; i < 32; ++i) { if (i < nk) { const unsigned long long word = __ballot(key[i] >= prefix); if (ln == i) { wl = (unsigned)word; wh = (unsigned)(word >> 32); } } }
                if (lane < nk) bmrow[lane] = ((unsigned long long)wh << 32) | (unsigned long long)wl;
            } else {
                int ngt = 0;
    #pragma unroll
                for (int i = 0; i < 32; ++i) { ngt += __builtin_popcountll(__ballot(key[i] > prefix)); if ((i & 3) == 3) __builtin_amdgcn_sched_barrier(0); }
                const int need = 256 - ngt; int running = 0;
                const unsigned long long lt_mask = (1ull << lane) - 1ull;
    #pragma unroll
                for (int i = 0; i < 32; ++i) {
                    const unsigned long long eq = __ballot(key[i] == prefix), gt = __ballot(key[i] > prefix);
                    const int rank = running + __builtin_popcountll(eq & lt_mask);
                    const unsigned long long se = __ballot(key[i] == prefix && rank < need);
                    running += __builtin_popcountll(eq);
                    const unsigned long long word = gt | se;
                    if (lane == 0) bmrow[i] = word;
                    __builtin_amdgcn_sched_barrier(0);
                }
            }
        }
#ifdef PROBE_SEL
        pr_extra += __builtin_amdgcn_s_memrealtime() - ps0;
#endif
        LDS_WAIT(); asm volatile("" ::: "memory");
    }
}

__device__ __forceinline__ void p3_hg_finalize(Frame& F) {
    bf16* HG = (bf16*)(F.ws + WS_HO); const bf16* GBp = (const bf16*)(F.ws + WS_GB); const float* ng = F.a->in[I_BNG];
    const int gw = blockIdx.x * NWAVES + F.wave, NGW = F.G * NWAVES, sub = F.lane >> 4, l16 = F.lane & 15;
    float gv[8];
#pragma unroll
    for (int j = 0; j < 8; ++j) gv[j] = ng[l16 * 8 + j];
    for (int r0 = gw; r0 < T; r0 += 4 * NGW) {
        v4u pp[4], qq[4];
#pragma unroll
        for (int u = 0; u < 4; ++u) { int r4 = r0 + u * NGW; r4 = r4 < T ? r4 : gw; const size_t off = (size_t)r4 * 512 + sub * 128 + l16 * 8, offh = off + (size_t)r4 * 512;
            pp[u] = *(const v4u*)(HG + offh); qq[u] = *(const v4u*)(GBp + off); }
#pragma unroll
        for (int u = 0; u < 4; ++u) { const int r4 = r0 + u * NGW; if (r4 >= T) continue;
            const size_t offh = (size_t)r4 * 1024 + sub * 128 + l16 * 8;
            const v4u p = pp[u], q = qq[u];
            float v[8] = {bflo(p.x), bfhi(p.x), bflo(p.y), bfhi(p.y), bflo(p.z), bfhi(p.z), bflo(p.w), bfhi(p.w)};
            float gg[8] = {bflo(q.x), bfhi(q.x), bflo(q.y), bfhi(q.y), bflo(q.z), bfhi(q.z), bflo(q.w), bfhi(q.w)};
            float ss = 0.f;
#pragma unroll
            for (int j = 0; j < 8; ++j) ss += v[j] * v[j];
            ss += dppf<0xB1>(ss); ss += dppf<0x4E>(ss); ss += dppf<0x141>(ss); ss += dppf<0x140>(ss);
            const float r = rsqrtf(ss * (1.0f / 128.0f) + RMS_EPS);
            float o[8];
#pragma unroll
            for (int j = 0; j < 8; ++j) o[j] = v[j] * r * gv[j] * gg[j] * sigmoidf_(gg[j]);
            v4u w; w.x = pk2(o[0], o[1]); w.y = pk2(o[2], o[3]); w.z = pk2(o[4], o[5]); w.w = pk2(o[6], o[7]);
            *(v4u*)(HG + offh) = w; }
    }
}

__device__ __forceinline__ int t5_bucket(int rel) {
    const int n = rel < 0 ? -rel : rel; const int base = rel > 0 ? 16 : 0;
    int v;
    if (n < 8) v = n; else v = n >= 91 ? 15 : n >= 64 ? 14 : n >= 46 ? 13 : n >= 32 ? 12 : n >= 23 ? 11 : n >= 16 ? 10 : n >= 12 ? 9 : 8;
    return base + v;
}
__device__ __forceinline__ void p3_attn_simple(Frame& F) {
    const bf16* CKV = (const bf16*)(F.ws + WS_CKV); bf16* QL = (bf16*)(F.ws + WS_QL);
    const unsigned long long* BMp = (const unsigned long long*)(F.ws + WS_BM);
    LAS float* relb = (LAS float*)(F.lds + 8 * 12800);
    LAS float* qlf = (LAS float*)(F.lds + F.wave * 12800);
    LAS float* pl = (LAS float*)(F.lds + F.wave * 12800 + 4096);
    LAS unsigned short* idx = (LAS unsigned short*)(F.lds + F.wave * 12800 + 4096 + 8192);
    if (F.tid < 256) relb[F.tid] = F.a->in[I_RELB][F.tid];
    __syncthreads();
    const int gw = blockIdx.x * NWAVES + F.wave, NGW = F.G * NWAVES, lane = F.lane;
    const unsigned long long lt_mask = (1ull << lane) - 1ull;
    for (int t = gw; t < T; t += NGW) {
        const int b = t >> 11, pos = t & 2047, nk = (pos >> 6) + 1;
        {
#pragma unroll
            for (int j = 0; j < 2; ++j) { const v4u p = *(const v4u*)(QL + (size_t)t * 1024 + j * 512 + lane * 8);
                f32x4 a = {bflo(p.x), bfhi(p.x), bflo(p.y), bfhi(p.y)}, c = {bflo(p.z), bfhi(p.z), bflo(p.w), bfhi(p.w)};
                *(LAS f32x4*)(qlf + j * 512 + lane * 8) = a; *(LAS f32x4*)(qlf + j * 512 + lane * 8 + 4) = c; }
        }
        int n = 0;
        for (int i = 0; i < nk; ++i) {
            const unsigned long long word = BMp[(size_t)t * 32 + i];
            if ((word >> lane) & 1ull) idx[n + __builtin_popcountll(word & lt_mask)] = (unsigned short)(i * 64 + lane);
            n += __builtin_popcountll(word);
        }
        LDS_WAIT(); asm volatile("" ::: "memory");
#pragma unroll 1
        for (int j = 0; j < 4; ++j) {
            const int k = lane + 64 * j; const bool ok = k < n; const int s = ok ? (int)idx[k] : 0;
            const v4u* row = (const v4u*)(CKV + ((size_t)b * SEQ + s) * 128);
            float d[8];
#pragma unroll
            for (int h = 0; h < 8; ++h) d[h] = 0.f;
#pragma unroll 1
            for (int q4 = 0; q4 < 4; ++q4) {
                asm volatile("" ::: "memory");
                float ck[32];
#pragma unroll
                for (int c = 0; c < 4; ++c) { const v4u p = row[q4 * 4 + c]; ck[c * 8 + 0] = bflo(p.x); ck[c * 8 + 1] = bfhi(p.x); ck[c * 8 + 2] = bflo(p.y); ck[c * 8 + 3] = bfhi(p.y); ck[c * 8 + 4] = bflo(p.z); ck[c * 8 + 5] = bfhi(p.z); ck[c * 8 + 6] = bflo(p.w); ck[c * 8 + 7] = bfhi(p.w); }
#pragma unroll
                for (int h = 0; h < 8; ++h) {
#pragma unroll
                    for (int c = 0; c < 8; ++c) { const f32x4 q = *(const LAS f32x4*)(qlf + h * 128 + q4 * 32 + c * 4); d[h] += q.x * ck[c * 4] + q.y * ck[c * 4 + 1] + q.z * ck[c * 4 + 2] + q.w * ck[c * 4 + 3]; }
                    __builtin_amdgcn_sched_barrier(0);
                }
            }
            const int bk = t5_bucket(s - pos);
            f32x4 s0, s1;
            s0.x = ok ? d[0] + relb[bk * 8 + 0] : -INFINITY; s0.y = ok ? d[1] + relb[bk * 8 + 1] : -INFINITY; s0.z = ok ? d[2] + relb[bk * 8 + 2] : -INFINITY; s0.w = ok ? d[3] + relb[bk * 8 + 3] : -INFINITY;
            s1.x = ok ? d[4] + relb[bk * 8 + 4] : -INFINITY; s1.y = ok ? d[5] + relb[bk * 8 + 5] : -INFINITY; s1.z = ok ? d[6] + relb[bk * 8 + 6] : -INFINITY; s1.w = ok ? d[7] + relb[bk * 8 + 7] : -INFINITY;
            *(LAS f32x4*)(pl + k * 8) = s0; *(LAS f32x4*)(pl + k * 8 + 4) = s1;
        }
        LDS_WAIT(); asm volatile("" ::: "memory");
        {
            f32x4 a0[4], a1[4];
#pragma unroll
            for (int j = 0; j < 4; ++j) { a0[j] = *(const LAS f32x4*)(pl + (lane + 64 * j) * 8); a1[j] = *(const LAS f32x4*)(pl + (lane + 64 * j) * 8 + 4); }
#pragma unroll
            for (int h = 0; h < 8; ++h) {
                float v[4];
#pragma unroll
                for (int j = 0; j < 4; ++j) v[j] = h < 4 ? a0[j][h & 3] : a1[j][h & 3];
                float m = wave_max(fmaxf(fmaxf(v[0], v[1]), fmaxf(v[2], v[3])));
                float sum = 0.f;
#pragma unroll
                for (int j = 0; j < 4; ++j) { v[j] = __expf(v[j] - m); sum += v[j]; }
                const float inv = 1.0f / wave_sum(sum);
#pragma unroll
                for (int j = 0; j < 4; ++j) { if (h < 4) a0[j][h & 3] = v[j] * inv; else a1[j][h & 3] = v[j] * inv; }
            }
#pragma unroll
            for (int j = 0; j < 4; ++j) { *(LAS f32x4*)(pl + (lane + 64 * j) * 8) = a0[j]; *(LAS f32x4*)(pl + (lane + 64 * j) * 8 + 4) = a1[j]; }
        }
        LDS_WAIT(); asm volatile("" ::: "memory");
        float acc[8][2];
#pragma unroll
        for (int h = 0; h < 8; ++h) { acc[h][0] = 0.f; acc[h][1] = 0.f; }
        for (int k = 0; k < n; ++k) {
            const int s = (int)idx[k];
            const unsigned vv = *(const unsigned*)(CKV + ((size_t)b * SEQ + s) * 128 + 2 * lane);
            const float v0 = bflo(vv), v1 = bfhi(vv);
            const f32x4 p0 = *(const LAS f32x4*)(pl + k * 8), p1 = *(const LAS f32x4*)(pl + k * 8 + 4);
            acc[0][0] += p0.x * v0; acc[0][1] += p0.x * v1; acc[1][0] += p0.y * v0; acc[1][1] += p0.y * v1;
            acc[2][0] += p0.z * v0; acc[2][1] += p0.z * v1; acc[3][0] += p0.w * v0; acc[3][1] += p0.w * v1;
            acc[4][0] += p1.x * v0; acc[4][1] += p1.x * v1; acc[5][0] += p1.y * v0; acc[5][1] += p1.y * v1;
            acc[6][0] += p1.z * v0; acc[6][1] += p1.z * v1; acc[7][0] += p1.w * v0; acc[7][1] += p1.w * v1;
        }
#pragma unroll
        for (int h = 0; h < 8; ++h) *(unsigned*)(QL + (size_t)t * 1024 + h * 128 + 2 * lane) = pk2(acc[h][0], acc[h][1]);
        LDS_WAIT(); asm volatile("" ::: "memory");
    }
}

__device__ __forceinline__ unsigned offb(unsigned row, unsigned ch) { return 256u * row + 16u * (ch ^ (((row & 3u) << 2) | ((row >> 2) & 3u))); }
__device__ __forceinline__ void p3_attn_mfma(Frame& F) {
    typedef short bf16x8 __attribute__((ext_vector_type(8)));
    typedef short s16x4 __attribute__((ext_vector_type(4)));
    typedef float f32x16 __attribute__((ext_vector_type(16)));
    const bf16* CKV = (const bf16*)(F.ws + WS_CKV); bf16* QL = (bf16*)(F.ws + WS_QL);
    const unsigned long long* BMp = (const unsigned long long*)(F.ws + WS_BM);
    LAS unsigned char* KV = F.lds;
    LAS float* LUT = (LAS float*)(F.lds + 49152);
    LAS unsigned char* QS = F.lds + 57344 + F.wave * 8192;
    const int tid = F.tid, lane = F.lane, head = F.wave, r = lane & 31, h = lane >> 5;
    for (int e = tid; e < 8 * 160; e += NTHREADS) { const int hh = e / 160, i = e % 160; const int rel = (i < 155 ? i : 154) - 91; LUT[e] = F.a->in[I_RELB][t5_bucket(rel) * 8 + hh] * LOG2E; }
    __syncthreads();
    const float bfar = LUT[head * 160];
    const unsigned blk = (lane >> 4) & 1, q4 = (lane & 15) >> 2, p4 = lane & 3;
    unsigned kofs[8], tofs[2][4];
#pragma unroll
    for (int ks = 0; ks < 8; ++ks) kofs[ks] = offb((unsigned)r, (unsigned)(2 * ks + h));
#pragma unroll
    for (int tp = 0; tp < 2; ++tp)
#pragma unroll
        for (int cb = 0; cb < 4; ++cb) tofs[tp][cb] = offb(8u * tp + 4u * h + q4, 4u * cb + 2u * blk + (p4 >> 1)) + 8u * (p4 & 1u);
    const unsigned qsb = 256u * (lane >> 4) + 16u * ((lane & 15) ^ ((lane >> 4) << 2)), owb = 256u * r + 16u * (((r & 3u) << 2) | ((r >> 2) & 3u)) + 8u * h;
#define ATT_QK(bb, ST) do { _Pragma("unroll") for (int s2 = 0; s2 < 2; ++s2) { \
        const f32x16 zero16 = {0.f, 0.f, 0.f, 0.f, 0.f, 0.f, 0.f, 0.f, 0.f, 0.f, 0.f, 0.f, 0.f, 0.f, 0.f, 0.f}; \
        { const bf16x8 a_ = *(const LAS bf16x8*)(KV + ((bb) + kofs[0]) + s2 * 8192); ST[s2] = __builtin_amdgcn_mfma_f32_32x32x16_bf16(a_, qreg[0], zero16, 0, 0, 0); } \
        _Pragma("unroll") for (int ks = 1; ks < 8; ++ks) { const bf16x8 a_ = *(const LAS bf16x8*)(KV + ((bb) + kofs[ks]) + s2 * 8192); \
            ST[s2] = __builtin_amdgcn_mfma_f32_32x32x16_bf16(a_, qreg[ks], ST[s2], 0, 0, 0); } } } while (0)
#define ATT_SM(kt, bw, FAR) do { \
        const int wsel_[2] = {(int)((unsigned)(bw) >> (4 * h)), (int)((unsigned)((bw) >> 32) >> (4 * h))}; \
        float mxa_[4] = {-1e30f, -1e30f, -1e30f, -1e30f}; \
        _Pragma("unroll") for (int s2 = 0; s2 < 2; ++s2) _Pragma("unroll") for (int i = 0; i < 16; ++i) { \
            const int cr_ = (i & 3) + 8 * (i >> 2); float bias_ = bfar; \
            if (!(FAR)) { int rel_ = (kt) * 64 + 32 * s2 + cr_ + 4 * h - (t0 + r); rel_ = rel_ < -91 ? -91 : rel_; bias_ = LUT[head * 160 + rel_ + 91]; } \
            const unsigned mk_ = (unsigned)__builtin_amdgcn_sbfe(wsel_[s2], cr_, 1); \
            const float sc_ = __uint_as_float((__float_as_uint(ST[s2][i] + bias_) & mk_) | (0xff800000u & ~mk_)); \
            ST[s2][i] = sc_; mxa_[i & 3] = fmaxf(mxa_[i & 3], sc_); } \
        float mx_ = fmaxf(fmaxf(mxa_[0], mxa_[1]), fmaxf(mxa_[2], mxa_[3])); \
        { const auto sw_ = __builtin_amdgcn_permlane32_swap(__float_as_uint(mx_), __float_as_uint(mx_), false, false); mx_ = fmaxf(__uint_as_float(sw_[0]), __uint_as_float(sw_[1])); }     \
          \
        const bool changed_ = __builtin_amdgcn_ballot_w64(mx_ - m > 8.0f) != 0ull; \
        const float mnew_ = changed_ ? fmaxf(m, mx_) : m, alpha_ = changed_ ? __builtin_amdgcn_exp2f(m - mnew_) : 1.0f; \
        m = mnew_; float psa_[4] = {0.f, 0.f, 0.f, 0.f}; \
        _Pragma("unroll") for (int s2 = 0; s2 < 2; ++s2) _Pragma("unroll") for (int i = 0; i < 16; ++i) { const float pv_ = __builtin_amdgcn_exp2f(ST[s2][i] - mnew_); ST[s2][i] = pv_; psa_[i & 3] += pv_; } \
        l = l * alpha_ + ((psa_[0] + psa_[1]) + (psa_[2] + psa_[3])); \
        if (changed_) { _Pragma("unroll") for (int cb = 0; cb < 4; ++cb) _Pragma("unroll") for (int i = 0; i < 16; ++i) O[cb][i] *= alpha_; } } while (0)
#define ATT_PV(bb) do { _Pragma("unroll") for (int s2 = 0; s2 < 2; ++s2) _Pragma("unroll") for (int u = 0; u < 2; ++u) { \
        v4u pk_; pk_.x = pk2(ST[s2][8 * u], ST[s2][8 * u + 1]); pk_.y = pk2(ST[s2][8 * u + 2], ST[s2][8 * u + 3]); pk_.z = pk2(ST[s2][8 * u + 4], ST[s2][8 * u + 5]); pk_.w = pk2(ST[s2][8 * u + 6], ST[s2][8 * u + 7]); \
        const bf16x8 pf_ = __builtin_bit_cast(bf16x8, pk_); \
        _Pragma("unroll") for (int cb = 0; cb < 4; ++cb) { \
            const s16x4 lo_ = __builtin_amdgcn_ds_read_tr16_b64_v4i16((LAS s16x4*)(KV + ((bb) + tofs[0][cb]) + s2 * 8192 + u * 4096)); \
            const s16x4 hi_ = __builtin_amdgcn_ds_read_tr16_b64_v4i16((LAS s16x4*)(KV + ((bb) + tofs[1][cb]) + s2 * 8192 + u * 4096)); \
            const bf16x8 va_ = __builtin_shufflevector(lo_, hi_, 0, 1, 2, 3, 4, 5, 6, 7); \
            O[cb] = __builtin_amdgcn_mfma_f32_32x32x16_bf16(va_, pf_, O[cb], 0, 0, 0); } __builtin_amdgcn_sched_barrier(0); } } while (0)
    for (int uidx = blockIdx.x; uidx < NB * 64; uidx += F.G) {
        const int k = uidx >> 8, c0 = (uidx >> 5) & 7;
        const int b = uidx & 31, qt = 8 * k + ((k & 1) ? 7 - c0 : c0);
        const int t0 = qt * 32, nkt = (qt >> 1) + 1;
        const size_t trow = (size_t)b * SEQ + t0 + r;
        const int drow = 4 * head + (lane >> 4), dch = (lane & 15) ^ (((drow & 3) << 2) | ((drow >> 2) & 3));
        const bf16* gsrc = CKV + ((size_t)b * SEQ + drow) * 128 + dch * 8;
#define ATT_LOAD(bufoff, ktile) do { _Pragma("unroll") for (int j_ = 0; j_ < 2; ++j_) \
            __builtin_amdgcn_global_load_lds((const unsigned*)(gsrc + ((size_t)(ktile) * 64 + 32 * j_) * 128), (LAS unsigned*)(KV + (bufoff) + j_ * 8192 + head * 1024), 16, 0, 0); } while (0)
        ATT_LOAD(0u, 0);
        if (nkt > 1) ATT_LOAD(16384u, 1);
        unsigned long long bw = BMp[trow * 32];
        __builtin_amdgcn_sched_barrier(0);
        {
            const size_t qb = ((size_t)b * SEQ + t0 + (lane >> 4)) * 1024 + head * 128 + (lane & 15) * 8;
            unsigned ql = qsb; asm volatile("" : "+v"(ql));
#pragma unroll
            for (int i = 0; i < 8; ++i) *(LAS v4u*)(QS + (ql ^ (16u * (i & 3))) + 1024 * i) = *(const v4u*)(QL + qb + (size_t)(4 * i) * 1024);
        }
        bf16x8 qreg[8];
#pragma unroll
        for (int ks = 0; ks < 8; ++ks) qreg[ks] = *(const LAS bf16x8*)(QS + kofs[ks]);
        f32x16 O[4], ST[2];
#pragma unroll
        for (int cb = 0; cb < 4; ++cb)
#pragma unroll
            for (int i = 0; i < 16; ++i) O[cb][i] = 0.f;
        float m = -1e30f, l = 0.f;
        asm volatile("s_waitcnt vmcnt(0)" ::: "memory");
        __syncthreads();
        ATT_QK(0u, ST);
        unsigned bi = 0u;
        const int kfar = t0 >= 154 ? ((t0 - 154) >> 6) + 1 : 0;
#define ATT_ITER(FAR) do { \
            const unsigned buf = bi; \
            const unsigned bi1 = bi == 32768u ? 0u : bi + 16384u, bi2 = bi1 == 32768u ? 0u : bi1 + 16384u; \
            if (kt + 2 < nkt) ATT_LOAD(bi2, kt + 2); \
            unsigned long long bwn = 0ull; if (kt + 1 < nkt) bwn = BMp[trow * 32 + kt + 1]; \
            const unsigned nb = (kt + 1 < nkt) ? bi1 : bi; \
            f32x16 SN[2]; \
            ATT_QK(nb, SN); \
            ATT_SM(kt, bw, FAR); \
            _Pragma("unroll") for (int sg = 0; sg < 16; ++sg) { __builtin_amdgcn_sched_group_barrier(0x008, 1, 0); __builtin_amdgcn_sched_group_barrier(0x100, 2, 0); __builtin_amdgcn_sched_group_barrier(0x002, 18, 0); } \
            ATT_PV(buf); \
            ST[0] = SN[0]; ST[1] = SN[1]; \
            bw = bwn; bi = bi1; \
            asm volatile("s_waitcnt vmcnt(0)" ::: "memory"); \
            __syncthreads(); } while (0)
        int kt = 0;
        for (; kt < kfar; ++kt) ATT_ITER(true);
        for (; kt < nkt; ++kt) ATT_ITER(false);
#undef ATT_ITER
#undef ATT_LOAD
        const float lt = l + __shfl_xor(l, 32), inv = 1.0f / lt;
        unsigned ow = owb; asm volatile("" : "+v"(ow));
#pragma unroll
        for (int cb = 0; cb < 4; ++cb)
#pragma unroll
            for (int g4 = 0; g4 < 4; ++g4) {
                v2u w; w.x = pk2(O[cb][4 * g4] * inv, O[cb][4 * g4 + 1] * inv); w.y = pk2(O[cb][4 * g4 + 2] * inv, O[cb][4 * g4 + 3] * inv);
                *(LAS v2u*)(QS + (ow ^ (16u * (4 * cb + g4)))) = w;
            }
        {
            const size_t qb = ((size_t)b * SEQ + t0 + (lane >> 4)) * 1024 + head * 128 + (lane & 15) * 8;
            unsigned ql = qsb; asm volatile("" : "+v"(ql));
#pragma unroll
            for (int i = 0; i < 8; ++i) *(v4u*)(QL + qb + (size_t)(4 * i) * 1024) = *(const LAS v4u*)(QS + (ql ^ (16u * (i & 3))) + 1024 * i);
        }
    }
#undef ATT_QK
#undef ATT_SM
#undef ATT_PV
}

__device__ __forceinline__ void p6_ln1(Frame& F) {
    bf16* X1B = (bf16*)(F.ws + WS_X1B); const float* g = F.a->in[I_LN1G]; const float* bb = F.a->in[I_LN1B];
    const int gw = blockIdx.x * NWAVES + F.wave, NGW = F.G * NWAVES, lane = F.lane;
    f32x4 gv[4], bv[4];
#pragma unroll
    for (int j = 0; j < 4; ++j) { gv[j] = ((const f32x4*)g)[lane + 64 * j]; bv[j] = ((const f32x4*)bb)[lane + 64 * j]; }
    for (int m0 = gw; m0 < T; m0 += 2 * NGW) {
        v2u pr[2][4];
#pragma unroll
        for (int u = 0; u < 2; ++u) { const int m = m0 + u * NGW < T ? m0 + u * NGW : m0; const v2u* o8 = (const v2u*)(X1B + (size_t)m * DM) + lane;
#pragma unroll
            for (int j = 0; j < 4; ++j) pr[u][j] = o8[64 * j]; }
#pragma unroll
        for (int u = 0; u < 2; ++u) { const int m = m0 + u * NGW; if (m >= T) continue;
            v2u* o8 = (v2u*)(X1B + (size_t)m * DM) + lane;
            f32x4 v[4]; float s = 0.f;
#pragma unroll
            for (int j = 0; j < 4; ++j) { const v2u p = pr[u][j]; v[j] = (f32x4){bflo(p.x), bfhi(p.x), bflo(p.y), bfhi(p.y)}; s += (v[j].x + v[j].y) + (v[j].z + v[j].w); }
            const float mean = wave_sum_dpp(s) * (1.f / DM); float s2 = 0.f;
#pragma unroll
            for (int j = 0; j < 4; ++j) { v[j] = v[j] - mean; s2 += (v[j].x * v[j].x + v[j].y * v[j].y) + (v[j].z * v[j].z + v[j].w * v[j].w); }
            const float rstd = rsqrtf(wave_sum_dpp(s2) * (1.f / DM) + LN_EPS);
            float am = 0.f;
#pragma unroll
            for (int j = 0; j < 4; ++j) { const f32x4 o = v[j] * rstd * gv[j] + bv[j]; v[j] = o; v2u w; w.x = pk2(o.x, o.y); w.y = pk2(o.z, o.w); o8[64 * j] = w;
                am = fmaxf(am, fmaxf(fmaxf(fabsf(o.x), fabsf(o.y)), fmaxf(fabsf(o.z), fabsf(o.w)))); }
            {
                am = wave_max(am);
                const float sc = am > 0.f ? 127.0f / am : 1.0f;
                if (lane == 0) ((float*)(F.ws + WS_XINV))[m] = am > 0.f ? am * (1.0f / 127.0f) : 1.0f;
#pragma unroll
                for (int j = 0; j < 4; ++j) { const int a0 = (int)rintf(v[j].x * sc), a1 = (int)rintf(v[j].y * sc), a2 = (int)rintf(v[j].z * sc), a3 = (int)rintf(v[j].w * sc);
                    *(unsigned*)(F.ws + WS_X8 + (size_t)m * DM + 4 * lane + 256 * j) = (unsigned)((a0 & 0xff) | ((a1 & 0xff) << 8) | ((a2 & 0xff) << 16) | ((a3 & 0xff) << 24)); }
            }
        }
    }
}

#define TOP16_INSERT(tv, ti, val, id) do { \
    _Pragma("unroll") for (int _j = 15; _j >= 1; --_j) { const bool _up = (val) > tv[_j - 1]; const bool _here = (val) > tv[_j]; \
        tv[_j] = _up ? tv[_j - 1] : (_here ? (val) : tv[_j]); ti[_j] = _up ? ti[_j - 1] : (_here ? (id) : ti[_j]); } \
    { const bool _h0 = (val) > tv[0]; tv[0] = _h0 ? (val) : tv[0]; ti[0] = _h0 ? (id) : ti[0]; } } while (0)
__device__ __forceinline__ void p8_peer_route_simple(Frame& F) {
    const bf16* PQ = (const bf16*)(F.ws + WS_PQ); unsigned short* IDS = (unsigned short*)(F.ws + WS_IDS); float* GATES = (float*)(F.ws + WS_GATES);
    LAS float* K1 = (LAS float*)(F.lds); LAS float* K2 = (LAS float*)(F.lds + 65536);
    for (int e = F.tid; e < 16384; e += NTHREADS) { K1[e] = F.a->in[I_SK1][e]; K2[e] = F.a->in[I_SK2][e]; }
    __syncthreads();
    const size_t gtid = (size_t)blockIdx.x * NTHREADS + F.tid, gthreads = (size_t)F.G * NTHREADS;
    for (size_t item = gtid; item < (size_t)T * 8; item += gthreads) {
        const size_t t = item >> 3; const int h = (int)(item & 7);
        float v1[16], v2[16]; int i1[16], i2[16];
#pragma unroll
        for (int half = 0; half < 2; ++half) {
            const v4u* qp = (const v4u*)(PQ + t * 2048 + h * 256 + half * 128);
            v4u q[16];
#pragma unroll
            for (int c = 0; c < 16; ++c) q[c] = qp[c];
            float tv[16]; int ti[16];
#pragma unroll
            for (int j = 0; j < 16; ++j) { tv[j] = -INFINITY; ti[j] = 0; }
            const LAS float* KK = half ? K2 : K1;
#pragma unroll 1
            for (int n = 0; n < 128; ++n) {
                float d = 0.f;
#pragma unroll
                for (int c = 0; c < 16; ++c) { const f32x4 ka = *(const LAS f32x4*)(KK + n * 128 + c * 8), kb = *(const LAS f32x4*)(KK + n * 128 + c * 8 + 4);
                    d += ka.x * bflo(q[c].x) + ka.y * bfhi(q[c].x) + ka.z * bflo(q[c].y) + ka.w * bfhi(q[c].y) + kb.x * bflo(q[c].z) + kb.y * bfhi(q[c].z) + kb.z * bflo(q[c].w) + kb.w * bfhi(q[c].w);
                    if ((c & 3) == 3) __builtin_amdgcn_sched_barrier(0); }
                TOP16_INSERT(tv, ti, d, n);
            }
#pragma unroll
            for (int j = 0; j < 16; ++j) { if (half) { v2[j] = tv[j]; i2[j] = ti[j]; } else { v1[j] = tv[j]; i1[j] = ti[j]; } }
        }
        float tv[16]; int ti[16];
#pragma unroll
        for (int j = 0; j < 16; ++j) { tv[j] = -INFINITY; ti[j] = 0; }
#pragma unroll
        for (int a = 0; a < 16; ++a)
#pragma unroll
            for (int c = 0; c < 16; ++c)
                if ((a + 1) * (c + 1) <= 16) { const float val = v1[a] + v2[c]; const int id = i1[a] * 128 + i2[c]; TOP16_INSERT(tv, ti, val, id); }
        float ev[16], sum = 0.f;
#pragma unroll
        for (int j = 0; j < 16; ++j) { ev[j] = __expf(tv[j] - tv[0]); sum += ev[j]; }
        const float inv = 1.0f / sum;
#pragma unroll
        for (int j8 = 0; j8 < 2; ++j8) {
            v4u w; w.x = (unsigned)ti[j8 * 8] | ((unsigned)ti[j8 * 8 + 1] << 16); w.y = (unsigned)ti[j8 * 8 + 2] | ((unsigned)ti[j8 * 8 + 3] << 16);
            w.z = (unsigned)ti[j8 * 8 + 4] | ((unsigned)ti[j8 * 8 + 5] << 16); w.w = (unsigned)ti[j8 * 8 + 6] | ((unsigned)ti[j8 * 8 + 7] << 16);
            *(v4u*)(IDS + t * 128 + h * 16 + j8 * 8) = w;
        }
#pragma unroll
        for (int j4 = 0; j4 < 4; ++j4)
            *(f32x4*)(GATES + t * 128 + h * 16 + j4 * 4) = (f32x4){ev[j4 * 4] * inv, ev[j4 * 4 + 1] * inv, ev[j4 * 4 + 2] * inv, ev[j4 * 4 + 3] * inv};
    }
}

#define RT_CE(a, b) do { const float hi_ = __builtin_amdgcn_fmed3f((a), (b), rt_pinf), lo_ = __builtin_amdgcn_fmed3f((a), (b), rt_ninf); (a) = hi_; (b) = lo_; } while (0)
#define RT_SORT16(x) do { RT_CE(x[0], x[13]); RT_CE(x[1], x[12]); RT_CE(x[2], x[15]); RT_CE(x[3], x[14]); RT_CE(x[4], x[8]); RT_CE(x[5], x[6]); RT_CE(x[7], x[11]); RT_CE(x[9], x[10]); RT_CE(x[0], x[5]); RT_CE(x[1], x[7]); RT_CE(x[2], x[9]); RT_CE(x[3], x[4]); RT_CE(x[6], x[13]); RT_CE(x[8], x[14]); RT_CE(x[10], x[15]); RT_CE(x[11], x[12]); RT_CE(x[0], x[1]); RT_CE(x[2], x[3]); RT_CE(x[4], x[5]); RT_CE(x[6], x[8]); RT_CE(x[7], x[9]); RT_CE(x[10], x[11]); RT_CE(x[12], x[13]); RT_CE(x[14], x[15]); RT_CE(x[0], x[2]); RT_CE(x[1], x[3]); RT_CE(x[4], x[10]); RT_CE(x[5], x[11]); RT_CE(x[6], x[7]); RT_CE(x[8], x[9]); RT_CE(x[12], x[14]); RT_CE(x[13], x[15]); RT_CE(x[1], x[2]); RT_CE(x[3], x[12]); RT_CE(x[4], x[6]); RT_CE(x[5], x[7]); RT_CE(x[8], x[10]); RT_CE(x[9], x[11]); RT_CE(x[13], x[14]); RT_CE(x[1], x[4]); RT_CE(x[2], x[6]); RT_CE(x[5], x[8]); RT_CE(x[7], x[10]); RT_CE(x[9], x[13]); RT_CE(x[11], x[14]); RT_CE(x[2], x[4]); RT_CE(x[3], x[6]); RT_CE(x[9], x[12]); RT_CE(x[11], x[13]); RT_CE(x[3], x[5]); RT_CE(x[6], x[8]); RT_CE(x[7], x[9]); RT_CE(x[10], x[12]); RT_CE(x[3], x[4]); RT_CE(x[5], x[6]); RT_CE(x[7], x[8]); RT_CE(x[9], x[10]); RT_CE(x[11], x[12]); RT_CE(x[6], x[7]); RT_CE(x[8], x[9]); } while (0)
#define RT_MERGE16(r, q) do { r[0] = __builtin_amdgcn_fmed3f(r[0], q[15], rt_pinf); r[1] = __builtin_amdgcn_fmed3f(r[1], q[14], rt_pinf); r[2] = __builtin_amdgcn_fmed3f(r[2], q[13], rt_pinf); r[3] = __builtin_amdgcn_fmed3f(r[3], q[12], rt_pinf); r[4] = __builtin_amdgcn_fmed3f(r[4], q[11], rt_pinf); r[5] = __builtin_amdgcn_fmed3f(r[5], q[10], rt_pinf); r[6] = __builtin_amdgcn_fmed3f(r[6], q[9], rt_pinf); r[7] = __builtin_amdgcn_fmed3f(r[7], q[8], rt_pinf); r[8] = __builtin_amdgcn_fmed3f(r[8], q[7], rt_pinf); r[9] = __builtin_amdgcn_fmed3f(r[9], q[6], rt_pinf); r[10] = __builtin_amdgcn_fmed3f(r[10], q[5], rt_pinf); r[11] = __builtin_amdgcn_fmed3f(r[11], q[4], rt_pinf); r[12] = __builtin_amdgcn_fmed3f(r[12], q[3], rt_pinf); r[13] = __builtin_amdgcn_fmed3f(r[13], q[2], rt_pinf); r[14] = __builtin_amdgcn_fmed3f(r[14], q[1], rt_pinf); r[15] = __builtin_amdgcn_fmed3f(r[15], q[0], rt_pinf); RT_CE(r[0], r[8]); RT_CE(r[1], r[9]); RT_CE(r[2], r[10]); RT_CE(r[3], r[11]); RT_CE(r[4], r[12]); RT_CE(r[5], r[13]); RT_CE(r[6], r[14]); RT_CE(r[7], r[15]); RT_CE(r[0], r[4]); RT_CE(r[1], r[5]); RT_CE(r[2], r[6]); RT_CE(r[3], r[7]); RT_CE(r[8], r[12]); RT_CE(r[9], r[13]); RT_CE(r[10], r[14]); RT_CE(r[11], r[15]); RT_CE(r[0], r[2]); RT_CE(r[1], r[3]); RT_CE(r[4], r[6]); RT_CE(r[5], r[7]); RT_CE(r[8], r[10]); RT_CE(r[9], r[11]); RT_CE(r[12], r[14]); RT_CE(r[13], r[15]); RT_CE(r[0], r[1]); RT_CE(r[2], r[3]); RT_CE(r[4], r[5]); RT_CE(r[6], r[7]); RT_CE(r[8], r[9]); RT_CE(r[10], r[11]); RT_CE(r[12], r[13]); RT_CE(r[14], r[15]); } while (0)
#define RT_MERGE8(r, q) do { r[8] = __builtin_amdgcn_fmed3f(r[8], q[7], rt_pinf); r[9] = __builtin_amdgcn_fmed3f(r[9], q[6], rt_pinf); r[10] = __builtin_amdgcn_fmed3f(r[10], q[5], rt_pinf); r[11] = __builtin_amdgcn_fmed3f(r[11], q[4], rt_pinf); r[12] = __builtin_amdgcn_fmed3f(r[12], q[3], rt_pinf); r[13] = __builtin_amdgcn_fmed3f(r[13], q[2], rt_pinf); r[14] = __builtin_amdgcn_fmed3f(r[14], q[1], rt_pinf); r[15] = __builtin_amdgcn_fmed3f(r[15], q[0], rt_pinf); RT_CE(r[0], r[8]); RT_CE(r[1], r[9]); RT_CE(r[2], r[10]); RT_CE(r[3], r[11]); RT_CE(r[4], r[12]); RT_CE(r[5], r[13]); RT_CE(r[6], r[14]); RT_CE(r[7], r[15]); RT_CE(r[0], r[4]); RT_CE(r[1], r[5]); RT_CE(r[2], r[6]); RT_CE(r[3], r[7]); RT_CE(r[8], r[12]); RT_CE(r[9], r[13]); RT_CE(r[10], r[14]); RT_CE(r[11], r[15]); RT_CE(r[0], r[2]); RT_CE(r[1], r[3]); RT_CE(r[4], r[6]); RT_CE(r[5], r[7]); RT_CE(r[8], r[10]); RT_CE(r[9], r[11]); RT_CE(r[12], r[14]); RT_CE(r[13], r[15]); RT_CE(r[0], r[1]); RT_CE(r[2], r[3]); RT_CE(r[4], r[5]); RT_CE(r[6], r[7]); RT_CE(r[8], r[9]); RT_CE(r[10], r[11]); RT_CE(r[12], r[13]); RT_CE(r[14], r[15]); } while (0)
#define MED16_INSERT(tv, key) do { _Pragma("unroll") for (int _j = 15; _j >= 1; --_j) tv[_j] = __builtin_amdgcn_fmed3f(tv[_j - 1], tv[_j], (key)); tv[0] = fmaxf(tv[0], (key)); } while (0)
__device__ __forceinline__ void p8_peer_route_mfma(Frame& F) {
    typedef short bf16x8 __attribute__((ext_vector_type(8)));
    typedef float f32x16 __attribute__((ext_vector_type(16)));
    const bf16* PQ = (const bf16*)(F.ws + WS_PQ); unsigned short* IDS = (unsigned short*)(F.ws + WS_IDS); float* GATES = (float*)(F.ws + WS_GATES);
    LAS bf16* KB = (LAS bf16*)(F.lds);
    for (int e = F.tid; e < 2 * 16384; e += NTHREADS) { const int hs = e >> 14, n = (e >> 7) & 127, d = e & 127;
        KB[hs * 128 * 136 + n * 136 + d] = (bf16)(pk2((hs ? F.a->in[I_SK2] : F.a->in[I_SK1])[n * 128 + d], 0.f) & 0xffffu); }
    __syncthreads();
    const int lane = F.lane, head = F.wave, r = lane & 31, h = lane >> 5;
    const float rt_pinf = INFINITY, rt_ninf = -INFINITY;
    for (int tile = blockIdx.x; tile < T / 32; tile += F.G) {
        const size_t tok = (size_t)tile * 32 + r;
        float v1[16], v2[16];
#pragma unroll
        for (int half = 0; half < 2; ++half) {
            bf16x8 qf[8];
#pragma unroll
            for (int ks = 0; ks < 8; ++ks) qf[ks] = *(const bf16x8*)(PQ + tok * 2048 + head * 256 + half * 128 + 16 * ks + 8 * h);
            float tv[16];
#pragma unroll
            for (int j = 0; j < 16; ++j) tv[j] = -INFINITY;
#pragma unroll 1
            for (int kt = 0; kt < 4; ++kt) {
                f32x16 st;
#pragma unroll
                for (int i = 0; i < 16; ++i) st[i] = 0.f;
#pragma unroll
                for (int ks = 0; ks < 8; ++ks) { const bf16x8 a = *(const LAS bf16x8*)(KB + half * 128 * 136 + (32 * kt + r) * 136 + 16 * ks + 8 * h);
                    st = __builtin_amdgcn_mfma_f32_32x32x16_bf16(a, qf[ks], st, 0, 0, 0); }
                float sk[16];
#pragma unroll
                for (int i = 0; i < 16; ++i) { const unsigned id = (unsigned)(32 * kt + (i & 3) + 8 * (i >> 2) + 4 * h);
                    sk[i] = __uint_as_float((__float_as_uint(st[i]) & 0xffffff80u) | (127u - id)); }
                RT_SORT16(sk);
                RT_MERGE16(tv, sk);
            }
            float pv[16];
#pragma unroll
            for (int j = 0; j < 16; ++j) pv[j] = __shfl_xor(tv[j], 32);
            RT_MERGE16(tv, pv);
#pragma unroll
            for (int j = 0; j < 16; ++j) { if (half) v2[j] = tv[j]; else v1[j] = tv[j]; }
        }
#define RT_CAND(a, c) __uint_as_float((__float_as_uint(v1[a] + v2[c]) & 0xffffff00u) | (unsigned)(255 - (16 * (a) + (c))))
        float tv[16];
#pragma unroll
        for (int c = 0; c < 16; ++c) tv[c] = RT_CAND(0, c);
        { float q8[8];
#pragma unroll
          for (int c = 0; c < 8; ++c) q8[c] = RT_CAND(1, c);
          RT_MERGE8(tv, q8);
#pragma unroll
          for (int a = 8; a < 16; ++a) q8[a - 8] = RT_CAND(a, 0);
          RT_MERGE8(tv, q8); }
#pragma unroll
        for (int a = 2; a < 8; ++a)
#pragma unroll
            for (int c = 0; c < 5; ++c)
                if ((a + 1) * (c + 1) <= 16) { const float key = RT_CAND(a, c); MED16_INSERT(tv, key); }
#undef RT_CAND
        float ev[16], sum = 0.f;
#pragma unroll
        for (int j = 0; j < 16; ++j) { ev[j] = __expf(tv[j] - tv[0]); sum += ev[j]; }
        const float inv = 1.0f / sum;
        unsigned t1[4], t2[4];
#pragma unroll
        for (int q = 0; q < 4; ++q) {
            t1[q] = (127u - (__float_as_uint(v1[4 * q]) & 0x7fu)) | ((127u - (__float_as_uint(v1[4 * q + 1]) & 0x7fu)) << 8) | ((127u - (__float_as_uint(v1[4 * q + 2]) & 0x7fu)) << 16) | ((127u - (__float_as_uint(v1[4 * q + 3]) & 0x7fu)) << 24);
            t2[q] = (127u - (__float_as_uint(v2[4 * q]) & 0x7fu)) | ((127u - (__float_as_uint(v2[4 * q + 1]) & 0x7fu)) << 8) | ((127u - (__float_as_uint(v2[4 * q + 2]) & 0x7fu)) << 16) | ((127u - (__float_as_uint(v2[4 * q + 3]) & 0x7fu)) << 24);
        }
        unsigned ids[16];
#pragma unroll
        for (int j = 0; j < 16; ++j) { const unsigned idx = 255u - (__float_as_uint(tv[j]) & 0xffu), a = idx >> 4, c = idx & 15u;
            const unsigned alo = (a & 8u) ? t1[2] : t1[0], ahi = (a & 8u) ? t1[3] : t1[1], clo = (c & 8u) ? t2[2] : t2[0], chi = (c & 8u) ? t2[3] : t2[1];
            const unsigned ia = __builtin_amdgcn_perm(ahi, alo, 0x0c0c0c00u | (a & 7u)), ic = __builtin_amdgcn_perm(chi, clo, 0x0c0c0c00u | (c & 7u));
            ids[j] = ia * 128u + ic; }
        if (h == 0) {
#pragma unroll
            for (int j8 = 0; j8 < 2; ++j8) {
                v4u w; w.x = ids[j8 * 8] | (ids[j8 * 8 + 1] << 16); w.y = ids[j8 * 8 + 2] | (ids[j8 * 8 + 3] << 16);
                w.z = ids[j8 * 8 + 4] | (ids[j8 * 8 + 5] << 16); w.w = ids[j8 * 8 + 6] | (ids[j8 * 8 + 7] << 16);
                *(v4u*)(IDS + tok * 128 + head * 16 + j8 * 8) = w;
            }
#pragma unroll
            for (int j4 = 0; j4 < 4; ++j4)
                *(f32x4*)(GATES + tok * 128 + head * 16 + j4 * 4) = (f32x4){ev[j4 * 4] * inv, ev[j4 * 4 + 1] * inv, ev[j4 * 4 + 2] * inv, ev[j4 * 4 + 3] * inv};
        }
    }
}

constexpr int Q_CHUNK = 32;
__device__ __forceinline__ void u_step(const v4u (&qc)[16], v4u (&qn)[16], const v4u xq, const v4u na, const v4u nb, const bool donext, const unsigned char* tab, bf16* hp, int sub) {
    const unsigned nw[8] = {na.x, na.y, na.z, na.w, nb.x, nb.y, nb.z, nb.w};
    int hs0 = 0, hs1 = 0;
    if (donext) {
#pragma unroll
        for (int i = 0; i < 16; ++i) { const unsigned e = (nw[i >> 1] >> (16 * (i & 1))) & 0xffffu; qn[i] = *(const v4u*)(tab + (size_t)e * 128); }
    }
    __builtin_amdgcn_sched_barrier(0);
#pragma unroll
    for (int i = 0; i < 16; ++i) {
        int p = __builtin_amdgcn_sdot4((int)qc[i].x, (int)xq.x, 0, false);
        p = __builtin_amdgcn_sdot4((int)qc[i].y, (int)xq.y, p, false);
        p = __builtin_amdgcn_sdot4((int)qc[i].z, (int)xq.z, p, false);
        p = __builtin_amdgcn_sdot4((int)qc[i].w, (int)xq.w, p, false);
        p += __builtin_amdgcn_mov_dpp(p, 0xB1, 0xf, 0xf, true); p += __builtin_amdgcn_mov_dpp(p, 0x4E, 0xf, 0xf, true); p += __builtin_amdgcn_mov_dpp(p, 0x141, 0xf, 0xf, true);
        if (i & 1) hs1 = (sub == (i >> 1)) ? p : hs1; else hs0 = (sub == (i >> 1)) ? p : hs0;
        __builtin_amdgcn_sched_barrier(0);
    }
    *(unsigned*)hp = pk2((float)hs0, (float)hs1);
}
__device__ __forceinline__ void p9_u_phase(Frame& F) {
    const unsigned char* UT8 = F.ws + WS_UT8; const unsigned char* X8 = F.ws + WS_X8; const unsigned short* IDS = (const unsigned short*)(F.ws + WS_IDS);
    bf16* HP = (bf16*)(F.ws + WS_HP); unsigned* qh = (unsigned*)(F.ws + WS_CTL) + CW_QU;
    const int lane = F.lane, sub = lane & 7, g = lane >> 3;
    const unsigned xcc = xb_xcc_id() & 7u;
    LAS unsigned char* IDL = F.lds + F.wave * 16384;
    LAS unsigned char* XL = IDL + 8192;
    for (int s = 0; s < 8; ++s) {
        const int j = (int)((xcc + (unsigned)s) & 7u);
        const unsigned char* tab = UT8 + (size_t)j * 16384 * 128 + sub * 16;
        for (;;) {
            unsigned base = 0u; if (lane == 0) base = xb_add(qh + 64 * j, (unsigned)Q_CHUNK);
            base = (unsigned)__builtin_amdgcn_readfirstlane((int)base);
            if (base >= (unsigned)T) break;
            bf16* hpb = HP + ((size_t)j * T + base) * 128 + g * 16 + 2 * sub;
            {
                const unsigned char* ig = (const unsigned char*)(IDS + (size_t)base * 128) + lane * 16;
                v4u t8[8], t4[4];
#pragma unroll
                for (int i = 0; i < 8; ++i) t8[i] = *(const v4u*)(ig + i * 1024);
#pragma unroll
                for (int i = 0; i < 4; ++i) { const int c = i * 64 + lane; t4[i] = *(const v4u*)(X8 + (size_t)(base + (c >> 3)) * 1024 + j * 128 + (c & 7) * 16); }
#pragma unroll
                for (int i = 0; i < 8; ++i) *(LAS v4u*)(IDL + i * 1024 + lane * 16) = t8[i];
#pragma unroll
                for (int i = 0; i < 4; ++i) *(LAS v4u*)(XL + i * 1024 + lane * 16) = t4[i];
            }
            LAS unsigned char* il = IDL + g * 32; LAS unsigned char* xl = XL + sub * 16;
            v4u q0[16], q1[16], q2[16];
            { const v4u ia = *(const LAS v4u*)il, ib = *(const LAS v4u*)(il + 16), ja = *(const LAS v4u*)(il + 256), jb = *(const LAS v4u*)(il + 256 + 16);
              const unsigned w0[8] = {ia.x, ia.y, ia.z, ia.w, ib.x, ib.y, ib.z, ib.w}, w1[8] = {ja.x, ja.y, ja.z, ja.w, jb.x, jb.y, jb.z, jb.w};
#pragma unroll
              for (int i = 0; i < 16; ++i) { const unsigned e = (w0[i >> 1] >> (16 * (i & 1))) & 0xffffu; q0[i] = *(const v4u*)(tab + (size_t)e * 128); }
#pragma unroll
              for (int i = 0; i < 16; ++i) { const unsigned e = (w1[i >> 1] >> (16 * (i & 1))) & 0xffffu; q1[i] = *(const v4u*)(tab + (size_t)e * 128); } }
#define U_IDS(t_) const int ti_ = (t_) < Q_CHUNK ? (t_) : Q_CHUNK - 1; const v4u na_ = *(const LAS v4u*)(il + ti_ * 256), nb_ = *(const LAS v4u*)(il + ti_ * 256 + 16)
#pragma unroll 1
            for (int tt = 0; tt + 2 < Q_CHUNK - 1; tt += 3) {
                { U_IDS(tt + 2); const v4u xq = *(const LAS v4u*)(xl + tt * 128);       u_step(q0, q2, xq, na_, nb_, true, tab, hpb + (size_t)tt * 128, sub); }
                { U_IDS(tt + 3); const v4u xq = *(const LAS v4u*)(xl + (tt + 1) * 128); u_step(q1, q0, xq, na_, nb_, true, tab, hpb + (size_t)(tt + 1) * 128, sub); }
                { U_IDS(tt + 4); const v4u xq = *(const LAS v4u*)(xl + (tt + 2) * 128); u_step(q2, q1, xq, na_, nb_, true, tab, hpb + (size_t)(tt + 2) * 128, sub); }
            }
            { U_IDS(0); const v4u xq = *(const LAS v4u*)(xl + (Q_CHUNK - 2) * 128); u_step(q0, q2, xq, na_, nb_, false, tab, hpb + (size_t)(Q_CHUNK - 2) * 128, sub); }
            { U_IDS(0); const v4u xq = *(const LAS v4u*)(xl + (Q_CHUNK - 1) * 128); u_step(q1, q2, xq, na_, nb_, false, tab, hpb + (size_t)(Q_CHUNK - 1) * 128, sub); }
#undef U_IDS
        }
    }
}
typedef float v2f __attribute__((ext_vector_type(2)));
__device__ __forceinline__ void p10_finalize(Frame& F) {
    const unsigned short* IDS = (const unsigned short*)(F.ws + WS_IDS); const float* W = (const float*)(F.ws + WS_GATES); const bf16* HP = (const bf16*)(F.ws + WS_HP);
    unsigned char* W8 = F.ws + WS_W8; float* WSC = (float*)(F.ws + WS_WSC);
    const v2f* UV = (const v2f*)(F.ws + WS_UINV); const float* XINV = (const float*)(F.ws + WS_XINV);
    const size_t gtid = (size_t)blockIdx.x * NTHREADS + F.tid, gthreads = (size_t)F.G * NTHREADS;
    constexpr size_t NGRP = (size_t)T * 128 / 8;
    for (size_t gi = gtid; gi < NGRP; gi += gthreads) {
        const size_t idx = gi * 8;
        const v4u idv = *(const v4u*)(IDS + idx);
        const f32x4 g0 = *(const f32x4*)(W + idx), g1 = *(const f32x4*)(W + idx + 4);
        v4u hp[8];
#pragma unroll
        for (int j = 0; j < 8; ++j) hp[j] = *(const v4u*)(HP + (size_t)j * T * 128 + idx);
        const float xi = XINV[idx >> 7];
        const unsigned iw[4] = {idv.x, idv.y, idv.z, idv.w};
        float ui[8], vi[8];
#pragma unroll
        for (int k = 0; k < 8; ++k) { const unsigned e = (iw[k >> 1] >> (16 * (k & 1))) & 0xffffu; const v2f uv = UV[e]; ui[k] = uv.x; vi[k] = uv.y; }
        const float gt[8] = {g0.x, g0.y, g0.z, g0.w, g1.x, g1.y, g1.z, g1.w};
        float o[8], am = 0.f;
#pragma unroll
        for (int k = 0; k < 8; ++k) { float h = 0.f;
#pragma unroll
            for (int j = 0; j < 8; ++j) { const unsigned wv = k < 2 ? hp[j].x : k < 4 ? hp[j].y : k < 6 ? hp[j].z : hp[j].w; h += (k & 1) ? bfhi(wv) : bflo(wv); }
            const float hh = h * ui[k] * xi;
            const float gl = 0.5f * hh * (1.0f + erff(hh * 0.7071067811865476f));
            o[k] = gt[k] * gl * vi[k]; am = fmaxf(am, fabsf(o[k])); }
        am = fmaxf(am, dppf<0xB1>(am)); am = fmaxf(am, dppf<0x4E>(am)); am = fmaxf(am, dppf<0x141>(am)); am = fmaxf(am, dppf<0x140>(am));
        const float qs = am > 0.f ? 127.0f / am : 0.f;
        int q[8];
#pragma unroll
        for (int k = 0; k < 8; ++k) q[k] = (int)rintf(o[k] * qs);
        v2u ov; ov.x = (unsigned)(q[0] & 0xff) | ((unsigned)(q[1] & 0xff) << 8) | ((unsigned)(q[2] & 0xff) << 16) | ((unsigned)(q[3] & 0xff) << 24);
        ov.y = (unsigned)(q[4] & 0xff) | ((unsigned)(q[5] & 0xff) << 8) | ((unsigned)(q[6] & 0xff) << 16) | ((unsigned)(q[7] & 0xff) << 24);
        *(v2u*)(W8 + idx) = ov;
        if ((gi & 15) == 0) WSC[idx >> 7] = am * (1.0f / 127.0f);
    }
}
__device__ __forceinline__ void v_step(const v4u (&qc)[16], v4u (&qn)[16], int (&acc)[16], const v4u w8, const v4u na, const v4u nb, const bool donext, const unsigned char* tab) {
    const unsigned nw[8] = {na.x, na.y, na.z, na.w, nb.x, nb.y, nb.z, nb.w};
    if (donext) {
#pragma unroll
        for (int i = 0; i < 16; ++i) { const unsigned e = (nw[i >> 1] >> (16 * (i & 1))) & 0xffffu; qn[i] = *(const v4u*)(tab + (size_t)e * 128); }
    }
    __builtin_amdgcn_sched_barrier(0);
    const unsigned wq[4] = {w8.x, w8.y, w8.z, w8.w};
#pragma unroll
    for (int kb = 0; kb < 4; ++kb) {
        const unsigned r0[4] = {qc[4 * kb].x, qc[4 * kb].y, qc[4 * kb].z, qc[4 * kb].w}, r1[4] = {qc[4 * kb + 1].x, qc[4 * kb + 1].y, qc[4 * kb + 1].z, qc[4 * kb + 1].w};
        const unsigned r2[4] = {qc[4 * kb + 2].x, qc[4 * kb + 2].y, qc[4 * kb + 2].z, qc[4 * kb + 2].w}, r3[4] = {qc[4 * kb + 3].x, qc[4 * kb + 3].y, qc[4 * kb + 3].z, qc[4 * kb + 3].w};
#pragma unroll
        for (int d = 0; d < 4; ++d) {
            const unsigned ab_lo = __builtin_amdgcn_perm(r1[d], r0[d], 0x05010400u), ab_hi = __builtin_amdgcn_perm(r1[d], r0[d], 0x07030602u);
            const unsigned ce_lo = __builtin_amdgcn_perm(r3[d], r2[d], 0x05010400u), ce_hi = __builtin_amdgcn_perm(r3[d], r2[d], 0x07030602u);
            const unsigned t0 = __builtin_amdgcn_perm(ce_lo, ab_lo, 0x05040100u), t1 = __builtin_amdgcn_perm(ce_lo, ab_lo, 0x07060302u);
            const unsigned t2 = __builtin_amdgcn_perm(ce_hi, ab_hi, 0x05040100u), t3 = __builtin_amdgcn_perm(ce_hi, ab_hi, 0x07060302u);
            acc[4 * d] = __builtin_amdgcn_sdot4((int)t0, (int)wq[kb], acc[4 * d], false);
            acc[4 * d + 1] = __builtin_amdgcn_sdot4((int)t1, (int)wq[kb], acc[4 * d + 1], false);
            acc[4 * d + 2] = __builtin_amdgcn_sdot4((int)t2, (int)wq[kb], acc[4 * d + 2], false);
            acc[4 * d + 3] = __builtin_amdgcn_sdot4((int)t3, (int)wq[kb], acc[4 * d + 3], false);
        }
        __builtin_amdgcn_sched_barrier(0);
    }
}
__device__ __forceinline__ void p11_v_phase(Frame& F) {
    const unsigned char* VT8 = F.ws + WS_VT8; const unsigned short* IDS = (const unsigned short*)(F.ws + WS_IDS); const unsigned char* W8 = F.ws + WS_W8; const float* WSC = (const float*)(F.ws + WS_WSC);
    bf16* FFN = (bf16*)(F.ws + WS_FFN); unsigned* qh = (unsigned*)(F.ws + WS_CTL) + CW_QV;
    const int lane = F.lane, sub = lane & 7, g = lane >> 3;
    const unsigned xcc = xb_xcc_id() & 7u;
    LAS unsigned char* IDL = F.lds + F.wave * 16384;
    LAS unsigned char* WL = IDL + 8192;
    for (int s = 0; s < 8; ++s) {
        const int j = (int)((xcc + (unsigned)s) & 7u);
        const unsigned char* tab = VT8 + (size_t)j * 16384 * 128 + sub * 16;
        for (;;) {
            unsigned base = 0u; if (lane == 0) base = xb_add(qh + 64 * j, (unsigned)Q_CHUNK);
            base = (unsigned)__builtin_amdgcn_readfirstlane((int)base);
            if (base >= (unsigned)T) break;
            bf16* fpb = FFN + ((size_t)base + g) * 1024 + j * 128 + sub * 16;
            const float* wsp = WSC + base + g;
            {
                const unsigned char* ig = (const unsigned char*)(IDS + (size_t)base * 128) + lane * 16;
                const unsigned char* wg = W8 + (size_t)base * 128 + lane * 16;
                v4u t8[8], u4[4];
#pragma unroll
                for (int i = 0; i < 8; ++i) t8[i] = *(const v4u*)(ig + i * 1024);
#pragma unroll
                for (int i = 0; i < 4; ++i) u4[i] = *(const v4u*)(wg + i * 1024);
#pragma unroll
                for (int i = 0; i < 8; ++i) *(LAS v4u*)(IDL + i * 1024 + lane * 16) = t8[i];
#pragma unroll
                for (int i = 0; i < 4; ++i) *(LAS v4u*)(WL + i * 1024 + lane * 16) = u4[i];
            }
            LAS unsigned char* il = IDL + g * 256; LAS unsigned char* wl = WL + g * 128;
            v4u q0[16], q1[16], q2[16];
            { const v4u ia = *(const LAS v4u*)il, ib = *(const LAS v4u*)(il + 16), ja = *(const LAS v4u*)(il + 32), jb = *(const LAS v4u*)(il + 32 + 16);
              const unsigned w0[8] = {ia.x, ia.y, ia.z, ia.w, ib.x, ib.y, ib.z, ib.w}, w1[8] = {ja.x, ja.y, ja.z, ja.w, jb.x, jb.y, jb.z, jb.w};
#pragma unroll
              for (int i = 0; i < 16; ++i) { const unsigned e = (w0[i >> 1] >> (16 * (i & 1))) & 0xffffu; q0[i] = *(const v4u*)(tab + (size_t)e * 128); }
#pragma unroll
              for (int i = 0; i < 16; ++i) { const unsigned e = (w1[i >> 1] >> (16 * (i & 1))) & 0xffffu; q1[i] = *(const v4u*)(tab + (size_t)e * 128); } }
            int acc[16];
#pragma unroll
            for (int c = 0; c < 16; ++c) acc[c] = 0;
#define V_IDS(t_) const int ti_ = (t_) < Q_CHUNK ? (t_) : Q_CHUNK - 1; const v4u na_ = *(const LAS v4u*)(il + (ti_ >> 3) * 2048 + (ti_ & 7) * 32), nb_ = *(const LAS v4u*)(il + (ti_ >> 3) * 2048 + (ti_ & 7) * 32 + 16)
#define V_W(t_) const v4u wa_ = *(const LAS v4u*)(wl + ((t_) >> 3) * 1024 + ((t_) & 7) * 16)
#define V_OUT(t_) do { if (((t_) & 7) == 7) { const int tg_ = (t_) >> 3; const float ws_ = wsp[8 * tg_]; \
                v4u o0_, o1_; o0_.x = pk2((float)acc[0] * ws_, (float)acc[1] * ws_); o0_.y = pk2((float)acc[2] * ws_, (float)acc[3] * ws_); o0_.z = pk2((float)acc[4] * ws_, (float)acc[5] * ws_); o0_.w = pk2((float)acc[6] * ws_, (float)acc[7] * ws_); \
                o1_.x = pk2((float)acc[8] * ws_, (float)acc[9] * ws_); o1_.y = pk2((float)acc[10] * ws_, (float)acc[11] * ws_); o1_.z = pk2((float)acc[12] * ws_, (float)acc[13] * ws_); o1_.w = pk2((float)acc[14] * ws_, (float)acc[15] * ws_); \
                bf16* fp_ = fpb + (size_t)(8 * tg_) * 1024; *(v4u*)fp_ = o0_; *(v4u*)(fp_ + 8) = o1_; \
                _Pragma("unroll") for (int c_ = 0; c_ < 16; ++c_) acc[c_] = 0; } } while (0)
#pragma unroll 1
            for (int tt = 0; tt + 2 < Q_CHUNK - 1; tt += 3) {
                { V_IDS(tt + 2); V_W(tt);     v_step(q0, q2, acc, wa_, na_, nb_, true, tab); V_OUT(tt); }
                { V_IDS(tt + 3); V_W(tt + 1); v_step(q1, q0, acc, wa_, na_, nb_, true, tab); V_OUT(tt + 1); }
                { V_IDS(tt + 4); V_W(tt + 2); v_step(q2, q1, acc, wa_, na_, nb_, true, tab); V_OUT(tt + 2); }
            }
            { V_IDS(0); V_W(Q_CHUNK - 2); v_step(q0, q2, acc, wa_, na_, nb_, false, tab); V_OUT(Q_CHUNK - 2); }
            { V_IDS(0); V_W(Q_CHUNK - 1); v_step(q1, q2, acc, wa_, na_, nb_, false, tab); V_OUT(Q_CHUNK - 1); }
#undef V_IDS
#undef V_W
#undef V_OUT
        }
    }
}
__device__ __forceinline__ void p12_ln2(Frame& F) {
    float* OUT = F.a->out; const bf16* FFN = (const bf16*)(F.ws + WS_FFN); const bf16* X1B = (const bf16*)(F.ws + WS_X1B);
    const float* g = F.a->in[I_LN2G]; const float* bb = F.a->in[I_LN2B];
    const int gw = blockIdx.x * NWAVES + F.wave, NGW = F.G * NWAVES, lane = F.lane;
    f32x4 gv[4], bv[4];
#pragma unroll
    for (int j = 0; j < 4; ++j) { gv[j] = ((const f32x4*)g)[lane + 64 * j]; bv[j] = ((const f32x4*)bb)[lane + 64 * j]; }
    v2u fn[4], xn[4];
    { const v2u* fr = (const v2u*)(FFN + (size_t)gw * DM) + lane; const v2u* xr = (const v2u*)(X1B + (size_t)gw * DM) + lane;
#pragma unroll
      for (int j = 0; j < 4; ++j) { fn[j] = fr[64 * j]; xn[j] = xr[64 * j]; } }
    for (int m = gw; m < T; m += NGW) {
        f32x4* yr = (f32x4*)(OUT + (size_t)m * DM) + lane;
        v2u fc[4], xc[4];
#pragma unroll
        for (int j = 0; j < 4; ++j) { fc[j] = fn[j]; xc[j] = xn[j]; }
        { const int mn = m + NGW < T ? m + NGW : m; const v2u* fr = (const v2u*)(FFN + (size_t)mn * DM) + lane; const v2u* xr = (const v2u*)(X1B + (size_t)mn * DM) + lane;
#pragma unroll
          for (int j = 0; j < 4; ++j) { fn[j] = fr[64 * j]; xn[j] = xr[64 * j]; } }
        f32x4 v[4]; float s = 0.f;
#pragma unroll
        for (int j = 0; j < 4; ++j) { const v2u f = fc[j], x = xc[j];
            v[j] = (f32x4){bflo(x.x), bfhi(x.x), bflo(x.y), bfhi(x.y)} * ALPHA + (f32x4){bflo(f.x), bfhi(f.x), bflo(f.y), bfhi(f.y)}; s += (v[j].x + v[j].y) + (v[j].z + v[j].w); }
        const float mean = wave_sum_dpp(s) * (1.f / DM); float s2 = 0.f;
#pragma unroll
        for (int j = 0; j < 4; ++j) { v[j] = v[j] - mean; s2 += (v[j].x * v[j].x + v[j].y * v[j].y) + (v[j].z * v[j].z + v[j].w * v[j].w); }
        const float rstd = rsqrtf(wave_sum_dpp(s2) * (1.f / DM) + LN_EPS);
#pragma unroll
        for (int j = 0; j < 4; ++j) yr[64 * j] = v[j] * rstd * gv[j] + bv[j];
    }
}

__global__ void __launch_bounds__(NTHREADS, 2) hybrid_fwd(Args args) {
    extern __shared__ __attribute__((aligned(16))) unsigned char lds[];
    Frame F;
    F.lds = (LAS unsigned char*)lds;
    F.tid = threadIdx.x; F.lane = F.tid & 63; F.wave = __builtin_amdgcn_readfirstlane(F.tid >> 6);
    F.G = gridDim.x; F.a = (KArgs)__builtin_amdgcn_kernarg_segment_ptr(); F.ws = args.ws;
#define FRESH() do { int _t = threadIdx.x; asm volatile("" : "+v"(_t)); F.tid = _t; F.lane = _t & 63; F.wave = __builtin_amdgcn_readfirstlane(_t >> 6); \
        KArgs _k = (KArgs)__builtin_amdgcn_kernarg_segment_ptr(); asm volatile("" : "+s"(_k)); F.a = _k; F.ws = _k->ws; } while (0)
    volatile LAS unsigned* MISC = (volatile LAS unsigned*)(F.lds + MISC_OFF);
    for (int u = F.tid; u < (LDS_BYTES - LDSCTL_OFF) / 4; u += NTHREADS) ((LAS unsigned*)(F.lds + LDSCTL_OFF))[u] = 0u;
    __syncthreads();
    const int lo = args.ph_lo, hi = args.ph_hi;
    const bool need_bar = (hi - lo) > 1;
    XcdBarrier bar; bar.bar = (unsigned*)(args.ws + WS_CTL) + CW_BAR + args.li * XCD_BAR_WORDS; bar.x = 0; bar.st = nullptr;
    if (need_bar) bar = xcd_barrier_post(bar.bar, MISC + 8);
#if defined(PHASE_MASK)
#define IN(k) (((PHASE_MASK >> (k)) & 1) && lo <= (k) && (k) < hi)
#elif defined(ONLY_PHASE)
#define IN(k) ((k) == ONLY_PHASE && lo <= (k) && (k) < hi)
#else
#define IN(k) (lo <= (k) && (k) < hi)
#endif
    unsigned long long pr_extra = 0ull;
#ifdef PROBE_LO
    unsigned long long pr_t0 = 0ull, pr_t1 = 0ull;
#define PSTAMP(k) do { if ((k) == PROBE_LO) pr_t0 = __builtin_amdgcn_s_memrealtime(); if ((k) == PROBE_HI + 1) pr_t1 = __builtin_amdgcn_s_memrealtime(); } while (0)
#else
#define PSTAMP(k) do {} while (0)
#endif
#ifdef PROBE_BARMASK
#define SEAM(k) do { if (IN(k) && IN((k) + 1)) { const unsigned long long _b0 = __builtin_amdgcn_s_memrealtime(); xcd_barrier(bar); if ((PROBE_BARMASK >> (k)) & 1) pr_extra += __builtin_amdgcn_s_memrealtime() - _b0; } } while (0)
#else
#define SEAM(k) do { if (IN(k) && IN((k) + 1)) xcd_barrier(bar); } while (0)
#endif
    LAS unsigned char* ring = F.lds;

    PSTAMP(0);
    if (IN(0)) { FRESH(); p0_prologue(F); }
    SEAM(0);
    PSTAMP(1);
    if (IN(1)) {
        FRESH();
        pg8::Gemm g{(const bf16*)(F.ws + WS_XB), (const bf16*)(F.ws + WS_WIN), T, NPROJ, 1024}; pg8::StaticOrder S; S.init(T, NPROJ, F.G, (int)blockIdx.x);
        EpiProj E{F.ws};
        pg8::gemm_phase<EpiProj, pg8::StaticOrder>(ring, g, S, E, F.tid);
    }
    SEAM(1);
    PSTAMP(2);
    if (IN(2)) {
        FRESH();
#if !defined(P2SEL) || (P2SEL & 1)
        p2_ckv_norm(F);
#endif
        PSTAMP(21);
#if !defined(P2SEL) || (P2SEL & 2)
#if defined(HGRN_DEBUG)
        p2_hgrn_chunked(F, (bf16*)(F.ws + WS_END), 16, 512);
        __syncthreads();
        FRESH();
        p2_hgrn_simple(F);
        VM_WAIT(); __syncthreads();
        FRESH();
        {
            unsigned* ctl = (unsigned*)(F.ws + WS_CTL);
            const bf16* A_ = (const bf16*)(F.ws + WS_END); const bf16* B_ = (const bf16*)(F.ws + WS_IB);
            float mx = 0.f; unsigned nn = 0;
            for (int item = blockIdx.x; item < NB * 4; item += F.G) { const int b = item >> 2, h = item & 3; if (b >= 16) continue;
                for (int e = F.tid; e < SEQ * 128; e += NTHREADS) { const size_t o = ((size_t)b * SEQ + (e >> 7)) * 512 + h * 128 + (e & 127);
                    const float x = bf2f(A_[o]), y = bf2f(B_[o]); if (x != x) ++nn; const float df = fabsf(x - y); if (df == df) mx = fmaxf(mx, df); } }
            mx = wave_max(mx); nn = (unsigned)wave_sum((float)nn);
            if (F.lane == 0) { atomicMax(ctl + 2048, __float_as_uint(mx)); atomicAdd(ctl + 2112, nn); }
        }
#elif defined(HGRN_SIMPLE)
        p2_hgrn_simple(F);
#else
        p2_hgrn_chunked(F, (bf16*)(F.ws + WS_HO), NB, 1024);
#endif
#endif
        __syncthreads();
        PSTAMP(22);
        FRESH();
#if !defined(P2SEL) || (P2SEL & 4)
#ifdef INDEXER_OLD
        p2_indexer_simple(F);
#else
        p2_indexer_blk(F, pr_extra);
#endif
#endif
    }
    SEAM(2);
    PSTAMP(3);
    if (IN(3)) { FRESH(); p3_hg_finalize(F); __syncthreads(); FRESH();
#ifdef ATTN_SIMPLE
        p3_attn_simple(F);
#else
        p3_attn_mfma(F);
#endif
    }
    SEAM(3);
    PSTAMP(4);
    if (IN(4)) {
        FRESH();
        { pg8::Gemm g{(const bf16*)(F.ws + WS_QL), (const bf16*)(F.ws + WS_WA), T, 1024, 1024}, g2{(const bf16*)(F.ws + WS_HO), (const bf16*)(F.ws + WS_WB), T, 1024, 512};
          pg8::StaticOrder S; S.init(T, 1024, F.G, (int)blockIdx.x);
          EpiMerge E{(const unsigned char*)(F.ws + WS_GA), (const unsigned char*)(F.ws + WS_GBT), (bf16*)(F.ws + WS_MERGED)};
          pg8::gemm_phase2<EpiMerge, pg8::StaticOrder>(ring, g, g2, S, E, F.tid); }
    }
    SEAM(4);
    PSTAMP(5);
    if (IN(5)) {
        FRESH();
        pg8::Gemm g{(const bf16*)(F.ws + WS_MERGED), (const bf16*)(F.ws + WS_WO), T, 1024, 1024}; pg8::StaticOrder S; S.init(T, 1024, F.G, (int)blockIdx.x);
        EpiResBf16 E{(const bf16*)(F.ws + WS_XB), (bf16*)(F.ws + WS_X1B)};
        pg8::gemm_phase<EpiResBf16, pg8::StaticOrder>(ring, g, S, E, F.tid);
    }
    SEAM(5);
    PSTAMP(6);
    if (IN(6)) { FRESH(); p6_ln1(F); }
    SEAM(6);
    PSTAMP(7);
    if (IN(7)) {
        FRESH();
        pg8::Gemm g{(const bf16*)(F.ws + WS_X1B), (const bf16*)(F.ws + WS_WPQ), T, 2048, 1024}; pg8::StaticOrder S; S.init(T, 2048, F.G, (int)blockIdx.x);
        EpiPlainBf16 E{(bf16*)(F.ws + WS_PQ), 2048};
        pg8::gemm_phase<EpiPlainBf16, pg8::StaticOrder>(ring, g, S, E, F.tid);
    }
    SEAM(7);
    PSTAMP(8);
    if (IN(8)) { FRESH();
#ifdef ROUTE_SIMPLE
        p8_peer_route_simple(F);
#else
        p8_peer_route_mfma(F);
#endif
    }
    SEAM(8);
    PSTAMP(9);
    if (IN(9)) { FRESH(); p9_u_phase(F); }
    SEAM(9);
    PSTAMP(10);
    if (IN(10)) { FRESH(); p10_finalize(F); }
    SEAM(10);
    PSTAMP(11);
    if (IN(11)) { FRESH(); p11_v_phase(F); }
    SEAM(11);
    PSTAMP(12);
    if (IN(12)) { FRESH(); p12_ln2(F); }
    PSTAMP(13);
#if defined(PROBE_SEL) || defined(PROBE_BARMASK)
    if (blockIdx.x == 0 && F.tid == 0) { const unsigned long long t2 = __builtin_amdgcn_s_memrealtime(); while (__builtin_amdgcn_s_memrealtime() - t2 < pr_extra) __builtin_amdgcn_s_sleep(8); }
#endif
#ifdef PROBE_LO
    if (blockIdx.x == 0 && F.tid == 0) { const unsigned long long dt = pr_t1 - pr_t0, t2 = __builtin_amdgcn_s_memrealtime(); while (__builtin_amdgcn_s_memrealtime() - t2 < dt) __builtin_amdgcn_s_sleep(8); }
#endif
#undef IN
#undef SEAM
}

extern "C" void kernel_launch(void* const* d_in, const int* in_sizes, int n_in, void* d_out, int out_size, void* d_ws, size_t ws_size, hipStream_t stream) {
    static int grid = 0;
    if (grid == 0) {
        if (n_in != 20 || out_size != T * DM || ws_size < WS_END) { fprintf(stderr, "kernel_launch: unexpected problem (n_in %d out %d ws %zu)\n", n_in, out_size, ws_size); grid = -1; return; }
        int dev = 0, cus = 0;
        if (hipGetDevice(&dev) != hipSuccess || hipDeviceGetAttribute(&cus, hipDeviceAttributeMultiprocessorCount, dev) != hipSuccess) { grid = -1; return; }
        if (hipFuncSetAttribute((const void*)hybrid_fwd, hipFuncAttributeMaxDynamicSharedMemorySize, LDS_BYTES) != hipSuccess) { fprintf(stderr, "kernel_launch: hipFuncSetAttribute failed\n"); grid = -1; return; }
        int per_cu = 0;
        if (hipOccupancyMaxActiveBlocksPerMultiprocessor(&per_cu, (const void*)hybrid_fwd, NTHREADS, LDS_BYTES) != hipSuccess || per_cu < 1) fprintf(stderr, "kernel_launch: occupancy query reports %d\n", per_cu);
        (void)hipGetLastError();
        grid = cus;
    }
    if (grid < 0) return;
    (void)hipMemsetAsync((char*)d_ws + WS_CTL, 0, CTL_ZERO_BYTES, stream);
    Args a{};
    for (int i = 0; i < 20; ++i) a.in[i] = (const float*)d_in[i];
    a.out = (float*)d_out; a.ws = (unsigned char*)d_ws;
    constexpr int NL = MK_N_LAUNCHES;
    for (int li = 0; li < NL; ++li) {
        a.ph_lo = (NL == 1) ? 0 : li; a.ph_hi = (NL == 1) ? N_PHASES : li + 1; a.li = li;
        hipLaunchKernelGGL(hybrid_fwd, dim3(grid), dim3(NTHREADS), LDS_BYTES, stream, a);
    }
}
```
